# Optimizing an MI355X kernel written in HIP

```python
import jax, jax.numpy as jnp
from jax import lax
import numpy as np

D_MODEL = 1024
BATCH = 32
SEQ = 2048
DEPTH = 2

CTX_LEN = 256
GRID_W = 64

RWKV_HEADS = 4
RWKV_HEAD = 64
RWKV_DIM = RWKV_HEADS * RWKV_HEAD
DECAY_LORA = 64
AAA_LORA = 64
MV_LORA = 32
GATE_LORA = 128
LNX_EPS = 64e-5
ATT_HEADS = 8
ATT_KV_HEADS = 2
ATT_GROUP = ATT_HEADS // ATT_KV_HEADS
ATT_HEAD = 64
ATT_Q_DIM = ATT_HEADS * ATT_HEAD
ATT_KV_DIM = ATT_KV_HEADS * ATT_HEAD
ATT_SCALE = ATT_HEAD ** -0.5
WINDOW = 128
BLOCK = 128
ROPE_BASE = 10000.0
ROPE_FREQS = ATT_HEAD // 4
NEG_INF = -1e30
FOURIER_GROUPS = 4
FOURIER_GROUP_DIM = 64
FOURIER_DIM = FOURIER_GROUPS * FOURIER_GROUP_DIM
N_BRANCH = 3
D_FF = 2816
EPS = 1e-6

RWKV_COL_SIZES = (RWKV_DIM, RWKV_DIM, RWKV_DIM, DECAY_LORA, DECAY_LORA, AAA_LORA, AAA_LORA, GATE_LORA)
RWKV_COLS = sum(RWKV_COL_SIZES)
IN_SIZES = (RWKV_COLS, ATT_Q_DIM, ATT_KV_DIM, ATT_KV_DIM, FOURIER_DIM, N_BRANCH * D_MODEL)
IN_COLS = sum(IN_SIZES)

kernel_name = "hybrid_rwkv7_swa_fourier_diffusion_block"


def _split(t, sizes):
    return jnp.split(t, [int(i) for i in np.cumsum(sizes)[:-1]], axis=-1)


def rms_norm(x, g):
    xf = x.astype(jnp.float32)
    y = xf * lax.rsqrt(jnp.mean(xf * xf, axis=-1, keepdims=True) + EPS)
    return (y * g.astype(jnp.float32)).astype(x.dtype)


def modulate(x, shift, scale):
    return x * (1 + scale) + shift


def _prev(x):
    return jnp.pad(x[:, :-1], ((0, 0), (1, 0), (0, 0)))


def _next(x):
    return jnp.pad(x[:, 1:], ((0, 0), (0, 1), (0, 0)))


def _heads(t):
    return t.astype(jnp.float32).reshape(t.shape[0], t.shape[1], RWKV_HEADS, RWKV_HEAD)


def rwkv_inputs(u, mu, w0, w2, a0, a2, g2, k_k, k_a, v_first, vres):
    u = u + mu[0] * (_prev(u) - u) + mu[1] * (_next(u) - u)
    r, k, v, xw_f, xw_b, xa_f, xa_b, xg = _split(u, RWKV_COL_SIZES)
    if vres is None:
        v_first = v
    else:
        v0, v1, v2 = vres
        v = v + (v_first - v) * jax.nn.sigmoid(v0 + (v @ v1) @ v2)
    kk = _heads(k * k_k)
    kk = kk * lax.rsqrt(jnp.maximum(jnp.sum(kk * kk, axis=-1, keepdims=True), 1e-24))
    decays, keys, removals = [], [], []
    for d, (xw, xa) in enumerate(((xw_f, xa_f), (xw_b, xa_b))):
        w_log = -jax.nn.softplus(-(w0[d] + jnp.tanh(xw) @ w2[d]).astype(jnp.float32)) - 0.5
        decays.append(_heads(jnp.exp(-jnp.exp(w_log))))
        a = jax.nn.sigmoid(a0[d] + xa @ a2[d])
        keys.append(_heads(k * (1 + (a - 1) * k_a)))
        removals.append(kk * _heads(a))
    g = jax.nn.sigmoid(xg) @ g2
    feat = (_heads(r), _heads(v), kk, tuple(decays), tuple(keys), tuple(removals), g)
    return feat, v_first


def wkv_scan(state0, feat, d, reverse):
    r, v, kk, decays, keys, removals, _ = feat

    def step(S, inp):
        r_t, w_t, k_t, v_t, kk_t, b_t = inp
        sa = jnp.einsum("bhvk,bhk->bhv", S, -kk_t)
        S = S * w_t[:, :, None, :] + sa[..., :, None] * b_t[..., None, :] + v_t[..., :, None] * k_t[..., None, :]
        return S, jnp.einsum("bhvk,bhk->bhv", S, r_t)

    xs = tuple(jnp.swapaxes(t, 0, 1) for t in (r, decays[d], keys[d], v, kk, removals[d]))
    S_last, y = lax.scan(step, state0, xs, reverse=reverse)
    return jnp.swapaxes(y, 0, 1), S_last


def rwkv_readout(y, feat, r_k, lnx_w, lnx_b):
    r, v, kk, decays, keys, removals, g = feat
    B, T = y.shape[:2]
    mean = jnp.mean(y, axis=-1, keepdims=True)
    var = jnp.mean(jnp.square(y - mean), axis=-1, keepdims=True)
    yn = ((y - mean) * lax.rsqrt(var + LNX_EPS)).reshape(B, T, RWKV_DIM) * lnx_w + lnx_b
    k_bar = 0.5 * (keys[0] + keys[1])
    bonus = jnp.sum(r * k_bar * r_k.reshape(RWKV_HEADS, RWKV_HEAD), axis=-1, keepdims=True) * v
    return (yn + bonus.reshape(B, T, RWKV_DIM)) * g


def rwkv_branch(u_ctx, u_lat, vf_ctx, vf_lat, vres, need_ctx, mu, w0, w2, a0, a2, g2, k_k, k_a, r_k, lnx_w, lnx_b):
    fc, vf_ctx = rwkv_inputs(u_ctx, mu, w0, w2, a0, a2, g2, k_k, k_a, vf_ctx, vres)
    fl, vf_lat = rwkv_inputs(u_lat, mu, w0, w2, a0, a2, g2, k_k, k_a, vf_lat, vres)
    S0 = jnp.zeros((u_lat.shape[0], RWKV_HEADS, RWKV_HEAD, RWKV_HEAD), jnp.float32)
    yc_f, Sc_f = wkv_scan(S0, fc, 0, reverse=False)
    yc_b, Sc_b = wkv_scan(S0, fc, 1, reverse=True)
    yl_f, _ = wkv_scan(Sc_f, fl, 0, reverse=False)
    yl_b, _ = wkv_scan(Sc_b, fl, 1, reverse=True)
    out_lat = rwkv_readout(yl_f + yl_b, fl, r_k, lnx_w, lnx_b)
    out_ctx = rwkv_readout(yc_f + yc_b, fc, r_k, lnx_w, lnx_b) if need_ctx else None
    return out_ctx, out_lat, vf_ctx, vf_lat


def axial_rope_tables(rows):
    row_id = jnp.repeat(jnp.arange(rows), GRID_W).astype(jnp.float32)
    col_id = jnp.tile(jnp.arange(GRID_W), rows).astype(jnp.float32)
    inv = ROPE_BASE ** (-jnp.arange(ROPE_FREQS, dtype=jnp.float32) / ROPE_FREQS)
    ang = jnp.stack([row_id[:, None] * inv, col_id[:, None] * inv], axis=1)
    return jnp.cos(ang), jnp.sin(ang)


def apply_axial_rope(x, cos, sin):
    B, T, H, _ = x.shape
    xr = x.astype(jnp.float32).reshape(B, T, H, 2, 2, ROPE_FREQS)
    x1, x2 = xr[..., 0, :], xr[..., 1, :]
    c, s = cos[:, None], sin[:, None]
    out = jnp.stack([x1 * c - x2 * s, x2 * c + x1 * s], axis=-2)
    return out.reshape(x.shape).astype(x.dtype)


def _sink_col(sink, shape):
    return jnp.broadcast_to(sink.astype(jnp.float32).reshape(1, ATT_KV_HEADS, ATT_GROUP, 1, 1), shape)


def context_attention(q, k, v, sink):
    s = jnp.einsum("bqhgd,bkhd->bhgqk", q, k).astype(jnp.float32) * ATT_SCALE
    logits = jnp.concatenate([s, _sink_col(sink, s.shape[:-1] + (1,))], axis=-1)
    p = jax.nn.softmax(logits, axis=-1)[..., :-1].astype(v.dtype)
    o = jnp.einsum("bhgqk,bkhd->bqhgd", p, v)
    return o.reshape(o.shape[0], o.shape[1], ATT_Q_DIM)


def windowed_attention(q, k, v, k_ctx, v_ctx, sink):
    B, T = q.shape[:2]
    n_ctx = k_ctx.shape[1]
    kp = jnp.pad(k, ((0, 0), (BLOCK, BLOCK), (0, 0), (0, 0)))
    vp = jnp.pad(v, ((0, 0), (BLOCK, BLOCK), (0, 0), (0, 0)))

    def block(i):
        start = i * BLOCK
        q_b = lax.dynamic_slice_in_dim(q, start, BLOCK, axis=1)
        k_b = lax.dynamic_slice_in_dim(kp, start, 3 * BLOCK, axis=1)
        v_b = lax.dynamic_slice_in_dim(vp, start, 3 * BLOCK, axis=1)
        q_pos = start + jnp.arange(BLOCK)
        k_pos = start - BLOCK + jnp.arange(3 * BLOCK)
        valid = (jnp.abs(q_pos[:, None] - k_pos[None, :]) <= WINDOW) & (k_pos[None, :] >= 0) & (k_pos[None, :] < T)
        s_w = jnp.einsum("bqhgd,bkhd->bhgqk", q_b, k_b).astype(jnp.float32) * ATT_SCALE
        s_w = jnp.where(valid, s_w, NEG_INF)
        s_c = jnp.einsum("bqhgd,bkhd->bhgqk", q_b, k_ctx).astype(jnp.float32) * ATT_SCALE
        logits = jnp.concatenate([s_c, s_w, _sink_col(sink, s_c.shape[:-1] + (1,))], axis=-1)
        p = jax.nn.softmax(logits, axis=-1).astype(v.dtype)
        p_c, p_w = p[..., :n_ctx], p[..., n_ctx:n_ctx + 3 * BLOCK]
        return jnp.einsum("bhgqk,bkhd->bqhgd", p_c, v_ctx) + jnp.einsum("bhgqk,bkhd->bqhgd", p_w, v_b)

    o = lax.map(block, jnp.arange(T // BLOCK))
    return jnp.moveaxis(o, 0, 1).reshape(B, T, ATT_Q_DIM)


def fourier_mix(u):
    B, T, _ = u.shape
    z = u.astype(jnp.float32).reshape(B, T, FOURIER_GROUPS, FOURIER_GROUP_DIM)
    return jnp.fft.fftn(z, axes=(1, 3), norm="ortho").real.reshape(B, T, FOURIER_DIM).astype(u.dtype)


def merge_branches(y_r, y_a, y_f, gate_logits, wb_r, wb_a, wb_f, w_o):
    g_r, g_a, g_f = jnp.split(jax.nn.sigmoid(gate_logits), N_BRANCH, axis=-1)
    return (g_r * (y_r @ wb_r) + g_a * (y_a @ wb_a) + g_f * (y_f @ wb_f)) @ w_o


def conv_ffn(f, up, conv_w, conv_b, down):
    z_gate, z_val = jnp.split(f @ up, 2, axis=-1)
    z_gate = conv_w[0] * _prev(z_gate) + conv_w[1] * z_gate + conv_w[2] * _next(z_gate) + conv_b
    return (jax.nn.gelu(z_gate, approximate=True) * z_val) @ down


def setup_inputs(seed: int = 0) -> dict:
    key = jax.random.key(seed)
    ks = iter(jax.random.split(key, 48))
    D, L = D_MODEL, DEPTH

    def nrm(shape, scale):
        return scale * jax.random.normal(next(ks), shape, jnp.float32)

    def unif(shape, lo, hi):
        return jax.random.uniform(next(ks), shape, jnp.float32, lo, hi)

    return {
        "x": nrm((BATCH, SEQ, D), 1.0),
        "c": nrm((BATCH, D), 1.0),
        "ctx": nrm((BATCH, CTX_LEN, D), 1.0),
        "c_ctx": nrm((D,), 1.0),
        "mod_w": nrm((L, D, 6 * D), 0.5 * D ** -0.5),
        "mod_b": nrm((L, 6 * D), 0.02),
        "norm_mix_pre": 1.0 + nrm((L, D), 0.02),
        "norm_mix_post": 1.0 + nrm((L, D), 0.02),
        "norm_ffn_pre": 1.0 + nrm((L, D), 0.02),
        "norm_ffn_post": 1.0 + nrm((L, D), 0.02),
        "w_in": nrm((L, D, IN_COLS), D ** -0.5),
        "rwkv_mu": unif((L, 2, RWKV_COLS), 0.0, 0.5),
        "rwkv_w0": unif((L, 2, RWKV_DIM), -5.0, 0.0),
        "rwkv_w2": nrm((L, 2, DECAY_LORA, RWKV_DIM), 0.1 * DECAY_LORA ** -0.5),
        "rwkv_a0": nrm((L, 2, RWKV_DIM), 0.1),
        "rwkv_a2": nrm((L, 2, AAA_LORA, RWKV_DIM), 0.5 * AAA_LORA ** -0.5),
        "rwkv_g2": nrm((L, GATE_LORA, RWKV_DIM), GATE_LORA ** -0.5),
        "rwkv_k_k": 0.85 + nrm((L, RWKV_DIM), 0.02),
        "rwkv_k_a": 1.0 + nrm((L, RWKV_DIM), 0.02),
        "rwkv_r_k": nrm((L, RWKV_DIM), 0.1),
        "rwkv_lnx_w": 1.0 + nrm((L, RWKV_DIM), 0.02),
        "rwkv_lnx_b": nrm((L, RWKV_DIM), 0.02),
        "rwkv_v0": nrm((L - 1, RWKV_DIM), 0.1),
        "rwkv_v1": nrm((L - 1, RWKV_DIM, MV_LORA), RWKV_DIM ** -0.5),
        "rwkv_v2": nrm((L - 1, MV_LORA, RWKV_DIM), 0.5 * MV_LORA ** -0.5),
        "attn_sink": nrm((L, ATT_HEADS), 0.5),
        "w_branch_rwkv": nrm((L, RWKV_DIM, D), RWKV_DIM ** -0.5),
        "w_branch_attn": nrm((L, ATT_Q_DIM, D), ATT_Q_DIM ** -0.5),
        "w_branch_fourier": nrm((L, FOURIER_DIM, D), FOURIER_DIM ** -0.5),
        "w_out": nrm((L, D, D), D ** -0.5),
        "ffn_up": nrm((L, D, 2 * D_FF), D ** -0.5),
        "ffn_conv_w": nrm((L, 3, D_FF), 0.5),
        "ffn_conv_b": nrm((L, D_FF), 0.02),
        "ffn_down": nrm((L, D_FF, D), D_FF ** -0.5),
    }


def reference(x, c, ctx, c_ctx, mod_w, mod_b, norm_mix_pre, norm_mix_post, norm_ffn_pre, norm_ffn_post,
              w_in, rwkv_mu, rwkv_w0, rwkv_w2, rwkv_a0, rwkv_a2, rwkv_g2, rwkv_k_k, rwkv_k_a, rwkv_r_k,
              rwkv_lnx_w, rwkv_lnx_b, rwkv_v0, rwkv_v1, rwkv_v2, attn_sink, w_branch_rwkv, w_branch_attn,
              w_branch_fourier, w_out, ffn_up, ffn_conv_w, ffn_conv_b, ffn_down):
    B, T, _ = x.shape
    n_ctx = ctx.shape[1]
    rows = T // GRID_W
    cos, sin = axial_rope_tables(rows)
    s_lat = jax.nn.silu(c)[:, None, :]
    s_ctx = jax.nn.silu(c_ctx)[None, None, :]
    h, hc = x, ctx
    vf_lat = vf_ctx = None
    for l in range(DEPTH):
        need_ctx = l < DEPTH - 1
        m = jnp.split(s_lat @ mod_w[l] + mod_b[l], 6, axis=-1)
        mc = jnp.split(s_ctx @ mod_w[l] + mod_b[l], 6, axis=-1)
        a = modulate(rms_norm(h, norm_mix_pre[l]), m[0], m[1])
        ac = modulate(rms_norm(hc, norm_mix_pre[l]), mc[0], mc[1])
        u_r, u_q, u_k, u_v, u_f, u_g = _split(a @ w_in[l], IN_SIZES)
        c_r, c_q, c_k, c_v, c_f, c_g = _split(ac @ w_in[l], IN_SIZES)
        vres = None if l == 0 else (rwkv_v0[l - 1], rwkv_v1[l - 1], rwkv_v2[l - 1])
        yr_c, yr, vf_ctx, vf_lat = rwkv_branch(
            c_r, u_r, vf_ctx, vf_lat, vres, need_ctx, rwkv_mu[l], rwkv_w0[l], rwkv_w2[l], rwkv_a0[l],
            rwkv_a2[l], rwkv_g2[l], rwkv_k_k[l], rwkv_k_a[l], rwkv_r_k[l], rwkv_lnx_w[l], rwkv_lnx_b[l])
        q = apply_axial_rope(u_q.reshape(B, T, ATT_HEADS, ATT_HEAD), cos, sin)
        q = q.reshape(B, T, ATT_KV_HEADS, ATT_GROUP, ATT_HEAD)
        k = apply_axial_rope(u_k.reshape(B, T, ATT_KV_HEADS, ATT_HEAD), cos, sin)
        v = u_v.reshape(B, T, ATT_KV_HEADS, ATT_HEAD)
        k_c = c_k.reshape(B, n_ctx, ATT_KV_HEADS, ATT_HEAD)
        v_c = c_v.reshape(B, n_ctx, ATT_KV_HEADS, ATT_HEAD)
        ya = windowed_attention(q, k, v, k_c, v_c, attn_sink[l])
        mix = merge_branches(yr, ya, fourier_mix(u_f), u_g, w_branch_rwkv[l], w_branch_attn[l],
                             w_branch_fourier[l], w_out[l])
        h = h + m[2] * rms_norm(mix, norm_mix_post[l])
        if need_ctx:
            ya_c = context_attention(c_q.reshape(B, n_ctx, ATT_KV_HEADS, ATT_GROUP, ATT_HEAD), k_c, v_c, attn_sink[l])
            mix_c = merge_branches(yr_c, ya_c, fourier_mix(c_f), c_g, w_branch_rwkv[l], w_branch_attn[l],
                                   w_branch_fourier[l], w_out[l])
            hc = hc + mc[2] * rms_norm(mix_c, norm_mix_post[l])
        f = modulate(rms_norm(h, norm_ffn_pre[l]), m[3], m[4])
        h = h + m[5] * rms_norm(conv_ffn(f, ffn_up[l], ffn_conv_w[l], ffn_conv_b[l], ffn_down[l]), norm_ffn_post[l])
        if need_ctx:
            fc = modulate(rms_norm(hc, norm_ffn_pre[l]), mc[3], mc[4])
            hc = hc + mc[5] * rms_norm(conv_ffn(fc, ffn_up[l], ffn_conv_w[l], ffn_conv_b[l], ffn_down[l]), norm_ffn_post[l])
    return h
```

```cpp
#include <hip/hip_runtime.h>
#include <hip/hip_cooperative_groups.h>
#include <cstdio>
#include <cstdint>
namespace cg = cooperative_groups;
__device__ __forceinline__ int otid() { int t = threadIdx.x; asm volatile("" : "+v"(t)); return t; }
namespace pg8 {
#define PG8_LAS __attribute__((address_space(3)))
typedef unsigned short bf16_t;
typedef short bf16x8 __attribute__((ext_vector_type(8)));
typedef float f32x4 __attribute__((ext_vector_type(4)));
typedef unsigned u32x4 __attribute__((ext_vector_type(4)));
constexpr int BM = 256, BK = 64, HALF = 128, HTB = HALF * BK * 2  , STAGE_BYTES = 8 * HTB, NXCD = 8, WGM = 8;

__host__ __device__ __forceinline__ int lds_byte(int r, int c) { const int st = (r >> 4) * 2 + (c >> 5), rr = r & 15, cc = c & 31, ob = rr * 64 + cc * 2; return st * 1024 + (ob ^ (((ob >> 9) & 1) << 5)); }
__host__ __device__ __forceinline__ void stage_rc(int b, int& R, int& C) { const int st = b / 1024, sb = b % 1024, swz = sb ^ (((sb >> 9) & 1) << 5); R = (st >> 1) * 16 + swz / 64; C = (st & 1) * 32 + (swz % 64) / 2; }
__host__ __device__ __forceinline__ int perm32(int rho) { const int n = rho >> 4, i = rho & 15; return 8 * (i >> 2) + 4 * n + (i & 3); }

struct Unit { int pm, pn; };
struct Gemm { const bf16_t* A; const bf16_t* Bt; int M, N, K; };

struct StaticOrder {
    int nM, nN, nwg, G, c;
    __host__ __device__ void init(int M, int N, int G_, int c_) { nM = M / BM; nN = N / BM; nwg = nM * nN; G = G_; c = c_; }
    __host__ __device__ bool next(int i, Unit& u) const {
        const long L = (long)i * G + c; if (L >= nwg) return false;
        int wgid = (int)L; { const int q = nwg / NXCD, r = nwg % NXCD, xcd = wgid % NXCD, off = wgid / NXCD; wgid = (xcd < r ? xcd * (q + 1) : r * (q + 1) + (xcd - r) * q) + off; }
        const int nig = WGM * nN, gid = wgid / nig, fm = gid * WGM, gsz = (nM - fm) < WGM ? (nM - fm) : WGM;
        u.pm = fm + ((wgid % nig) % gsz); u.pn = (wgid % nig) / gsz; return true;
    }
    __device__ __forceinline__ void a_ready(const Unit&) const {}
    __device__ __forceinline__ void done(const Unit&) const {}
};

__device__ __forceinline__ unsigned cvt_pk_bf16(float lo, float hi) { unsigned r; asm volatile("v_cvt_pk_bf16_f32 %0, %1, %2" : "=v"(r) : "v"(lo), "v"(hi)); return r; }
typedef float f32x2 __attribute__((ext_vector_type(2)));
__device__ __forceinline__ f32x2 gelu_pk(f32x2 v) {
    const f32x2 av = __builtin_elementwise_abs(v), d = av * 0.2316418882f + 1.0f;
    f32x2 t; t.x = __builtin_amdgcn_rcpf(d.x); t.y = __builtin_amdgcn_rcpf(d.y);
    f32x2 q = t * 0.5307027145f + (-0.7265760135f); q = q * t + 0.7107068705f; q = q * t + (-0.142248368f); q = q * t + 0.127414796f; q = q * t;
    const f32x2 s = (v * v) * (-0.72134752044f);
    f32x2 e; e.x = __builtin_amdgcn_exp2f(s.x); e.y = __builtin_amdgcn_exp2f(s.y);
    const f32x2 m = v * (q * e), r = v - m;
    f32x2 o; o.x = v.x < 0.f ? m.x : r.x; o.y = v.y < 0.f ? m.y : r.y; return o;
}

template <class Epi, class Sched, bool ALIGN_EPI = false, bool SP2 = false>
__device__ __forceinline__ void gemm_phase(PG8_LAS unsigned char* lds, const Gemm g, const Sched& S, const Epi& E) {
    const int tid = otid(), wid = __builtin_amdgcn_readfirstlane(tid >> 6), lane = tid & 63, wr = wid >> 2, wc = wid & 3, fr = lane & 15, fq = lane >> 4;
    const int K = g.K, nt = K / BK;
    unsigned voffA[2], voffB[2];
#pragma unroll
    for (int i = 0; i < 2; ++i) { int R, C; stage_rc(tid * 16 + i * 8192, R, C); const int Rb = Epi::PERM ? ((R & ~31) + perm32(R & 31)) : R;
        voffA[i] = (unsigned)(R * K + C) * 2u; voffB[i] = (unsigned)(Rb * K + C) * 2u; }
    const size_t kstep = (size_t)(BK * 2);
    const size_t hstep = (size_t)HALF * K * 2;
    const size_t tstep = 2 * hstep;
    const unsigned ldsw = (unsigned)wid * 1024u;
    const int aoff = lds_byte(wr * 64 + fr, fq * 8), boff = lds_byte(wc * 32 + fr, fq * 8);
#define PG8_SA(b, h) (((b) * 2 + (h)) * HTB)
#define PG8_SB(b, h) ((4 + (b) * 2 + (h)) * HTB)
#define PG8_STAGE(bufoff, gbase, voff) do { _Pragma("unroll") for (int _i = 0; _i < 2; ++_i) \
        __builtin_amdgcn_global_load_lds((const unsigned*)((const char*)(gbase) + (voff)[_i]), (PG8_LAS unsigned*)(lds + (bufoff) + ldsw + _i * 8192), 16, 0, 0); } while (0)
#define PG8_LDA(dst, b, h) do { _Pragma("unroll") for (int m = 0; m < 4; ++m) _Pragma("unroll") for (int k = 0; k < 2; ++k) dst[m][k] = *(const PG8_LAS bf16x8*)(lds + PG8_SA(b, h) + aoff + m * 2048 + k * 1024); } while (0)
#define PG8_LDB(dst, b, h) do { _Pragma("unroll") for (int n = 0; n < 2; ++n) _Pragma("unroll") for (int k = 0; k < 2; ++k) dst[n][k] = *(const PG8_LAS bf16x8*)(lds + PG8_SB(b, h) + boff + n * 2048 + k * 1024); } while (0)
#define PG8_MMA(ai, bj, At, Bt) do { __builtin_amdgcn_s_setprio(1); _Pragma("unroll") for (int m = 0; m < 4; ++m) _Pragma("unroll") for (int n = 0; n < 2; ++n) _Pragma("unroll") for (int k = 0; k < 2; ++k) \
        acc[ai][bj][m][n] = __builtin_amdgcn_mfma_f32_16x16x32_bf16(Bt[n][k], At[m][k], acc[ai][bj][m][n], 0, 0, 0); __builtin_amdgcn_s_setprio(0); } while (0)
#define PG8_WAIT_V(n) asm volatile("s_waitcnt vmcnt(" #n ")" ::: "memory")
#define PG8_WAIT_L(n) asm volatile("s_waitcnt lgkmcnt(" #n ")" ::: "memory")
#define PG8_BAR __builtin_amdgcn_s_barrier()
#define PG8_SCHED __builtin_amdgcn_sched_barrier(0)
    Unit cur, nxt; int ui = 0;
    if (!S.next(0, cur)) return;
    f32x4 acc[2][2][4][2];
#pragma unroll
    for (int a = 0; a < 2; ++a)
#pragma unroll
        for (int b = 0; b < 2; ++b)
#pragma unroll
            for (int m = 0; m < 4; ++m)
#pragma unroll
                for (int n = 0; n < 2; ++n) acc[a][b][m][n] = (f32x4){0.f, 0.f, 0.f, 0.f};
    bf16x8 At[4][2], B0[2][2], B1[2][2];
    const char* cA = (const char*)g.A + (size_t)cur.pm * tstep; const char* cB = (const char*)g.Bt + (size_t)cur.pn * tstep;
    S.a_ready(cur);
    if constexpr (SP2) {
        PG8_STAGE(PG8_SB(0, 0), cB, voffB); PG8_STAGE(PG8_SB(0, 1), cB + hstep, voffB); PG8_STAGE(PG8_SA(0, 0), cA, voffA); PG8_STAGE(PG8_SA(0, 1), cA + hstep, voffA);
        if (wr == 1) PG8_BAR;
        PG8_WAIT_V(2); PG8_BAR;
        PG8_STAGE(PG8_SB(1, 0), cB + kstep, voffB); PG8_STAGE(PG8_SA(1, 0), cA + kstep, voffA); PG8_STAGE(PG8_SB(1, 1), cB + hstep + kstep, voffB);
        PG8_WAIT_V(6); PG8_BAR;
    } else {
        PG8_STAGE(PG8_SB(0, 0), cB, voffB); PG8_STAGE(PG8_SA(0, 0), cA, voffA); PG8_STAGE(PG8_SB(0, 1), cB + hstep, voffB); PG8_STAGE(PG8_SA(0, 1), cA + hstep, voffA);
        if (wr == 1) PG8_BAR;
        PG8_WAIT_V(4); PG8_BAR;
        PG8_STAGE(PG8_SB(1, 0), cB + kstep, voffB); PG8_STAGE(PG8_SA(1, 0), cA + kstep, voffA); PG8_STAGE(PG8_SB(1, 1), cB + hstep + kstep, voffB);
        PG8_WAIT_V(6); PG8_BAR;
    }
    for (;;) {
        const bool has_next = S.next(ui + 1, nxt);
        const char* nA = has_next ? (const char*)g.A + (size_t)nxt.pm * tstep : cA; const char* nB = has_next ? (const char*)g.Bt + (size_t)nxt.pn * tstep : cB;
        for (int t = 0; t < nt; t += 2) {
            const bool last = (t == nt - 2);
            const char* a1 = cA + (size_t)(t + 1) * kstep;
            const char* a2 = last ? nA : cA + (size_t)(t + 2) * kstep; const char* b2 = last ? nB : cB + (size_t)(t + 2) * kstep;
            const char* a3 = a2 + kstep; const char* b3 = b2 + kstep;
            if (last && has_next) S.a_ready(nxt);
            if constexpr (SP2) {
            PG8_LDB(B0, 0, 0); PG8_LDB(B1, 0, 1); PG8_SCHED; PG8_LDA(At, 0, 0); PG8_STAGE(PG8_SA(1, 1), a1 + hstep, voffA);
            PG8_WAIT_V(8); PG8_WAIT_L(0); PG8_BAR; PG8_MMA(0, 0, At, B0); PG8_MMA(0, 1, At, B1); PG8_BAR; PG8_SCHED;
            PG8_LDA(At, 0, 1); PG8_STAGE(PG8_SB(0, 0), b2, voffB); PG8_STAGE(PG8_SB(0, 1), b2 + hstep, voffB); PG8_STAGE(PG8_SA(0, 0), a2, voffA);
            PG8_WAIT_V(8); PG8_WAIT_L(0); PG8_BAR; PG8_MMA(1, 0, At, B0); PG8_MMA(1, 1, At, B1); PG8_BAR; PG8_SCHED;
            PG8_LDB(B0, 1, 0); PG8_LDB(B1, 1, 1); PG8_SCHED; PG8_LDA(At, 1, 0); PG8_STAGE(PG8_SA(0, 1), a2 + hstep, voffA);
            PG8_WAIT_V(8); PG8_WAIT_L(0); PG8_BAR; PG8_MMA(0, 0, At, B0); PG8_MMA(0, 1, At, B1); PG8_BAR; PG8_SCHED;
            PG8_LDA(At, 1, 1); PG8_STAGE(PG8_SB(1, 0), b3, voffB); PG8_STAGE(PG8_SB(1, 1), b3 + hstep, voffB); PG8_STAGE(PG8_SA(1, 0), a3, voffA);
            PG8_WAIT_V(8); PG8_WAIT_L(0); PG8_BAR; PG8_MMA(1, 0, At, B0); PG8_MMA(1, 1, At, B1); PG8_BAR; PG8_SCHED;
            } else {
            PG8_LDB(B0, 0, 0); PG8_SCHED; PG8_LDA(At, 0, 0); PG8_STAGE(PG8_SA(1, 1), a1 + hstep, voffA);
            PG8_WAIT_L(8); PG8_BAR; PG8_WAIT_L(0); PG8_MMA(0, 0, At, B0); PG8_BAR; PG8_SCHED;
            PG8_LDB(B1, 0, 1); PG8_STAGE(PG8_SB(0, 0), b2, voffB);
            PG8_BAR; PG8_WAIT_L(0); PG8_MMA(0, 1, At, B1); PG8_BAR;
            PG8_LDA(At, 0, 1); PG8_STAGE(PG8_SA(0, 0), a2, voffA);
            PG8_BAR; PG8_WAIT_L(0); PG8_MMA(1, 0, At, B0); PG8_BAR; PG8_SCHED;
            PG8_STAGE(PG8_SB(0, 1), b2 + hstep, voffB);
            PG8_WAIT_V(6); PG8_BAR; PG8_MMA(1, 1, At, B1); PG8_BAR;
            PG8_LDB(B0, 1, 0); PG8_SCHED; PG8_LDA(At, 1, 0); PG8_STAGE(PG8_SA(0, 1), a2 + hstep, voffA);
            PG8_WAIT_L(8); PG8_BAR; PG8_WAIT_L(0); PG8_MMA(0, 0, At, B0); PG8_BAR; PG8_SCHED;
            PG8_LDB(B1, 1, 1); PG8_STAGE(PG8_SB(1, 0), b3, voffB);
            PG8_BAR; PG8_WAIT_L(0); PG8_MMA(0, 1, At, B1); PG8_BAR;
            PG8_LDA(At, 1, 1); PG8_STAGE(PG8_SA(1, 0), a3, voffA);
            PG8_BAR; PG8_WAIT_L(0); PG8_MMA(1, 0, At, B0); PG8_BAR; PG8_SCHED;
            PG8_STAGE(PG8_SB(1, 1), b3 + hstep, voffB);
            PG8_WAIT_V(6); PG8_BAR; PG8_MMA(1, 1, At, B1); PG8_BAR;
            }
        }
        if constexpr (ALIGN_EPI) { if (wr == 0) PG8_BAR; }
        if constexpr (!Epi::AFTER_DRAIN) { E(acc, cur, wr, wc, fr, fq); S.done(cur); }
        if (!has_next) break;
#pragma unroll
        for (int a = 0; a < 2; ++a)
#pragma unroll
            for (int b = 0; b < 2; ++b)
#pragma unroll
                for (int m = 0; m < 4; ++m)
#pragma unroll
                    for (int n = 0; n < 2; ++n) acc[a][b][m][n] = (f32x4){0.f, 0.f, 0.f, 0.f};
        cur = nxt; cA = nA; cB = nB; ++ui;
        if constexpr (ALIGN_EPI) { if (wr == 1) PG8_BAR; }
    }
    PG8_WAIT_V(0);
    if constexpr (!ALIGN_EPI) { if (wr == 0) PG8_BAR; }
    PG8_BAR;
    if constexpr (Epi::AFTER_DRAIN) { E.fused(acc, cur, wr, wc, fr, fq, lds, wid, lane); S.done(cur); }
#undef PG8_SA
#undef PG8_SB
#undef PG8_STAGE
#undef PG8_LDA
#undef PG8_LDB
#undef PG8_MMA
#undef PG8_WAIT_V
#undef PG8_WAIT_L
#undef PG8_BAR
#undef PG8_SCHED
}
}

#define DI __device__ __forceinline__
#define LAS __attribute__((address_space(3)))
typedef unsigned short bf16;
typedef float f32x4 __attribute__((ext_vector_type(4)));
typedef float f32x2 __attribute__((ext_vector_type(2)));
typedef float f32x16 __attribute__((ext_vector_type(16)));
typedef short bf16x8 __attribute__((ext_vector_type(8)));
typedef short s16x4 __attribute__((ext_vector_type(4)));
typedef unsigned u32x4 __attribute__((ext_vector_type(4)));
typedef unsigned u32x2 __attribute__((ext_vector_type(2)));
typedef __bf16 bf16x2_t __attribute__((ext_vector_type(2)));

constexpr int DM = 1024, NB = 32, TL = 2048, TC = 256, NLAT = NB * TL, NCTX = NB * TC, NT = NLAT + NCTX, CTXB = NLAT;
constexpr int DFF = 2816, RW = 1152, NIN = 2560, NGATE = 3072;
constexpr int IN_COLS = 5248;
constexpr float LOG2E = 1.4426950408889634f;
constexpr int NTHREADS = 512, NWAVES = 8;
constexpr int LDS_BYTES = 147456;

constexpr size_t MiB = 1u << 20;
constexpr size_t WS_CTL = 0;
constexpr size_t WS_MOD = 1 * MiB;
constexpr size_t WS_SMALL = 3 * MiB;
constexpr size_t WS_BON = 4 * MiB;
constexpr size_t WS_W = 6 * MiB;
constexpr size_t WL_IN = 0, WL_G = 5 * MiB, WL_BR = 11 * MiB, WL_BA = 11 * MiB + 512 * 1024, WL_BF = 12 * MiB + 512 * 1024, WL_O = 13 * MiB, WL_UP = 15 * MiB, WL_DN = 26 * MiB, WL_SIZE = 32 * MiB;
constexpr size_t WS_DFT = WS_W + 2 * WL_SIZE;
constexpr size_t WS_DFTC = WS_DFT + 16 * MiB;
constexpr size_t WS_HC = WS_DFTC + 1 * MiB;
constexpr size_t WS_A = WS_HC + 32 * MiB;
constexpr size_t WS_VF = WS_A + 144 * MiB;
constexpr size_t WS_X = WS_VF + 36 * MiB;
constexpr size_t X_F = 0;
constexpr size_t X_QKV = 288 * MiB;
constexpr size_t X_ZT = 396 * MiB;
constexpr size_t X_ZTC = 460 * MiB;
constexpr size_t X_UR = 468 * MiB;
constexpr size_t X_G = 630 * MiB;
constexpr size_t X_END = 666 * MiB;
constexpr size_t X_PP = 0;
constexpr size_t X_MIX = 0;
constexpr size_t X_HH = 0;
constexpr size_t X_HALO = 396 * MiB;
constexpr size_t X_FFO = 436 * MiB;
constexpr size_t WS_TOTAL = WS_X + X_END;
constexpr size_t FSZ = (size_t)NT * 256;

struct Params { const float* in[34]; float* out; unsigned char* ws; };

DI float bf2f(bf16 v) { return __builtin_bit_cast(float, (unsigned)v << 16); }
DI float lo2f(unsigned u) { return __builtin_bit_cast(float, u << 16); }
DI float hi2f(unsigned u) { return __builtin_bit_cast(float, u & 0xffff0000u); }
DI unsigned pk(float lo, float hi) { f32x2 v = {lo, hi}; bf16x2_t b = __builtin_convertvector(v, bf16x2_t); return __builtin_bit_cast(unsigned, b); }
DI bf16 f2bf(float x) { return (bf16)(pk(x, 0.f) & 0xffffu); }
DI float fexp2(float x) { return __builtin_amdgcn_exp2f(x); }
DI float frcp(float x) { return __builtin_amdgcn_rcpf(x); }
DI float sigm(float x) { return frcp(1.f + fexp2(-x * LOG2E)); }
DI float tanh_(float x) { return 2.f * sigm(2.f * x) - 1.f; }
DI float gelu_tanh(float z) { const float u = 1.5957691216057308f * (z + 0.044715f * z * z * z); return z * sigm(u); }
DI float wave_sum(float v) {
#pragma unroll
    for (int o = 1; o < 64; o <<= 1) v += __shfl_xor(v, o);
    return v;
}
template <int CTRL, bool BC> DI float dppf(float old, float src) {
    return __builtin_bit_cast(float, __builtin_amdgcn_update_dpp(__builtin_bit_cast(int, old), __builtin_bit_cast(int, src), CTRL, 0xf, 0xf, BC));
}
DI float allred4(float x) {
    unsigned u = __builtin_bit_cast(unsigned, x);
    auto r = __builtin_amdgcn_permlane16_swap(u, u, false, false);
    float y = __builtin_bit_cast(float, (unsigned)r[0]) + __builtin_bit_cast(float, (unsigned)r[1]);
    unsigned v = __builtin_bit_cast(unsigned, y);
    auto s = __builtin_amdgcn_permlane32_swap(v, v, false, false);
    return __builtin_bit_cast(float, (unsigned)s[0]) + __builtin_bit_cast(float, (unsigned)s[1]);
}

DI u32x4 pack8(const f32x4& a, const f32x4& b) { u32x4 w; w.x = pk(a[0], a[1]); w.y = pk(a[2], a[3]); w.z = pk(b[0], b[1]); w.w = pk(b[2], b[3]); return w; }

struct EpiStore {
    static constexpr bool PERM = true, AFTER_DRAIN = false;
    bf16* O; int ld; int row_base, row_pn, col_pn;
    DI void operator()(const f32x4 (&acc)[2][2][4][2], const pg8::Unit& u, int wr, int wc, int fr, int fq) const {
        const int row0 = row_base + u.pn * row_pn + u.pm * 256 + wr * 64 + fr, col0 = u.pn * col_pn + wc * 32 + 8 * fq;
#pragma unroll
        for (int ai = 0; ai < 2; ++ai)
#pragma unroll
            for (int m = 0; m < 4; ++m) { bf16* rowp = O + (size_t)(row0 + ai * 128 + m * 16) * ld + col0;
#pragma unroll
                for (int bj = 0; bj < 2; ++bj) *(u32x4*)(rowp + bj * 128) = pack8(acc[ai][bj][m][0], acc[ai][bj][m][1]); }
    }
};

struct EpiIn {
    static constexpr bool PERM = true, AFTER_DRAIN = false;
    bf16 *QKV, *ZT, *ZTC, *UR;
    DI void operator()(const f32x4 (&acc)[2][2][4][2], const pg8::Unit& u, int wr, int wc, int fr, int fq) const {
        const int pn = u.pn, rl0 = wr * 64 + fr, cl = wc * 32 + 8 * fq;
        if (pn < 3) {
#pragma unroll
            for (int ai = 0; ai < 2; ++ai)
#pragma unroll
                for (int m = 0; m < 4; ++m) { bf16* rowp = QKV + (size_t)(u.pm * 256 + rl0 + ai * 128 + m * 16) * 768 + pn * 256 + cl;
#pragma unroll
                    for (int bj = 0; bj < 2; ++bj) *(u32x4*)(rowp + bj * 128) = pack8(acc[ai][bj][m][0], acc[ai][bj][m][1]); }
        } else if (pn < 5) {
            bf16* base; int stride;
            if (u.pm < 256) { const int b = u.pm >> 3, t0 = (u.pm & 7) * 256; base = ZT + (size_t)b * 256 * 4096 + (pn - 3) * 2048 + t0; stride = 4096; }
            else { const int b = u.pm - 256; base = ZTC + (size_t)b * 256 * 512 + (pn - 3) * 256; stride = 512; }
#pragma unroll
            for (int ai = 0; ai < 2; ++ai)
#pragma unroll
                for (int m = 0; m < 4; ++m) { const int rl = rl0 + ai * 128 + m * 16;
#pragma unroll
                    for (int bj = 0; bj < 2; ++bj)
#pragma unroll
                        for (int n = 0; n < 2; ++n)
#pragma unroll
                            for (int e = 0; e < 4; ++e) base[(size_t)(bj * 128 + cl + 4 * n + e) * stride + rl] = f2bf(acc[ai][bj][m][n][e]); }
        } else {
#pragma unroll
            for (int ai = 0; ai < 2; ++ai)
#pragma unroll
                for (int m = 0; m < 4; ++m) { bf16* rowp = UR + (size_t)(u.pm * 256 + rl0 + ai * 128 + m * 16) * RW + (pn - 5) * 256 + cl;
#pragma unroll
                    for (int bj = 0; bj < 2; ++bj) if ((pn - 5) * 256 + bj * 128 < RW) *(u32x4*)(rowp + bj * 128) = pack8(acc[ai][bj][m][0], acc[ai][bj][m][1]); }
        }
    }
};

struct EpiGate {
    static constexpr bool PERM = true, AFTER_DRAIN = false;
    const bf16* PP; bf16* MG;
    DI void operator()(const f32x4 (&acc)[2][2][4][2], const pg8::Unit& u, int wr, int wc, int fr, int fq) const {
        const int br = u.pn >> 2, cn = u.pn & 3, row0 = u.pm * 256 + wr * 64 + fr, col0 = cn * 256 + wc * 32 + 8 * fq;
#pragma unroll
        for (int ai = 0; ai < 2; ++ai)
#pragma unroll
            for (int m = 0; m < 4; ++m) { const size_t row = (size_t)(row0 + ai * 128 + m * 16);
#pragma unroll
                for (int bj = 0; bj < 2; ++bj) {
                    const u32x4 pp = *(const u32x4*)(PP + row * NGATE + br * 1024 + col0 + bj * 128);
                    bf16* mp = MG + row * 1024 + col0 + bj * 128;
                    f32x4 a = acc[ai][bj][m][0], b = acc[ai][bj][m][1];
                    a[0] = sigm(a[0]) * lo2f(pp.x); a[1] = sigm(a[1]) * hi2f(pp.x); a[2] = sigm(a[2]) * lo2f(pp.y); a[3] = sigm(a[3]) * hi2f(pp.y);
                    b[0] = sigm(b[0]) * lo2f(pp.z); b[1] = sigm(b[1]) * hi2f(pp.z); b[2] = sigm(b[2]) * lo2f(pp.w); b[3] = sigm(b[3]) * hi2f(pp.w);
                    if (br) { const u32x4 o = *(const u32x4*)mp;
                        a[0] += lo2f(o.x); a[1] += hi2f(o.x); a[2] += lo2f(o.y); a[3] += hi2f(o.y); b[0] += lo2f(o.z); b[1] += hi2f(o.z); b[2] += lo2f(o.w); b[3] += hi2f(o.w); }
                    *(u32x4*)mp = pack8(a, b); } }
    }
};

struct EpiUp {
    static constexpr bool PERM = true, AFTER_DRAIN = false;
    bf16* HH; bf16* HALO; const float* cw; const float* cb;
    DI void operator()(const f32x4 (&acc)[2][2][4][2], const pg8::Unit& u, int wr, int wc, int fr, int fq) const {
        const int j0 = 128 * u.pn + 32 * wc + 8 * fq;
        f32x4 w0[2], w1[2], w2[2], bb[2];
#pragma unroll
        for (int n = 0; n < 2; ++n) { w0[n] = *(const f32x4*)(cw + j0 + 4 * n); w1[n] = *(const f32x4*)(cw + DFF + j0 + 4 * n); w2[n] = *(const f32x4*)(cw + 2 * DFF + j0 + 4 * n); bb[n] = *(const f32x4*)(cb + j0 + 4 * n); }
#pragma unroll
        for (int ai = 0; ai < 2; ++ai) {
            const int grp = u.pm * 4 + ai * 2 + wr;
            bf16* hb = HALO + (size_t)grp * 6 * DFF + j0;
            if (fr < 2) { *(u32x4*)(hb + fr * DFF) = pack8(acc[ai][0][0][0], acc[ai][0][0][1]); if (fr == 0) *(u32x4*)(hb + 4 * DFF) = pack8(acc[ai][1][0][0], acc[ai][1][0][1]); }
            if (fr >= 14) { *(u32x4*)(hb + (fr - 12) * DFF) = pack8(acc[ai][0][3][0], acc[ai][0][3][1]); if (fr == 15) *(u32x4*)(hb + 5 * DFF) = pack8(acc[ai][1][3][0], acc[ai][1][3][1]); }
#pragma unroll
            for (int m = 0; m < 4; ++m) {
                f32x4 o[2];
#pragma unroll
                for (int n = 0; n < 2; ++n)
#pragma unroll
                    for (int e = 0; e < 4; ++e) {
                        const float x = acc[ai][0][m][n][e];
                        const float xm = (m > 0) ? acc[ai][0][m > 0 ? m - 1 : 0][n][e] : 0.f, xp = (m < 3) ? acc[ai][0][m < 3 ? m + 1 : 3][n][e] : 0.f;
                        const float t1 = dppf<0x121, true>(0.f, xm);
                        const float prev = dppf<0x111, false>(t1, x);
                        const float t2 = dppf<0x12F, true>(0.f, xp);
                        const float next = dppf<0x101, false>(t2, x);
                        const float z = w0[n][e] * prev + w1[n][e] * x + w2[n][e] * next + bb[n][e];
                        o[n][e] = gelu_tanh(z) * acc[ai][1][m][n][e];
                    }
                const bool edge = (m == 0 && fr == 0) || (m == 3 && fr == 15);
                if (!edge) *(u32x4*)(HH + (size_t)(u.pm * 256 + ai * 128 + wr * 64 + m * 16 + fr) * DFF + j0) = pack8(o[0], o[1]);
            }
        }
    }
};

struct GateOrder {
    int nU, G, c;
    DI bool next(int i, pg8::Unit& u) const { const int j = i / 3, br = i - 3 * j; const long L = (long)j * G + c; if (L >= nU) return false; u.pm = (int)(L >> 2); u.pn = br * 4 + (int)(L & 3); return true; }
    DI void a_ready(const pg8::Unit&) const {}
    DI void done(const pg8::Unit&) const {}
};

struct Ctx {
    LAS unsigned char* lds; unsigned char* ws; const Params& P; float* out;
    int tid, lane, wave, G, bid, z;
};
DI Ctx rectx(const Ctx& C0) { const int t = otid(); int z = 0; asm volatile("" : "+s"(z)); return Ctx{C0.lds, C0.P.ws + z, C0.P, C0.P.out + z, t, t & 63, __builtin_amdgcn_readfirstlane(t >> 6), C0.G, C0.bid, z}; }
#define WSP(T, off) ((T*)(C.ws + (off)))
#define WL(T, l, off) ((T*)(C.ws + WS_W + (size_t)(l) * WL_SIZE + (off)))

DI void tr_item(const float* src, int ldw, int k0, int n0, bf16* dst, int ldd, int drow0, LAS float* scr, int lane) {
#pragma unroll 8
    for (int i = 0; i < 32; ++i) { const int kk = 2 * i + (lane >> 5); scr[kk * 33 + (lane & 31)] = src[(size_t)(k0 + kk) * ldw + n0 + (lane & 31)]; }
    asm volatile("s_waitcnt lgkmcnt(0)" ::: "memory");
    const int c = lane & 7;
#pragma unroll
    for (int j = 0; j < 4; ++j) { const int n = (lane >> 3) + 8 * j; const LAS float* s = scr + (8 * c) * 33 + n;
        u32x4 o; o.x = pk(s[0 * 33], s[1 * 33]); o.y = pk(s[2 * 33], s[3 * 33]); o.z = pk(s[4 * 33], s[5 * 33]); o.w = pk(s[6 * 33], s[7 * 33]);
        *(u32x4*)(dst + (size_t)(drow0 + n) * ldd + k0 + 8 * c) = o; }
    asm volatile("s_waitcnt lgkmcnt(0)" ::: "memory");
}
DI void tr_matrix(const Ctx& C, const float* src, int ldw, int K, int n_src0, int ncols, bf16* dst, int drow0, LAS float* scr) {
    const int gw = C.bid * NWAVES + C.wave, NGW = C.G * NWAVES, nb = ncols / 32, nit = (K / 64) * nb;
    for (int it = gw; it < nit; it += NGW) { const int kb = it / nb, b = it % nb; tr_item(src, ldw, kb * 64, n_src0 + b * 32, dst, K, drow0 + b * 32, scr, C.lane); }
}

DI void prologue(const Ctx& C0) {
    const Ctx C = rectx(C0);
    LAS float* scr = (LAS float*)(C.lds + 49152 + C.wave * 8704);
    const int gth = C.bid * NTHREADS + C.tid, NGT = C.G * NTHREADS;
    for (int tsk = C.bid; tsk < 72; tsk += C.G) {
        const int l = tsk / 36, rem = tsk % 36, cb = rem / 3, rg = rem % 3;
        LAS float* s = (LAS float*)C.lds;
        for (int i = C.tid; i < 11 * 1024; i += NTHREADS) { const int r = rg * 11 + i / 1024, k = i % 1024; const float cv = (r < 32) ? C.P.in[1 + C.z][r * 1024 + k] : C.P.in[3 + C.z][k]; s[i] = cv * sigm(cv); }
        __syncthreads();
        const int j = cb * 512 + C.tid;
        float acc[11];
        const float bj = C.P.in[5 + C.z][l * 6144 + j];
#pragma unroll
        for (int i = 0; i < 11; ++i) acc[i] = bj;
        const float* wp = C.P.in[4 + C.z] + (size_t)l * 1024 * 6144 + j;
        for (int k = 0; k < 1024; k += 4) {
            const float w0 = wp[(size_t)k * 6144], w1 = wp[(size_t)(k + 1) * 6144], w2 = wp[(size_t)(k + 2) * 6144], w3 = wp[(size_t)(k + 3) * 6144];
#pragma unroll
            for (int i = 0; i < 11; ++i) { const f32x4 x = *(const LAS f32x4*)(s + i * 1024 + k); acc[i] += x[0] * w0 + x[1] * w1 + x[2] * w2 + x[3] * w3; }
        }
#pragma unroll
        for (int i = 0; i < 11; ++i) WSP(float, WS_MOD)[(size_t)(l * 33 + rg * 11 + i) * 6144 + j] = acc[i];
        __syncthreads();
    }
    if (C.bid == C.G - 1) for (int i = C.tid; i < 1024; i += NTHREADS) { const int p = i >> 4, f = i & 15; const float inv = powf(10000.f, -(float)f / 16.f), ang = (float)p * inv; WSP(float, WS_SMALL)[2 * i] = cosf(ang); WSP(float, WS_SMALL)[2 * i + 1] = sinf(ang); }
    for (int i = gth; i < 2048 * 4096 / 2; i += NGT) {
        const int tp = i / 2048, kk = (i % 2048) * 2; float v[2];
#pragma unroll
        for (int e = 0; e < 2; ++e) { const int k = kk + e, t = k & 2047; const int ph = (tp * t) & 2047; const float x = (float)ph * (1.f / 1024.f); v[e] = ((k < 2048) ? cospif(x) : -sinpif(x)) * 0.0027621358640099513f; }
        WSP(unsigned, WS_DFT)[i] = pk(v[0], v[1]);
    }
    for (int i = gth; i < 256 * 512 / 2; i += NGT) {
        const int tp = i / 256, kk = (i % 256) * 2; float v[2];
#pragma unroll
        for (int e = 0; e < 2; ++e) { const int k = kk + e, t = k & 255; const int ph = (tp * t) & 255; const float x = (float)ph * (1.f / 128.f); v[e] = ((k < 256) ? cospif(x) : -sinpif(x)) * 0.0078125f; }
        WSP(unsigned, WS_DFTC)[i] = pk(v[0], v[1]);
    }
    for (int l = 0; l < 2; ++l) {
        const float* win = C.P.in[10 + C.z] + (size_t)l * 1024 * IN_COLS;
        bf16* wi = WL(bf16, l, WL_IN);
        tr_matrix(C, win, IN_COLS, 1024, 1152, 512, wi, 0, scr);
        tr_matrix(C, win, IN_COLS, 1024, 1664, 128, wi, 512, scr);
        tr_matrix(C, win, IN_COLS, 1024, 1792, 128, wi, 640, scr);
        tr_matrix(C, win, IN_COLS, 1024, 0, 1152, wi, 1280, scr);
        for (int i = gth; i < 128 * 1024 / 2; i += NGT) ((unsigned*)(wi + (size_t)2432 * 1024))[i] = 0u;
        for (int i = gth; i < 512 * 1024; i += NGT) {
            const int k = i & 1023, np = i >> 10, sn = np >> 8, g = (np >> 6) & 3, cp = np & 63;
            const float* wr_ = win + (size_t)k * IN_COLS + 1920 + g * 64; float a = 0.f;
            for (int c = 0; c < 64; ++c) { const float x = (float)((c * cp) & 63) * (1.f / 32.f); a += wr_[c] * (sn ? sinpif(x) : cospif(x)); }
            wi[(size_t)(768 + np) * 1024 + k] = f2bf(a);
        }
        tr_matrix(C, win, IN_COLS, 1024, 2176, 3072, WL(bf16, l, WL_G), 0, scr);
        tr_matrix(C, C.P.in[26 + C.z] + (size_t)l * 256 * 1024, 1024, 256, 0, 1024, WL(bf16, l, WL_BR), 0, scr);
        tr_matrix(C, C.P.in[27 + C.z] + (size_t)l * 512 * 1024, 1024, 512, 0, 1024, WL(bf16, l, WL_BA), 0, scr);
        tr_matrix(C, C.P.in[28 + C.z] + (size_t)l * 256 * 1024, 1024, 256, 0, 1024, WL(bf16, l, WL_BF), 0, scr);
        tr_matrix(C, C.P.in[29 + C.z] + (size_t)l * 1024 * 1024, 1024, 1024, 0, 1024, WL(bf16, l, WL_O), 0, scr);
        {
            const float* up = C.P.in[30 + C.z] + (size_t)l * 1024 * 2 * DFF; bf16* wu = WL(bf16, l, WL_UP);
            const int gw = C.bid * NWAVES + C.wave, NGW = C.G * NWAVES, nit = 16 * 44 * 4;
            for (int it = gw; it < nit; it += NGW) { const int kb = it / 176, r = it % 176, seg = r >> 2, b = r & 3, pn = seg >> 1, bj = seg & 1;
                tr_item(up, 2 * DFF, kb * 64, bj * DFF + pn * 128 + b * 32, wu, 1024, pn * 256 + bj * 128 + b * 32, scr, C.lane); }
        }
        tr_matrix(C, C.P.in[33 + C.z] + (size_t)l * DFF * 1024, 1024, DFF, 0, 1024, WL(bf16, l, WL_DN), 0, scr);
    }
}

template <bool HAS_ADD, bool HAS_OUT>
DI void rowop(const Ctx& C0, int nrows, const float* hin_l, const float* hin_c, float* hout_l, float* hout_c, const bf16* add, int ga, const float* g_add, const float* g_out, int sh, int sc, const float* modl, const float* modo, bf16* Aout) {
    const Ctx C = rectx(C0);
    const int gw = C.bid * NWAVES + C.wave, NGW = C.G * NWAVES;
    for (int tok = gw; tok < nrows; tok += NGW) {
        const bool lat = tok < NLAT; const int b = lat ? tok / TL : 32;
        const float* hp = lat ? hin_l + (size_t)tok * DM : hin_c + (size_t)(tok - NLAT) * DM;
        const float* mp = modl + (size_t)b * 6144; const float* mq = modo + (size_t)b * 6144;
        f32x4 h[4];
#pragma unroll
        for (int j = 0; j < 4; ++j) h[j] = *(const f32x4*)(hp + 4 * C.lane + 256 * j);
        if (HAS_ADD) {
            f32x4 a[4]; float ss = 0.f;
#pragma unroll
            for (int j = 0; j < 4; ++j) { const u32x2 r = *(const u32x2*)(add + (size_t)tok * DM + 4 * C.lane + 256 * j); a[j] = (f32x4){lo2f(r.x), hi2f(r.x), lo2f(r.y), hi2f(r.y)}; ss += a[j][0] * a[j][0] + a[j][1] * a[j][1] + a[j][2] * a[j][2] + a[j][3] * a[j][3]; }
            const float rstd = rsqrtf(wave_sum(ss) * (1.f / DM) + 1e-6f);
            float* op = lat ? hout_l + (size_t)tok * DM : hout_c + (size_t)(tok - NLAT) * DM;
#pragma unroll
            for (int j = 0; j < 4; ++j) { const int col = 4 * C.lane + 256 * j; const f32x4 gg = *(const f32x4*)(g_add + col), mm = *(const f32x4*)(mp + ga * 1024 + col);
                h[j] = h[j] + mm * (a[j] * rstd * gg); *(f32x4*)(op + col) = h[j]; }
        }
        if (HAS_OUT) {
            float ss = 0.f;
#pragma unroll
            for (int j = 0; j < 4; ++j) ss += h[j][0] * h[j][0] + h[j][1] * h[j][1] + h[j][2] * h[j][2] + h[j][3] * h[j][3];
            const float rstd = rsqrtf(wave_sum(ss) * (1.f / DM) + 1e-6f);
#pragma unroll
            for (int j = 0; j < 4; ++j) { const int col = 4 * C.lane + 256 * j; const f32x4 gg = *(const f32x4*)(g_out + col), s1 = *(const f32x4*)(mq + sc * 1024 + col), s0 = *(const f32x4*)(mq + sh * 1024 + col);
                const f32x4 y = (h[j] * rstd * gg) * (s1 + 1.f) + s0; u32x2 o; o.x = pk(y[0], y[1]); o.y = pk(y[2], y[3]);
                *(u32x2*)(Aout + (size_t)tok * DM + col) = o; }
        }
    }
}

DI void feat_phase(const Ctx& C0, int l) {
    const Ctx C = rectx(C0);
    LAS bf16* raw = (LAS bf16*)C.lds;
    LAS float* sh = (LAS float*)(C.lds + 41472);
    LAS float* t32 = (LAS float*)(C.lds + 41472 + 73728);
    const bf16* UR = WSP(bf16, WS_X + X_UR);
    bf16* F = WSP(bf16, WS_X + X_F); bf16* Gq = WSP(bf16, WS_X + X_G); bf16* VF = WSP(bf16, WS_VF); float* BON = WSP(float, WS_BON);
    const float* mu = C.P.in[11 + C.z] + (size_t)l * 2 * RW;
    const float* w0 = C.P.in[12 + C.z] + l * 512; const float* w2 = C.P.in[13 + C.z] + (size_t)l * 2 * 64 * 256;
    const float* a0 = C.P.in[14 + C.z] + l * 512; const float* a2 = C.P.in[15 + C.z] + (size_t)l * 2 * 64 * 256;
    const float* g2 = C.P.in[16 + C.z] + (size_t)l * 128 * 256;
    const float* k_k = C.P.in[17 + C.z] + l * 256; const float* k_a = C.P.in[18 + C.z] + l * 256; const float* r_k = C.P.in[19 + C.z] + l * 256;
    const float* v0 = C.P.in[22 + C.z]; const float* v1 = C.P.in[23 + C.z]; const float* v2 = C.P.in[24 + C.z];
    const int c = C.tid & 255, th = C.tid >> 8, hd = (C.tid >> 6) & 3;
    for (int item = C.bid; item < 4608; item += C.G) {
        int b, tile, T, tokbase;
        if (item < 4096) { b = item >> 7; tile = item & 127; T = TL; tokbase = b * TL; } else { const int i2 = item - 4096; b = i2 >> 4; tile = i2 & 15; T = TC; tokbase = CTXB + b * TC; }
        const int t0 = tile * 16;
        for (int idx = C.tid; idx < 18 * 144; idx += NTHREADS) { const int row = idx / 144, pc = idx % 144, t = t0 - 1 + row;
            u32x4 v = {0u, 0u, 0u, 0u}; if (t >= 0 && t < T) v = *(const u32x4*)(UR + (size_t)(tokbase + t) * RW + pc * 8);
            *(LAS u32x4*)(raw + row * RW + pc * 8) = v; }
        __syncthreads();
        for (int idx = C.tid; idx < 16 * RW; idx += NTHREADS) { const int t = idx / RW, cc = idx % RW;
            const float u = bf2f(raw[(t + 1) * RW + cc]), up = bf2f(raw[t * RW + cc]), un = bf2f(raw[(t + 2) * RW + cc]);
            float s = u + mu[cc] * (up - u) + mu[RW + cc] * (un - u);
            if (cc >= 768 && cc < 896) s = tanh_(s); else if (cc >= 1024) s = sigm(s);
            sh[idx] = s; }
        __syncthreads();
        if (l == 1) { const int tk = C.tid >> 5, j = C.tid & 31; float a = 0.f;
            for (int cc = 0; cc < 256; ++cc) a += sh[tk * RW + 512 + cc] * v1[cc * 32 + j];
            t32[tk * 32 + j] = a; __syncthreads(); }
        float awf[8], awb[8], aaf[8], aab[8], ag[8];
#pragma unroll
        for (int i = 0; i < 8; ++i) { awf[i] = 0.f; awb[i] = 0.f; aaf[i] = 0.f; aab[i] = 0.f; ag[i] = 0.f; }
        for (int k = 0; k < 64; k += 4) {
            float wf[4], wb[4], af[4], ab[4];
#pragma unroll
            for (int e = 0; e < 4; ++e) { wf[e] = w2[(k + e) * 256 + c]; wb[e] = w2[(64 + k + e) * 256 + c]; af[e] = a2[(k + e) * 256 + c]; ab[e] = a2[(64 + k + e) * 256 + c]; }
#pragma unroll
            for (int i = 0; i < 8; ++i) { const LAS float* sp = sh + (th * 8 + i) * RW + k;
                const f32x4 x0 = *(const LAS f32x4*)(sp + 768), x1 = *(const LAS f32x4*)(sp + 832), x2 = *(const LAS f32x4*)(sp + 896), x3 = *(const LAS f32x4*)(sp + 960);
#pragma unroll
                for (int e = 0; e < 4; ++e) { awf[i] += x0[e] * wf[e]; awb[i] += x1[e] * wb[e]; aaf[i] += x2[e] * af[e]; aab[i] += x3[e] * ab[e]; } }
        }
        for (int k = 0; k < 128; k += 4) {
            float gw_[4];
#pragma unroll
            for (int e = 0; e < 4; ++e) gw_[e] = g2[(k + e) * 256 + c];
#pragma unroll
            for (int i = 0; i < 8; ++i) { const f32x4 x = *(const LAS f32x4*)(sh + (th * 8 + i) * RW + 1024 + k);
#pragma unroll
                for (int e = 0; e < 4; ++e) ag[i] += x[e] * gw_[e]; }
        }
        float zv[8];
        if (l == 1) {
#pragma unroll
            for (int i = 0; i < 8; ++i) zv[i] = v0[c];
            for (int j = 0; j < 32; ++j) { const float vv = v2[j * 256 + c];
#pragma unroll
                for (int i = 0; i < 8; ++i) zv[i] += t32[(th * 8 + i) * 32 + j] * vv; }
        }
        const float kkw = k_k[c], kaw = k_a[c], rkw = r_k[c], w0f = w0[c], w0b = w0[256 + c], a0f = a0[c], a0b = a0[256 + c];
#pragma unroll
        for (int i = 0; i < 8; ++i) {
            const int tt = th * 8 + i; const size_t o = (size_t)(tokbase + t0 + tt) * 256 + c;
            const float r = sh[tt * RW + c], k = sh[tt * RW + 256 + c]; float v = sh[tt * RW + 512 + c];
            if (l == 1) { const float vf = bf2f(VF[o]); v = v + (vf - v) * sigm(zv[i]); } else VF[o] = f2bf(v);
            const float kr = k * kkw, ss = wave_sum(kr * kr), kk = kr * rsqrtf(fmaxf(ss, 1e-24f));
            const float ef = 0.6065306597126334f * sigm(w0f + awf[i]), eb = 0.6065306597126334f * sigm(w0b + awb[i]);
            const float af = sigm(a0f + aaf[i]), ab = sigm(a0b + aab[i]);
            const float bon = wave_sum(r * k * (1.f + (0.5f * (af + ab) - 1.f) * kaw) * rkw);
            if (C.lane == 0) BON[(size_t)(tokbase + t0 + tt) * 4 + hd] = bon;
            F[o] = f2bf(r); F[FSZ + o] = f2bf(kk); F[2 * FSZ + o] = f2bf(v); F[3 * FSZ + o] = f2bf(k);
            F[4 * FSZ + o] = f2bf(ef); F[5 * FSZ + o] = f2bf(eb); F[6 * FSZ + o] = f2bf(af); F[7 * FSZ + o] = f2bf(ab);
            Gq[o] = f2bf(ag[i]);
        }
        __syncthreads();
    }
}

template <int J> DI void fmac_bc(float& acc, float x, float s) { asm volatile("v_fmac_f32_dpp %0, %1, %2 row_newbcast:%3 row_mask:0xf bank_mask:0xf" : "+v"(acc) : "v"(x), "v"(s), "n"(J)); }
template <int J> DI void mul_bc(float& s, float x) { asm volatile("v_mul_f32_dpp %0, %1, %0 row_newbcast:%2 row_mask:0xf bank_mask:0xf" : "+v"(s) : "v"(x), "n"(J)); }
struct ScanOp { bf16 r, kk, k, e, a, v; };
DI int scan_tok(int n, int dir, int b) { n = n < 2303 ? n : 2303; if (n < 256) return CTXB + b * 256 + (dir ? 255 - n : n); const int t = n - 256; return b * TL + (dir ? TL - 1 - t : t); }
DI ScanOp scan_load(const bf16* F, int dir, size_t ik, size_t iv) {
    ScanOp o; o.r = F[ik]; o.kk = F[FSZ + ik]; o.k = F[3 * FSZ + ik]; o.e = F[(4 + dir) * FSZ + ik]; o.a = F[(6 + dir) * FSZ + ik]; o.v = F[2 * FSZ + iv]; return o;
}
#define SCAN16(M) M(0) M(1) M(2) M(3) M(4) M(5) M(6) M(7) M(8) M(9) M(10) M(11) M(12) M(13) M(14) M(15)
DI void scan_step(float (&S)[16], const ScanOp& op, float ka, bf16* yp, bool wr) {
    float r = bf2f(op.r), kk = bf2f(op.kk), k = bf2f(op.k), e = bf2f(op.e), a = bf2f(op.a); const float v = bf2f(op.v);
    float w = fexp2(-e * LOG2E), kd = k * (1.f + (a - 1.f) * ka), bd = kk * a, nkk = -kk;
    asm volatile("s_nop 4" : "+v"(r), "+v"(w), "+v"(kd), "+v"(bd), "+v"(nkk));
    float sa0 = 0.f, sa1 = 0.f;
#define SA_(j) fmac_bc<j>((j & 1) ? sa1 : sa0, nkk, S[j]);
    SCAN16(SA_)
#undef SA_
    const float sa = allred4(sa0 + sa1);
#define UP_(j) mul_bc<j>(S[j], w); fmac_bc<j>(S[j], bd, sa); fmac_bc<j>(S[j], kd, v);
    SCAN16(UP_)
#undef UP_
    float y0 = 0.f, y1 = 0.f;
#define Y_(j) fmac_bc<j>((j & 1) ? y1 : y0, r, S[j]);
    SCAN16(Y_)
#undef Y_
    const float y = allred4(y0 + y1);
    if (wr) *yp = f2bf(y);
}
DI void scan_run(const Ctx& C0, int l, int b, int h) {
    const Ctx C = rectx(C0);
    const int dir = C.wave >> 2, wv = C.wave & 3, q = C.lane >> 4, vi = C.lane & 15;
    const int ck = h * 64 + C.lane, cv = h * 64 + 16 * wv + vi;
    const bf16* F = WSP(bf16, WS_X + X_F);
    bf16* YS = WSP(bf16, WS_X + X_UR) + (size_t)dir * FSZ;
    const float ka = C.P.in[18 + C.z][l * 256 + ck];
    float S[16];
#pragma unroll
    for (int j = 0; j < 16; ++j) S[j] = 0.f;
    const bool wr = (q == 0);
    size_t t0 = (size_t)scan_tok(0, dir, b) * 256, t1 = (size_t)scan_tok(1, dir, b) * 256, t2 = (size_t)scan_tok(2, dir, b) * 256, t3 = (size_t)scan_tok(3, dir, b) * 256;
    ScanOp o0 = scan_load(F, dir, t0 + ck, t0 + cv), o1 = scan_load(F, dir, t1 + ck, t1 + cv), o2 = scan_load(F, dir, t2 + ck, t2 + cv), o3 = scan_load(F, dir, t3 + ck, t3 + cv);
    for (int n = 0; n < 2304; n += 4) {
        size_t tn;
        scan_step(S, o0, ka, YS + t0 + cv, wr); tn = (size_t)scan_tok(n + 4, dir, b) * 256; o0 = scan_load(F, dir, tn + ck, tn + cv); t0 = tn;
        scan_step(S, o1, ka, YS + t1 + cv, wr); tn = (size_t)scan_tok(n + 5, dir, b) * 256; o1 = scan_load(F, dir, tn + ck, tn + cv); t1 = tn;
        scan_step(S, o2, ka, YS + t2 + cv, wr); tn = (size_t)scan_tok(n + 6, dir, b) * 256; o2 = scan_load(F, dir, tn + ck, tn + cv); t2 = tn;
        scan_step(S, o3, ka, YS + t3 + cv, wr); tn = (size_t)scan_tok(n + 7, dir, b) * 256; o3 = scan_load(F, dir, tn + ck, tn + cv); t3 = tn;
    }
}

DI void readout_phase(const Ctx& C0, int l, int nrows) {
    const Ctx C = rectx(C0);
    const int gw = C.bid * NWAVES + C.wave, NGW = C.G * NWAVES;
    const bf16* F = WSP(bf16, WS_X + X_F); const bf16* Gq = WSP(bf16, WS_X + X_G); const bf16* YS = WSP(bf16, WS_X + X_UR); const float* BON = WSP(float, WS_BON);
    bf16* YR = WSP(bf16, WS_A + (size_t)108 * MiB);
    const float* lw = C.P.in[20 + C.z] + l * 256; const float* lb = C.P.in[21 + C.z] + l * 256;
    for (int tok = gw; tok < nrows; tok += NGW) {
#pragma unroll
        for (int h = 0; h < 4; ++h) { const int c = h * 64 + C.lane; const size_t o = (size_t)tok * 256 + c;
            const float y = bf2f(YS[o]) + bf2f(YS[FSZ + o]); const float mean = wave_sum(y) * (1.f / 64.f), d = y - mean, var = wave_sum(d * d) * (1.f / 64.f);
            const float yn = d * rsqrtf(var + 64e-5f) * lw[c] + lb[c];
            YR[o] = f2bf((yn + BON[(size_t)tok * 4 + h] * bf2f(F[2 * FSZ + o])) * bf2f(Gq[o])); }
    }
}

DI void fixup_phase(const Ctx& C0, int l, int nrows) {
    const Ctx C = rectx(C0);
    const int gw = C.bid * NWAVES + C.wave, NGW = C.G * NWAVES, nitem = (nrows / 64) * 2;
    const bf16* HALO = WSP(bf16, WS_X + X_HALO); bf16* HH = WSP(bf16, WS_X + X_HH);
    const float* cw = C.P.in[31 + C.z] + (size_t)l * 3 * DFF; const float* cb = C.P.in[32 + C.z] + (size_t)l * DFF;
    for (int it = gw; it < nitem; it += NGW) {
        const int grp = it >> 1, last = it & 1, row = grp * 64 + (last ? 63 : 0);
        const int t = (row < NLAT) ? (row & (TL - 1)) : ((row - NLAT) & (TC - 1)), T = (row < NLAT) ? TL : TC;
        const bf16* hb = HALO + (size_t)grp * 6 * DFF;
        const bf16 *pp, *pc, *pn, *pv; bool zp = false, zn = false;
        if (!last) { pc = hb; pn = hb + DFF; pv = hb + 4 * DFF; zp = (t == 0); pp = zp ? hb : hb - 6 * DFF + 3 * DFF; }
        else { pp = hb + 2 * DFF; pc = hb + 3 * DFF; pv = hb + 5 * DFF; zn = (t == T - 1); pn = zn ? hb : hb + 6 * DFF; }
        for (int p = C.lane; p < DFF / 8; p += 64) { const int j = p * 8;
            const u32x4 a = *(const u32x4*)(pp + j), bq = *(const u32x4*)(pc + j), cq = *(const u32x4*)(pn + j), vq = *(const u32x4*)(pv + j);
            float o[8];
#pragma unroll
            for (int e = 0; e < 8; ++e) { const unsigned ua = a[e >> 1], ub = bq[e >> 1], uc = cq[e >> 1], uv = vq[e >> 1];
                const float xp = zp ? 0.f : ((e & 1) ? hi2f(ua) : lo2f(ua)), xc = (e & 1) ? hi2f(ub) : lo2f(ub), xn = zn ? 0.f : ((e & 1) ? hi2f(uc) : lo2f(uc)), xv = (e & 1) ? hi2f(uv) : lo2f(uv);
                const float z = cw[j + e] * xp + cw[DFF + j + e] * xc + cw[2 * DFF + j + e] * xn + cb[j + e]; o[e] = gelu_tanh(z) * xv; }
            u32x4 w; w.x = pk(o[0], o[1]); w.y = pk(o[2], o[3]); w.z = pk(o[4], o[5]); w.w = pk(o[6], o[7]);
            *(u32x4*)(HH + (size_t)row * DFF + j) = w; }
    }
}

DI int crow(int i, int hh) { return (i & 3) + 8 * (i >> 2) + 4 * hh; }
DI void attn_unit(const Ctx& C, int l, int b, int kh, int qblk, bool isctx) {
    LAS bf16* Ks = (LAS bf16*)C.lds; LAS bf16* Vt = Ks + 64 * 72;
    const bf16* QKV = WSP(bf16, WS_X + X_QKV); bf16* YA = WSP(bf16, WS_A); const float* RT = WSP(float, WS_SMALL);
    const int g = C.wave >> 1, qt = C.wave & 1, hq = kh * 4 + g, r = C.lane & 31, hh = C.lane >> 5;
    const int qi = qblk * 64 + qt * 32 + r;
    const size_t tq = isctx ? (size_t)(CTXB + b * TC + qi) : (size_t)(b * TL + qi);
    bf16x8 qf[4];
    {
        float qv[4][8]; const bf16* qp = QKV + tq * 768 + hq * 64 + 8 * hh;
#pragma unroll
        for (int ks = 0; ks < 4; ++ks) { const u32x4 u = *(const u32x4*)(qp + 16 * ks);
#pragma unroll
            for (int e = 0; e < 4; ++e) { qv[ks][2 * e] = lo2f(u[e]); qv[ks][2 * e + 1] = hi2f(u[e]); } }
        if (!isctx) { const int rid = qi >> 6, cid = qi & 63;
#pragma unroll
            for (int j = 0; j < 8; ++j) { const int f = 8 * hh + j;
                const float c0 = RT[(rid * 16 + f) * 2], s0 = RT[(rid * 16 + f) * 2 + 1], c1 = RT[(cid * 16 + f) * 2], s1 = RT[(cid * 16 + f) * 2 + 1];
                const float a1 = qv[0][j], a2 = qv[1][j], b1 = qv[2][j], b2 = qv[3][j];
                qv[0][j] = a1 * c0 - a2 * s0; qv[1][j] = a2 * c0 + a1 * s0; qv[2][j] = b1 * c1 - b2 * s1; qv[3][j] = b2 * c1 + b1 * s1; } }
        const float sc = 0.125f * LOG2E;
#pragma unroll
        for (int ks = 0; ks < 4; ++ks) { u32x4 w; w.x = pk(qv[ks][0] * sc, qv[ks][1] * sc); w.y = pk(qv[ks][2] * sc, qv[ks][3] * sc); w.z = pk(qv[ks][4] * sc, qv[ks][5] * sc); w.w = pk(qv[ks][6] * sc, qv[ks][7] * sc); qf[ks] = __builtin_bit_cast(bf16x8, w); }
    }
    float m_run = C.P.in[25 + C.z][l * 8 + hq] * LOG2E, l_run = hh == 0 ? 1.f : 0.f;
    f32x16 o0, o1;
#pragma unroll
    for (int i = 0; i < 16; ++i) { o0[i] = 0.f; o1[i] = 0.f; }
    const int nch = isctx ? 4 : 9, skey = C.tid >> 3, oct = C.tid & 7;
    for (int ch = 0; ch < nch; ++ch) {
        const bool win = ch >= 4; int kb = 0; size_t ktok0;
        if (!win) ktok0 = (size_t)(CTXB + b * TC + ch * 64);
        else { kb = qblk * 64 - 128 + (ch - 4) * 64; if (kb < 0 || kb >= TL) continue; ktok0 = (size_t)(b * TL + kb); }
        __syncthreads();
        {
            const bf16* kp = QKV + (ktok0 + skey) * 768 + 512 + kh * 64; const bf16* vp = kp + 128;
            u32x4 ku = *(const u32x4*)(kp + 8 * oct);
            if (win) { const u32x4 pu = *(const u32x4*)(kp + 8 * (oct ^ 2));
                const int p = kb + skey, pos = (oct >> 2) ? (p & 63) : (p >> 6), fb = 8 * (oct & 1); const bool isx1 = (oct & 2) == 0;
                float o[8];
#pragma unroll
                for (int e = 0; e < 8; ++e) { const float own = (e & 1) ? hi2f(ku[e >> 1]) : lo2f(ku[e >> 1]), par = (e & 1) ? hi2f(pu[e >> 1]) : lo2f(pu[e >> 1]);
                    const float cc = RT[(pos * 16 + fb + e) * 2], ss = RT[(pos * 16 + fb + e) * 2 + 1];
                    o[e] = isx1 ? (own * cc - par * ss) : (own * cc + par * ss); }
                ku.x = pk(o[0], o[1]); ku.y = pk(o[2], o[3]); ku.z = pk(o[4], o[5]); ku.w = pk(o[6], o[7]); }
            *(LAS u32x4*)(Ks + skey * 72 + 8 * oct) = ku;
            const u32x4 vu = *(const u32x4*)(vp + 8 * oct);
#pragma unroll
            for (int e = 0; e < 8; ++e) Vt[(8 * oct + e) * 72 + skey] = (bf16)((e & 1) ? (vu[e >> 1] >> 16) : (vu[e >> 1] & 0xffffu));
        }
        __syncthreads();
        f32x16 x0, x1;
#pragma unroll
        for (int i = 0; i < 16; ++i) { x0[i] = 0.f; x1[i] = 0.f; }
#pragma unroll
        for (int ks = 0; ks < 4; ++ks) {
            const bf16x8 a0 = *(const LAS bf16x8*)(Ks + r * 72 + 16 * ks + 8 * hh), a1 = *(const LAS bf16x8*)(Ks + (32 + r) * 72 + 16 * ks + 8 * hh);
            x0 = __builtin_amdgcn_mfma_f32_32x32x16_bf16(a0, qf[ks], x0, 0, 0, 0);
            x1 = __builtin_amdgcn_mfma_f32_32x32x16_bf16(a1, qf[ks], x1, 0, 0, 0);
        }
        if (win) {
#pragma unroll
            for (int i = 0; i < 16; ++i) { const int k0 = kb + crow(i, hh), d0 = qi - k0, d1 = d0 - 32;
                if (d0 > 128 || d0 < -128) x0[i] = -1e30f; if (d1 > 128 || d1 < -128) x1[i] = -1e30f; }
        }
        float mx = x0[0];
#pragma unroll
        for (int i = 0; i < 16; ++i) { mx = fmaxf(mx, x0[i]); mx = fmaxf(mx, x1[i]); }
        mx = fmaxf(mx, __shfl_xor(mx, 32));
        const float m_new = fmaxf(m_run, mx), alpha = fexp2(m_run - m_new);
        float ps = 0.f;
#pragma unroll
        for (int i = 0; i < 16; ++i) { x0[i] = fexp2(x0[i] - m_new); x1[i] = fexp2(x1[i] - m_new); ps += x0[i] + x1[i]; o0[i] *= alpha; o1[i] *= alpha; }
        l_run = l_run * alpha + ps; m_run = m_new;
#pragma unroll
        for (int kt = 0; kt < 2; ++kt)
#pragma unroll
            for (int s = 0; s < 2; ++s) {
                const f32x16& x = kt ? x1 : x0;
                u32x4 w; w.x = pk(x[8 * s], x[8 * s + 1]); w.y = pk(x[8 * s + 2], x[8 * s + 3]); w.z = pk(x[8 * s + 4], x[8 * s + 5]); w.w = pk(x[8 * s + 6], x[8 * s + 7]);
                const bf16x8 pb = __builtin_bit_cast(bf16x8, w);
                const int ko = kt * 32 + 16 * s + 4 * hh;
                const s16x4 l0 = *(const LAS s16x4*)(Vt + r * 72 + ko), h0 = *(const LAS s16x4*)(Vt + r * 72 + ko + 8);
                const s16x4 l1 = *(const LAS s16x4*)(Vt + (32 + r) * 72 + ko), h1 = *(const LAS s16x4*)(Vt + (32 + r) * 72 + ko + 8);
                o0 = __builtin_amdgcn_mfma_f32_32x32x16_bf16(__builtin_shufflevector(l0, h0, 0, 1, 2, 3, 4, 5, 6, 7), pb, o0, 0, 0, 0);
                o1 = __builtin_amdgcn_mfma_f32_32x32x16_bf16(__builtin_shufflevector(l1, h1, 0, 1, 2, 3, 4, 5, 6, 7), pb, o1, 0, 0, 0);
            }
    }
    const float inv = frcp(l_run + __shfl_xor(l_run, 32));
    bf16* op = YA + tq * 512 + hq * 64 + 4 * hh;
#pragma unroll
    for (int i4 = 0; i4 < 4; ++i4) {
        u32x2 w0, w1; w0.x = pk(o0[4 * i4] * inv, o0[4 * i4 + 1] * inv); w0.y = pk(o0[4 * i4 + 2] * inv, o0[4 * i4 + 3] * inv);
        w1.x = pk(o1[4 * i4] * inv, o1[4 * i4 + 1] * inv); w1.y = pk(o1[4 * i4 + 2] * inv, o1[4 * i4 + 3] * inv);
        *(u32x2*)(op + 8 * i4) = w0; *(u32x2*)(op + 32 + 8 * i4) = w1;
    }
}
DI void attn_loop(const Ctx& C0, int l) {
    const Ctx C = rectx(C0);
    unsigned* ctr = WSP(unsigned, WS_CTL) + 64 * (l + 1);
    volatile LAS unsigned* slot = (volatile LAS unsigned*)(C.lds + 32768);
    const unsigned NU = 2048u + (l == 0 ? 256u : 0u);
    for (;;) {
        __syncthreads();
        if (C.tid == 0) *slot = atomicAdd(ctr, 1u);
        __syncthreads();
        const unsigned u = *slot;
        if (u >= NU) break;
        if (u < 2048u) attn_unit(C, l, (int)(u >> 6), (int)((u >> 5) & 1), (int)(u & 31), false);
        else { const unsigned v = u - 2048u; attn_unit(C, l, (int)(v >> 3), (int)((v >> 2) & 1), (int)(v & 3), true); }
    }
}


#ifdef DBG
DI float exp_f(float x) { return fexp2(x * LOG2E); }
DI unsigned hsh(unsigned x) { x ^= x >> 16; x *= 0x7feb352du; x ^= x >> 15; x *= 0x846ca68bu; x ^= x >> 16; return x; }
DI void dbg_put(const Ctx& C, int k, float got, float ref, float S) {
    float err = fabsf(got - ref) / (fabsf(ref) + S); if (!(err == err)) err = 1e9f;
    atomicMax(WSP(unsigned, WS_CTL) + 1024 + k, __builtin_bit_cast(unsigned, err));
}
DI float ndot(const bf16* a, const bf16* b, int K) { float s = 0.f; for (int k = 0; k < K; ++k) s += bf2f(a[k]) * bf2f(b[k]); return s; }
DI void dbg_check(const Ctx& C0, int stage, int l) {
    if (C0.bid != 0 || l != 0) return;
    const Ctx C = rectx(C0);
    const unsigned h1 = hsh(C.tid * 3u + 17u + stage * 1000u), h2 = hsh(h1 + 0x9e3779b9u), h3 = hsh(h2 + 77u);
    const Params& P = C.P;
    if (stage == 0) {
        {
            const int n = h1 % 2432, k = h2 % 1024; int src = -1;
            if (n < 512) src = 1152 + n; else if (n < 640) src = 1664 + (n - 512); else if (n < 768) src = 1792 + (n - 640); else if (n >= 1280) src = n - 1280;
            if (src >= 0) dbg_put(C, 0, bf2f(WL(bf16, 0, WL_IN)[(size_t)n * 1024 + k]), bf2f(f2bf(P.in[10 + C.z][(size_t)k * IN_COLS + src])), 1e-6f);
            const int ng = h3 % 3072;
            dbg_put(C, 0, bf2f(WL(bf16, 0, WL_G)[(size_t)ng * 1024 + k]), bf2f(f2bf(P.in[10 + C.z][(size_t)k * IN_COLS + 2176 + ng])), 1e-6f);
            const int nu = h3 % 5632, pn = nu >> 8, bj = (nu >> 7) & 1, j = nu & 127;
            dbg_put(C, 0, bf2f(WL(bf16, 0, WL_UP)[(size_t)nu * 1024 + k]), bf2f(f2bf(P.in[30 + C.z][(size_t)k * 5632 + bj * DFF + pn * 128 + j])), 1e-6f);
            const int nd = h1 % 1024, kd = h3 % DFF;
            dbg_put(C, 0, bf2f(WL(bf16, 0, WL_DN)[(size_t)nd * DFF + kd]), bf2f(f2bf(P.in[33 + C.z][(size_t)kd * 1024 + nd])), 1e-6f);
            dbg_put(C, 0, bf2f(WL(bf16, 0, WL_O)[(size_t)nd * 1024 + k]), bf2f(f2bf(P.in[29 + C.z][(size_t)k * 1024 + nd])), 1e-6f);
            dbg_put(C, 0, bf2f(WL(bf16, 0, WL_BA)[(size_t)nd * 512 + (k & 511)]), bf2f(f2bf(P.in[27 + C.z][(size_t)(k & 511) * 1024 + nd])), 1e-6f);
            dbg_put(C, 0, bf2f(WL(bf16, 0, WL_BR)[(size_t)nd * 256 + (k & 255)]), bf2f(f2bf(P.in[26 + C.z][(size_t)(k & 255) * 1024 + nd])), 1e-6f);
        }
        {
            const int r = h1 % 33, j = h2 % 6144; float a = P.in[5 + C.z][j];
            for (int k = 0; k < 1024; ++k) { const float cv = (r < 32) ? P.in[1 + C.z][r * 1024 + k] : P.in[3 + C.z][k]; a += cv / (1.f + exp_f(-cv)) * P.in[4 + C.z][(size_t)k * 6144 + j]; }
            dbg_put(C, 1, WSP(float, WS_MOD)[(size_t)r * 6144 + j], a, 0.01f);
        }
    } else if (stage == 1) {
        const int tok = h1 % NT, col = h2 % 1024; const bool lat = tok < NLAT; const float* hp = lat ? P.in[0 + C.z] + (size_t)tok * DM : P.in[2 + C.z] + (size_t)(tok - NLAT) * DM;
        float ss = 0.f; for (int k = 0; k < 1024; ++k) ss += hp[k] * hp[k];
        const float* mp = WSP(float, WS_MOD) + (size_t)(lat ? tok / TL : 32) * 6144;
        const float ref = hp[col] * rsqrtf(ss / 1024.f + 1e-6f) * P.in[6 + C.z][col] * (1.f + mp[1024 + col]) + mp[col];
        dbg_put(C, 2, bf2f(WSP(bf16, WS_A)[(size_t)tok * DM + col]), ref, 0.05f);
    } else if (stage == 2) {
        const int tok = h1 % NT, n = h2 % 2432; const float ref = ndot(WSP(bf16, WS_A) + (size_t)tok * DM, WL(bf16, 0, WL_IN) + (size_t)n * 1024, 1024);
        float got; int k;
        if (n < 768) { got = bf2f(WSP(bf16, WS_X + X_QKV)[(size_t)tok * 768 + n]); k = 3; }
        else if (n < 1280) { const int sn = (n - 768) >> 8, ch = (n - 768) & 255; k = 4;
            if (tok < NLAT) got = bf2f(WSP(bf16, WS_X + X_ZT)[((size_t)(tok / TL) * 256 + ch) * 4096 + sn * 2048 + (tok % TL)]);
            else got = bf2f(WSP(bf16, WS_X + X_ZTC)[((size_t)((tok - NLAT) / TC) * 256 + ch) * 512 + sn * 256 + ((tok - NLAT) % TC)]); }
        else { got = bf2f(WSP(bf16, WS_X + X_UR)[(size_t)tok * RW + n - 1280]); k = 5; }
        dbg_put(C, k, got, ref, 0.1f);
    } else if (stage == 3) {
        const int b = h1 % 32, t = 1 + h2 % 2046, c = h3 % 256; const size_t tok = (size_t)b * TL + t; const bf16* UR = WSP(bf16, WS_X + X_UR);
        const float u = bf2f(UR[tok * RW + c]), up = bf2f(UR[(tok - 1) * RW + c]), un = bf2f(UR[(tok + 1) * RW + c]);
        dbg_put(C, 7, bf2f(WSP(bf16, WS_X + X_F)[tok * 256 + c]), u + P.in[11 + C.z][c] * (up - u) + P.in[11 + C.z][RW + c] * (un - u), 0.05f);
        float ss = 0.f; for (int k = 0; k < 64; ++k) { const float x = bf2f(WSP(bf16, WS_X + X_F)[FSZ + tok * 256 + (c & 192) + k]); ss += x * x; }
        dbg_put(C, 7, ss, 1.f, 0.f);
    } else if (stage == 4) {
        {
            LAS float* S = (LAS float*)C.lds; LAS float* sa = S + 4096; const bf16* F = WSP(bf16, WS_X + X_F); const int b = 1, h = 2;
            for (int dir = 0; dir < 2; ++dir) {
                for (int e = C.tid; e < 4096; e += NTHREADS) S[e] = 0.f;
                __syncthreads();
                for (int n = 0; n < 24; ++n) {
                    const size_t o = (size_t)scan_tok(n, dir, b) * 256 + h * 64;
                    if (C.tid < 64) { float a = 0.f; for (int k = 0; k < 64; ++k) a -= S[C.tid * 64 + k] * bf2f(F[FSZ + o + k]); sa[C.tid] = a; }
                    __syncthreads();
                    for (int e = C.tid; e < 4096; e += NTHREADS) { const int v = e >> 6, k = e & 63;
                        const float kk = bf2f(F[FSZ + o + k]), kr = bf2f(F[3 * FSZ + o + k]), ee = bf2f(F[(4 + dir) * FSZ + o + k]), a = bf2f(F[(6 + dir) * FSZ + o + k]), vv = bf2f(F[2 * FSZ + o + v]);
                        S[e] = S[e] * exp_f(-ee) + sa[v] * (kk * a) + vv * (kr * (1.f + (a - 1.f) * P.in[18 + C.z][h * 64 + k])); }
                    __syncthreads();
                    if (C.tid < 64) { float y = 0.f; for (int k = 0; k < 64; ++k) y += S[C.tid * 64 + k] * bf2f(F[o + k]);
                        dbg_put(C, 8, bf2f(WSP(bf16, WS_X + X_UR)[(size_t)dir * FSZ + o + C.tid]), y, 0.05f); }
                    __syncthreads();
                }
            }
        }
        {
            LAS float* qs = (LAS float*)C.lds + (size_t)C.tid * 65; const bf16* QKV = WSP(bf16, WS_X + X_QKV);
            const int b = h1 % 32, t = (C.tid & 1) ? (int)(h2 % 2048) : ((C.tid & 2) ? (int)(h2 % 200) : 2047 - (int)(h2 % 200)), hq = h3 % 8, dd = (h3 >> 8) % 64, kh = hq >> 2;
            const size_t tq = (size_t)b * TL + t;
            for (int d = 0; d < 64; ++d) { const int ax = d >> 5, hf = (d >> 4) & 1, f = d & 15; const int ps = ax ? (t & 63) : (t >> 6); const float cs = WSP(float, WS_SMALL)[(ps * 16 + f) * 2], sn = WSP(float, WS_SMALL)[(ps * 16 + f) * 2 + 1];
                const float x1 = bf2f(QKV[tq * 768 + hq * 64 + ax * 32 + f]), x2 = bf2f(QKV[tq * 768 + hq * 64 + ax * 32 + 16 + f]);
                qs[d] = hf ? (x2 * cs + x1 * sn) : (x1 * cs - x2 * sn); }
            float m = P.in[25 + C.z][hq], den = 1.f, acc = 0.f;
            for (int j = 0; j < 256 + 257; ++j) {
                const bool win = j >= 256; const int kp = win ? t - 128 + (j - 256) : j; if (win && (kp < 0 || kp >= TL)) continue;
                const size_t tk = win ? (size_t)b * TL + kp : (size_t)(CTXB + b * TC + kp); float s = 0.f;
                for (int d = 0; d < 64; ++d) { float kv;
                    if (!win) kv = bf2f(QKV[tk * 768 + 512 + kh * 64 + d]);
                    else { const int ax = d >> 5, hf = (d >> 4) & 1, f = d & 15; const int ps = ax ? (kp & 63) : (kp >> 6); const float cs = WSP(float, WS_SMALL)[(ps * 16 + f) * 2], sn = WSP(float, WS_SMALL)[(ps * 16 + f) * 2 + 1];
                        const float x1 = bf2f(QKV[tk * 768 + 512 + kh * 64 + ax * 32 + f]), x2 = bf2f(QKV[tk * 768 + 512 + kh * 64 + ax * 32 + 16 + f]);
                        kv = hf ? (x2 * cs + x1 * sn) : (x1 * cs - x2 * sn); }
                    s += qs[d] * kv; }
                s *= 0.125f; const float mn = fmaxf(m, s), al = exp_f(m - mn), p = exp_f(s - mn);
                den = den * al + p; acc = acc * al + p * bf2f(QKV[tk * 768 + 640 + kh * 64 + dd]); m = mn;
            }
            dbg_put(C, 9, bf2f(WSP(bf16, WS_A)[tq * 512 + hq * 64 + dd]), acc / den, 0.03f);
        }
        __syncthreads();
        {
            LAS float* qs = (LAS float*)C.lds + (size_t)C.tid * 65; const bf16* QKV = WSP(bf16, WS_X + X_QKV);
            const int b = h2 % 32, t = h1 % 256, hq = h3 % 8, dd = (h3 >> 8) % 64, kh = hq >> 2; const size_t tq = (size_t)(CTXB + b * TC + t);
            for (int d = 0; d < 64; ++d) qs[d] = bf2f(QKV[tq * 768 + hq * 64 + d]);
            float m = P.in[25 + C.z][hq], den = 1.f, acc = 0.f;
            for (int j = 0; j < 256; ++j) { const size_t tk = (size_t)(CTXB + b * TC + j); float s = 0.f;
                for (int d = 0; d < 64; ++d) s += qs[d] * bf2f(QKV[tk * 768 + 512 + kh * 64 + d]);
                s *= 0.125f; const float mn = fmaxf(m, s), al = exp_f(m - mn), p = exp_f(s - mn); den = den * al + p; acc = acc * al + p * bf2f(QKV[tk * 768 + 640 + kh * 64 + dd]); m = mn; }
            dbg_put(C, 10, bf2f(WSP(bf16, WS_A)[tq * 512 + hq * 64 + dd]), acc / den, 0.03f);
        }
        {
            const int b = h1 % 32, tp = h2 % 2048, ch = h3 % 256;
            dbg_put(C, 11, bf2f(WSP(bf16, WS_A + (size_t)72 * MiB)[((size_t)b * TL + tp) * 256 + ch]), ndot(WSP(bf16, WS_DFT) + (size_t)tp * 4096, WSP(bf16, WS_X + X_ZT) + ((size_t)b * 256 + ch) * 4096, 4096), 0.05f);
            const int tc = h2 % 256;
            dbg_put(C, 11, bf2f(WSP(bf16, WS_A + (size_t)72 * MiB)[((size_t)CTXB + b * TC + tc) * 256 + ch]), ndot(WSP(bf16, WS_DFTC) + (size_t)tc * 512, WSP(bf16, WS_X + X_ZTC) + ((size_t)b * 256 + ch) * 512, 512), 0.05f);
        }
    } else if (stage == 5) {
        const int tok = h1 % NT, col = h2 % 1024; const bf16* PP = WSP(bf16, WS_X + X_PP);
        dbg_put(C, 13, bf2f(PP[(size_t)tok * NGATE + col]), ndot(WSP(bf16, WS_A + (size_t)108 * MiB) + (size_t)tok * 256, WL(bf16, 0, WL_BR) + (size_t)col * 256, 256), 0.05f);
        dbg_put(C, 13, bf2f(PP[(size_t)tok * NGATE + 1024 + col]), ndot(WSP(bf16, WS_A) + (size_t)tok * 512, WL(bf16, 0, WL_BA) + (size_t)col * 512, 512), 0.05f);
        dbg_put(C, 13, bf2f(PP[(size_t)tok * NGATE + 2048 + col]), ndot(WSP(bf16, WS_A + (size_t)72 * MiB) + (size_t)tok * 256, WL(bf16, 0, WL_BF) + (size_t)col * 256, 256), 0.05f);
    } else if (stage == 6) {
        const int tok = h1 % NT, col = h2 % 1024; float ref = 0.f;
        for (int br = 0; br < 3; ++br) { const float gl = ndot(WSP(bf16, WS_A) + (size_t)tok * DM, WL(bf16, 0, WL_G) + (size_t)(br * 1024 + col) * 1024, 1024); ref += bf2f(WSP(bf16, WS_X + X_PP)[(size_t)tok * NGATE + br * 1024 + col]) / (1.f + exp_f(-gl)); }
        dbg_put(C, 14, bf2f(WSP(bf16, WS_X + X_UR)[(size_t)tok * DM + col]), ref, 0.05f);
    } else if (stage == 7) {
        const int tok = h1 % NT, col = h2 % 1024;
        dbg_put(C, 15, bf2f(WSP(bf16, WS_X + X_MIX)[(size_t)tok * DM + col]), ndot(WSP(bf16, WS_X + X_UR) + (size_t)tok * DM, WL(bf16, 0, WL_O) + (size_t)col * 1024, 1024), 0.05f);
    } else if (stage == 8) {
        const int tok = h1 % NT, col = h2 % 1024; const bool lat = tok < NLAT; const float* hp = lat ? P.in[0 + C.z] + (size_t)tok * DM : P.in[2 + C.z] + (size_t)(tok - NLAT) * DM;
        const bf16* mx = WSP(bf16, WS_X + X_MIX) + (size_t)tok * DM; const float* mp = WSP(float, WS_MOD) + (size_t)(lat ? tok / TL : 32) * 6144;
        float ss = 0.f; for (int k = 0; k < 1024; ++k) ss += bf2f(mx[k]) * bf2f(mx[k]);
        const float rs = rsqrtf(ss / 1024.f + 1e-6f); float s2 = 0.f, hc = 0.f;
        for (int k = 0; k < 1024; ++k) { const float hn = hp[k] + mp[2048 + k] * bf2f(mx[k]) * rs * P.in[7 + C.z][k]; s2 += hn * hn; if (k == col) hc = hn; }
        const float* ho = lat ? C.out + (size_t)tok * DM : WSP(float, WS_HC) + (size_t)(tok - NLAT) * DM;
        dbg_put(C, 16, ho[col], hc, 0.01f);
        dbg_put(C, 16, bf2f(WSP(bf16, WS_A)[(size_t)tok * DM + col]), hc * rsqrtf(s2 / 1024.f + 1e-6f) * P.in[8 + C.z][col] * (1.f + mp[4096 + col]) + mp[3072 + col], 0.05f);
    } else if (stage == 9) {
        int tok = h1 % NT; if (C.tid & 1) tok = (tok & ~63) + ((C.tid & 2) ? 63 : 0);
        const int j = h2 % DFF; const int t = (tok < NLAT) ? (tok % TL) : ((tok - NLAT) % TC), T = (tok < NLAT) ? TL : TC;
        const bf16* A = WSP(bf16, WS_A); const bf16* wu = WL(bf16, 0, WL_UP); const int pn = j >> 7, jj = j & 127;
        const bf16* wg = wu + (size_t)(pn * 256 + jj) * 1024; const bf16* wv = wu + (size_t)(pn * 256 + 128 + jj) * 1024;
        const float zc = ndot(A + (size_t)tok * DM, wg, 1024), zp = (t > 0) ? ndot(A + (size_t)(tok - 1) * DM, wg, 1024) : 0.f, zn = (t < T - 1) ? ndot(A + (size_t)(tok + 1) * DM, wg, 1024) : 0.f, zv = ndot(A + (size_t)tok * DM, wv, 1024);
        const float z = P.in[31 + C.z][j] * zp + P.in[31 + C.z][DFF + j] * zc + P.in[31 + C.z][2 * DFF + j] * zn + P.in[32 + C.z][j];
        const float ge = 0.5f * z * (1.f + tanh_(0.7978845608028654f * (z + 0.044715f * z * z * z)));
        dbg_put(C, 17, bf2f(WSP(bf16, WS_X + X_HH)[(size_t)tok * DFF + j]), ge * zv, 0.05f);
    } else if (stage == 10) {
        const int tok = h1 % NT, col = h2 % 1024;
        dbg_put(C, 18, bf2f(WSP(bf16, WS_X + X_FFO)[(size_t)tok * DM + col]), ndot(WSP(bf16, WS_X + X_HH) + (size_t)tok * DFF, WL(bf16, 0, WL_DN) + (size_t)col * DFF, DFF), 0.05f);
    }
}
DI void dbg_report(const Ctx& C) {
    if (C.bid == 0 && threadIdx.x == 0) {
        int first = -1; for (int k = 0; k < 24; ++k) if (first < 0 && __builtin_bit_cast(float, WSP(unsigned, WS_CTL)[1024 + k]) > 0.05f) first = k;
        if (first >= 0) C.out[12345] = 1000.f * (float)(first + 1);
    }
}
#define DBGCHK(stage) do { grid.sync(); dbg_check(CK, stage, l); grid.sync(); } while (0)
#else
#define DBGCHK(stage) do { } while (0)
#endif
__global__ void __launch_bounds__(NTHREADS, 2) fwd_kernel(Params P) {
    extern __shared__ __attribute__((aligned(16))) unsigned char lds_raw[];
    cg::grid_group grid = cg::this_grid();
    const int tid_ = threadIdx.x;
    const Ctx CK{(LAS unsigned char*)lds_raw, P.ws, P, P.out, tid_, tid_ & 63, __builtin_amdgcn_readfirstlane(tid_ >> 6), (int)gridDim.x, (int)blockIdx.x, 0};
#define PH_BEGIN { const Ctx C = rectx(CK); LAS unsigned char* glds = C.lds;
#define PH_END }
#define ABUF WSP(bf16, WS_A)
#define HCB WSP(float, WS_HC)
#define MODL(ll) (WSP(float, WS_MOD) + (size_t)(ll) * 33 * 6144)
#define HIN_L ((l == 0) ? C.P.in[0 + C.z] : (const float*)C.out)
#define HIN_C ((l == 0) ? C.P.in[2 + C.z] : (const float*)HCB)
#define GEMM_STD(Aptr, Bptr, M_, N_, K_, EPI, ...) do { pg8::Gemm g{Aptr, Bptr, M_, N_, K_}; pg8::StaticOrder S; S.init(M_, N_, C.G, C.bid); EPI E{__VA_ARGS__}; pg8::gemm_phase<EPI, pg8::StaticOrder, true, true>(glds, g, S, E); } while (0)
    prologue(CK);
    grid.sync();
    { const int l = 0; DBGCHK(0); }
    for (int l = 0; l < 2; ++l) {
        const int Mmix = (l == 0) ? NT : NLAT;
        if (l == 0) { PH_BEGIN rowop<false, true>(C, NT, HIN_L, HIN_C, nullptr, nullptr, nullptr, 0, nullptr, C.P.in[6 + C.z] + l * DM, 0, 1, MODL(l), MODL(l), ABUF); PH_END grid.sync(); DBGCHK(1); }
        PH_BEGIN
            GEMM_STD(ABUF, WL(bf16, l, WL_IN), NT, NIN, DM, EpiIn, WSP(bf16, WS_X + X_QKV), WSP(bf16, WS_X + X_ZT), WSP(bf16, WS_X + X_ZTC), WSP(bf16, WS_X + X_UR));
        PH_END
        grid.sync(); DBGCHK(2);
        feat_phase(CK, l);
        grid.sync(); DBGCHK(3);
        if (CK.bid < 128) scan_run(CK, l, CK.bid >> 2, CK.bid & 3);
        else {
            PH_BEGIN
                pg8::Gemm g{WSP(bf16, WS_DFT), WSP(bf16, WS_X + X_ZT), 2048, 8192, 4096}; pg8::StaticOrder S; S.init(2048, 8192, C.G - 128, C.bid - 128);
                EpiStore E{WSP(bf16, WS_A + (size_t)72 * MiB), 256, 0, 2048, 0};
                pg8::gemm_phase<EpiStore, pg8::StaticOrder, true, true>(glds, g, S, E);
            PH_END
            if (l == 0) { PH_BEGIN
                pg8::Gemm g{WSP(bf16, WS_DFTC), WSP(bf16, WS_X + X_ZTC), 256, 8192, 512}; pg8::StaticOrder S; S.init(256, 8192, C.G - 128, C.bid - 128);
                EpiStore E{WSP(bf16, WS_A + (size_t)72 * MiB), 256, CTXB, 256, 0};
                pg8::gemm_phase<EpiStore, pg8::StaticOrder, true, true>(glds, g, S, E);
            PH_END }
        }
        attn_loop(CK, l);
        grid.sync(); DBGCHK(4);
        readout_phase(CK, l, Mmix);
        grid.sync();
        PH_BEGIN GEMM_STD(WSP(bf16, WS_A + (size_t)108 * MiB), WL(bf16, l, WL_BR), Mmix, 1024, 256, EpiStore, WSP(bf16, WS_X + X_PP), NGATE, 0, 0, 256); PH_END
        PH_BEGIN GEMM_STD(WSP(bf16, WS_A), WL(bf16, l, WL_BA), Mmix, 1024, 512, EpiStore, WSP(bf16, WS_X + X_PP) + 1024, NGATE, 0, 0, 256); PH_END
        PH_BEGIN GEMM_STD(WSP(bf16, WS_A + (size_t)72 * MiB), WL(bf16, l, WL_BF), Mmix, 1024, 256, EpiStore, WSP(bf16, WS_X + X_PP) + 2048, NGATE, 0, 0, 256); PH_END
        grid.sync(); DBGCHK(5);
        PH_BEGIN rowop<false, true>(C, Mmix, HIN_L, HIN_C, nullptr, nullptr, nullptr, 0, nullptr, C.P.in[6 + C.z] + l * DM, 0, 1, MODL(l), MODL(l), ABUF); PH_END
        grid.sync();
        PH_BEGIN
            pg8::Gemm g{ABUF, WL(bf16, l, WL_G), Mmix, NGATE, DM}; GateOrder S{(Mmix / 256) * 4, C.G, C.bid};
            EpiGate E{WSP(bf16, WS_X + X_PP), WSP(bf16, WS_X + X_UR)};
            pg8::gemm_phase<EpiGate, GateOrder, true, true>(glds, g, S, E);
        PH_END
        grid.sync(); DBGCHK(6);
        PH_BEGIN GEMM_STD(WSP(bf16, WS_X + X_UR), WL(bf16, l, WL_O), Mmix, DM, DM, EpiStore, WSP(bf16, WS_X + X_MIX), DM, 0, 0, 256); PH_END
        grid.sync(); DBGCHK(7);
        PH_BEGIN rowop<true, true>(C, Mmix, HIN_L, HIN_C, C.out, HCB, WSP(bf16, WS_X + X_MIX), 2, C.P.in[7 + C.z] + l * DM, C.P.in[8 + C.z] + l * DM, 3, 4, MODL(l), MODL(l), ABUF); PH_END
        grid.sync(); DBGCHK(8);
        PH_BEGIN GEMM_STD(ABUF, WL(bf16, l, WL_UP), Mmix, 2 * DFF, DM, EpiUp, WSP(bf16, WS_X + X_HH), WSP(bf16, WS_X + X_HALO), C.P.in[31 + C.z] + (size_t)l * 3 * DFF, C.P.in[32 + C.z] + (size_t)l * DFF); PH_END
        grid.sync();
        fixup_phase(CK, l, Mmix);
        grid.sync(); DBGCHK(9);
        PH_BEGIN GEMM_STD(WSP(bf16, WS_X + X_HH), WL(bf16, l, WL_DN), Mmix, DM, DFF, EpiStore, WSP(bf16, WS_X + X_FFO), DM, 0, 0, 256); PH_END
        grid.sync(); DBGCHK(10);
        if (l == 0) { PH_BEGIN rowop<true, true>(C, NT, C.out, HCB, C.out, HCB, WSP(bf16, WS_X + X_FFO), 5, C.P.in[9 + C.z] + l * DM, C.P.in[6 + C.z] + (l + 1) * DM, 0, 1, MODL(l), MODL(l + 1), ABUF); PH_END grid.sync(); }
        else { PH_BEGIN rowop<true, false>(C, NLAT, C.out, HCB, C.out, HCB, WSP(bf16, WS_X + X_FFO), 5, C.P.in[9 + C.z] + l * DM, nullptr, 0, 1, MODL(l), MODL(l), nullptr); PH_END }
    }
#ifdef DBG
    grid.sync(); dbg_report(CK);
#endif
}


extern "C" void kernel_launch(void* const* d_in, const int* in_sizes, int n_in, void* d_out, int out_size, void* d_ws, size_t ws_size, hipStream_t stream) {
    static int grid = 0;
    if (grid == 0) {
        if (n_in != 34 || out_size != NLAT * DM || ws_size < WS_TOTAL) { fprintf(stderr, "kernel_launch: unexpected shapes (n_in %d out %d ws %zu, need %zu)\n", n_in, out_size, ws_size, (size_t)WS_TOTAL); grid = -1; return; }
        int dev = 0, cus = 0, per_cu = 0;
        hipGetDevice(&dev); hipDeviceGetAttribute(&cus, hipDeviceAttributeMultiprocessorCount, dev);
        if (hipFuncSetAttribute((const void*)fwd_kernel, hipFuncAttributeMaxDynamicSharedMemorySize, LDS_BYTES) != hipSuccess) { fprintf(stderr, "kernel_launch: hipFuncSetAttribute failed\n"); grid = -1; return; }
        hipOccupancyMaxActiveBlocksPerMultiprocessor(&per_cu, (const void*)fwd_kernel, NTHREADS, LDS_BYTES);
        (void)hipGetLastError();
        if (per_cu < 1 || cus < 136) { fprintf(stderr, "kernel_launch: occupancy %d, cus %d\n", per_cu, cus); grid = -1; return; }
        grid = cus;
    }
    if (grid < 0) return;
    (void)hipMemsetAsync((char*)d_ws + WS_CTL, 0, 1 * MiB, stream);
    Params p{};
    for (int i = 0; i < 34; ++i) p.in[i] = (const float*)d_in[i];
    p.out = (float*)d_out; p.ws = (unsigned char*)d_ws;
    void* args[] = {&p};
    hipError_t e = hipLaunchCooperativeKernel((const void*)fwd_kernel, dim3(grid), dim3(NTHREADS), args, LDS_BYTES, stream);
    if (e != hipSuccess) fprintf(stderr, "kernel_launch: cooperative launch failed: %s (grid %d)\n", hipGetErrorString(e), grid);
}
```

```cpp
#define PROBE_A 2
#define PROBE_B 3
#include <hip/hip_runtime.h>
#include <hip/hip_cooperative_groups.h>
#include <cstdio>
#include <cstdint>
namespace cg = cooperative_groups;
__device__ __forceinline__ int otid() { int t = threadIdx.x; asm volatile("" : "+v"(t)); return t; }
namespace pg8 {
#define PG8_LAS __attribute__((address_space(3)))
typedef unsigned short bf16_t;
typedef short bf16x8 __attribute__((ext_vector_type(8)));
typedef float f32x4 __attribute__((ext_vector_type(4)));
typedef unsigned u32x4 __attribute__((ext_vector_type(4)));
constexpr int BM = 256, BK = 64, HALF = 128, HTB = HALF * BK * 2  , STAGE_BYTES = 8 * HTB, NXCD = 8, WGM = 8;

__host__ __device__ __forceinline__ int lds_byte(int r, int c) { const int st = (r >> 4) * 2 + (c >> 5), rr = r & 15, cc = c & 31, ob = rr * 64 + cc * 2; return st * 1024 + (ob ^ (((ob >> 9) & 1) << 5)); }
__host__ __device__ __forceinline__ void stage_rc(int b, int& R, int& C) { const int st = b / 1024, sb = b % 1024, swz = sb ^ (((sb >> 9) & 1) << 5); R = (st >> 1) * 16 + swz / 64; C = (st & 1) * 32 + (swz % 64) / 2; }
__host__ __device__ __forceinline__ int perm32(int rho) { const int n = rho >> 4, i = rho & 15; return 8 * (i >> 2) + 4 * n + (i & 3); }

struct Unit { int pm, pn; };
struct Gemm { const bf16_t* A; const bf16_t* Bt; int M, N, K; };

struct StaticOrder {
    int nM, nN, nwg, G, c;
    __host__ __device__ void init(int M, int N, int G_, int c_) { nM = M / BM; nN = N / BM; nwg = nM * nN; G = G_; c = c_; }
    __host__ __device__ bool next(int i, Unit& u) const {
        const long L = (long)i * G + c; if (L >= nwg) return false;
        int wgid = (int)L; { const int q = nwg / NXCD, r = nwg % NXCD, xcd = wgid % NXCD, off = wgid / NXCD; wgid = (xcd < r ? xcd * (q + 1) : r * (q + 1) + (xcd - r) * q) + off; }
        const int nig = WGM * nN, gid = wgid / nig, fm = gid * WGM, gsz = (nM - fm) < WGM ? (nM - fm) : WGM;
        u.pm = fm + ((wgid % nig) % gsz); u.pn = (wgid % nig) / gsz; return true;
    }
    __device__ __forceinline__ void a_ready(const Unit&) const {}
    __device__ __forceinline__ void done(const Unit&) const {}
};

__device__ __forceinline__ unsigned cvt_pk_bf16(float lo, float hi) { unsigned r; asm volatile("v_cvt_pk_bf16_f32 %0, %1, %2" : "=v"(r) : "v"(lo), "v"(hi)); return r; }
typedef float f32x2 __attribute__((ext_vector_type(2)));
__device__ __forceinline__ f32x2 gelu_pk(f32x2 v) {
    const f32x2 av = __builtin_elementwise_abs(v), d = av * 0.2316418882f + 1.0f;
    f32x2 t; t.x = __builtin_amdgcn_rcpf(d.x); t.y = __builtin_amdgcn_rcpf(d.y);
    f32x2 q = t * 0.5307027145f + (-0.7265760135f); q = q * t + 0.7107068705f; q = q * t + (-0.142248368f); q = q * t + 0.127414796f; q = q * t;
    const f32x2 s = (v * v) * (-0.72134752044f);
    f32x2 e; e.x = __builtin_amdgcn_exp2f(s.x); e.y = __builtin_amdgcn_exp2f(s.y);
    const f32x2 m = v * (q * e), r = v - m;
    f32x2 o; o.x = v.x < 0.f ? m.x : r.x; o.y = v.y < 0.f ? m.y : r.y; return o;
}

template <class Epi, class Sched, bool ALIGN_EPI = false, bool SP2 = false>
__device__ __forceinline__ void gemm_phase(PG8_LAS unsigned char* lds, const Gemm g, const Sched& S, const Epi& E) {
    const int tid = otid(), wid = __builtin_amdgcn_readfirstlane(tid >> 6), lane = tid & 63, wr = wid >> 2, wc = wid & 3, fr = lane & 15, fq = lane >> 4;
    const int K = g.K, nt = K / BK;
    unsigned voffA[2], voffB[2];
#pragma unroll
    for (int i = 0; i < 2; ++i) { int R, C; stage_rc(tid * 16 + i * 8192, R, C); const int Rb = Epi::PERM ? ((R & ~31) + perm32(R & 31)) : R;
        voffA[i] = (unsigned)(R * K + C) * 2u; voffB[i] = (unsigned)(Rb * K + C) * 2u; }
    const size_t kstep = (size_t)(BK * 2);
    const size_t hstep = (size_t)HALF * K * 2;
    const size_t tstep = 2 * hstep;
    const unsigned ldsw = (unsigned)wid * 1024u;
    const int aoff = lds_byte(wr * 64 + fr, fq * 8), boff = lds_byte(wc * 32 + fr, fq * 8);
#define PG8_SA(b, h) (((b) * 2 + (h)) * HTB)
#define PG8_SB(b, h) ((4 + (b) * 2 + (h)) * HTB)
#define PG8_STAGE(bufoff, gbase, voff) do { _Pragma("unroll") for (int _i = 0; _i < 2; ++_i) \
        __builtin_amdgcn_global_load_lds((const unsigned*)((const char*)(gbase) + (voff)[_i]), (PG8_LAS unsigned*)(lds + (bufoff) + ldsw + _i * 8192), 16, 0, 0); } while (0)
#define PG8_LDA(dst, b, h) do { _Pragma("unroll") for (int m = 0; m < 4; ++m) _Pragma("unroll") for (int k = 0; k < 2; ++k) dst[m][k] = *(const PG8_LAS bf16x8*)(lds + PG8_SA(b, h) + aoff + m * 2048 + k * 1024); } while (0)
#define PG8_LDB(dst, b, h) do { _Pragma("unroll") for (int n = 0; n < 2; ++n) _Pragma("unroll") for (int k = 0; k < 2; ++k) dst[n][k] = *(const PG8_LAS bf16x8*)(lds + PG8_SB(b, h) + boff + n * 2048 + k * 1024); } while (0)
#define PG8_MMA(ai, bj, At, Bt) do { __builtin_amdgcn_s_setprio(1); _Pragma("unroll") for (int m = 0; m < 4; ++m) _Pragma("unroll") for (int n = 0; n < 2; ++n) _Pragma("unroll") for (int k = 0; k < 2; ++k) \
        acc[ai][bj][m][n] = __builtin_amdgcn_mfma_f32_16x16x32_bf16(Bt[n][k], At[m][k], acc[ai][bj][m][n], 0, 0, 0); __builtin_amdgcn_s_setprio(0); } while (0)
#define PG8_WAIT_V(n) asm volatile("s_waitcnt vmcnt(" #n ")" ::: "memory")
#define PG8_WAIT_L(n) asm volatile("s_waitcnt lgkmcnt(" #n ")" ::: "memory")
#define PG8_BAR __builtin_amdgcn_s_barrier()
#define PG8_SCHED __builtin_amdgcn_sched_barrier(0)
    Unit cur, nxt; int ui = 0;
    if (!S.next(0, cur)) return;
    f32x4 acc[2][2][4][2];
#pragma unroll
    for (int a = 0; a < 2; ++a)
#pragma unroll
        for (int b = 0; b < 2; ++b)
#pragma unroll
            for (int m = 0; m < 4; ++m)
#pragma unroll
                for (int n = 0; n < 2; ++n) acc[a][b][m][n] = (f32x4){0.f, 0.f, 0.f, 0.f};
    bf16x8 At[4][2], B0[2][2], B1[2][2];
    const char* cA = (const char*)g.A + (size_t)cur.pm * tstep; const char* cB = (const char*)g.Bt + (size_t)cur.pn * tstep;
    S.a_ready(cur);
    if constexpr (SP2) {
        PG8_STAGE(PG8_SB(0, 0), cB, voffB); PG8_STAGE(PG8_SB(0, 1), cB + hstep, voffB); PG8_STAGE(PG8_SA(0, 0), cA, voffA); PG8_STAGE(PG8_SA(0, 1), cA + hstep, voffA);
        if (wr == 1) PG8_BAR;
        PG8_WAIT_V(2); PG8_BAR;
        PG8_STAGE(PG8_SB(1, 0), cB + kstep, voffB); PG8_STAGE(PG8_SA(1, 0), cA + kstep, voffA); PG8_STAGE(PG8_SB(1, 1), cB + hstep + kstep, voffB);
        PG8_WAIT_V(6); PG8_BAR;
    } else {
        PG8_STAGE(PG8_SB(0, 0), cB, voffB); PG8_STAGE(PG8_SA(0, 0), cA, voffA); PG8_STAGE(PG8_SB(0, 1), cB + hstep, voffB); PG8_STAGE(PG8_SA(0, 1), cA + hstep, voffA);
        if (wr == 1) PG8_BAR;
        PG8_WAIT_V(4); PG8_BAR;
        PG8_STAGE(PG8_SB(1, 0), cB + kstep, voffB); PG8_STAGE(PG8_SA(1, 0), cA + kstep, voffA); PG8_STAGE(PG8_SB(1, 1), cB + hstep + kstep, voffB);
        PG8_WAIT_V(6); PG8_BAR;
    }
    for (;;) {
        const bool has_next = S.next(ui + 1, nxt);
        const char* nA = has_next ? (const char*)g.A + (size_t)nxt.pm * tstep : cA; const char* nB = has_next ? (const char*)g.Bt + (size_t)nxt.pn * tstep : cB;
        for (int t = 0; t < nt; t += 2) {
            const bool last = (t == nt - 2);
            const char* a1 = cA + (size_t)(t + 1) * kstep;
            const char* a2 = last ? nA : cA + (size_t)(t + 2) * kstep; const char* b2 = last ? nB : cB + (size_t)(t + 2) * kstep;
            const char* a3 = a2 + kstep; const char* b3 = b2 + kstep;
            if (last && has_next) S.a_ready(nxt);
            if constexpr (SP2) {
            PG8_LDB(B0, 0, 0); PG8_LDB(B1, 0, 1); PG8_SCHED; PG8_LDA(At, 0, 0); PG8_STAGE(PG8_SA(1, 1), a1 + hstep, voffA);
            PG8_WAIT_V(8); PG8_WAIT_L(0); PG8_BAR; PG8_MMA(0, 0, At, B0); PG8_MMA(0, 1, At, B1); PG8_BAR; PG8_SCHED;
            PG8_LDA(At, 0, 1); PG8_STAGE(PG8_SB(0, 0), b2, voffB); PG8_STAGE(PG8_SB(0, 1), b2 + hstep, voffB); PG8_STAGE(PG8_SA(0, 0), a2, voffA);
            PG8_WAIT_V(8); PG8_WAIT_L(0); PG8_BAR; PG8_MMA(1, 0, At, B0); PG8_MMA(1, 1, At, B1); PG8_BAR; PG8_SCHED;
            PG8_LDB(B0, 1, 0); PG8_LDB(B1, 1, 1); PG8_SCHED; PG8_LDA(At, 1, 0); PG8_STAGE(PG8_SA(0, 1), a2 + hstep, voffA);
            PG8_WAIT_V(8); PG8_WAIT_L(0); PG8_BAR; PG8_MMA(0, 0, At, B0); PG8_MMA(0, 1, At, B1); PG8_BAR; PG8_SCHED;
            PG8_LDA(At, 1, 1); PG8_STAGE(PG8_SB(1, 0), b3, voffB); PG8_STAGE(PG8_SB(1, 1), b3 + hstep, voffB); PG8_STAGE(PG8_SA(1, 0), a3, voffA);
            PG8_WAIT_V(8); PG8_WAIT_L(0); PG8_BAR; PG8_MMA(1, 0, At, B0); PG8_MMA(1, 1, At, B1); PG8_BAR; PG8_SCHED;
            } else {
            PG8_LDB(B0, 0, 0); PG8_SCHED; PG8_LDA(At, 0, 0); PG8_STAGE(PG8_SA(1, 1), a1 + hstep, voffA);
            PG8_WAIT_L(8); PG8_BAR; PG8_WAIT_L(0); PG8_MMA(0, 0, At, B0); PG8_BAR; PG8_SCHED;
            PG8_LDB(B1, 0, 1); PG8_STAGE(PG8_SB(0, 0), b2, voffB);
            PG8_BAR; PG8_WAIT_L(0); PG8_MMA(0, 1, At, B1); PG8_BAR;
            PG8_LDA(At, 0, 1); PG8_STAGE(PG8_SA(0, 0), a2, voffA);
            PG8_BAR; PG8_WAIT_L(0); PG8_MMA(1, 0, At, B0); PG8_BAR; PG8_SCHED;
            PG8_STAGE(PG8_SB(0, 1), b2 + hstep, voffB);
            PG8_WAIT_V(6); PG8_BAR; PG8_MMA(1, 1, At, B1); PG8_BAR;
            PG8_LDB(B0, 1, 0); PG8_SCHED; PG8_LDA(At, 1, 0); PG8_STAGE(PG8_SA(0, 1), a2 + hstep, voffA);
            PG8_WAIT_L(8); PG8_BAR; PG8_WAIT_L(0); PG8_MMA(0, 0, At, B0); PG8_BAR; PG8_SCHED;
            PG8_LDB(B1, 1, 1); PG8_STAGE(PG8_SB(1, 0), b3, voffB);
            PG8_BAR; PG8_WAIT_L(0); PG8_MMA(0, 1, At, B1); PG8_BAR;
            PG8_LDA(At, 1, 1); PG8_STAGE(PG8_SA(1, 0), a3, voffA);
            PG8_BAR; PG8_WAIT_L(0); PG8_MMA(1, 0, At, B0); PG8_BAR; PG8_SCHED;
            PG8_STAGE(PG8_SB(1, 1), b3 + hstep, voffB);
            PG8_WAIT_V(6); PG8_BAR; PG8_MMA(1, 1, At, B1); PG8_BAR;
            }
        }
        if constexpr (ALIGN_EPI) { if (wr == 0) PG8_BAR; }
        if constexpr (!Epi::AFTER_DRAIN) { E(acc, cur, wr, wc, fr, fq); S.done(cur); }
        if (!has_next) break;
#pragma unroll
        for (int a = 0; a < 2; ++a)
#pragma unroll
            for (int b = 0; b < 2; ++b)
#pragma unroll
                for (int m = 0; m < 4; ++m)
#pragma unroll
                    for (int n = 0; n < 2; ++n) acc[a][b][m][n] = (f32x4){0.f, 0.f, 0.f, 0.f};
        cur = nxt; cA = nA; cB = nB; ++ui;
        if constexpr (ALIGN_EPI) { if (wr == 1) PG8_BAR; }
    }
    PG8_WAIT_V(0);
    if constexpr (!ALIGN_EPI) { if (wr == 0) PG8_BAR; }
    PG8_BAR;
    if constexpr (Epi::AFTER_DRAIN) { E.fused(acc, cur, wr, wc, fr, fq, lds, wid, lane); S.done(cur); }
#undef PG8_SA
#undef PG8_SB
#undef PG8_STAGE
#undef PG8_LDA
#undef PG8_LDB
#undef PG8_MMA
#undef PG8_WAIT_V
#undef PG8_WAIT_L
#undef PG8_BAR
#undef PG8_SCHED
}
}

#define DI __device__ __forceinline__
#define LAS __attribute__((address_space(3)))
typedef unsigned short bf16;
typedef float f32x4 __attribute__((ext_vector_type(4)));
typedef float f32x2 __attribute__((ext_vector_type(2)));
typedef float f32x16 __attribute__((ext_vector_type(16)));
typedef short bf16x8 __attribute__((ext_vector_type(8)));
typedef short s16x4 __attribute__((ext_vector_type(4)));
typedef unsigned u32x4 __attribute__((ext_vector_type(4)));
typedef unsigned u32x2 __attribute__((ext_vector_type(2)));
typedef __bf16 bf16x2_t __attribute__((ext_vector_type(2)));

constexpr int DM = 1024, NB = 32, TL = 2048, TC = 256, NLAT = NB * TL, NCTX = NB * TC, NT = NLAT + NCTX, CTXB = NLAT;
constexpr int DFF = 2816, RW = 1152, NIN = 2560, NGATE = 3072;
constexpr int IN_COLS = 5248;
constexpr float LOG2E = 1.4426950408889634f;
constexpr int NTHREADS = 512, NWAVES = 8;
constexpr int LDS_BYTES = 147456;

constexpr size_t MiB = 1u << 20;
constexpr size_t WS_CTL = 0;
constexpr size_t WS_MOD = 1 * MiB;
constexpr size_t WS_SMALL = 3 * MiB;
constexpr size_t WS_BON = 4 * MiB;
constexpr size_t WS_W = 6 * MiB;
constexpr size_t WL_IN = 0, WL_G = 5 * MiB, WL_BR = 11 * MiB, WL_BA = 11 * MiB + 512 * 1024, WL_BF = 12 * MiB + 512 * 1024, WL_O = 13 * MiB, WL_UP = 15 * MiB, WL_DN = 26 * MiB, WL_SIZE = 32 * MiB;
constexpr size_t WS_DFT = WS_W + 2 * WL_SIZE;
constexpr size_t WS_DFTC = WS_DFT + 16 * MiB;
constexpr size_t WS_HC = WS_DFTC + 1 * MiB;
constexpr size_t WS_A = WS_HC + 32 * MiB;
constexpr size_t WS_VF = WS_A + 144 * MiB;
constexpr size_t WS_X = WS_VF + 36 * MiB;
constexpr size_t X_F = 0;
constexpr size_t X_QKV = 288 * MiB;
constexpr size_t X_ZT = 396 * MiB;
constexpr size_t X_ZTC = 460 * MiB;
constexpr size_t X_UR = 504 * MiB;
constexpr size_t X_G = 468 * MiB;
constexpr size_t X_LO = 504 * MiB;
constexpr size_t X_END = 720 * MiB;
constexpr size_t WS_WLORA = WS_X + X_END;
constexpr int KLO = 640, NLO = 1536;
constexpr size_t X_PP = 0;
constexpr size_t X_MIX = 0;
constexpr size_t X_HH = 0;
constexpr size_t X_HALO = 396 * MiB;
constexpr size_t X_FFO = 436 * MiB;
constexpr size_t WS_TOTAL = WS_WLORA + 4 * MiB;
constexpr size_t FSZ = (size_t)NT * 256;

struct Params { const float* in[34]; float* out; unsigned char* ws; };

DI float bf2f(bf16 v) { return __builtin_bit_cast(float, (unsigned)v << 16); }
DI float lo2f(unsigned u) { return __builtin_bit_cast(float, u << 16); }
DI float hi2f(unsigned u) { return __builtin_bit_cast(float, u & 0xffff0000u); }
DI unsigned pk(float lo, float hi) { f32x2 v = {lo, hi}; bf16x2_t b = __builtin_convertvector(v, bf16x2_t); return __builtin_bit_cast(unsigned, b); }
DI bf16 f2bf(float x) { return (bf16)(pk(x, 0.f) & 0xffffu); }
DI float fexp2(float x) { return __builtin_amdgcn_exp2f(x); }
DI float frcp(float x) { return __builtin_amdgcn_rcpf(x); }
DI float sigm(float x) { return frcp(1.f + fexp2(-x * LOG2E)); }
DI float tanh_(float x) { return 2.f * sigm(2.f * x) - 1.f; }
DI float gelu_tanh(float z) { const float u = 1.5957691216057308f * (z + 0.044715f * z * z * z); return z * sigm(u); }
DI float wave_sum(float v) {
#pragma unroll
    for (int o = 1; o < 64; o <<= 1) v += __shfl_xor(v, o);
    return v;
}
template <int CTRL, bool BC> DI float dppf(float old, float src) {
    return __builtin_bit_cast(float, __builtin_amdgcn_update_dpp(__builtin_bit_cast(int, old), __builtin_bit_cast(int, src), CTRL, 0xf, 0xf, BC));
}
DI float allred4(float x) {
    unsigned u = __builtin_bit_cast(unsigned, x);
    auto r = __builtin_amdgcn_permlane16_swap(u, u, false, false);
    float y = __builtin_bit_cast(float, (unsigned)r[0]) + __builtin_bit_cast(float, (unsigned)r[1]);
    unsigned v = __builtin_bit_cast(unsigned, y);
    auto s = __builtin_amdgcn_permlane32_swap(v, v, false, false);
    return __builtin_bit_cast(float, (unsigned)s[0]) + __builtin_bit_cast(float, (unsigned)s[1]);
}

DI u32x4 pack8(const f32x4& a, const f32x4& b) { u32x4 w; w.x = pk(a[0], a[1]); w.y = pk(a[2], a[3]); w.z = pk(b[0], b[1]); w.w = pk(b[2], b[3]); return w; }

struct EpiStore {
    static constexpr bool PERM = true, AFTER_DRAIN = false;
    bf16* O; int ld; int row_base, row_pn, col_pn;
    DI void operator()(const f32x4 (&acc)[2][2][4][2], const pg8::Unit& u, int wr, int wc, int fr, int fq) const {
        const int row0 = row_base + u.pn * row_pn + u.pm * 256 + wr * 64 + fr, col0 = u.pn * col_pn + wc * 32 + 8 * fq;
#pragma unroll
        for (int ai = 0; ai < 2; ++ai)
#pragma unroll
            for (int m = 0; m < 4; ++m) { bf16* rowp = O + (size_t)(row0 + ai * 128 + m * 16) * ld + col0;
#pragma unroll
                for (int bj = 0; bj < 2; ++bj) *(u32x4*)(rowp + bj * 128) = pack8(acc[ai][bj][m][0], acc[ai][bj][m][1]); }
    }
};

struct EpiIn {
    static constexpr bool PERM = true, AFTER_DRAIN = false;
    bf16 *QKV, *ZT, *ZTC, *UR;
    DI void operator()(const f32x4 (&acc)[2][2][4][2], const pg8::Unit& u, int wr, int wc, int fr, int fq) const {
        const int pn = u.pn, rl0 = wr * 64 + fr, cl = wc * 32 + 8 * fq;
        if (pn < 3) {
#pragma unroll
            for (int ai = 0; ai < 2; ++ai)
#pragma unroll
                for (int m = 0; m < 4; ++m) { bf16* rowp = QKV + (size_t)(u.pm * 256 + rl0 + ai * 128 + m * 16) * 768 + pn * 256 + cl;
#pragma unroll
                    for (int bj = 0; bj < 2; ++bj) *(u32x4*)(rowp + bj * 128) = pack8(acc[ai][bj][m][0], acc[ai][bj][m][1]); }
        } else if (pn < 5) {
            bf16* base; int stride;
            if (u.pm < 256) { const int b = u.pm >> 3, t0 = (u.pm & 7) * 256; base = ZT + (size_t)b * 256 * 4096 + (pn - 3) * 2048 + t0; stride = 4096; }
            else { const int b = u.pm - 256; base = ZTC + (size_t)b * 256 * 512 + (pn - 3) * 256; stride = 512; }
#pragma unroll
            for (int ai = 0; ai < 2; ++ai)
#pragma unroll
                for (int m = 0; m < 4; ++m) { const int rl = rl0 + ai * 128 + m * 16;
#pragma unroll
                    for (int bj = 0; bj < 2; ++bj)
#pragma unroll
                        for (int n = 0; n < 2; ++n)
#pragma unroll
                            for (int e = 0; e < 4; ++e) base[(size_t)(bj * 128 + cl + 4 * n + e) * stride + rl] = f2bf(acc[ai][bj][m][n][e]); }
        } else {
#pragma unroll
            for (int ai = 0; ai < 2; ++ai)
#pragma unroll
                for (int m = 0; m < 4; ++m) { bf16* rowp = UR + (size_t)(u.pm * 256 + rl0 + ai * 128 + m * 16) * RW + (pn - 5) * 256 + cl;
#pragma unroll
                    for (int bj = 0; bj < 2; ++bj) if ((pn - 5) * 256 + bj * 128 < RW) *(u32x4*)(rowp + bj * 128) = pack8(acc[ai][bj][m][0], acc[ai][bj][m][1]); }
        }
    }
};

struct EpiGate {
    static constexpr bool PERM = true, AFTER_DRAIN = false;
    const bf16* PP; bf16* MG;
    DI void operator()(const f32x4 (&acc)[2][2][4][2], const pg8::Unit& u, int wr, int wc, int fr, int fq) const {
        const int br = u.pn >> 2, cn = u.pn & 3, row0 = u.pm * 256 + wr * 64 + fr, col0 = cn * 256 + wc * 32 + 8 * fq;
#pragma unroll
        for (int ai = 0; ai < 2; ++ai)
#pragma unroll
            for (int m = 0; m < 4; ++m) { const size_t row = (size_t)(row0 + ai * 128 + m * 16);
#pragma unroll
                for (int bj = 0; bj < 2; ++bj) {
                    const u32x4 pp = *(const u32x4*)(PP + row * NGATE + br * 1024 + col0 + bj * 128);
                    bf16* mp = MG + row * 1024 + col0 + bj * 128;
                    f32x4 a = acc[ai][bj][m][0], b = acc[ai][bj][m][1];
                    a[0] = sigm(a[0]) * lo2f(pp.x); a[1] = sigm(a[1]) * hi2f(pp.x); a[2] = sigm(a[2]) * lo2f(pp.y); a[3] = sigm(a[3]) * hi2f(pp.y);
                    b[0] = sigm(b[0]) * lo2f(pp.z); b[1] = sigm(b[1]) * hi2f(pp.z); b[2] = sigm(b[2]) * lo2f(pp.w); b[3] = sigm(b[3]) * hi2f(pp.w);
                    if (br) { const u32x4 o = *(const u32x4*)mp;
                        a[0] += lo2f(o.x); a[1] += hi2f(o.x); a[2] += lo2f(o.y); a[3] += hi2f(o.y); b[0] += lo2f(o.z); b[1] += hi2f(o.z); b[2] += lo2f(o.w); b[3] += hi2f(o.w); }
                    *(u32x4*)mp = pack8(a, b); } }
    }
};

struct EpiUp {
    static constexpr bool PERM = true, AFTER_DRAIN = false;
    bf16* HH; bf16* HALO; const float* cw; const float* cb;
    DI void operator()(const f32x4 (&acc)[2][2][4][2], const pg8::Unit& u, int wr, int wc, int fr, int fq) const {
        const int j0 = 128 * u.pn + 32 * wc + 8 * fq;
        f32x4 w0[2], w1[2], w2[2], bb[2];
#pragma unroll
        for (int n = 0; n < 2; ++n) { w0[n] = *(const f32x4*)(cw + j0 + 4 * n); w1[n] = *(const f32x4*)(cw + DFF + j0 + 4 * n); w2[n] = *(const f32x4*)(cw + 2 * DFF + j0 + 4 * n); bb[n] = *(const f32x4*)(cb + j0 + 4 * n); }
#pragma unroll
        for (int ai = 0; ai < 2; ++ai) {
            const int grp = u.pm * 4 + ai * 2 + wr;
            bf16* hb = HALO + (size_t)grp * 6 * DFF + j0;
            if (fr < 2) { *(u32x4*)(hb + fr * DFF) = pack8(acc[ai][0][0][0], acc[ai][0][0][1]); if (fr == 0) *(u32x4*)(hb + 4 * DFF) = pack8(acc[ai][1][0][0], acc[ai][1][0][1]); }
            if (fr >= 14) { *(u32x4*)(hb + (fr - 12) * DFF) = pack8(acc[ai][0][3][0], acc[ai][0][3][1]); if (fr == 15) *(u32x4*)(hb + 5 * DFF) = pack8(acc[ai][1][3][0], acc[ai][1][3][1]); }
#pragma unroll
            for (int m = 0; m < 4; ++m) {
                f32x4 o[2];
#pragma unroll
                for (int n = 0; n < 2; ++n)
#pragma unroll
                    for (int e = 0; e < 4; ++e) {
                        const float x = acc[ai][0][m][n][e];
                        const float xm = (m > 0) ? acc[ai][0][m > 0 ? m - 1 : 0][n][e] : 0.f, xp = (m < 3) ? acc[ai][0][m < 3 ? m + 1 : 3][n][e] : 0.f;
                        const float t1 = dppf<0x121, true>(0.f, xm);
                        const float prev = dppf<0x111, false>(t1, x);
                        const float t2 = dppf<0x12F, true>(0.f, xp);
                        const float next = dppf<0x101, false>(t2, x);
                        const float z = w0[n][e] * prev + w1[n][e] * x + w2[n][e] * next + bb[n][e];
                        o[n][e] = gelu_tanh(z) * acc[ai][1][m][n][e];
                    }
                const bool edge = (m == 0 && fr == 0) || (m == 3 && fr == 15);
                if (!edge) *(u32x4*)(HH + (size_t)(u.pm * 256 + ai * 128 + wr * 64 + m * 16 + fr) * DFF + j0) = pack8(o[0], o[1]);
            }
        }
    }
};

struct GateOrder {
    int nU, G, c;
    DI bool next(int i, pg8::Unit& u) const { const int j = i / 3, br = i - 3 * j; const long L = (long)j * G + c; if (L >= nU) return false; u.pm = (int)(L >> 2); u.pn = br * 4 + (int)(L & 3); return true; }
    DI void a_ready(const pg8::Unit&) const {}
    DI void done(const pg8::Unit&) const {}
};

struct Ctx {
    LAS unsigned char* lds; unsigned char* ws; const Params& P; float* out;
    int tid, lane, wave, G, bid, z;
};
DI Ctx rectx(const Ctx& C0) { const int t = otid(); int z = 0; asm volatile("" : "+s"(z)); return Ctx{C0.lds, C0.P.ws + z, C0.P, C0.P.out + z, t, t & 63, __builtin_amdgcn_readfirstlane(t >> 6), C0.G, C0.bid, z}; }
#define WSP(T, off) ((T*)(C.ws + (off)))
#define WL(T, l, off) ((T*)(C.ws + WS_W + (size_t)(l) * WL_SIZE + (off)))

DI void tr_item(const float* src, int ldw, int k0, int n0, bf16* dst, int ldd, int drow0, LAS float* scr, int lane) {
#pragma unroll 8
    for (int i = 0; i < 32; ++i) { const int kk = 2 * i + (lane >> 5); scr[kk * 33 + (lane & 31)] = src[(size_t)(k0 + kk) * ldw + n0 + (lane & 31)]; }
    asm volatile("s_waitcnt lgkmcnt(0)" ::: "memory");
    const int c = lane & 7;
#pragma unroll
    for (int j = 0; j < 4; ++j) { const int n = (lane >> 3) + 8 * j; const LAS float* s = scr + (8 * c) * 33 + n;
        u32x4 o; o.x = pk(s[0 * 33], s[1 * 33]); o.y = pk(s[2 * 33], s[3 * 33]); o.z = pk(s[4 * 33], s[5 * 33]); o.w = pk(s[6 * 33], s[7 * 33]);
        *(u32x4*)(dst + (size_t)(drow0 + n) * ldd + k0 + 8 * c) = o; }
    asm volatile("s_waitcnt lgkmcnt(0)" ::: "memory");
}
DI void tr_matrix(const Ctx& C, const float* src, int ldw, int K, int n_src0, int ncols, bf16* dst, int drow0, LAS float* scr) {
    const int gw = C.bid * NWAVES + C.wave, NGW = C.G * NWAVES, nb = ncols / 32, nit = (K / 64) * nb;
    for (int it = gw; it < nit; it += NGW) { const int kb = it / nb, b = it % nb; tr_item(src, ldw, kb * 64, n_src0 + b * 32, dst, K, drow0 + b * 32, scr, C.lane); }
}

DI void prologue(const Ctx& C0) {
    const Ctx C = rectx(C0);
    LAS float* scr = (LAS float*)(C.lds + 49152 + C.wave * 8704);
    const int gth = C.bid * NTHREADS + C.tid, NGT = C.G * NTHREADS;
    for (int tsk = C.bid; tsk < 72; tsk += C.G) {
        const int l = tsk / 36, rem = tsk % 36, cb = rem / 3, rg = rem % 3;
        LAS float* s = (LAS float*)C.lds;
        for (int i = C.tid; i < 11 * 1024; i += NTHREADS) { const int r = rg * 11 + i / 1024, k = i % 1024; const float cv = (r < 32) ? C.P.in[1 + C.z][r * 1024 + k] : C.P.in[3 + C.z][k]; s[i] = cv * sigm(cv); }
        __syncthreads();
        const int j = cb * 512 + C.tid;
        float acc[11];
        const float bj = C.P.in[5 + C.z][l * 6144 + j];
#pragma unroll
        for (int i = 0; i < 11; ++i) acc[i] = bj;
        const float* wp = C.P.in[4 + C.z] + (size_t)l * 1024 * 6144 + j;
        for (int k = 0; k < 1024; k += 4) {
            const float w0 = wp[(size_t)k * 6144], w1 = wp[(size_t)(k + 1) * 6144], w2 = wp[(size_t)(k + 2) * 6144], w3 = wp[(size_t)(k + 3) * 6144];
#pragma unroll
            for (int i = 0; i < 11; ++i) { const f32x4 x = *(const LAS f32x4*)(s + i * 1024 + k); acc[i] += x[0] * w0 + x[1] * w1 + x[2] * w2 + x[3] * w3; }
        }
#pragma unroll
        for (int i = 0; i < 11; ++i) WSP(float, WS_MOD)[(size_t)(l * 33 + rg * 11 + i) * 6144 + j] = acc[i];
        __syncthreads();
    }
    if (C.bid == C.G - 1) for (int i = C.tid; i < 1024; i += NTHREADS) { const int p = i >> 4, f = i & 15; const float inv = powf(10000.f, -(float)f / 16.f), ang = (float)p * inv; WSP(float, WS_SMALL)[2 * i] = cosf(ang); WSP(float, WS_SMALL)[2 * i + 1] = sinf(ang); }
    for (int i = gth; i < 2048 * 4096 / 2; i += NGT) {
        const int tp = i / 2048, kk = (i % 2048) * 2; float v[2];
#pragma unroll
        for (int e = 0; e < 2; ++e) { const int k = kk + e, t = k & 2047; const int ph = (tp * t) & 2047; const float x = (float)ph * (1.f / 1024.f); v[e] = ((k < 2048) ? cospif(x) : -sinpif(x)) * 0.0027621358640099513f; }
        WSP(unsigned, WS_DFT)[i] = pk(v[0], v[1]);
    }
    for (int i = gth; i < 256 * 512 / 2; i += NGT) {
        const int tp = i / 256, kk = (i % 256) * 2; float v[2];
#pragma unroll
        for (int e = 0; e < 2; ++e) { const int k = kk + e, t = k & 255; const int ph = (tp * t) & 255; const float x = (float)ph * (1.f / 128.f); v[e] = ((k < 256) ? cospif(x) : -sinpif(x)) * 0.0078125f; }
        WSP(unsigned, WS_DFTC)[i] = pk(v[0], v[1]);
    }
    for (int l = 0; l < 2; ++l) {
        const float* win = C.P.in[10 + C.z] + (size_t)l * 1024 * IN_COLS;
        bf16* wi = WL(bf16, l, WL_IN);
        tr_matrix(C, win, IN_COLS, 1024, 1152, 512, wi, 0, scr);
        tr_matrix(C, win, IN_COLS, 1024, 1664, 128, wi, 512, scr);
        tr_matrix(C, win, IN_COLS, 1024, 1792, 128, wi, 640, scr);
        tr_matrix(C, win, IN_COLS, 1024, 0, 1152, wi, 1280, scr);
        for (int i = gth; i < 128 * 1024 / 2; i += NGT) ((unsigned*)(wi + (size_t)2432 * 1024))[i] = 0u;
        for (int i = gth; i < 512 * 1024; i += NGT) {
            const int k = i & 1023, np = i >> 10, sn = np >> 8, g = (np >> 6) & 3, cp = np & 63;
            const float* wr_ = win + (size_t)k * IN_COLS + 1920 + g * 64; float a = 0.f;
            for (int c = 0; c < 64; ++c) { const float x = (float)((c * cp) & 63) * (1.f / 32.f); a += wr_[c] * (sn ? sinpif(x) : cospif(x)); }
            wi[(size_t)(768 + np) * 1024 + k] = f2bf(a);
        }
        {
            bf16* wl = WSP(bf16, WS_WLORA + (size_t)l * 2 * MiB);
            const float* w2 = C.P.in[13 + C.z] + (size_t)l * 2 * 64 * 256; const float* a2 = C.P.in[15 + C.z] + (size_t)l * 2 * 64 * 256; const float* g2 = C.P.in[16 + C.z] + (size_t)l * 128 * 256;
            for (int i = gth; i < NLO * KLO; i += NGT) {
                const int c = i & 255, nb = (i >> 8) % 6, k = i / (256 * 6); float v = 0.f;
                if (nb == 0) { if (k < 64) v = w2[k * 256 + c]; }
                else if (nb == 1) { if (k >= 64 && k < 128) v = w2[(64 + k - 64) * 256 + c]; }
                else if (nb == 2) { if (k >= 128 && k < 192) v = a2[(k - 128) * 256 + c]; }
                else if (nb == 3) { if (k >= 192 && k < 256) v = a2[(64 + k - 192) * 256 + c]; }
                else if (nb == 4) { if (k >= 256 && k < 384) v = g2[(k - 256) * 256 + c]; }
                else if (l == 1 && k >= 384) { const float* v1 = C.P.in[23 + C.z] + (k - 384) * 32; const float* v2 = C.P.in[24 + C.z] + c; for (int j = 0; j < 32; ++j) v += v1[j] * v2[j * 256]; }
                wl[(size_t)(nb * 256 + c) * KLO + k] = f2bf(v);
            }
        }
        tr_matrix(C, win, IN_COLS, 1024, 2176, 3072, WL(bf16, l, WL_G), 0, scr);
        tr_matrix(C, C.P.in[26 + C.z] + (size_t)l * 256 * 1024, 1024, 256, 0, 1024, WL(bf16, l, WL_BR), 0, scr);
        tr_matrix(C, C.P.in[27 + C.z] + (size_t)l * 512 * 1024, 1024, 512, 0, 1024, WL(bf16, l, WL_BA), 0, scr);
        tr_matrix(C, C.P.in[28 + C.z] + (size_t)l * 256 * 1024, 1024, 256, 0, 1024, WL(bf16, l, WL_BF), 0, scr);
        tr_matrix(C, C.P.in[29 + C.z] + (size_t)l * 1024 * 1024, 1024, 1024, 0, 1024, WL(bf16, l, WL_O), 0, scr);
        {
            const float* up = C.P.in[30 + C.z] + (size_t)l * 1024 * 2 * DFF; bf16* wu = WL(bf16, l, WL_UP);
            const int gw = C.bid * NWAVES + C.wave, NGW = C.G * NWAVES, nit = 16 * 44 * 4;
            for (int it = gw; it < nit; it += NGW) { const int kb = it / 176, r = it % 176, seg = r >> 2, b = r & 3, pn = seg >> 1, bj = seg & 1;
                tr_item(up, 2 * DFF, kb * 64, bj * DFF + pn * 128 + b * 32, wu, 1024, pn * 256 + bj * 128 + b * 32, scr, C.lane); }
        }
        tr_matrix(C, C.P.in[33 + C.z] + (size_t)l * DFF * 1024, 1024, DFF, 0, 1024, WL(bf16, l, WL_DN), 0, scr);
    }
}

template <bool HAS_ADD, bool HAS_OUT>
DI void rowop(const Ctx& C0, int nrows, const float* hin_l, const float* hin_c, float* hout_l, float* hout_c, const bf16* add, int ga, const float* g_add, const float* g_out, int sh, int sc, const float* modl, const float* modo, bf16* Aout) {
    const Ctx C = rectx(C0);
    const int rpw = (nrows + C.G * NWAVES - 1) / (C.G * NWAVES), r0 = (C.bid * NWAVES + C.wave) * rpw, r1 = (r0 + rpw < nrows) ? r0 + rpw : nrows;
    if (r0 >= r1) return;
    const int c0 = 4 * C.lane;
    f32x4 gA[4], gO[4], mG[4], mS[4], mB[4];
#pragma unroll
    for (int j = 0; j < 4; ++j) { if (HAS_ADD) gA[j] = *(const f32x4*)(g_add + c0 + 256 * j); if (HAS_OUT) gO[j] = *(const f32x4*)(g_out + c0 + 256 * j); }
    int bcur = -1;
    f32x4 hn[4]; u32x2 an[4];
#define ROW_HP(t) (((t) < NLAT) ? hin_l + (size_t)(t) * DM : hin_c + (size_t)((t) - NLAT) * DM)
    { const float* hp = ROW_HP(r0);
#pragma unroll
      for (int j = 0; j < 4; ++j) { hn[j] = *(const f32x4*)(hp + c0 + 256 * j); if (HAS_ADD) an[j] = *(const u32x2*)(add + (size_t)r0 * DM + c0 + 256 * j); } }
    for (int tok = r0; tok < r1; ++tok) {
        f32x4 h[4]; u32x2 ar[4];
#pragma unroll
        for (int j = 0; j < 4; ++j) { h[j] = hn[j]; if (HAS_ADD) ar[j] = an[j]; }
        if (tok + 1 < r1) { const float* hp = ROW_HP(tok + 1);
#pragma unroll
            for (int j = 0; j < 4; ++j) { hn[j] = *(const f32x4*)(hp + c0 + 256 * j); if (HAS_ADD) an[j] = *(const u32x2*)(add + (size_t)(tok + 1) * DM + c0 + 256 * j); } }
        const bool lat = tok < NLAT; const int b = lat ? tok / TL : 32;
        if (b != bcur) { bcur = b; const float* mp = modl + (size_t)b * 6144; const float* mq = modo + (size_t)b * 6144;
#pragma unroll
            for (int j = 0; j < 4; ++j) { if (HAS_ADD) mG[j] = *(const f32x4*)(mp + ga * 1024 + c0 + 256 * j); if (HAS_OUT) { mS[j] = *(const f32x4*)(mq + sc * 1024 + c0 + 256 * j) + 1.f; mB[j] = *(const f32x4*)(mq + sh * 1024 + c0 + 256 * j); } } }
        if (HAS_ADD) {
            f32x4 a[4]; float ss = 0.f;
#pragma unroll
            for (int j = 0; j < 4; ++j) { a[j] = (f32x4){lo2f(ar[j].x), hi2f(ar[j].x), lo2f(ar[j].y), hi2f(ar[j].y)}; ss += a[j][0] * a[j][0] + a[j][1] * a[j][1] + a[j][2] * a[j][2] + a[j][3] * a[j][3]; }
            const float rstd = rsqrtf(wave_sum(ss) * (1.f / DM) + 1e-6f);
            float* op = lat ? hout_l + (size_t)tok * DM : hout_c + (size_t)(tok - NLAT) * DM;
#pragma unroll
            for (int j = 0; j < 4; ++j) { h[j] = h[j] + mG[j] * (a[j] * rstd * gA[j]); *(f32x4*)(op + c0 + 256 * j) = h[j]; }
        }
        if (HAS_OUT) {
            float ss = 0.f;
#pragma unroll
            for (int j = 0; j < 4; ++j) ss += h[j][0] * h[j][0] + h[j][1] * h[j][1] + h[j][2] * h[j][2] + h[j][3] * h[j][3];
            const float rstd = rsqrtf(wave_sum(ss) * (1.f / DM) + 1e-6f);
#pragma unroll
            for (int j = 0; j < 4; ++j) { const f32x4 y = (h[j] * rstd * gO[j]) * mS[j] + mB[j]; u32x2 o; o.x = pk(y[0], y[1]); o.y = pk(y[2], y[3]);
                *(u32x2*)(Aout + (size_t)tok * DM + c0 + 256 * j) = o; }
        }
    }
#undef ROW_HP
}

DI void feat1_phase(const Ctx& C0, int l) {
    const Ctx C = rectx(C0);
    const bf16* UR = WSP(bf16, WS_X + X_UR); bf16* F = WSP(bf16, WS_X + X_F); bf16* X2 = WSP(bf16, WS_A);
    const float* mu = C.P.in[11 + C.z] + (size_t)l * 2 * RW;
    const int gth = C.bid * NTHREADS + C.tid, NGT = C.G * NTHREADS;
    for (int idx = gth; idx < NT * 144; idx += NGT) {
        const int tok = idx / 144, pc = idx - tok * 144, cc = pc * 8;
        const int t = (tok < NLAT) ? (tok & (TL - 1)) : ((tok - NLAT) & (TC - 1)), T = (tok < NLAT) ? TL : TC;
        const bf16* up_ = UR + (size_t)tok * RW + cc;
        const u32x4 u = *(const u32x4*)up_;
        u32x4 p = {0u, 0u, 0u, 0u}, nx = {0u, 0u, 0u, 0u};
        if (t > 0) p = *(const u32x4*)(up_ - RW);
        if (t < T - 1) nx = *(const u32x4*)(up_ + RW);
        const f32x4 m0a = *(const f32x4*)(mu + cc), m0b = *(const f32x4*)(mu + cc + 4), m1a = *(const f32x4*)(mu + RW + cc), m1b = *(const f32x4*)(mu + RW + cc + 4);
        float s[8];
#pragma unroll
        for (int e = 0; e < 8; ++e) { const float uu = (e & 1) ? hi2f(u[e >> 1]) : lo2f(u[e >> 1]), pp = (e & 1) ? hi2f(p[e >> 1]) : lo2f(p[e >> 1]), nn = (e & 1) ? hi2f(nx[e >> 1]) : lo2f(nx[e >> 1]);
            const float m0 = (e < 4) ? m0a[e & 3] : m0b[e & 3], m1 = (e < 4) ? m1a[e & 3] : m1b[e & 3];
            s[e] = uu + m0 * (pp - uu) + m1 * (nn - uu); }
        if (cc >= 768 && cc < 896) {
#pragma unroll
            for (int e = 0; e < 8; ++e) s[e] = tanh_(s[e]); }
        else if (cc >= 1024) {
#pragma unroll
            for (int e = 0; e < 8; ++e) s[e] = sigm(s[e]); }
        u32x4 w; w.x = pk(s[0], s[1]); w.y = pk(s[2], s[3]); w.z = pk(s[4], s[5]); w.w = pk(s[6], s[7]);
        if (cc < 256) *(u32x4*)(F + (size_t)tok * 256 + cc) = w;
        else if (cc < 512) *(u32x4*)(F + 3 * FSZ + (size_t)tok * 256 + cc - 256) = w;
        else if (cc < 768) { *(u32x4*)(F + 2 * FSZ + (size_t)tok * 256 + cc - 512) = w; *(u32x4*)(X2 + (size_t)tok * KLO + 384 + cc - 512) = w; }
        else *(u32x4*)(X2 + (size_t)tok * KLO + cc - 768) = w;
    }
}
DI void feat3_phase(const Ctx& C0, int l) {
    const Ctx C = rectx(C0);
    bf16* F = WSP(bf16, WS_X + X_F); bf16* Gq = WSP(bf16, WS_X + X_G); bf16* VF = WSP(bf16, WS_VF); float* BON = WSP(float, WS_BON); const bf16* LO = WSP(bf16, WS_X + X_LO);
    const float* w0 = C.P.in[12 + C.z] + l * 512; const float* a0 = C.P.in[14 + C.z] + l * 512;
    const float* k_k = C.P.in[17 + C.z] + l * 256; const float* k_a = C.P.in[18 + C.z] + l * 256; const float* r_k = C.P.in[19 + C.z] + l * 256; const float* v0 = C.P.in[22 + C.z];
    const int rpw = NT / (256 * NWAVES), r0 = (C.bid * NWAVES + C.wave) * rpw;
    if (C.bid >= 256) return;
    float kkw[4], kaw[4], rkw[4], w0f[4], w0b[4], a0f[4], a0b[4], v0c[4];
#pragma unroll
    for (int h = 0; h < 4; ++h) { const int c = h * 64 + C.lane; kkw[h] = k_k[c]; kaw[h] = k_a[c]; rkw[h] = r_k[c]; w0f[h] = w0[c]; w0b[h] = w0[256 + c]; a0f[h] = a0[c]; a0b[h] = a0[256 + c]; v0c[h] = v0[c]; }
    for (int tok = r0; tok < r0 + rpw; ++tok) {
        bf16 rr[4], kr_[4], vr[4], lo[6][4], vfr[4];
#pragma unroll
        for (int h = 0; h < 4; ++h) { const int c = h * 64 + C.lane; const size_t o = (size_t)tok * 256 + c;
            rr[h] = F[o]; kr_[h] = F[3 * FSZ + o]; vr[h] = F[2 * FSZ + o]; if (l == 1) vfr[h] = VF[o];
#pragma unroll
            for (int q = 0; q < 6; ++q) if (q < 5 || l == 1) lo[q][h] = LO[(size_t)tok * NLO + q * 256 + c]; }
#pragma unroll
        for (int h = 0; h < 4; ++h) { const int c = h * 64 + C.lane; const size_t o = (size_t)tok * 256 + c;
            const float r = bf2f(rr[h]), k = bf2f(kr_[h]); float v = bf2f(vr[h]);
            if (l == 1) { const float vf = bf2f(vfr[h]); v = v + (vf - v) * sigm(v0c[h] + bf2f(lo[5][h])); F[2 * FSZ + o] = f2bf(v); } else VF[o] = vr[h];
            const float kr = k * kkw[h], ss = wave_sum(kr * kr), kk = kr * rsqrtf(fmaxf(ss, 1e-24f));
            const float ef = 0.6065306597126334f * sigm(w0f[h] + bf2f(lo[0][h])), eb = 0.6065306597126334f * sigm(w0b[h] + bf2f(lo[1][h]));
            const float af = sigm(a0f[h] + bf2f(lo[2][h])), ab = sigm(a0b[h] + bf2f(lo[3][h]));
            const float bon = wave_sum(r * k * (1.f + (0.5f * (af + ab) - 1.f) * kaw[h]) * rkw[h]);
            if (C.lane == 0) BON[(size_t)tok * 4 + h] = bon;
            F[FSZ + o] = f2bf(kk); F[4 * FSZ + o] = f2bf(ef); F[5 * FSZ + o] = f2bf(eb); F[6 * FSZ + o] = f2bf(af); F[7 * FSZ + o] = f2bf(ab);
            Gq[o] = lo[4][h]; }
    }
}

struct ScanOp { bf16 r, kk, k, e, a, v; };
DI int scan_tok(int n, int dir, int b) { n = n < 2303 ? n : 2303; if (n < 256) return CTXB + b * 256 + (dir ? 255 - n : n); const int t = n - 256; return b * TL + (dir ? TL - 1 - t : t); }
DI ScanOp scan_load(const bf16* Ft, int dir, int ck, int cv) {
    ScanOp o; o.r = Ft[ck]; o.kk = (Ft + FSZ)[ck]; o.k = (Ft + 3 * FSZ)[ck]; o.e = (Ft + (size_t)(4 + dir) * FSZ)[ck]; o.a = (Ft + (size_t)(6 + dir) * FSZ)[ck]; o.v = (Ft + 2 * FSZ)[cv]; return o;
}
#define DPPT " row_mask:0xf bank_mask:0xf\n\t"
#define SOPS(S) "+v"(S[0]), "+v"(S[1]), "+v"(S[2]), "+v"(S[3]), "+v"(S[4]), "+v"(S[5]), "+v"(S[6]), "+v"(S[7]), "+v"(S[8]), "+v"(S[9]), "+v"(S[10]), "+v"(S[11]), "+v"(S[12]), "+v"(S[13]), "+v"(S[14]), "+v"(S[15])
DI void scan_step(float (&S)[16], const ScanOp& op, float ka, bf16* yp, bool wr) {
    float r = bf2f(op.r), kk = bf2f(op.kk), k = bf2f(op.k), e = bf2f(op.e), a = bf2f(op.a); const float v = bf2f(op.v);
    float w = fexp2(-e * LOG2E), kd = k * (1.f + (a - 1.f) * ka), nbd = -(kk * a);
    asm volatile("s_nop 4" : "+v"(r), "+v"(w), "+v"(kd), "+v"(nbd), "+v"(kk));
    float sa0 = 0.f, sa1 = 0.f;
    asm volatile(
        "v_fmac_f32_dpp %16, %18, %0 row_newbcast:0" DPPT "v_fmac_f32_dpp %17, %18, %1 row_newbcast:1" DPPT "v_fmac_f32_dpp %16, %18, %2 row_newbcast:2" DPPT "v_fmac_f32_dpp %17, %18, %3 row_newbcast:3" DPPT
        "v_fmac_f32_dpp %16, %18, %4 row_newbcast:4" DPPT "v_fmac_f32_dpp %17, %18, %5 row_newbcast:5" DPPT "v_fmac_f32_dpp %16, %18, %6 row_newbcast:6" DPPT "v_fmac_f32_dpp %17, %18, %7 row_newbcast:7" DPPT
        "v_fmac_f32_dpp %16, %18, %8 row_newbcast:8" DPPT "v_fmac_f32_dpp %17, %18, %9 row_newbcast:9" DPPT "v_fmac_f32_dpp %16, %18, %10 row_newbcast:10" DPPT "v_fmac_f32_dpp %17, %18, %11 row_newbcast:11" DPPT
        "v_fmac_f32_dpp %16, %18, %12 row_newbcast:12" DPPT "v_fmac_f32_dpp %17, %18, %13 row_newbcast:13" DPPT "v_fmac_f32_dpp %16, %18, %14 row_newbcast:14" DPPT "v_fmac_f32_dpp %17, %18, %15 row_newbcast:15" DPPT
        : SOPS(S), "+v"(sa0), "+v"(sa1) : "v"(kk));
    const float sa = allred4(sa0 + sa1);
#define UPM(j) "v_mul_f32_dpp %" #j ", %16, %" #j " row_newbcast:" #j DPPT
#define UPA(j) "v_fmac_f32_dpp %" #j ", %17, %19 row_newbcast:" #j DPPT
#define UPB(j) "v_fmac_f32_dpp %" #j ", %18, %20 row_newbcast:" #j DPPT
#define ALL16(M) M(0) M(1) M(2) M(3) M(4) M(5) M(6) M(7) M(8) M(9) M(10) M(11) M(12) M(13) M(14) M(15)
    asm volatile(ALL16(UPM) ALL16(UPA) ALL16(UPB) : SOPS(S) : "v"(w), "v"(nbd), "v"(kd), "v"(sa), "v"(v));
#undef UPM
#undef UPA
#undef UPB
    float y0 = 0.f, y1 = 0.f;
    asm volatile(
        "v_fmac_f32_dpp %16, %18, %0 row_newbcast:0" DPPT "v_fmac_f32_dpp %17, %18, %1 row_newbcast:1" DPPT "v_fmac_f32_dpp %16, %18, %2 row_newbcast:2" DPPT "v_fmac_f32_dpp %17, %18, %3 row_newbcast:3" DPPT
        "v_fmac_f32_dpp %16, %18, %4 row_newbcast:4" DPPT "v_fmac_f32_dpp %17, %18, %5 row_newbcast:5" DPPT "v_fmac_f32_dpp %16, %18, %6 row_newbcast:6" DPPT "v_fmac_f32_dpp %17, %18, %7 row_newbcast:7" DPPT
        "v_fmac_f32_dpp %16, %18, %8 row_newbcast:8" DPPT "v_fmac_f32_dpp %17, %18, %9 row_newbcast:9" DPPT "v_fmac_f32_dpp %16, %18, %10 row_newbcast:10" DPPT "v_fmac_f32_dpp %17, %18, %11 row_newbcast:11" DPPT
        "v_fmac_f32_dpp %16, %18, %12 row_newbcast:12" DPPT "v_fmac_f32_dpp %17, %18, %13 row_newbcast:13" DPPT "v_fmac_f32_dpp %16, %18, %14 row_newbcast:14" DPPT "v_fmac_f32_dpp %17, %18, %15 row_newbcast:15" DPPT
        : SOPS(S), "+v"(y0), "+v"(y1) : "v"(r));
    const float y = allred4(y0 + y1);
    if (wr) *yp = f2bf(y);
}
DI void scan_run(const Ctx& C0, int l, int b, int h, int dir) {
    const Ctx C = rectx(C0);
    if (C.wave >= 4) return;
    const int wv = C.wave & 3, q = C.lane >> 4, vi = C.lane & 15;
    const int ck = h * 64 + C.lane, cv = h * 64 + 16 * wv + vi;
    const bf16* F = WSP(bf16, WS_X + X_F);
    bf16* YS = WSP(bf16, WS_X + X_UR) + (size_t)dir * FSZ;
    const float ka = C.P.in[18 + C.z][l * 256 + ck];
    float S[16];
#pragma unroll
    for (int j = 0; j < 16; ++j) S[j] = 0.f;
    const bool wr = (q == 0);
    size_t t0 = (size_t)scan_tok(0, dir, b) * 256, t1 = (size_t)scan_tok(1, dir, b) * 256, t2 = (size_t)scan_tok(2, dir, b) * 256, t3 = (size_t)scan_tok(3, dir, b) * 256;
    ScanOp o0 = scan_load(F + t0, dir, ck, cv), o1 = scan_load(F + t1, dir, ck, cv), o2 = scan_load(F + t2, dir, ck, cv), o3 = scan_load(F + t3, dir, ck, cv);
    for (int n = 0; n < 2304; n += 4) {
        size_t tn;
        scan_step(S, o0, ka, YS + t0 + cv, wr); tn = (size_t)scan_tok(n + 4, dir, b) * 256; o0 = scan_load(F + tn, dir, ck, cv); t0 = tn;
        scan_step(S, o1, ka, YS + t1 + cv, wr); tn = (size_t)scan_tok(n + 5, dir, b) * 256; o1 = scan_load(F + tn, dir, ck, cv); t1 = tn;
        scan_step(S, o2, ka, YS + t2 + cv, wr); tn = (size_t)scan_tok(n + 6, dir, b) * 256; o2 = scan_load(F + tn, dir, ck, cv); t2 = tn;
        scan_step(S, o3, ka, YS + t3 + cv, wr); tn = (size_t)scan_tok(n + 7, dir, b) * 256; o3 = scan_load(F + tn, dir, ck, cv); t3 = tn;
    }
}

DI void readout_phase(const Ctx& C0, int l, int nrows) {
    const Ctx C = rectx(C0);
    const int gw = C.bid * NWAVES + C.wave, NGW = C.G * NWAVES;
    const bf16* F = WSP(bf16, WS_X + X_F); const bf16* Gq = WSP(bf16, WS_X + X_G); const bf16* YS = WSP(bf16, WS_X + X_UR); const float* BON = WSP(float, WS_BON);
    bf16* YR = WSP(bf16, WS_A + (size_t)108 * MiB);
    const float* lw = C.P.in[20 + C.z] + l * 256; const float* lb = C.P.in[21 + C.z] + l * 256;
    for (int tok = gw; tok < nrows; tok += NGW) {
#pragma unroll
        for (int h = 0; h < 4; ++h) { const int c = h * 64 + C.lane; const size_t o = (size_t)tok * 256 + c;
            const float y = bf2f(YS[o]) + bf2f(YS[FSZ + o]); const float mean = wave_sum(y) * (1.f / 64.f), d = y - mean, var = wave_sum(d * d) * (1.f / 64.f);
            const float yn = d * rsqrtf(var + 64e-5f) * lw[c] + lb[c];
            YR[o] = f2bf((yn + BON[(size_t)tok * 4 + h] * bf2f(F[2 * FSZ + o])) * bf2f(Gq[o])); }
    }
}

DI void fixup_phase(const Ctx& C0, int l, int nrows) {
    const Ctx C = rectx(C0);
    const int gw = C.bid * NWAVES + C.wave, NGW = C.G * NWAVES, nitem = (nrows / 64) * 2;
    const bf16* HALO = WSP(bf16, WS_X + X_HALO); bf16* HH = WSP(bf16, WS_X + X_HH);
    const float* cw = C.P.in[31 + C.z] + (size_t)l * 3 * DFF; const float* cb = C.P.in[32 + C.z] + (size_t)l * DFF;
    for (int it = gw; it < nitem; it += NGW) {
        const int grp = it >> 1, last = it & 1, row = grp * 64 + (last ? 63 : 0);
        const int t = (row < NLAT) ? (row & (TL - 1)) : ((row - NLAT) & (TC - 1)), T = (row < NLAT) ? TL : TC;
        const bf16* hb = HALO + (size_t)grp * 6 * DFF;
        const bf16 *pp, *pc, *pn, *pv; bool zp = false, zn = false;
        if (!last) { pc = hb; pn = hb + DFF; pv = hb + 4 * DFF; zp = (t == 0); pp = zp ? hb : hb - 6 * DFF + 3 * DFF; }
        else { pp = hb + 2 * DFF; pc = hb + 3 * DFF; pv = hb + 5 * DFF; zn = (t == T - 1); pn = zn ? hb : hb + 6 * DFF; }
        for (int p = C.lane; p < DFF / 8; p += 64) { const int j = p * 8;
            const u32x4 a = *(const u32x4*)(pp + j), bq = *(const u32x4*)(pc + j), cq = *(const u32x4*)(pn + j), vq = *(const u32x4*)(pv + j);
            float o[8];
#pragma unroll
            for (int e = 0; e < 8; ++e) { const unsigned ua = a[e >> 1], ub = bq[e >> 1], uc = cq[e >> 1], uv = vq[e >> 1];
                const float xp = zp ? 0.f : ((e & 1) ? hi2f(ua) : lo2f(ua)), xc = (e & 1) ? hi2f(ub) : lo2f(ub), xn = zn ? 0.f : ((e & 1) ? hi2f(uc) : lo2f(uc)), xv = (e & 1) ? hi2f(uv) : lo2f(uv);
                const float z = cw[j + e] * xp + cw[DFF + j + e] * xc + cw[2 * DFF + j + e] * xn + cb[j + e]; o[e] = gelu_tanh(z) * xv; }
            u32x4 w; w.x = pk(o[0], o[1]); w.y = pk(o[2], o[3]); w.z = pk(o[4], o[5]); w.w = pk(o[6], o[7]);
            *(u32x4*)(HH + (size_t)row * DFF + j) = w; }
    }
}

DI int crow(int i, int hh) { return (i & 3) + 8 * (i >> 2) + 4 * hh; }
DI void attn_unit(const Ctx& C, int l, int b, int kh, int qblk, bool isctx) {
    LAS bf16* Ks = (LAS bf16*)C.lds; LAS bf16* Vt = Ks + 64 * 72;
    const bf16* QKV = WSP(bf16, WS_X + X_QKV); bf16* YA = WSP(bf16, WS_A); const float* RT = WSP(float, WS_SMALL);
    const int g = C.wave >> 1, qt = C.wave & 1, hq = kh * 4 + g, r = C.lane & 31, hh = C.lane >> 5;
    const int qi = qblk * 64 + qt * 32 + r;
    const size_t tq = isctx ? (size_t)(CTXB + b * TC + qi) : (size_t)(b * TL + qi);
    bf16x8 qf[4];
    {
        float qv[4][8]; const bf16* qp = QKV + tq * 768 + hq * 64 + 8 * hh;
#pragma unroll
        for (int ks = 0; ks < 4; ++ks) { const u32x4 u = *(const u32x4*)(qp + 16 * ks);
#pragma unroll
            for (int e = 0; e < 4; ++e) { qv[ks][2 * e] = lo2f(u[e]); qv[ks][2 * e + 1] = hi2f(u[e]); } }
        if (!isctx) { const int rid = qi >> 6, cid = qi & 63;
#pragma unroll
            for (int j = 0; j < 8; ++j) { const int f = 8 * hh + j;
                const float c0 = RT[(rid * 16 + f) * 2], s0 = RT[(rid * 16 + f) * 2 + 1], c1 = RT[(cid * 16 + f) * 2], s1 = RT[(cid * 16 + f) * 2 + 1];
                const float a1 = qv[0][j], a2 = qv[1][j], b1 = qv[2][j], b2 = qv[3][j];
                qv[0][j] = a1 * c0 - a2 * s0; qv[1][j] = a2 * c0 + a1 * s0; qv[2][j] = b1 * c1 - b2 * s1; qv[3][j] = b2 * c1 + b1 * s1; } }
        const float sc = 0.125f * LOG2E;
#pragma unroll
        for (int ks = 0; ks < 4; ++ks) { u32x4 w; w.x = pk(qv[ks][0] * sc, qv[ks][1] * sc); w.y = pk(qv[ks][2] * sc, qv[ks][3] * sc); w.z = pk(qv[ks][4] * sc, qv[ks][5] * sc); w.w = pk(qv[ks][6] * sc, qv[ks][7] * sc); qf[ks] = __builtin_bit_cast(bf16x8, w); }
    }
    float m_run = C.P.in[25 + C.z][l * 8 + hq] * LOG2E, l_run = hh == 0 ? 1.f : 0.f;
    f32x16 o0, o1;
#pragma unroll
    for (int i = 0; i < 16; ++i) { o0[i] = 0.f; o1[i] = 0.f; }
    const int nch = isctx ? 4 : 9, skey = C.tid >> 3, oct = C.tid & 7;
    for (int ch = 0; ch < nch; ++ch) {
        const bool win = ch >= 4; int kb = 0; size_t ktok0;
        if (!win) ktok0 = (size_t)(CTXB + b * TC + ch * 64);
        else { kb = qblk * 64 - 128 + (ch - 4) * 64; if (kb < 0 || kb >= TL) continue; ktok0 = (size_t)(b * TL + kb); }
        __syncthreads();
        {
            const bf16* kp = QKV + (ktok0 + skey) * 768 + 512 + kh * 64; const bf16* vp = kp + 128;
            u32x4 ku = *(const u32x4*)(kp + 8 * oct);
            if (win) { const u32x4 pu = *(const u32x4*)(kp + 8 * (oct ^ 2));
                const int p = kb + skey, pos = (oct >> 2) ? (p & 63) : (p >> 6), fb = 8 * (oct & 1); const bool isx1 = (oct & 2) == 0;
                float o[8];
#pragma unroll
                for (int e = 0; e < 8; ++e) { const float own = (e & 1) ? hi2f(ku[e >> 1]) : lo2f(ku[e >> 1]), par = (e & 1) ? hi2f(pu[e >> 1]) : lo2f(pu[e >> 1]);
                    const float cc = RT[(pos * 16 + fb + e) * 2], ss = RT[(pos * 16 + fb + e) * 2 + 1];
                    o[e] = isx1 ? (own * cc - par * ss) : (own * cc + par * ss); }
                ku.x = pk(o[0], o[1]); ku.y = pk(o[2], o[3]); ku.z = pk(o[4], o[5]); ku.w = pk(o[6], o[7]); }
            *(LAS u32x4*)(Ks + skey * 72 + 8 * oct) = ku;
            const u32x4 vu = *(const u32x4*)(vp + 8 * oct);
#pragma unroll
            for (int e = 0; e < 8; ++e) Vt[(8 * oct + e) * 72 + skey] = (bf16)((e & 1) ? (vu[e >> 1] >> 16) : (vu[e >> 1] & 0xffffu));
        }
        __syncthreads();
        f32x16 x0, x1;
#pragma unroll
        for (int i = 0; i < 16; ++i) { x0[i] = 0.f; x1[i] = 0.f; }
#pragma unroll
        for (int ks = 0; ks < 4; ++ks) {
            const bf16x8 a0 = *(const LAS bf16x8*)(Ks + r * 72 + 16 * ks + 8 * hh), a1 = *(const LAS bf16x8*)(Ks + (32 + r) * 72 + 16 * ks + 8 * hh);
            x0 = __builtin_amdgcn_mfma_f32_32x32x16_bf16(a0, qf[ks], x0, 0, 0, 0);
            x1 = __builtin_amdgcn_mfma_f32_32x32x16_bf16(a1, qf[ks], x1, 0, 0, 0);
        }
        if (win) {
#pragma unroll
            for (int i = 0; i < 16; ++i) { const int k0 = kb + crow(i, hh), d0 = qi - k0, d1 = d0 - 32;
                if (d0 > 128 || d0 < -128) x0[i] = -1e30f; if (d1 > 128 || d1 < -128) x1[i] = -1e30f; }
        }
        float mx = x0[0];
#pragma unroll
        for (int i = 0; i < 16; ++i) { mx = fmaxf(mx, x0[i]); mx = fmaxf(mx, x1[i]); }
        mx = fmaxf(mx, __shfl_xor(mx, 32));
        const float m_new = fmaxf(m_run, mx), alpha = fexp2(m_run - m_new);
        float ps = 0.f;
#pragma unroll
        for (int i = 0; i < 16; ++i) { x0[i] = fexp2(x0[i] - m_new); x1[i] = fexp2(x1[i] - m_new); ps += x0[i] + x1[i]; o0[i] *= alpha; o1[i] *= alpha; }
        l_run = l_run * alpha + ps; m_run = m_new;
#pragma unroll
        for (int kt = 0; kt < 2; ++kt)
#pragma unroll
            for (int s = 0; s < 2; ++s) {
                const f32x16& x = kt ? x1 : x0;
                u32x4 w; w.x = pk(x[8 * s], x[8 * s + 1]); w.y = pk(x[8 * s + 2], x[8 * s + 3]); w.z = pk(x[8 * s + 4], x[8 * s + 5]); w.w = pk(x[8 * s + 6], x[8 * s + 7]);
                const bf16x8 pb = __builtin_bit_cast(bf16x8, w);
                const int ko = kt * 32 + 16 * s + 4 * hh;
                const s16x4 l0 = *(const LAS s16x4*)(Vt + r * 72 + ko), h0 = *(const LAS s16x4*)(Vt + r * 72 + ko + 8);
                const s16x4 l1 = *(const LAS s16x4*)(Vt + (32 + r) * 72 + ko), h1 = *(const LAS s16x4*)(Vt + (32 + r) * 72 + ko + 8);
                o0 = __builtin_amdgcn_mfma_f32_32x32x16_bf16(__builtin_shufflevector(l0, h0, 0, 1, 2, 3, 4, 5, 6, 7), pb, o0, 0, 0, 0);
                o1 = __builtin_amdgcn_mfma_f32_32x32x16_bf16(__builtin_shufflevector(l1, h1, 0, 1, 2, 3, 4, 5, 6, 7), pb, o1, 0, 0, 0);
            }
    }
    const float inv = frcp(l_run + __shfl_xor(l_run, 32));
    bf16* op = YA + tq * 512 + hq * 64 + 4 * hh;
#pragma unroll
    for (int i4 = 0; i4 < 4; ++i4) {
        u32x2 w0, w1; w0.x = pk(o0[4 * i4] * inv, o0[4 * i4 + 1] * inv); w0.y = pk(o0[4 * i4 + 2] * inv, o0[4 * i4 + 3] * inv);
        w1.x = pk(o1[4 * i4] * inv, o1[4 * i4 + 1] * inv); w1.y = pk(o1[4 * i4 + 2] * inv, o1[4 * i4 + 3] * inv);
        *(u32x2*)(op + 8 * i4) = w0; *(u32x2*)(op + 32 + 8 * i4) = w1;
    }
}
DI void attn_loop(const Ctx& C0, int l) {
    const Ctx C = rectx(C0);
    unsigned* ctr = WSP(unsigned, WS_CTL) + 64 * (l + 1);
    volatile LAS unsigned* slot = (volatile LAS unsigned*)(C.lds + 32768);
    const unsigned NU = 2048u + (l == 0 ? 256u : 0u);
    for (;;) {
        __syncthreads();
        if (C.tid == 0) *slot = atomicAdd(ctr, 1u);
        __syncthreads();
        const unsigned u = *slot;
        if (u >= NU) break;
        if (u < 2048u) attn_unit(C, l, (int)(u >> 6), (int)((u >> 5) & 1), (int)(u & 31), false);
        else { const unsigned v = u - 2048u; attn_unit(C, l, (int)(v >> 3), (int)((v >> 2) & 1), (int)(v & 3), true); }
    }
}


#ifdef DBG
DI float exp_f(float x) { return fexp2(x * LOG2E); }
DI unsigned hsh(unsigned x) { x ^= x >> 16; x *= 0x7feb352du; x ^= x >> 15; x *= 0x846ca68bu; x ^= x >> 16; return x; }
DI void dbg_put(const Ctx& C, int k, float got, float ref, float S) {
    float err = fabsf(got - ref) / (fabsf(ref) + S); if (!(err == err)) err = 1e9f;
    atomicMax(WSP(unsigned, WS_CTL) + 1024 + k, __builtin_bit_cast(unsigned, err));
}
DI float ndot(const bf16* a, const bf16* b, int K) { float s = 0.f; for (int k = 0; k < K; ++k) s += bf2f(a[k]) * bf2f(b[k]); return s; }
DI void dbg_check(const Ctx& C0, int stage, int l) {
    if (C0.bid != 0 || l != 0) return;
    const Ctx C = rectx(C0);
    const unsigned h1 = hsh(C.tid * 3u + 17u + stage * 1000u), h2 = hsh(h1 + 0x9e3779b9u), h3 = hsh(h2 + 77u);
    const Params& P = C.P;
    if (stage == 0) {
        {
            const int n = h1 % 2432, k = h2 % 1024; int src = -1;
            if (n < 512) src = 1152 + n; else if (n < 640) src = 1664 + (n - 512); else if (n < 768) src = 1792 + (n - 640); else if (n >= 1280) src = n - 1280;
            if (src >= 0) dbg_put(C, 0, bf2f(WL(bf16, 0, WL_IN)[(size_t)n * 1024 + k]), bf2f(f2bf(P.in[10 + C.z][(size_t)k * IN_COLS + src])), 1e-6f);
            const int ng = h3 % 3072;
            dbg_put(C, 0, bf2f(WL(bf16, 0, WL_G)[(size_t)ng * 1024 + k]), bf2f(f2bf(P.in[10 + C.z][(size_t)k * IN_COLS + 2176 + ng])), 1e-6f);
            const int nu = h3 % 5632, pn = nu >> 8, bj = (nu >> 7) & 1, j = nu & 127;
            dbg_put(C, 0, bf2f(WL(bf16, 0, WL_UP)[(size_t)nu * 1024 + k]), bf2f(f2bf(P.in[30 + C.z][(size_t)k * 5632 + bj * DFF + pn * 128 + j])), 1e-6f);
            const int nd = h1 % 1024, kd = h3 % DFF;
            dbg_put(C, 0, bf2f(WL(bf16, 0, WL_DN)[(size_t)nd * DFF + kd]), bf2f(f2bf(P.in[33 + C.z][(size_t)kd * 1024 + nd])), 1e-6f);
            dbg_put(C, 0, bf2f(WL(bf16, 0, WL_O)[(size_t)nd * 1024 + k]), bf2f(f2bf(P.in[29 + C.z][(size_t)k * 1024 + nd])), 1e-6f);
            dbg_put(C, 0, bf2f(WL(bf16, 0, WL_BA)[(size_t)nd * 512 + (k & 511)]), bf2f(f2bf(P.in[27 + C.z][(size_t)(k & 511) * 1024 + nd])), 1e-6f);
            dbg_put(C, 0, bf2f(WL(bf16, 0, WL_BR)[(size_t)nd * 256 + (k & 255)]), bf2f(f2bf(P.in[26 + C.z][(size_t)(k & 255) * 1024 + nd])), 1e-6f);
        }
        {
            const int r = h1 % 33, j = h2 % 6144; float a = P.in[5 + C.z][j];
            for (int k = 0; k < 1024; ++k) { const float cv = (r < 32) ? P.in[1 + C.z][r * 1024 + k] : P.in[3 + C.z][k]; a += cv / (1.f + exp_f(-cv)) * P.in[4 + C.z][(size_t)k * 6144 + j]; }
            dbg_put(C, 1, WSP(float, WS_MOD)[(size_t)r * 6144 + j], a, 0.01f);
        }
    } else if (stage == 1) {
        const int tok = h1 % NT, col = h2 % 1024; const bool lat = tok < NLAT; const float* hp = lat ? P.in[0 + C.z] + (size_t)tok * DM : P.in[2 + C.z] + (size_t)(tok - NLAT) * DM;
        float ss = 0.f; for (int k = 0; k < 1024; ++k) ss += hp[k] * hp[k];
        const float* mp = WSP(float, WS_MOD) + (size_t)(lat ? tok / TL : 32) * 6144;
        const float ref = hp[col] * rsqrtf(ss / 1024.f + 1e-6f) * P.in[6 + C.z][col] * (1.f + mp[1024 + col]) + mp[col];
        dbg_put(C, 2, bf2f(WSP(bf16, WS_A)[(size_t)tok * DM + col]), ref, 0.05f);
    } else if (stage == 2) {
        const int tok = h1 % NT, n = h2 % 2432; const float ref = ndot(WSP(bf16, WS_A) + (size_t)tok * DM, WL(bf16, 0, WL_IN) + (size_t)n * 1024, 1024);
        float got; int k;
        if (n < 768) { got = bf2f(WSP(bf16, WS_X + X_QKV)[(size_t)tok * 768 + n]); k = 3; }
        else if (n < 1280) { const int sn = (n - 768) >> 8, ch = (n - 768) & 255; k = 4;
            if (tok < NLAT) got = bf2f(WSP(bf16, WS_X + X_ZT)[((size_t)(tok / TL) * 256 + ch) * 4096 + sn * 2048 + (tok % TL)]);
            else got = bf2f(WSP(bf16, WS_X + X_ZTC)[((size_t)((tok - NLAT) / TC) * 256 + ch) * 512 + sn * 256 + ((tok - NLAT) % TC)]); }
        else { got = bf2f(WSP(bf16, WS_X + X_UR)[(size_t)tok * RW + n - 1280]); k = 5; }
        dbg_put(C, k, got, ref, 0.1f);
    } else if (stage == 3) {
        const int b = h1 % 32, t = 1 + h2 % 2046, c = h3 % 256; const size_t tok = (size_t)b * TL + t; const bf16* UR = WSP(bf16, WS_X + X_UR);
        const float u = bf2f(UR[tok * RW + c]), up = bf2f(UR[(tok - 1) * RW + c]), un = bf2f(UR[(tok + 1) * RW + c]);
        dbg_put(C, 7, bf2f(WSP(bf16, WS_X + X_F)[tok * 256 + c]), u + P.in[11 + C.z][c] * (up - u) + P.in[11 + C.z][RW + c] * (un - u), 0.05f);
        float ss = 0.f; for (int k = 0; k < 64; ++k) { const float x = bf2f(WSP(bf16, WS_X + X_F)[FSZ + tok * 256 + (c & 192) + k]); ss += x * x; }
        dbg_put(C, 7, ss, 1.f, 0.f);
    } else if (stage == 4) {
        {
            LAS float* S = (LAS float*)C.lds; LAS float* sa = S + 4096; const bf16* F = WSP(bf16, WS_X + X_F); const int b = 1, h = 2;
            for (int dir = 0; dir < 2; ++dir) {
                for (int e = C.tid; e < 4096; e += NTHREADS) S[e] = 0.f;
                __syncthreads();
                for (int n = 0; n < 24; ++n) {
                    const size_t o = (size_t)scan_tok(n, dir, b) * 256 + h * 64;
                    if (C.tid < 64) { float a = 0.f; for (int k = 0; k < 64; ++k) a -= S[C.tid * 64 + k] * bf2f(F[FSZ + o + k]); sa[C.tid] = a; }
                    __syncthreads();
                    for (int e = C.tid; e < 4096; e += NTHREADS) { const int v = e >> 6, k = e & 63;
                        const float kk = bf2f(F[FSZ + o + k]), kr = bf2f(F[3 * FSZ + o + k]), ee = bf2f(F[(4 + dir) * FSZ + o + k]), a = bf2f(F[(6 + dir) * FSZ + o + k]), vv = bf2f(F[2 * FSZ + o + v]);
                        S[e] = S[e] * exp_f(-ee) + sa[v] * (kk * a) + vv * (kr * (1.f + (a - 1.f) * P.in[18 + C.z][h * 64 + k])); }
                    __syncthreads();
                    if (C.tid < 64) { float y = 0.f; for (int k = 0; k < 64; ++k) y += S[C.tid * 64 + k] * bf2f(F[o + k]);
                        dbg_put(C, 8, bf2f(WSP(bf16, WS_X + X_UR)[(size_t)dir * FSZ + o + C.tid]), y, 0.05f); }
                    __syncthreads();
                }
            }
        }
        {
            LAS float* qs = (LAS float*)C.lds + (size_t)C.tid * 65; const bf16* QKV = WSP(bf16, WS_X + X_QKV);
            const int b = h1 % 32, t = (C.tid & 1) ? (int)(h2 % 2048) : ((C.tid & 2) ? (int)(h2 % 200) : 2047 - (int)(h2 % 200)), hq = h3 % 8, dd = (h3 >> 8) % 64, kh = hq >> 2;
            const size_t tq = (size_t)b * TL + t;
            for (int d = 0; d < 64; ++d) { const int ax = d >> 5, hf = (d >> 4) & 1, f = d & 15; const int ps = ax ? (t & 63) : (t >> 6); const float cs = WSP(float, WS_SMALL)[(ps * 16 + f) * 2], sn = WSP(float, WS_SMALL)[(ps * 16 + f) * 2 + 1];
                const float x1 = bf2f(QKV[tq * 768 + hq * 64 + ax * 32 + f]), x2 = bf2f(QKV[tq * 768 + hq * 64 + ax * 32 + 16 + f]);
                qs[d] = hf ? (x2 * cs + x1 * sn) : (x1 * cs - x2 * sn); }
            float m = P.in[25 + C.z][hq], den = 1.f, acc = 0.f;
            for (int j = 0; j < 256 + 257; ++j) {
                const bool win = j >= 256; const int kp = win ? t - 128 + (j - 256) : j; if (win && (kp < 0 || kp >= TL)) continue;
                const size_t tk = win ? (size_t)b * TL + kp : (size_t)(CTXB + b * TC + kp); float s = 0.f;
                for (int d = 0; d < 64; ++d) { float kv;
                    if (!win) kv = bf2f(QKV[tk * 768 + 512 + kh * 64 + d]);
                    else { const int ax = d >> 5, hf = (d >> 4) & 1, f = d & 15; const int ps = ax ? (kp & 63) : (kp >> 6); const float cs = WSP(float, WS_SMALL)[(ps * 16 + f) * 2], sn = WSP(float, WS_SMALL)[(ps * 16 + f) * 2 + 1];
                        const float x1 = bf2f(QKV[tk * 768 + 512 + kh * 64 + ax * 32 + f]), x2 = bf2f(QKV[tk * 768 + 512 + kh * 64 + ax * 32 + 16 + f]);
                        kv = hf ? (x2 * cs + x1 * sn) : (x1 * cs - x2 * sn); }
                    s += qs[d] * kv; }
                s *= 0.125f; const float mn = fmaxf(m, s), al = exp_f(m - mn), p = exp_f(s - mn);
                den = den * al + p; acc = acc * al + p * bf2f(QKV[tk * 768 + 640 + kh * 64 + dd]); m = mn;
            }
            dbg_put(C, 9, bf2f(WSP(bf16, WS_A)[tq * 512 + hq * 64 + dd]), acc / den, 0.03f);
        }
        __syncthreads();
        {
            LAS float* qs = (LAS float*)C.lds + (size_t)C.tid * 65; const bf16* QKV = WSP(bf16, WS_X + X_QKV);
            const int b = h2 % 32, t = h1 % 256, hq = h3 % 8, dd = (h3 >> 8) % 64, kh = hq >> 2; const size_t tq = (size_t)(CTXB + b * TC + t);
            for (int d = 0; d < 64; ++d) qs[d] = bf2f(QKV[tq * 768 + hq * 64 + d]);
            float m = P.in[25 + C.z][hq], den = 1.f, acc = 0.f;
            for (int j = 0; j < 256; ++j) { const size_t tk = (size_t)(CTXB + b * TC + j); float s = 0.f;
                for (int d = 0; d < 64; ++d) s += qs[d] * bf2f(QKV[tk * 768 + 512 + kh * 64 + d]);
                s *= 0.125f; const float mn = fmaxf(m, s), al = exp_f(m - mn), p = exp_f(s - mn); den = den * al + p; acc = acc * al + p * bf2f(QKV[tk * 768 + 640 + kh * 64 + dd]); m = mn; }
            dbg_put(C, 10, bf2f(WSP(bf16, WS_A)[tq * 512 + hq * 64 + dd]), acc / den, 0.03f);
        }
        {
            const int b = h1 % 32, tp = h2 % 2048, ch = h3 % 256;
            dbg_put(C, 11, bf2f(WSP(bf16, WS_A + (size_t)72 * MiB)[((size_t)b * TL + tp) * 256 + ch]), ndot(WSP(bf16, WS_DFT) + (size_t)tp * 4096, WSP(bf16, WS_X + X_ZT) + ((size_t)b * 256 + ch) * 4096, 4096), 0.05f);
            const int tc = h2 % 256;
            dbg_put(C, 11, bf2f(WSP(bf16, WS_A + (size_t)72 * MiB)[((size_t)CTXB + b * TC + tc) * 256 + ch]), ndot(WSP(bf16, WS_DFTC) + (size_t)tc * 512, WSP(bf16, WS_X + X_ZTC) + ((size_t)b * 256 + ch) * 512, 512), 0.05f);
        }
    } else if (stage == 5) {
        const int tok = h1 % NT, col = h2 % 1024; const bf16* PP = WSP(bf16, WS_X + X_PP);
        dbg_put(C, 13, bf2f(PP[(size_t)tok * NGATE + col]), ndot(WSP(bf16, WS_A + (size_t)108 * MiB) + (size_t)tok * 256, WL(bf16, 0, WL_BR) + (size_t)col * 256, 256), 0.05f);
        dbg_put(C, 13, bf2f(PP[(size_t)tok * NGATE + 1024 + col]), ndot(WSP(bf16, WS_A) + (size_t)tok * 512, WL(bf16, 0, WL_BA) + (size_t)col * 512, 512), 0.05f);
        dbg_put(C, 13, bf2f(PP[(size_t)tok * NGATE + 2048 + col]), ndot(WSP(bf16, WS_A + (size_t)72 * MiB) + (size_t)tok * 256, WL(bf16, 0, WL_BF) + (size_t)col * 256, 256), 0.05f);
    } else if (stage == 6) {
        const int tok = h1 % NT, col = h2 % 1024; float ref = 0.f;
        for (int br = 0; br < 3; ++br) { const float gl = ndot(WSP(bf16, WS_A) + (size_t)tok * DM, WL(bf16, 0, WL_G) + (size_t)(br * 1024 + col) * 1024, 1024); ref += bf2f(WSP(bf16, WS_X + X_PP)[(size_t)tok * NGATE + br * 1024 + col]) / (1.f + exp_f(-gl)); }
        dbg_put(C, 14, bf2f(WSP(bf16, WS_X + X_UR)[(size_t)tok * DM + col]), ref, 0.05f);
    } else if (stage == 7) {
        const int tok = h1 % NT, col = h2 % 1024;
        dbg_put(C, 15, bf2f(WSP(bf16, WS_X + X_MIX)[(size_t)tok * DM + col]), ndot(WSP(bf16, WS_X + X_UR) + (size_t)tok * DM, WL(bf16, 0, WL_O) + (size_t)col * 1024, 1024), 0.05f);
    } else if (stage == 8) {
        const int tok = h1 % NT, col = h2 % 1024; const bool lat = tok < NLAT; const float* hp = lat ? P.in[0 + C.z] + (size_t)tok * DM : P.in[2 + C.z] + (size_t)(tok - NLAT) * DM;
        const bf16* mx = WSP(bf16, WS_X + X_MIX) + (size_t)tok * DM; const float* mp = WSP(float, WS_MOD) + (size_t)(lat ? tok / TL : 32) * 6144;
        float ss = 0.f; for (int k = 0; k < 1024; ++k) ss += bf2f(mx[k]) * bf2f(mx[k]);
        const float rs = rsqrtf(ss / 1024.f + 1e-6f); float s2 = 0.f, hc = 0.f;
        for (int k = 0; k < 1024; ++k) { const float hn = hp[k] + mp[2048 + k] * bf2f(mx[k]) * rs * P.in[7 + C.z][k]; s2 += hn * hn; if (k == col) hc = hn; }
        const float* ho = lat ? C.out + (size_t)tok * DM : WSP(float, WS_HC) + (size_t)(tok - NLAT) * DM;
        dbg_put(C, 16, ho[col], hc, 0.01f);
        dbg_put(C, 16, bf2f(WSP(bf16, WS_A)[(size_t)tok * DM + col]), hc * rsqrtf(s2 / 1024.f + 1e-6f) * P.in[8 + C.z][col] * (1.f + mp[4096 + col]) + mp[3072 + col], 0.05f);
    } else if (stage == 9) {
        int tok = h1 % NT; if (C.tid & 1) tok = (tok & ~63) + ((C.tid & 2) ? 63 : 0);
        const int j = h2 % DFF; const int t = (tok < NLAT) ? (tok % TL) : ((tok - NLAT) % TC), T = (tok < NLAT) ? TL : TC;
        const bf16* A = WSP(bf16, WS_A); const bf16* wu = WL(bf16, 0, WL_UP); const int pn = j >> 7, jj = j & 127;
        const bf16* wg = wu + (size_t)(pn * 256 + jj) * 1024; const bf16* wv = wu + (size_t)(pn * 256 + 128 + jj) * 1024;
        const float zc = ndot(A + (size_t)tok * DM, wg, 1024), zp = (t > 0) ? ndot(A + (size_t)(tok - 1) * DM, wg, 1024) : 0.f, zn = (t < T - 1) ? ndot(A + (size_t)(tok + 1) * DM, wg, 1024) : 0.f, zv = ndot(A + (size_t)tok * DM, wv, 1024);
        const float z = P.in[31 + C.z][j] * zp + P.in[31 + C.z][DFF + j] * zc + P.in[31 + C.z][2 * DFF + j] * zn + P.in[32 + C.z][j];
        const float ge = 0.5f * z * (1.f + tanh_(0.7978845608028654f * (z + 0.044715f * z * z * z)));
        dbg_put(C, 17, bf2f(WSP(bf16, WS_X + X_HH)[(size_t)tok * DFF + j]), ge * zv, 0.05f);
    } else if (stage == 10) {
        const int tok = h1 % NT, col = h2 % 1024;
        dbg_put(C, 18, bf2f(WSP(bf16, WS_X + X_FFO)[(size_t)tok * DM + col]), ndot(WSP(bf16, WS_X + X_HH) + (size_t)tok * DFF, WL(bf16, 0, WL_DN) + (size_t)col * DFF, DFF), 0.05f);
    }
}
DI void dbg_report(const Ctx& C) {
    if (C.bid == 0 && threadIdx.x == 0) {
        int first = -1; for (int k = 0; k < 24; ++k) if (first < 0 && __builtin_bit_cast(float, WSP(unsigned, WS_CTL)[1024 + k]) > 0.05f) first = k;
        if (first >= 0) C.out[12345] = 1000.f * (float)(first + 1);
    }
}
#define DBGCHK(stage) do { grid.sync(); dbg_check(CK, stage, l); grid.sync(); } while (0)
#else
#define DBGCHK(stage) do { } while (0)
#endif
__global__ void __launch_bounds__(NTHREADS, 2) fwd_kernel(Params P) {
    extern __shared__ __attribute__((aligned(16))) unsigned char lds_raw[];
    cg::grid_group grid = cg::this_grid();
    const int tid_ = threadIdx.x;
    const Ctx CK{(LAS unsigned char*)lds_raw, P.ws, P, P.out, tid_, tid_ & 63, __builtin_amdgcn_readfirstlane(tid_ >> 6), (int)gridDim.x, (int)blockIdx.x, 0};
#ifdef PROBE
#define TS(k) do { if (tid_ == 0 && blockIdx.x == 0) ((volatile LAS unsigned long long*)(CK.lds + 131072))[k] = __builtin_amdgcn_s_memrealtime(); } while (0)
#else
#define TS(k) do { } while (0)
#endif
#define PH_BEGIN { const Ctx C = rectx(CK); LAS unsigned char* glds = C.lds;
#define PH_END }
#define ABUF WSP(bf16, WS_A)
#define HCB WSP(float, WS_HC)
#define MODL(ll) (WSP(float, WS_MOD) + (size_t)(ll) * 33 * 6144)
#define HIN_L ((l == 0) ? C.P.in[0 + C.z] : (const float*)C.out)
#define HIN_C ((l == 0) ? C.P.in[2 + C.z] : (const float*)HCB)
#define GEMM_STD(Aptr, Bptr, M_, N_, K_, EPI, ...) do { pg8::Gemm g{Aptr, Bptr, M_, N_, K_}; pg8::StaticOrder S; S.init(M_, N_, C.G, C.bid); EPI E{__VA_ARGS__}; pg8::gemm_phase<EPI, pg8::StaticOrder, true, true>(glds, g, S, E); } while (0)
    TS(40);
    if (blockIdx.x == 0) for (int i = tid_; i < 2048; i += NTHREADS) ((unsigned*)P.ws)[i] = 0u;
    prologue(CK);
    grid.sync(); TS(41);
    { const int l = 0; DBGCHK(0); }
    for (int l = 0; l < 2; ++l) {
        TS(l * 16 + 0);
        const int Mmix = (l == 0) ? NT : NLAT;
        if (l == 0) { PH_BEGIN rowop<false, true>(C, NT, HIN_L, HIN_C, nullptr, nullptr, nullptr, 0, nullptr, C.P.in[6 + C.z] + l * DM, 0, 1, MODL(l), MODL(l), ABUF); PH_END grid.sync(); TS(l * 16 + 1); DBGCHK(1); }
        PH_BEGIN
            GEMM_STD(ABUF, WL(bf16, l, WL_IN), NT, NIN, DM, EpiIn, WSP(bf16, WS_X + X_QKV), WSP(bf16, WS_X + X_ZT), WSP(bf16, WS_X + X_ZTC), WSP(bf16, WS_X + X_UR));
        PH_END
        grid.sync(); TS(l * 16 + 2); DBGCHK(2);
        feat1_phase(CK, l);
        grid.sync();
        PH_BEGIN GEMM_STD(WSP(bf16, WS_A), WSP(bf16, WS_WLORA + (size_t)l * 2 * MiB), NT, (l == 0 ? 1280 : NLO), KLO, EpiStore, WSP(bf16, WS_X + X_LO), NLO, 0, 0, 256); PH_END
        grid.sync();
        feat3_phase(CK, l);
        grid.sync(); TS(l * 16 + 3); DBGCHK(3);
        if (CK.bid < 256) scan_run(CK, l, CK.bid >> 3, (CK.bid >> 1) & 3, CK.bid & 1);
        __syncthreads(); TS(l * 16 + 15);
        {
            PH_BEGIN
                pg8::Gemm g{WSP(bf16, WS_DFT), WSP(bf16, WS_X + X_ZT), 2048, 8192, 4096}; pg8::StaticOrder S; S.init(2048, 8192, C.G, C.bid);
                EpiStore E{WSP(bf16, WS_A + (size_t)72 * MiB), 256, 0, 2048, 0};
                pg8::gemm_phase<EpiStore, pg8::StaticOrder, true, true>(glds, g, S, E);
            PH_END
            if (l == 0) { PH_BEGIN
                pg8::Gemm g{WSP(bf16, WS_DFTC), WSP(bf16, WS_X + X_ZTC), 256, 8192, 512}; pg8::StaticOrder S; S.init(256, 8192, C.G, C.bid);
                EpiStore E{WSP(bf16, WS_A + (size_t)72 * MiB), 256, CTXB, 256, 0};
                pg8::gemm_phase<EpiStore, pg8::StaticOrder, true, true>(glds, g, S, E);
            PH_END }
        }
        attn_loop(CK, l);
        grid.sync(); TS(l * 16 + 4); DBGCHK(4);
        readout_phase(CK, l, Mmix);
        grid.sync(); TS(l * 16 + 5);
        PH_BEGIN GEMM_STD(WSP(bf16, WS_A + (size_t)108 * MiB), WL(bf16, l, WL_BR), Mmix, 1024, 256, EpiStore, WSP(bf16, WS_X + X_PP), NGATE, 0, 0, 256); PH_END
        PH_BEGIN GEMM_STD(WSP(bf16, WS_A), WL(bf16, l, WL_BA), Mmix, 1024, 512, EpiStore, WSP(bf16, WS_X + X_PP) + 1024, NGATE, 0, 0, 256); PH_END
        PH_BEGIN GEMM_STD(WSP(bf16, WS_A + (size_t)72 * MiB), WL(bf16, l, WL_BF), Mmix, 1024, 256, EpiStore, WSP(bf16, WS_X + X_PP) + 2048, NGATE, 0, 0, 256); PH_END
        grid.sync(); TS(l * 16 + 6); DBGCHK(5);
        PH_BEGIN rowop<false, true>(C, Mmix, HIN_L, HIN_C, nullptr, nullptr, nullptr, 0, nullptr, C.P.in[6 + C.z] + l * DM, 0, 1, MODL(l), MODL(l), ABUF); PH_END
        grid.sync(); TS(l * 16 + 7);
        PH_BEGIN
            pg8::Gemm g{ABUF, WL(bf16, l, WL_G), Mmix, NGATE, DM}; GateOrder S{(Mmix / 256) * 4, C.G, C.bid};
            EpiGate E{WSP(bf16, WS_X + X_PP), WSP(bf16, WS_X + X_UR)};
            pg8::gemm_phase<EpiGate, GateOrder, true, true>(glds, g, S, E);
        PH_END
        grid.sync(); TS(l * 16 + 8); DBGCHK(6);
        PH_BEGIN GEMM_STD(WSP(bf16, WS_X + X_UR), WL(bf16, l, WL_O), Mmix, DM, DM, EpiStore, WSP(bf16, WS_X + X_MIX), DM, 0, 0, 256); PH_END
        grid.sync(); TS(l * 16 + 9); DBGCHK(7);
        PH_BEGIN rowop<true, true>(C, Mmix, HIN_L, HIN_C, C.out, HCB, WSP(bf16, WS_X + X_MIX), 2, C.P.in[7 + C.z] + l * DM, C.P.in[8 + C.z] + l * DM, 3, 4, MODL(l), MODL(l), ABUF); PH_END
        grid.sync(); TS(l * 16 + 10); DBGCHK(8);
        PH_BEGIN GEMM_STD(ABUF, WL(bf16, l, WL_UP), Mmix, 2 * DFF, DM, EpiUp, WSP(bf16, WS_X + X_HH), WSP(bf16, WS_X + X_HALO), C.P.in[31 + C.z] + (size_t)l * 3 * DFF, C.P.in[32 + C.z] + (size_t)l * DFF); PH_END
        grid.sync(); TS(l * 16 + 11);
        fixup_phase(CK, l, Mmix);
        grid.sync(); TS(l * 16 + 12); DBGCHK(9);
        PH_BEGIN GEMM_STD(WSP(bf16, WS_X + X_HH), WL(bf16, l, WL_DN), Mmix, DM, DFF, EpiStore, WSP(bf16, WS_X + X_FFO), DM, 0, 0, 256); PH_END
        grid.sync(); TS(l * 16 + 13); DBGCHK(10);
        if (l == 0) { PH_BEGIN rowop<true, true>(C, NT, C.out, HCB, C.out, HCB, WSP(bf16, WS_X + X_FFO), 5, C.P.in[9 + C.z] + l * DM, C.P.in[6 + C.z] + (l + 1) * DM, 0, 1, MODL(l), MODL(l + 1), ABUF); PH_END grid.sync(); TS(l * 16 + 14); }
        else { PH_BEGIN rowop<true, false>(C, NLAT, C.out, HCB, C.out, HCB, WSP(bf16, WS_X + X_FFO), 5, C.P.in[9 + C.z] + l * DM, nullptr, 0, 1, MODL(l), MODL(l), nullptr); PH_END }
    }
#ifdef DBG
    grid.sync(); dbg_report(CK);
#endif
#ifdef PROBE
    TS(60);
    grid.sync();
    if (blockIdx.x == 0) {
        volatile LAS unsigned long long* ts = (volatile LAS unsigned long long*)(CK.lds + 131072);
#ifdef PROBE_PRO
        unsigned long long d = (ts[60] - ts[40]) / 10ull;
#else
        unsigned long long d = 0; for (int ll = 0; ll < 2; ++ll) d += ts[ll * 16 + PROBE_B] - ts[ll * 16 + PROBE_A];
#endif
        const int n = (int)(d / 500ull);
        for (int i = tid_; i < n; i += NTHREADS) P.out[1000000 + i] += 0.15f;
    }
#endif
}


extern "C" void kernel_launch(void* const* d_in, const int* in_sizes, int n_in, void* d_out, int out_size, void* d_ws, size_t ws_size, hipStream_t stream) {
    static int grid = 0;
    if (grid == 0) {
        if (n_in != 34 || out_size != NLAT * DM || ws_size < WS_TOTAL) { fprintf(stderr, "kernel_launch: unexpected shapes (n_in %d out %d ws %zu, need %zu)\n", n_in, out_size, ws_size, (size_t)WS_TOTAL); grid = -1; return; }
        int dev = 0, cus = 0, per_cu = 0;
        hipGetDevice(&dev); hipDeviceGetAttribute(&cus, hipDeviceAttributeMultiprocessorCount, dev);
        if (hipFuncSetAttribute((const void*)fwd_kernel, hipFuncAttributeMaxDynamicSharedMemorySize, LDS_BYTES) != hipSuccess) { fprintf(stderr, "kernel_launch: hipFuncSetAttribute failed\n"); grid = -1; return; }
        hipOccupancyMaxActiveBlocksPerMultiprocessor(&per_cu, (const void*)fwd_kernel, NTHREADS, LDS_BYTES);
        (void)hipGetLastError();
        if (per_cu < 1 || cus < 256) { fprintf(stderr, "kernel_launch: occupancy %d, cus %d\n", per_cu, cus); grid = -1; return; }
        grid = 256;
    }
    if (grid < 0) return;
    Params p{};
    for (int i = 0; i < 34; ++i) p.in[i] = (const float*)d_in[i];
    p.out = (float*)d_out; p.ws = (unsigned char*)d_ws;
    void* args[] = {&p};
    hipError_t e = hipLaunchCooperativeKernel((const void*)fwd_kernel, dim3(grid), dim3(NTHREADS), args, LDS_BYTES, stream);
    if (e != hipSuccess) fprintf(stderr, "kernel_launch: cooperative launch failed: %s (grid %d)\n", hipGetErrorString(e), grid);
}
```

```cpp
#define PROBE_A 2
#define PROBE_B 3
#include <hip/hip_runtime.h>
#include <hip/hip_cooperative_groups.h>
#include <cstdio>
#include <cstdint>
namespace cg = cooperative_groups;
__device__ __forceinline__ int otid() { int t = threadIdx.x; asm volatile("" : "+v"(t)); return t; }
namespace pg8 {
#define PG8_LAS __attribute__((address_space(3)))
typedef unsigned short bf16_t;
typedef short bf16x8 __attribute__((ext_vector_type(8)));
typedef float f32x4 __attribute__((ext_vector_type(4)));
typedef unsigned u32x4 __attribute__((ext_vector_type(4)));
constexpr int BM = 256, BK = 64, HALF = 128, HTB = HALF * BK * 2  , STAGE_BYTES = 8 * HTB, NXCD = 8, WGM = 8;

__host__ __device__ __forceinline__ int lds_byte(int r, int c) { const int st = (r >> 4) * 2 + (c >> 5), rr = r & 15, cc = c & 31, ob = rr * 64 + cc * 2; return st * 1024 + (ob ^ (((ob >> 9) & 1) << 5)); }
__host__ __device__ __forceinline__ void stage_rc(int b, int& R, int& C) { const int st = b / 1024, sb = b % 1024, swz = sb ^ (((sb >> 9) & 1) << 5); R = (st >> 1) * 16 + swz / 64; C = (st & 1) * 32 + (swz % 64) / 2; }
__host__ __device__ __forceinline__ int perm32(int rho) { const int n = rho >> 4, i = rho & 15; return 8 * (i >> 2) + 4 * n + (i & 3); }

struct Unit { int pm, pn; };
struct Gemm { const bf16_t* A; const bf16_t* Bt; int M, N, K; };

struct StaticOrder {
    int nM, nN, nwg, G, c;
    __host__ __device__ void init(int M, int N, int G_, int c_) { nM = M / BM; nN = N / BM; nwg = nM * nN; G = G_; c = c_; }
    __host__ __device__ bool next(int i, Unit& u) const {
        const long L = (long)i * G + c; if (L >= nwg) return false;
        int wgid = (int)L; { const int q = nwg / NXCD, r = nwg % NXCD, xcd = wgid % NXCD, off = wgid / NXCD; wgid = (xcd < r ? xcd * (q + 1) : r * (q + 1) + (xcd - r) * q) + off; }
        const int nig = WGM * nN, gid = wgid / nig, fm = gid * WGM, gsz = (nM - fm) < WGM ? (nM - fm) : WGM;
        u.pm = fm + ((wgid % nig) % gsz); u.pn = (wgid % nig) / gsz; return true;
    }
    __device__ __forceinline__ void a_ready(const Unit&) const {}
    __device__ __forceinline__ void done(const Unit&) const {}
};

__device__ __forceinline__ unsigned cvt_pk_bf16(float lo, float hi) { unsigned r; asm volatile("v_cvt_pk_bf16_f32 %0, %1, %2" : "=v"(r) : "v"(lo), "v"(hi)); return r; }
typedef float f32x2 __attribute__((ext_vector_type(2)));
__device__ __forceinline__ f32x2 gelu_pk(f32x2 v) {
    const f32x2 av = __builtin_elementwise_abs(v), d = av * 0.2316418882f + 1.0f;
    f32x2 t; t.x = __builtin_amdgcn_rcpf(d.x); t.y = __builtin_amdgcn_rcpf(d.y);
    f32x2 q = t * 0.5307027145f + (-0.7265760135f); q = q * t + 0.7107068705f; q = q * t + (-0.142248368f); q = q * t + 0.127414796f; q = q * t;
    const f32x2 s = (v * v) * (-0.72134752044f);
    f32x2 e; e.x = __builtin_amdgcn_exp2f(s.x); e.y = __builtin_amdgcn_exp2f(s.y);
    const f32x2 m = v * (q * e), r = v - m;
    f32x2 o; o.x = v.x < 0.f ? m.x : r.x; o.y = v.y < 0.f ? m.y : r.y; return o;
}

template <class Epi, class Sched, bool ALIGN_EPI = false, bool SP2 = false>
__device__ __forceinline__ void gemm_phase(PG8_LAS unsigned char* lds, const Gemm g, const Sched& S, const Epi& E) {
    const int tid = otid(), wid = __builtin_amdgcn_readfirstlane(tid >> 6), lane = tid & 63, wr = wid >> 2, wc = wid & 3, fr = lane & 15, fq = lane >> 4;
    const int K = g.K, nt = K / BK;
    unsigned voffA[2], voffB[2];
#pragma unroll
    for (int i = 0; i < 2; ++i) { int R, C; stage_rc(tid * 16 + i * 8192, R, C); const int Rb = Epi::PERM ? ((R & ~31) + perm32(R & 31)) : R;
        voffA[i] = (unsigned)(R * K + C) * 2u; voffB[i] = (unsigned)(Rb * K + C) * 2u; }
    const size_t kstep = (size_t)(BK * 2);
    const size_t hstep = (size_t)HALF * K * 2;
    const size_t tstep = 2 * hstep;
    const unsigned ldsw = (unsigned)wid * 1024u;
    const int aoff = lds_byte(wr * 64 + fr, fq * 8), boff = lds_byte(wc * 32 + fr, fq * 8);
#define PG8_SA(b, h) (((b) * 2 + (h)) * HTB)
#define PG8_SB(b, h) ((4 + (b) * 2 + (h)) * HTB)
#define PG8_STAGE(bufoff, gbase, voff) do { _Pragma("unroll") for (int _i = 0; _i < 2; ++_i) \
        __builtin_amdgcn_global_load_lds((const unsigned*)((const char*)(gbase) + (voff)[_i]), (PG8_LAS unsigned*)(lds + (bufoff) + ldsw + _i * 8192), 16, 0, 0); } while (0)
#define PG8_LDA(dst, b, h) do { _Pragma("unroll") for (int m = 0; m < 4; ++m) _Pragma("unroll") for (int k = 0; k < 2; ++k) dst[m][k] = *(const PG8_LAS bf16x8*)(lds + PG8_SA(b, h) + aoff + m * 2048 + k * 1024); } while (0)
#define PG8_LDB(dst, b, h) do { _Pragma("unroll") for (int n = 0; n < 2; ++n) _Pragma("unroll") for (int k = 0; k < 2; ++k) dst[n][k] = *(const PG8_LAS bf16x8*)(lds + PG8_SB(b, h) + boff + n * 2048 + k * 1024); } while (0)
#define PG8_MMA(ai, bj, At, Bt) do { __builtin_amdgcn_s_setprio(1); _Pragma("unroll") for (int m = 0; m < 4; ++m) _Pragma("unroll") for (int n = 0; n < 2; ++n) _Pragma("unroll") for (int k = 0; k < 2; ++k) \
        acc[ai][bj][m][n] = __builtin_amdgcn_mfma_f32_16x16x32_bf16(Bt[n][k], At[m][k], acc[ai][bj][m][n], 0, 0, 0); __builtin_amdgcn_s_setprio(0); } while (0)
#define PG8_WAIT_V(n) asm volatile("s_waitcnt vmcnt(" #n ")" ::: "memory")
#define PG8_WAIT_L(n) asm volatile("s_waitcnt lgkmcnt(" #n ")" ::: "memory")
#define PG8_BAR __builtin_amdgcn_s_barrier()
#define PG8_SCHED __builtin_amdgcn_sched_barrier(0)
    Unit cur, nxt; int ui = 0;
    if (!S.next(0, cur)) return;
    f32x4 acc[2][2][4][2];
#pragma unroll
    for (int a = 0; a < 2; ++a)
#pragma unroll
        for (int b = 0; b < 2; ++b)
#pragma unroll
            for (int m = 0; m < 4; ++m)
#pragma unroll
                for (int n = 0; n < 2; ++n) acc[a][b][m][n] = (f32x4){0.f, 0.f, 0.f, 0.f};
    bf16x8 At[4][2], B0[2][2], B1[2][2];
    const char* cA = (const char*)g.A + (size_t)cur.pm * tstep; const char* cB = (const char*)g.Bt + (size_t)cur.pn * tstep;
    S.a_ready(cur);
    if constexpr (SP2) {
        PG8_STAGE(PG8_SB(0, 0), cB, voffB); PG8_STAGE(PG8_SB(0, 1), cB + hstep, voffB); PG8_STAGE(PG8_SA(0, 0), cA, voffA); PG8_STAGE(PG8_SA(0, 1), cA + hstep, voffA);
        if (wr == 1) PG8_BAR;
        PG8_WAIT_V(2); PG8_BAR;
        PG8_STAGE(PG8_SB(1, 0), cB + kstep, voffB); PG8_STAGE(PG8_SA(1, 0), cA + kstep, voffA); PG8_STAGE(PG8_SB(1, 1), cB + hstep + kstep, voffB);
        PG8_WAIT_V(6); PG8_BAR;
    } else {
        PG8_STAGE(PG8_SB(0, 0), cB, voffB); PG8_STAGE(PG8_SA(0, 0), cA, voffA); PG8_STAGE(PG8_SB(0, 1), cB + hstep, voffB); PG8_STAGE(PG8_SA(0, 1), cA + hstep, voffA);
        if (wr == 1) PG8_BAR;
        PG8_WAIT_V(4); PG8_BAR;
        PG8_STAGE(PG8_SB(1, 0), cB + kstep, voffB); PG8_STAGE(PG8_SA(1, 0), cA + kstep, voffA); PG8_STAGE(PG8_SB(1, 1), cB + hstep + kstep, voffB);
        PG8_WAIT_V(6); PG8_BAR;
    }
    for (;;) {
        const bool has_next = S.next(ui + 1, nxt);
        const char* nA = has_next ? (const char*)g.A + (size_t)nxt.pm * tstep : cA; const char* nB = has_next ? (const char*)g.Bt + (size_t)nxt.pn * tstep : cB;
        for (int t = 0; t < nt; t += 2) {
            const bool last = (t == nt - 2);
            const char* a1 = cA + (size_t)(t + 1) * kstep;
            const char* a2 = last ? nA : cA + (size_t)(t + 2) * kstep; const char* b2 = last ? nB : cB + (size_t)(t + 2) * kstep;
            const char* a3 = a2 + kstep; const char* b3 = b2 + kstep;
            if (last && has_next) S.a_ready(nxt);
            if constexpr (SP2) {
            PG8_LDB(B0, 0, 0); PG8_LDB(B1, 0, 1); PG8_SCHED; PG8_LDA(At, 0, 0); PG8_STAGE(PG8_SA(1, 1), a1 + hstep, voffA);
            PG8_WAIT_V(8); PG8_WAIT_L(0); PG8_BAR; PG8_MMA(0, 0, At, B0); PG8_MMA(0, 1, At, B1); PG8_BAR; PG8_SCHED;
            PG8_LDA(At, 0, 1); PG8_STAGE(PG8_SB(0, 0), b2, voffB); PG8_STAGE(PG8_SB(0, 1), b2 + hstep, voffB); PG8_STAGE(PG8_SA(0, 0), a2, voffA);
            PG8_WAIT_V(8); PG8_WAIT_L(0); PG8_BAR; PG8_MMA(1, 0, At, B0); PG8_MMA(1, 1, At, B1); PG8_BAR; PG8_SCHED;
            PG8_LDB(B0, 1, 0); PG8_LDB(B1, 1, 1); PG8_SCHED; PG8_LDA(At, 1, 0); PG8_STAGE(PG8_SA(0, 1), a2 + hstep, voffA);
            PG8_WAIT_V(8); PG8_WAIT_L(0); PG8_BAR; PG8_MMA(0, 0, At, B0); PG8_MMA(0, 1, At, B1); PG8_BAR; PG8_SCHED;
            PG8_LDA(At, 1, 1); PG8_STAGE(PG8_SB(1, 0), b3, voffB); PG8_STAGE(PG8_SB(1, 1), b3 + hstep, voffB); PG8_STAGE(PG8_SA(1, 0), a3, voffA);
            PG8_WAIT_V(8); PG8_WAIT_L(0); PG8_BAR; PG8_MMA(1, 0, At, B0); PG8_MMA(1, 1, At, B1); PG8_BAR; PG8_SCHED;
            } else {
            PG8_LDB(B0, 0, 0); PG8_SCHED; PG8_LDA(At, 0, 0); PG8_STAGE(PG8_SA(1, 1), a1 + hstep, voffA);
            PG8_WAIT_L(8); PG8_BAR; PG8_WAIT_L(0); PG8_MMA(0, 0, At, B0); PG8_BAR; PG8_SCHED;
            PG8_LDB(B1, 0, 1); PG8_STAGE(PG8_SB(0, 0), b2, voffB);
            PG8_BAR; PG8_WAIT_L(0); PG8_MMA(0, 1, At, B1); PG8_BAR;
            PG8_LDA(At, 0, 1); PG8_STAGE(PG8_SA(0, 0), a2, voffA);
            PG8_BAR; PG8_WAIT_L(0); PG8_MMA(1, 0, At, B0); PG8_BAR; PG8_SCHED;
            PG8_STAGE(PG8_SB(0, 1), b2 + hstep, voffB);
            PG8_WAIT_V(6); PG8_BAR; PG8_MMA(1, 1, At, B1); PG8_BAR;
            PG8_LDB(B0, 1, 0); PG8_SCHED; PG8_LDA(At, 1, 0); PG8_STAGE(PG8_SA(0, 1), a2 + hstep, voffA);
            PG8_WAIT_L(8); PG8_BAR; PG8_WAIT_L(0); PG8_MMA(0, 0, At, B0); PG8_BAR; PG8_SCHED;
            PG8_LDB(B1, 1, 1); PG8_STAGE(PG8_SB(1, 0), b3, voffB);
            PG8_BAR; PG8_WAIT_L(0); PG8_MMA(0, 1, At, B1); PG8_BAR;
            PG8_LDA(At, 1, 1); PG8_STAGE(PG8_SA(1, 0), a3, voffA);
            PG8_BAR; PG8_WAIT_L(0); PG8_MMA(1, 0, At, B0); PG8_BAR; PG8_SCHED;
            PG8_STAGE(PG8_SB(1, 1), b3 + hstep, voffB);
            PG8_WAIT_V(6); PG8_BAR; PG8_MMA(1, 1, At, B1); PG8_BAR;
            }
        }
        if constexpr (ALIGN_EPI) { if (wr == 0) PG8_BAR; }
        if constexpr (!Epi::AFTER_DRAIN) { E(acc, cur, wr, wc, fr, fq); S.done(cur); }
        if (!has_next) break;
#pragma unroll
        for (int a = 0; a < 2; ++a)
#pragma unroll
            for (int b = 0; b < 2; ++b)
#pragma unroll
                for (int m = 0; m < 4; ++m)
#pragma unroll
                    for (int n = 0; n < 2; ++n) acc[a][b][m][n] = (f32x4){0.f, 0.f, 0.f, 0.f};
        cur = nxt; cA = nA; cB = nB; ++ui;
        if constexpr (ALIGN_EPI) { if (wr == 1) PG8_BAR; }
    }
    PG8_WAIT_V(0);
    if constexpr (!ALIGN_EPI) { if (wr == 0) PG8_BAR; }
    PG8_BAR;
    if constexpr (Epi::AFTER_DRAIN) { E.fused(acc, cur, wr, wc, fr, fq, lds, wid, lane); S.done(cur); }
#undef PG8_SA
#undef PG8_SB
#undef PG8_STAGE
#undef PG8_LDA
#undef PG8_LDB
#undef PG8_MMA
#undef PG8_WAIT_V
#undef PG8_WAIT_L
#undef PG8_BAR
#undef PG8_SCHED
}
}

#define DI __device__ __forceinline__
#define LAS __attribute__((address_space(3)))
typedef unsigned short bf16;
typedef float f32x4 __attribute__((ext_vector_type(4)));
typedef float f32x2 __attribute__((ext_vector_type(2)));
typedef float f32x16 __attribute__((ext_vector_type(16)));
typedef short bf16x8 __attribute__((ext_vector_type(8)));
typedef short s16x4 __attribute__((ext_vector_type(4)));
typedef unsigned u32x4 __attribute__((ext_vector_type(4)));
typedef unsigned u32x2 __attribute__((ext_vector_type(2)));
typedef __bf16 bf16x2_t __attribute__((ext_vector_type(2)));

constexpr int DM = 1024, NB = 32, TL = 2048, TC = 256, NLAT = NB * TL, NCTX = NB * TC, NT = NLAT + NCTX, CTXB = NLAT;
constexpr int DFF = 2816, RW = 1152, NIN = 2560, NGATE = 3072;
constexpr int IN_COLS = 5248;
constexpr float LOG2E = 1.4426950408889634f;
constexpr int NTHREADS = 512, NWAVES = 8;
constexpr int LDS_BYTES = 147456;

constexpr size_t MiB = 1u << 20;
constexpr size_t WS_CTL = 0;
constexpr size_t WS_MOD = 1 * MiB;
constexpr size_t WS_SMALL = 3 * MiB;
constexpr size_t WS_BON = 4 * MiB;
constexpr size_t WS_W = 6 * MiB;
constexpr size_t WL_IN = 0, WL_G = 5 * MiB, WL_BR = 11 * MiB, WL_BA = 11 * MiB + 512 * 1024, WL_BF = 12 * MiB + 512 * 1024, WL_O = 13 * MiB, WL_UP = 15 * MiB, WL_DN = 26 * MiB, WL_SIZE = 32 * MiB;
constexpr size_t WS_DFT = WS_W + 2 * WL_SIZE;
constexpr size_t WS_DFTC = WS_DFT + 16 * MiB;
constexpr size_t WS_HC = WS_DFTC + 1 * MiB;
constexpr size_t WS_A = WS_HC + 32 * MiB;
constexpr size_t WS_VF = WS_A + 144 * MiB;
constexpr size_t WS_X = WS_VF + 36 * MiB;
constexpr size_t X_F = 0;
constexpr size_t X_QKV = 288 * MiB;
constexpr size_t X_ZT = 396 * MiB;
constexpr size_t X_ZTC = 460 * MiB;
constexpr size_t X_UR = 504 * MiB;
constexpr size_t X_G = 468 * MiB;
constexpr size_t X_LO = 504 * MiB;
constexpr size_t X_END = 720 * MiB;
constexpr size_t WS_WLORA = WS_X + X_END;
constexpr int KLO = 640, NLO = 1536;
constexpr size_t X_PP = 0;
constexpr size_t X_MIX = 0;
constexpr size_t X_HH = 0;
constexpr size_t X_HALO = 396 * MiB;
constexpr size_t X_FFO = 436 * MiB;
constexpr size_t WS_TOTAL = WS_WLORA + 4 * MiB;
constexpr size_t FSZ = (size_t)NT * 256;

struct Params { const float* in[34]; float* out; unsigned char* ws; };

DI float bf2f(bf16 v) { return __builtin_bit_cast(float, (unsigned)v << 16); }
DI float lo2f(unsigned u) { return __builtin_bit_cast(float, u << 16); }
DI float hi2f(unsigned u) { return __builtin_bit_cast(float, u & 0xffff0000u); }
DI unsigned pk(float lo, float hi) { f32x2 v = {lo, hi}; bf16x2_t b = __builtin_convertvector(v, bf16x2_t); return __builtin_bit_cast(unsigned, b); }
DI bf16 f2bf(float x) { return (bf16)(pk(x, 0.f) & 0xffffu); }
DI float fexp2(float x) { return __builtin_amdgcn_exp2f(x); }
DI float frcp(float x) { return __builtin_amdgcn_rcpf(x); }
DI float sigm(float x) { return frcp(1.f + fexp2(-x * LOG2E)); }
DI float tanh_(float x) { return 2.f * sigm(2.f * x) - 1.f; }
DI float gelu_tanh(float z) { const float u = 1.5957691216057308f * (z + 0.044715f * z * z * z); return z * sigm(u); }
DI float wave_sum(float v) {
#pragma unroll
    for (int o = 1; o < 64; o <<= 1) v += __shfl_xor(v, o);
    return v;
}
template <int CTRL, bool BC> DI float dppf(float old, float src) {
    return __builtin_bit_cast(float, __builtin_amdgcn_update_dpp(__builtin_bit_cast(int, old), __builtin_bit_cast(int, src), CTRL, 0xf, 0xf, BC));
}
DI float row16_sum(float x) { x += dppf<0x128, true>(0.f, x); x += dppf<0x124, true>(0.f, x); x += dppf<0x122, true>(0.f, x); x += dppf<0x121, true>(0.f, x); return x; }
DI f32x4 bf4(u32x2 u) { return (f32x4){lo2f(u.x), hi2f(u.x), lo2f(u.y), hi2f(u.y)}; }
DI u32x2 pk4(f32x4 v) { u32x2 o; o.x = pk(v[0], v[1]); o.y = pk(v[2], v[3]); return o; }
DI float allred4(float x) {
    unsigned u = __builtin_bit_cast(unsigned, x);
    auto r = __builtin_amdgcn_permlane16_swap(u, u, false, false);
    float y = __builtin_bit_cast(float, (unsigned)r[0]) + __builtin_bit_cast(float, (unsigned)r[1]);
    unsigned v = __builtin_bit_cast(unsigned, y);
    auto s = __builtin_amdgcn_permlane32_swap(v, v, false, false);
    return __builtin_bit_cast(float, (unsigned)s[0]) + __builtin_bit_cast(float, (unsigned)s[1]);
}

DI u32x4 pack8(const f32x4& a, const f32x4& b) { u32x4 w; w.x = pk(a[0], a[1]); w.y = pk(a[2], a[3]); w.z = pk(b[0], b[1]); w.w = pk(b[2], b[3]); return w; }

struct EpiStore {
    static constexpr bool PERM = true, AFTER_DRAIN = false;
    bf16* O; int ld; int row_base, row_pn, col_pn;
    DI void operator()(const f32x4 (&acc)[2][2][4][2], const pg8::Unit& u, int wr, int wc, int fr, int fq) const {
        const int row0 = row_base + u.pn * row_pn + u.pm * 256 + wr * 64 + fr, col0 = u.pn * col_pn + wc * 32 + 8 * fq;
#pragma unroll
        for (int ai = 0; ai < 2; ++ai)
#pragma unroll
            for (int m = 0; m < 4; ++m) { bf16* rowp = O + (size_t)(row0 + ai * 128 + m * 16) * ld + col0;
#pragma unroll
                for (int bj = 0; bj < 2; ++bj) *(u32x4*)(rowp + bj * 128) = pack8(acc[ai][bj][m][0], acc[ai][bj][m][1]); }
    }
};

struct EpiIn {
    static constexpr bool PERM = true, AFTER_DRAIN = false;
    bf16 *QKV, *ZT, *ZTC, *UR;
    DI void operator()(const f32x4 (&acc)[2][2][4][2], const pg8::Unit& u, int wr, int wc, int fr, int fq) const {
        const int pn = u.pn, rl0 = wr * 64 + fr, cl = wc * 32 + 8 * fq;
        if (pn < 3) {
#pragma unroll
            for (int ai = 0; ai < 2; ++ai)
#pragma unroll
                for (int m = 0; m < 4; ++m) { bf16* rowp = QKV + (size_t)(u.pm * 256 + rl0 + ai * 128 + m * 16) * 768 + pn * 256 + cl;
#pragma unroll
                    for (int bj = 0; bj < 2; ++bj) *(u32x4*)(rowp + bj * 128) = pack8(acc[ai][bj][m][0], acc[ai][bj][m][1]); }
        } else if (pn < 5) {
            bf16* base; int stride;
            if (u.pm < 256) { const int b = u.pm >> 3, t0 = (u.pm & 7) * 256; base = ZT + (size_t)b * 256 * 4096 + (pn - 3) * 2048 + t0; stride = 4096; }
            else { const int b = u.pm - 256; base = ZTC + (size_t)b * 256 * 512 + (pn - 3) * 256; stride = 512; }
#pragma unroll
            for (int ai = 0; ai < 2; ++ai)
#pragma unroll
                for (int m = 0; m < 4; ++m) { const int rl = rl0 + ai * 128 + m * 16;
#pragma unroll
                    for (int bj = 0; bj < 2; ++bj)
#pragma unroll
                        for (int n = 0; n < 2; ++n)
#pragma unroll
                            for (int e = 0; e < 4; ++e) base[(size_t)(bj * 128 + cl + 4 * n + e) * stride + rl] = f2bf(acc[ai][bj][m][n][e]); }
        } else {
#pragma unroll
            for (int ai = 0; ai < 2; ++ai)
#pragma unroll
                for (int m = 0; m < 4; ++m) { bf16* rowp = UR + (size_t)(u.pm * 256 + rl0 + ai * 128 + m * 16) * RW + (pn - 5) * 256 + cl;
#pragma unroll
                    for (int bj = 0; bj < 2; ++bj) if ((pn - 5) * 256 + bj * 128 < RW) *(u32x4*)(rowp + bj * 128) = pack8(acc[ai][bj][m][0], acc[ai][bj][m][1]); }
        }
    }
};

struct EpiGate {
    static constexpr bool PERM = true, AFTER_DRAIN = false;
    const bf16* PP; bf16* MG;
    DI void operator()(const f32x4 (&acc)[2][2][4][2], const pg8::Unit& u, int wr, int wc, int fr, int fq) const {
        const int br = u.pn >> 2, cn = u.pn & 3, row0 = u.pm * 256 + wr * 64 + fr, col0 = cn * 256 + wc * 32 + 8 * fq;
#pragma unroll
        for (int ai = 0; ai < 2; ++ai)
#pragma unroll
            for (int m = 0; m < 4; ++m) { const size_t row = (size_t)(row0 + ai * 128 + m * 16);
#pragma unroll
                for (int bj = 0; bj < 2; ++bj) {
                    const u32x4 pp = *(const u32x4*)(PP + row * NGATE + br * 1024 + col0 + bj * 128);
                    bf16* mp = MG + row * 1024 + col0 + bj * 128;
                    f32x4 a = acc[ai][bj][m][0], b = acc[ai][bj][m][1];
                    a[0] = sigm(a[0]) * lo2f(pp.x); a[1] = sigm(a[1]) * hi2f(pp.x); a[2] = sigm(a[2]) * lo2f(pp.y); a[3] = sigm(a[3]) * hi2f(pp.y);
                    b[0] = sigm(b[0]) * lo2f(pp.z); b[1] = sigm(b[1]) * hi2f(pp.z); b[2] = sigm(b[2]) * lo2f(pp.w); b[3] = sigm(b[3]) * hi2f(pp.w);
                    if (br) { const u32x4 o = *(const u32x4*)mp;
                        a[0] += lo2f(o.x); a[1] += hi2f(o.x); a[2] += lo2f(o.y); a[3] += hi2f(o.y); b[0] += lo2f(o.z); b[1] += hi2f(o.z); b[2] += lo2f(o.w); b[3] += hi2f(o.w); }
                    *(u32x4*)mp = pack8(a, b); } }
    }
};

struct EpiUp {
    static constexpr bool PERM = true, AFTER_DRAIN = false;
    bf16* HH; bf16* HALO; const float* cw; const float* cb;
    DI void operator()(const f32x4 (&acc)[2][2][4][2], const pg8::Unit& u, int wr, int wc, int fr, int fq) const {
        const int j0 = 128 * u.pn + 32 * wc + 8 * fq;
        f32x4 w0[2], w1[2], w2[2], bb[2];
#pragma unroll
        for (int n = 0; n < 2; ++n) { w0[n] = *(const f32x4*)(cw + j0 + 4 * n); w1[n] = *(const f32x4*)(cw + DFF + j0 + 4 * n); w2[n] = *(const f32x4*)(cw + 2 * DFF + j0 + 4 * n); bb[n] = *(const f32x4*)(cb + j0 + 4 * n); }
#pragma unroll
        for (int ai = 0; ai < 2; ++ai) {
            const int grp = u.pm * 4 + ai * 2 + wr;
            bf16* hb = HALO + (size_t)grp * 6 * DFF + j0;
            if (fr < 2) { *(u32x4*)(hb + fr * DFF) = pack8(acc[ai][0][0][0], acc[ai][0][0][1]); if (fr == 0) *(u32x4*)(hb + 4 * DFF) = pack8(acc[ai][1][0][0], acc[ai][1][0][1]); }
            if (fr >= 14) { *(u32x4*)(hb + (fr - 12) * DFF) = pack8(acc[ai][0][3][0], acc[ai][0][3][1]); if (fr == 15) *(u32x4*)(hb + 5 * DFF) = pack8(acc[ai][1][3][0], acc[ai][1][3][1]); }
#pragma unroll
            for (int m = 0; m < 4; ++m) {
                f32x4 o[2];
#pragma unroll
                for (int n = 0; n < 2; ++n)
#pragma unroll
                    for (int e = 0; e < 4; ++e) {
                        const float x = acc[ai][0][m][n][e];
                        const float xm = (m > 0) ? acc[ai][0][m > 0 ? m - 1 : 0][n][e] : 0.f, xp = (m < 3) ? acc[ai][0][m < 3 ? m + 1 : 3][n][e] : 0.f;
                        const float t1 = dppf<0x121, true>(0.f, xm);
                        const float prev = dppf<0x111, false>(t1, x);
                        const float t2 = dppf<0x12F, true>(0.f, xp);
                        const float next = dppf<0x101, false>(t2, x);
                        const float z = w0[n][e] * prev + w1[n][e] * x + w2[n][e] * next + bb[n][e];
                        o[n][e] = gelu_tanh(z) * acc[ai][1][m][n][e];
                    }
                const bool edge = (m == 0 && fr == 0) || (m == 3 && fr == 15);
                if (!edge) *(u32x4*)(HH + (size_t)(u.pm * 256 + ai * 128 + wr * 64 + m * 16 + fr) * DFF + j0) = pack8(o[0], o[1]);
            }
        }
    }
};

struct GateOrder {
    int nU, G, c;
    DI bool next(int i, pg8::Unit& u) const { const int j = i / 3, br = i - 3 * j; const long L = (long)j * G + c; if (L >= nU) return false; u.pm = (int)(L >> 2); u.pn = br * 4 + (int)(L & 3); return true; }
    DI void a_ready(const pg8::Unit&) const {}
    DI void done(const pg8::Unit&) const {}
};

struct Ctx {
    LAS unsigned char* lds; unsigned char* ws; const Params& P; float* out;
    int tid, lane, wave, G, bid, z;
};
DI Ctx rectx(const Ctx& C0) { const int t = otid(); int z = 0; asm volatile("" : "+s"(z)); return Ctx{C0.lds, C0.P.ws + z, C0.P, C0.P.out + z, t, t & 63, __builtin_amdgcn_readfirstlane(t >> 6), C0.G, C0.bid, z}; }
#define WSP(T, off) ((T*)(C.ws + (off)))
#define WL(T, l, off) ((T*)(C.ws + WS_W + (size_t)(l) * WL_SIZE + (off)))

DI void tr_item(const float* src, int ldw, int k0, int n0, bf16* dst, int ldd, int drow0, LAS float* scr, int lane) {
#pragma unroll 8
    for (int i = 0; i < 32; ++i) { const int kk = 2 * i + (lane >> 5); scr[kk * 33 + (lane & 31)] = src[(size_t)(k0 + kk) * ldw + n0 + (lane & 31)]; }
    asm volatile("s_waitcnt lgkmcnt(0)" ::: "memory");
    const int c = lane & 7;
#pragma unroll
    for (int j = 0; j < 4; ++j) { const int n = (lane >> 3) + 8 * j; const LAS float* s = scr + (8 * c) * 33 + n;
        u32x4 o; o.x = pk(s[0 * 33], s[1 * 33]); o.y = pk(s[2 * 33], s[3 * 33]); o.z = pk(s[4 * 33], s[5 * 33]); o.w = pk(s[6 * 33], s[7 * 33]);
        *(u32x4*)(dst + (size_t)(drow0 + n) * ldd + k0 + 8 * c) = o; }
    asm volatile("s_waitcnt lgkmcnt(0)" ::: "memory");
}
DI void tr_matrix(const Ctx& C, const float* src, int ldw, int K, int n_src0, int ncols, bf16* dst, int drow0, LAS float* scr) {
    const int gw = C.bid * NWAVES + C.wave, NGW = C.G * NWAVES, nb = ncols / 32, nit = (K / 64) * nb;
    for (int it = gw; it < nit; it += NGW) { const int kb = it / nb, b = it % nb; tr_item(src, ldw, kb * 64, n_src0 + b * 32, dst, K, drow0 + b * 32, scr, C.lane); }
}

DI void prologue(const Ctx& C0) {
    const Ctx C = rectx(C0);
    LAS float* scr = (LAS float*)(C.lds + 49152 + C.wave * 8704);
    const int gth = C.bid * NTHREADS + C.tid, NGT = C.G * NTHREADS;
    for (int tsk = C.bid; tsk < 72; tsk += C.G) {
        const int l = tsk / 36, rem = tsk % 36, cb = rem / 3, rg = rem % 3;
        LAS float* s = (LAS float*)C.lds;
        for (int i = C.tid; i < 11 * 1024; i += NTHREADS) { const int r = rg * 11 + i / 1024, k = i % 1024; const float cv = (r < 32) ? C.P.in[1 + C.z][r * 1024 + k] : C.P.in[3 + C.z][k]; s[i] = cv * sigm(cv); }
        __syncthreads();
        const int j = cb * 512 + C.tid;
        float acc[11];
        const float bj = C.P.in[5 + C.z][l * 6144 + j];
#pragma unroll
        for (int i = 0; i < 11; ++i) acc[i] = bj;
        const float* wp = C.P.in[4 + C.z] + (size_t)l * 1024 * 6144 + j;
        for (int k = 0; k < 1024; k += 4) {
            const float w0 = wp[(size_t)k * 6144], w1 = wp[(size_t)(k + 1) * 6144], w2 = wp[(size_t)(k + 2) * 6144], w3 = wp[(size_t)(k + 3) * 6144];
#pragma unroll
            for (int i = 0; i < 11; ++i) { const f32x4 x = *(const LAS f32x4*)(s + i * 1024 + k); acc[i] += x[0] * w0 + x[1] * w1 + x[2] * w2 + x[3] * w3; }
        }
#pragma unroll
        for (int i = 0; i < 11; ++i) WSP(float, WS_MOD)[(size_t)(l * 33 + rg * 11 + i) * 6144 + j] = acc[i];
        __syncthreads();
    }
    if (C.bid == C.G - 1) for (int i = C.tid; i < 1024; i += NTHREADS) { const int p = i >> 4, f = i & 15; const float inv = powf(10000.f, -(float)f / 16.f), ang = (float)p * inv; WSP(float, WS_SMALL)[2 * i] = cosf(ang); WSP(float, WS_SMALL)[2 * i + 1] = sinf(ang); }
    for (int i = gth; i < 2048 * 4096 / 2; i += NGT) {
        const int tp = i / 2048, kk = (i % 2048) * 2; float v[2];
#pragma unroll
        for (int e = 0; e < 2; ++e) { const int k = kk + e, t = k & 2047; const int ph = (tp * t) & 2047; const float x = (float)ph * (1.f / 1024.f); v[e] = ((k < 2048) ? cospif(x) : -sinpif(x)) * 0.0027621358640099513f; }
        WSP(unsigned, WS_DFT)[i] = pk(v[0], v[1]);
    }
    for (int i = gth; i < 256 * 512 / 2; i += NGT) {
        const int tp = i / 256, kk = (i % 256) * 2; float v[2];
#pragma unroll
        for (int e = 0; e < 2; ++e) { const int k = kk + e, t = k & 255; const int ph = (tp * t) & 255; const float x = (float)ph * (1.f / 128.f); v[e] = ((k < 256) ? cospif(x) : -sinpif(x)) * 0.0078125f; }
        WSP(unsigned, WS_DFTC)[i] = pk(v[0], v[1]);
    }
    for (int l = 0; l < 2; ++l) {
        const float* win = C.P.in[10 + C.z] + (size_t)l * 1024 * IN_COLS;
        bf16* wi = WL(bf16, l, WL_IN);
        tr_matrix(C, win, IN_COLS, 1024, 1152, 512, wi, 0, scr);
        tr_matrix(C, win, IN_COLS, 1024, 1664, 128, wi, 512, scr);
        tr_matrix(C, win, IN_COLS, 1024, 1792, 128, wi, 640, scr);
        tr_matrix(C, win, IN_COLS, 1024, 0, 1152, wi, 1280, scr);
        for (int i = gth; i < 128 * 1024 / 2; i += NGT) ((unsigned*)(wi + (size_t)2432 * 1024))[i] = 0u;
        for (int i = gth; i < 512 * 1024; i += NGT) {
            const int k = i & 1023, np = i >> 10, sn = np >> 8, g = (np >> 6) & 3, cp = np & 63;
            const float* wr_ = win + (size_t)k * IN_COLS + 1920 + g * 64; float a = 0.f;
            for (int c = 0; c < 64; ++c) { const float x = (float)((c * cp) & 63) * (1.f / 32.f); a += wr_[c] * (sn ? sinpif(x) : cospif(x)); }
            wi[(size_t)(768 + np) * 1024 + k] = f2bf(a);
        }
        {
            bf16* wl = WSP(bf16, WS_WLORA + (size_t)l * 2 * MiB);
            const float* w2 = C.P.in[13 + C.z] + (size_t)l * 2 * 64 * 256; const float* a2 = C.P.in[15 + C.z] + (size_t)l * 2 * 64 * 256; const float* g2 = C.P.in[16 + C.z] + (size_t)l * 128 * 256;
            for (int i = gth; i < NLO * KLO; i += NGT) {
                const int c = i & 255, nb = (i >> 8) % 6, k = i / (256 * 6); float v = 0.f;
                if (nb == 0) { if (k < 64) v = w2[k * 256 + c]; }
                else if (nb == 1) { if (k >= 64 && k < 128) v = w2[(64 + k - 64) * 256 + c]; }
                else if (nb == 2) { if (k >= 128 && k < 192) v = a2[(k - 128) * 256 + c]; }
                else if (nb == 3) { if (k >= 192 && k < 256) v = a2[(64 + k - 192) * 256 + c]; }
                else if (nb == 4) { if (k >= 256 && k < 384) v = g2[(k - 256) * 256 + c]; }
                else if (l == 1 && k >= 384) { const float* v1 = C.P.in[23 + C.z] + (k - 384) * 32; const float* v2 = C.P.in[24 + C.z] + c; for (int j = 0; j < 32; ++j) v += v1[j] * v2[j * 256]; }
                wl[(size_t)(nb * 256 + c) * KLO + k] = f2bf(v);
            }
        }
        tr_matrix(C, win, IN_COLS, 1024, 2176, 3072, WL(bf16, l, WL_G), 0, scr);
        tr_matrix(C, C.P.in[26 + C.z] + (size_t)l * 256 * 1024, 1024, 256, 0, 1024, WL(bf16, l, WL_BR), 0, scr);
        tr_matrix(C, C.P.in[27 + C.z] + (size_t)l * 512 * 1024, 1024, 512, 0, 1024, WL(bf16, l, WL_BA), 0, scr);
        tr_matrix(C, C.P.in[28 + C.z] + (size_t)l * 256 * 1024, 1024, 256, 0, 1024, WL(bf16, l, WL_BF), 0, scr);
        tr_matrix(C, C.P.in[29 + C.z] + (size_t)l * 1024 * 1024, 1024, 1024, 0, 1024, WL(bf16, l, WL_O), 0, scr);
        {
            const float* up = C.P.in[30 + C.z] + (size_t)l * 1024 * 2 * DFF; bf16* wu = WL(bf16, l, WL_UP);
            const int gw = C.bid * NWAVES + C.wave, NGW = C.G * NWAVES, nit = 16 * 44 * 4;
            for (int it = gw; it < nit; it += NGW) { const int kb = it / 176, r = it % 176, seg = r >> 2, b = r & 3, pn = seg >> 1, bj = seg & 1;
                tr_item(up, 2 * DFF, kb * 64, bj * DFF + pn * 128 + b * 32, wu, 1024, pn * 256 + bj * 128 + b * 32, scr, C.lane); }
        }
        tr_matrix(C, C.P.in[33 + C.z] + (size_t)l * DFF * 1024, 1024, DFF, 0, 1024, WL(bf16, l, WL_DN), 0, scr);
    }
}

template <bool HAS_ADD, bool HAS_OUT>
DI void rowop(const Ctx& C0, int nrows, const float* hin_l, const float* hin_c, float* hout_l, float* hout_c, const bf16* add, int ga, const float* g_add, const float* g_out, int sh, int sc, const float* modl, const float* modo, bf16* Aout) {
    const Ctx C = rectx(C0);
    const int rpw = (nrows + C.G * NWAVES - 1) / (C.G * NWAVES), r0 = (C.bid * NWAVES + C.wave) * rpw, r1 = (r0 + rpw < nrows) ? r0 + rpw : nrows;
    if (r0 >= r1) return;
    const int c0 = 4 * C.lane;
    f32x4 gA[4], gO[4], mG[4], mS[4], mB[4];
#pragma unroll
    for (int j = 0; j < 4; ++j) { if (HAS_ADD) gA[j] = *(const f32x4*)(g_add + c0 + 256 * j); if (HAS_OUT) gO[j] = *(const f32x4*)(g_out + c0 + 256 * j); }
    int bcur = -1;
    f32x4 hn[4]; u32x2 an[4];
#define ROW_HP(t) (((t) < NLAT) ? hin_l + (size_t)(t) * DM : hin_c + (size_t)((t) - NLAT) * DM)
    { const float* hp = ROW_HP(r0);
#pragma unroll
      for (int j = 0; j < 4; ++j) { hn[j] = *(const f32x4*)(hp + c0 + 256 * j); if (HAS_ADD) an[j] = *(const u32x2*)(add + (size_t)r0 * DM + c0 + 256 * j); } }
    for (int tok = r0; tok < r1; ++tok) {
        f32x4 h[4]; u32x2 ar[4];
#pragma unroll
        for (int j = 0; j < 4; ++j) { h[j] = hn[j]; if (HAS_ADD) ar[j] = an[j]; }
        if (tok + 1 < r1) { const float* hp = ROW_HP(tok + 1);
#pragma unroll
            for (int j = 0; j < 4; ++j) { hn[j] = *(const f32x4*)(hp + c0 + 256 * j); if (HAS_ADD) an[j] = *(const u32x2*)(add + (size_t)(tok + 1) * DM + c0 + 256 * j); } }
        const bool lat = tok < NLAT; const int b = lat ? tok / TL : 32;
        if (b != bcur) { bcur = b; const float* mp = modl + (size_t)b * 6144; const float* mq = modo + (size_t)b * 6144;
#pragma unroll
            for (int j = 0; j < 4; ++j) { if (HAS_ADD) mG[j] = *(const f32x4*)(mp + ga * 1024 + c0 + 256 * j); if (HAS_OUT) { mS[j] = *(const f32x4*)(mq + sc * 1024 + c0 + 256 * j) + 1.f; mB[j] = *(const f32x4*)(mq + sh * 1024 + c0 + 256 * j); } } }
        if (HAS_ADD) {
            f32x4 a[4]; float ss = 0.f;
#pragma unroll
            for (int j = 0; j < 4; ++j) { a[j] = (f32x4){lo2f(ar[j].x), hi2f(ar[j].x), lo2f(ar[j].y), hi2f(ar[j].y)}; ss += a[j][0] * a[j][0] + a[j][1] * a[j][1] + a[j][2] * a[j][2] + a[j][3] * a[j][3]; }
            const float rstd = rsqrtf(wave_sum(ss) * (1.f / DM) + 1e-6f);
            float* op = lat ? hout_l + (size_t)tok * DM : hout_c + (size_t)(tok - NLAT) * DM;
#pragma unroll
            for (int j = 0; j < 4; ++j) { h[j] = h[j] + mG[j] * (a[j] * rstd * gA[j]); *(f32x4*)(op + c0 + 256 * j) = h[j]; }
        }
        if (HAS_OUT) {
            float ss = 0.f;
#pragma unroll
            for (int j = 0; j < 4; ++j) ss += h[j][0] * h[j][0] + h[j][1] * h[j][1] + h[j][2] * h[j][2] + h[j][3] * h[j][3];
            const float rstd = rsqrtf(wave_sum(ss) * (1.f / DM) + 1e-6f);
#pragma unroll
            for (int j = 0; j < 4; ++j) { const f32x4 y = (h[j] * rstd * gO[j]) * mS[j] + mB[j]; u32x2 o; o.x = pk(y[0], y[1]); o.y = pk(y[2], y[3]);
                *(u32x2*)(Aout + (size_t)tok * DM + c0 + 256 * j) = o; }
        }
    }
#undef ROW_HP
}

DI void feat1_phase(const Ctx& C0, int l) {
    const Ctx C = rectx(C0);
    const bf16* UR = WSP(bf16, WS_X + X_UR); bf16* F = WSP(bf16, WS_X + X_F); bf16* X2 = WSP(bf16, WS_A);
    const float* mu = C.P.in[11 + C.z] + (size_t)l * 2 * RW;
    const int gth = C.bid * NTHREADS + C.tid, NGT = C.G * NTHREADS;
    for (int idx = gth; idx < NT * 144; idx += NGT) {
        const int tok = idx / 144, pc = idx - tok * 144, cc = pc * 8;
        const int t = (tok < NLAT) ? (tok & (TL - 1)) : ((tok - NLAT) & (TC - 1)), T = (tok < NLAT) ? TL : TC;
        const bf16* up_ = UR + (size_t)tok * RW + cc;
        const u32x4 u = *(const u32x4*)up_;
        u32x4 p = {0u, 0u, 0u, 0u}, nx = {0u, 0u, 0u, 0u};
        if (t > 0) p = *(const u32x4*)(up_ - RW);
        if (t < T - 1) nx = *(const u32x4*)(up_ + RW);
        const f32x4 m0a = *(const f32x4*)(mu + cc), m0b = *(const f32x4*)(mu + cc + 4), m1a = *(const f32x4*)(mu + RW + cc), m1b = *(const f32x4*)(mu + RW + cc + 4);
        float s[8];
#pragma unroll
        for (int e = 0; e < 8; ++e) { const float uu = (e & 1) ? hi2f(u[e >> 1]) : lo2f(u[e >> 1]), pp = (e & 1) ? hi2f(p[e >> 1]) : lo2f(p[e >> 1]), nn = (e & 1) ? hi2f(nx[e >> 1]) : lo2f(nx[e >> 1]);
            const float m0 = (e < 4) ? m0a[e & 3] : m0b[e & 3], m1 = (e < 4) ? m1a[e & 3] : m1b[e & 3];
            s[e] = uu + m0 * (pp - uu) + m1 * (nn - uu); }
        if (cc >= 768 && cc < 896) {
#pragma unroll
            for (int e = 0; e < 8; ++e) s[e] = tanh_(s[e]); }
        else if (cc >= 1024) {
#pragma unroll
            for (int e = 0; e < 8; ++e) s[e] = sigm(s[e]); }
        u32x4 w; w.x = pk(s[0], s[1]); w.y = pk(s[2], s[3]); w.z = pk(s[4], s[5]); w.w = pk(s[6], s[7]);
        if (cc < 256) *(u32x4*)(F + (size_t)tok * 2048 + cc) = w;
        else if (cc < 512) *(u32x4*)(F + (size_t)tok * 2048 + 768 + cc - 256) = w;
        else if (cc < 768) { *(u32x4*)(F + (size_t)tok * 2048 + 512 + cc - 512) = w; *(u32x4*)(X2 + (size_t)tok * KLO + 384 + cc - 512) = w; }
        else *(u32x4*)(X2 + (size_t)tok * KLO + cc - 768) = w;
    }
}
DI void feat3_phase(const Ctx& C0, int l) {
    const Ctx C = rectx(C0);
    bf16* F = WSP(bf16, WS_X + X_F); bf16* Gq = WSP(bf16, WS_X + X_G); bf16* VF = WSP(bf16, WS_VF); float* BON = WSP(float, WS_BON); const bf16* LO = WSP(bf16, WS_X + X_LO);
    const int c = (C.lane >> 4) * 64 + (C.lane & 15) * 4;
    const f32x4 kkw = *(const f32x4*)(C.P.in[17 + C.z] + l * 256 + c), kaw = *(const f32x4*)(C.P.in[18 + C.z] + l * 256 + c), rkw = *(const f32x4*)(C.P.in[19 + C.z] + l * 256 + c);
    const f32x4 w0f = *(const f32x4*)(C.P.in[12 + C.z] + l * 512 + c), w0b = *(const f32x4*)(C.P.in[12 + C.z] + l * 512 + 256 + c), a0f = *(const f32x4*)(C.P.in[14 + C.z] + l * 512 + c), a0b = *(const f32x4*)(C.P.in[14 + C.z] + l * 512 + 256 + c);
    const f32x4 v0c = *(const f32x4*)(C.P.in[22 + C.z] + c);
    const int rpw = NT / (256 * NWAVES), r0 = (C.bid * NWAVES + C.wave) * rpw;
    if (C.bid >= 256) return;
    u32x2 nR, nK, nV, nVF, nL[6];
#define F3_LOAD(t) do { const size_t o_ = (size_t)(t) * 256 + c; const bf16* f_ = F + (size_t)(t) * 2048 + c; nR = *(const u32x2*)(f_); nK = *(const u32x2*)(f_ + 768); nV = *(const u32x2*)(f_ + 512); if (l == 1) nVF = *(const u32x2*)(VF + o_); \
        _Pragma("unroll") for (int q = 0; q < 6; ++q) if (q < 5 || l == 1) nL[q] = *(const u32x2*)(LO + (size_t)(t) * NLO + q * 256 + c); } while (0)
    F3_LOAD(r0);
    for (int tok = r0; tok < r0 + rpw; ++tok) {
        const u32x2 cR = nR, cK = nK, cV = nV, cVF = nVF; u32x2 cL[6];
#pragma unroll
        for (int q = 0; q < 6; ++q) cL[q] = nL[q];
        if (tok + 1 < r0 + rpw) F3_LOAD(tok + 1);
        const size_t o = (size_t)tok * 256 + c;
        const f32x4 r = bf4(cR), k = bf4(cK); f32x4 v = bf4(cV);
        if (l == 1) { const f32x4 vf = bf4(cVF), z = v0c + bf4(cL[5]);
#pragma unroll
            for (int e = 0; e < 4; ++e) v[e] = v[e] + (vf[e] - v[e]) * sigm(z[e]);
            *(u32x2*)(F + (size_t)tok * 2048 + 512 + c) = pk4(v); }
        else *(u32x2*)(VF + o) = cV;
        const f32x4 kr = k * kkw;
        const float ss = row16_sum(kr[0] * kr[0] + kr[1] * kr[1] + kr[2] * kr[2] + kr[3] * kr[3]), rn = rsqrtf(fmaxf(ss, 1e-24f));
        const f32x4 lf = w0f + bf4(cL[0]), lb = w0b + bf4(cL[1]), xf = a0f + bf4(cL[2]), xb = a0b + bf4(cL[3]);
        f32x4 ef, eb, af, ab; float bp = 0.f;
#pragma unroll
        for (int e = 0; e < 4; ++e) { ef[e] = 0.6065306597126334f * sigm(lf[e]); eb[e] = 0.6065306597126334f * sigm(lb[e]); af[e] = sigm(xf[e]); ab[e] = sigm(xb[e]);
            bp += r[e] * k[e] * (1.f + (0.5f * (af[e] + ab[e]) - 1.f) * kaw[e]) * rkw[e]; }
        const float bon = row16_sum(bp);
        if ((C.lane & 15) == 0) BON[(size_t)tok * 4 + (C.lane >> 4)] = bon;
        { bf16* f_ = F + (size_t)tok * 2048 + c; *(u32x2*)(f_ + 256) = pk4(kr * rn); *(u32x2*)(f_ + 1024) = pk4(ef); *(u32x2*)(f_ + 1280) = pk4(eb); *(u32x2*)(f_ + 1536) = pk4(af); *(u32x2*)(f_ + 1792) = pk4(ab); }
        *(u32x2*)(Gq + o) = cL[4];
    }
#undef F3_LOAD
}

struct ScanOp { bf16 r, kk, k, e, a, v; };
DI int scan_tok(int n, int dir, int b) { n = n < 2303 ? n : 2303; if (n < 256) return CTXB + b * 256 + (dir ? 255 - n : n); const int t = n - 256; return b * TL + (dir ? TL - 1 - t : t); }
DI ScanOp scan_load(const bf16* Ft, int dir, unsigned ck, unsigned cv) {
    ScanOp o; o.r = Ft[ck]; o.kk = Ft[256 + ck]; o.k = Ft[768 + ck]; o.e = (Ft + (4 + dir) * 256)[ck]; o.a = (Ft + (6 + dir) * 256)[ck]; o.v = Ft[512 + cv]; return o;
}
#define DPPT " row_mask:0xf bank_mask:0xf\n\t"
#define SOPS(S) "+v"(S[0]), "+v"(S[1]), "+v"(S[2]), "+v"(S[3]), "+v"(S[4]), "+v"(S[5]), "+v"(S[6]), "+v"(S[7]), "+v"(S[8]), "+v"(S[9]), "+v"(S[10]), "+v"(S[11]), "+v"(S[12]), "+v"(S[13]), "+v"(S[14]), "+v"(S[15])
DI void scan_step(float (&S)[16], const ScanOp& op, float ka, bf16* yp, bool wr) {
    float r = bf2f(op.r), kk = bf2f(op.kk), k = bf2f(op.k), e = bf2f(op.e), a = bf2f(op.a); const float v = bf2f(op.v);
    float w = fexp2(-e * LOG2E), kd = k * (1.f + (a - 1.f) * ka), nbd = -(kk * a);
    asm volatile("s_nop 4" : "+v"(r), "+v"(w), "+v"(kd), "+v"(nbd), "+v"(kk));
    float sa0 = 0.f, sa1 = 0.f;
    asm volatile(
        "v_fmac_f32_dpp %16, %18, %0 row_newbcast:0" DPPT "v_fmac_f32_dpp %17, %18, %1 row_newbcast:1" DPPT "v_fmac_f32_dpp %16, %18, %2 row_newbcast:2" DPPT "v_fmac_f32_dpp %17, %18, %3 row_newbcast:3" DPPT
        "v_fmac_f32_dpp %16, %18, %4 row_newbcast:4" DPPT "v_fmac_f32_dpp %17, %18, %5 row_newbcast:5" DPPT "v_fmac_f32_dpp %16, %18, %6 row_newbcast:6" DPPT "v_fmac_f32_dpp %17, %18, %7 row_newbcast:7" DPPT
        "v_fmac_f32_dpp %16, %18, %8 row_newbcast:8" DPPT "v_fmac_f32_dpp %17, %18, %9 row_newbcast:9" DPPT "v_fmac_f32_dpp %16, %18, %10 row_newbcast:10" DPPT "v_fmac_f32_dpp %17, %18, %11 row_newbcast:11" DPPT
        "v_fmac_f32_dpp %16, %18, %12 row_newbcast:12" DPPT "v_fmac_f32_dpp %17, %18, %13 row_newbcast:13" DPPT "v_fmac_f32_dpp %16, %18, %14 row_newbcast:14" DPPT "v_fmac_f32_dpp %17, %18, %15 row_newbcast:15" DPPT
        : SOPS(S), "+v"(sa0), "+v"(sa1) : "v"(kk));
    const float sa = allred4(sa0 + sa1);
#define UPM(j) "v_mul_f32_dpp %" #j ", %16, %" #j " row_newbcast:" #j DPPT
#define UPA(j) "v_fmac_f32_dpp %" #j ", %17, %19 row_newbcast:" #j DPPT
#define UPB(j) "v_fmac_f32_dpp %" #j ", %18, %20 row_newbcast:" #j DPPT
#define ALL16(M) M(0) M(1) M(2) M(3) M(4) M(5) M(6) M(7) M(8) M(9) M(10) M(11) M(12) M(13) M(14) M(15)
    asm volatile(ALL16(UPM) ALL16(UPA) ALL16(UPB) : SOPS(S) : "v"(w), "v"(nbd), "v"(kd), "v"(sa), "v"(v));
#undef UPM
#undef UPA
#undef UPB
    float y0 = 0.f, y1 = 0.f;
    asm volatile(
        "v_fmac_f32_dpp %16, %18, %0 row_newbcast:0" DPPT "v_fmac_f32_dpp %17, %18, %1 row_newbcast:1" DPPT "v_fmac_f32_dpp %16, %18, %2 row_newbcast:2" DPPT "v_fmac_f32_dpp %17, %18, %3 row_newbcast:3" DPPT
        "v_fmac_f32_dpp %16, %18, %4 row_newbcast:4" DPPT "v_fmac_f32_dpp %17, %18, %5 row_newbcast:5" DPPT "v_fmac_f32_dpp %16, %18, %6 row_newbcast:6" DPPT "v_fmac_f32_dpp %17, %18, %7 row_newbcast:7" DPPT
        "v_fmac_f32_dpp %16, %18, %8 row_newbcast:8" DPPT "v_fmac_f32_dpp %17, %18, %9 row_newbcast:9" DPPT "v_fmac_f32_dpp %16, %18, %10 row_newbcast:10" DPPT "v_fmac_f32_dpp %17, %18, %11 row_newbcast:11" DPPT
        "v_fmac_f32_dpp %16, %18, %12 row_newbcast:12" DPPT "v_fmac_f32_dpp %17, %18, %13 row_newbcast:13" DPPT "v_fmac_f32_dpp %16, %18, %14 row_newbcast:14" DPPT "v_fmac_f32_dpp %17, %18, %15 row_newbcast:15" DPPT
        : SOPS(S), "+v"(y0), "+v"(y1) : "v"(r));
    const float y = allred4(y0 + y1);
    if (wr) *yp = f2bf(y);
}
DI void scan_run(const Ctx& C0, int l, int b, int h, int dir) {
    const Ctx C = rectx(C0);
    if (C.wave >= 4) return;
    const int wv = C.wave & 3, q = C.lane >> 4, vi = C.lane & 15;
    const unsigned ck = h * 64 + C.lane, cv = h * 64 + 16 * wv + vi;
    const bf16* F = WSP(bf16, WS_X + X_F);
    bf16* YS = WSP(bf16, WS_X + X_UR) + (size_t)dir * FSZ;
    const float ka = C.P.in[18 + C.z][l * 256 + ck];
    float S[16];
#pragma unroll
    for (int j = 0; j < 16; ++j) S[j] = 0.f;
    const bool wr = (q == 0);
    size_t t0 = (size_t)scan_tok(0, dir, b) * 256, t1 = (size_t)scan_tok(1, dir, b) * 256, t2 = (size_t)scan_tok(2, dir, b) * 256, t3 = (size_t)scan_tok(3, dir, b) * 256;
    ScanOp o0 = scan_load(F + t0 * 8, dir, ck, cv), o1 = scan_load(F + t1 * 8, dir, ck, cv), o2 = scan_load(F + t2 * 8, dir, ck, cv), o3 = scan_load(F + t3 * 8, dir, ck, cv);
    for (int n = 0; n < 2304; n += 4) {
        size_t tn;
        scan_step(S, o0, ka, &(YS + t0)[cv], wr); tn = (size_t)__builtin_amdgcn_readfirstlane(scan_tok(n + 4, dir, b)) * 256; o0 = scan_load(F + tn * 8, dir, ck, cv); t0 = tn;
        scan_step(S, o1, ka, &(YS + t1)[cv], wr); tn = (size_t)__builtin_amdgcn_readfirstlane(scan_tok(n + 5, dir, b)) * 256; o1 = scan_load(F + tn * 8, dir, ck, cv); t1 = tn;
        scan_step(S, o2, ka, &(YS + t2)[cv], wr); tn = (size_t)__builtin_amdgcn_readfirstlane(scan_tok(n + 6, dir, b)) * 256; o2 = scan_load(F + tn * 8, dir, ck, cv); t2 = tn;
        scan_step(S, o3, ka, &(YS + t3)[cv], wr); tn = (size_t)__builtin_amdgcn_readfirstlane(scan_tok(n + 7, dir, b)) * 256; o3 = scan_load(F + tn * 8, dir, ck, cv); t3 = tn;
    }
}

DI void readout_phase(const Ctx& C0, int l, int nrows) {
    const Ctx C = rectx(C0);
    const bf16* F = WSP(bf16, WS_X + X_F); const bf16* Gq = WSP(bf16, WS_X + X_G); const bf16* YS = WSP(bf16, WS_X + X_UR); const float* BON = WSP(float, WS_BON);
    bf16* YR = WSP(bf16, WS_A + (size_t)108 * MiB);
    const int c = (C.lane >> 4) * 64 + (C.lane & 15) * 4;
    const f32x4 lw = *(const f32x4*)(C.P.in[20 + C.z] + l * 256 + c), lb = *(const f32x4*)(C.P.in[21 + C.z] + l * 256 + c);
    const int rpw = (nrows + C.G * NWAVES - 1) / (C.G * NWAVES), r0 = (C.bid * NWAVES + C.wave) * rpw, r1 = (r0 + rpw < nrows) ? r0 + rpw : nrows;
    if (r0 >= r1) return;
    u32x2 nF, nB, nV, nG; float nBon;
#define RO_LOAD(t) do { const size_t o_ = (size_t)(t) * 256 + c; nF = *(const u32x2*)(YS + o_); nB = *(const u32x2*)(YS + FSZ + o_); nV = *(const u32x2*)(F + (size_t)(t) * 2048 + 512 + c); nG = *(const u32x2*)(Gq + o_); nBon = BON[(size_t)(t) * 4 + (C.lane >> 4)]; } while (0)
    RO_LOAD(r0);
    for (int tok = r0; tok < r1; ++tok) {
        const u32x2 cF = nF, cB = nB, cV = nV, cG = nG; const float bon = nBon;
        if (tok + 1 < r1) RO_LOAD(tok + 1);
        const f32x4 y = bf4(cF) + bf4(cB);
        const float mean = row16_sum(y[0] + y[1] + y[2] + y[3]) * (1.f / 64.f);
        const f32x4 d = y - mean;
        const float var = row16_sum(d[0] * d[0] + d[1] * d[1] + d[2] * d[2] + d[3] * d[3]) * (1.f / 64.f);
        const f32x4 yn = d * rsqrtf(var + 64e-5f) * lw + lb;
        *(u32x2*)(YR + (size_t)tok * 256 + c) = pk4((yn + bf4(cV) * bon) * bf4(cG));
    }
#undef RO_LOAD
}

DI void fixup_phase(const Ctx& C0, int l, int nrows) {
    const Ctx C = rectx(C0);
    const int gw = C.bid * NWAVES + C.wave, NGW = C.G * NWAVES, nitem = (nrows / 64) * 2;
    const bf16* HALO = WSP(bf16, WS_X + X_HALO); bf16* HH = WSP(bf16, WS_X + X_HH);
    const float* cw = C.P.in[31 + C.z] + (size_t)l * 3 * DFF; const float* cb = C.P.in[32 + C.z] + (size_t)l * DFF;
    for (int it = gw; it < nitem; it += NGW) {
        const int grp = it >> 1, last = it & 1, row = grp * 64 + (last ? 63 : 0);
        const int t = (row < NLAT) ? (row & (TL - 1)) : ((row - NLAT) & (TC - 1)), T = (row < NLAT) ? TL : TC;
        const bf16* hb = HALO + (size_t)grp * 6 * DFF;
        const bf16 *pp, *pc, *pn, *pv; bool zp = false, zn = false;
        if (!last) { pc = hb; pn = hb + DFF; pv = hb + 4 * DFF; zp = (t == 0); pp = zp ? hb : hb - 6 * DFF + 3 * DFF; }
        else { pp = hb + 2 * DFF; pc = hb + 3 * DFF; pv = hb + 5 * DFF; zn = (t == T - 1); pn = zn ? hb : hb + 6 * DFF; }
        for (int p = C.lane; p < DFF / 8; p += 64) { const int j = p * 8;
            const u32x4 a = *(const u32x4*)(pp + j), bq = *(const u32x4*)(pc + j), cq = *(const u32x4*)(pn + j), vq = *(const u32x4*)(pv + j);
            float o[8];
#pragma unroll
            for (int e = 0; e < 8; ++e) { const unsigned ua = a[e >> 1], ub = bq[e >> 1], uc = cq[e >> 1], uv = vq[e >> 1];
                const float xp = zp ? 0.f : ((e & 1) ? hi2f(ua) : lo2f(ua)), xc = (e & 1) ? hi2f(ub) : lo2f(ub), xn = zn ? 0.f : ((e & 1) ? hi2f(uc) : lo2f(uc)), xv = (e & 1) ? hi2f(uv) : lo2f(uv);
                const float z = cw[j + e] * xp + cw[DFF + j + e] * xc + cw[2 * DFF + j + e] * xn + cb[j + e]; o[e] = gelu_tanh(z) * xv; }
            u32x4 w; w.x = pk(o[0], o[1]); w.y = pk(o[2], o[3]); w.z = pk(o[4], o[5]); w.w = pk(o[6], o[7]);
            *(u32x4*)(HH + (size_t)row * DFF + j) = w; }
    }
}

DI int crow(int i, int hh) { return (i & 3) + 8 * (i >> 2) + 4 * hh; }
DI void attn_unit(const Ctx& C, int l, int b, int kh, int qblk, bool isctx) {
    LAS bf16* Ks = (LAS bf16*)C.lds; LAS bf16* Vt = Ks + 64 * 72;
    const bf16* QKV = WSP(bf16, WS_X + X_QKV); bf16* YA = WSP(bf16, WS_A); const float* RT = WSP(float, WS_SMALL);
    const int g = C.wave >> 1, qt = C.wave & 1, hq = kh * 4 + g, r = C.lane & 31, hh = C.lane >> 5;
    const int qi = qblk * 64 + qt * 32 + r;
    const size_t tq = isctx ? (size_t)(CTXB + b * TC + qi) : (size_t)(b * TL + qi);
    bf16x8 qf[4];
    {
        float qv[4][8]; const bf16* qp = QKV + tq * 768 + hq * 64 + 8 * hh;
#pragma unroll
        for (int ks = 0; ks < 4; ++ks) { const u32x4 u = *(const u32x4*)(qp + 16 * ks);
#pragma unroll
            for (int e = 0; e < 4; ++e) { qv[ks][2 * e] = lo2f(u[e]); qv[ks][2 * e + 1] = hi2f(u[e]); } }
        if (!isctx) { const int rid = qi >> 6, cid = qi & 63;
#pragma unroll
            for (int j = 0; j < 8; ++j) { const int f = 8 * hh + j;
                const float c0 = RT[(rid * 16 + f) * 2], s0 = RT[(rid * 16 + f) * 2 + 1], c1 = RT[(cid * 16 + f) * 2], s1 = RT[(cid * 16 + f) * 2 + 1];
                const float a1 = qv[0][j], a2 = qv[1][j], b1 = qv[2][j], b2 = qv[3][j];
                qv[0][j] = a1 * c0 - a2 * s0; qv[1][j] = a2 * c0 + a1 * s0; qv[2][j] = b1 * c1 - b2 * s1; qv[3][j] = b2 * c1 + b1 * s1; } }
        const float sc = 0.125f * LOG2E;
#pragma unroll
        for (int ks = 0; ks < 4; ++ks) { u32x4 w; w.x = pk(qv[ks][0] * sc, qv[ks][1] * sc); w.y = pk(qv[ks][2] * sc, qv[ks][3] * sc); w.z = pk(qv[ks][4] * sc, qv[ks][5] * sc); w.w = pk(qv[ks][6] * sc, qv[ks][7] * sc); qf[ks] = __builtin_bit_cast(bf16x8, w); }
    }
    float m_run = C.P.in[25 + C.z][l * 8 + hq] * LOG2E, l_run = hh == 0 ? 1.f : 0.f;
    f32x16 o0, o1;
#pragma unroll
    for (int i = 0; i < 16; ++i) { o0[i] = 0.f; o1[i] = 0.f; }
    const int nch = isctx ? 4 : 9, skey = C.tid >> 3, oct = C.tid & 7;
    for (int ch = 0; ch < nch; ++ch) {
        const bool win = ch >= 4; int kb = 0; size_t ktok0;
        if (!win) ktok0 = (size_t)(CTXB + b * TC + ch * 64);
        else { kb = qblk * 64 - 128 + (ch - 4) * 64; if (kb < 0 || kb >= TL) continue; ktok0 = (size_t)(b * TL + kb); }
        __syncthreads();
        {
            const bf16* kp = QKV + (ktok0 + skey) * 768 + 512 + kh * 64; const bf16* vp = kp + 128;
            u32x4 ku = *(const u32x4*)(kp + 8 * oct);
            if (win) { const u32x4 pu = *(const u32x4*)(kp + 8 * (oct ^ 2));
                const int p = kb + skey, pos = (oct >> 2) ? (p & 63) : (p >> 6), fb = 8 * (oct & 1); const bool isx1 = (oct & 2) == 0;
                float o[8];
#pragma unroll
                for (int e = 0; e < 8; ++e) { const float own = (e & 1) ? hi2f(ku[e >> 1]) : lo2f(ku[e >> 1]), par = (e & 1) ? hi2f(pu[e >> 1]) : lo2f(pu[e >> 1]);
                    const float cc = RT[(pos * 16 + fb + e) * 2], ss = RT[(pos * 16 + fb + e) * 2 + 1];
                    o[e] = isx1 ? (own * cc - par * ss) : (own * cc + par * ss); }
                ku.x = pk(o[0], o[1]); ku.y = pk(o[2], o[3]); ku.z = pk(o[4], o[5]); ku.w = pk(o[6], o[7]); }
            *(LAS u32x4*)(Ks + skey * 72 + 8 * oct) = ku;
            const u32x4 vu = *(const u32x4*)(vp + 8 * oct);
#pragma unroll
            for (int e = 0; e < 8; ++e) Vt[(8 * oct + e) * 72 + skey] = (bf16)((e & 1) ? (vu[e >> 1] >> 16) : (vu[e >> 1] & 0xffffu));
        }
        __syncthreads();
        f32x16 x0, x1;
#pragma unroll
        for (int i = 0; i < 16; ++i) { x0[i] = 0.f; x1[i] = 0.f; }
#pragma unroll
        for (int ks = 0; ks < 4; ++ks) {
            const bf16x8 a0 = *(const LAS bf16x8*)(Ks + r * 72 + 16 * ks + 8 * hh), a1 = *(const LAS bf16x8*)(Ks + (32 + r) * 72 + 16 * ks + 8 * hh);
            x0 = __builtin_amdgcn_mfma_f32_32x32x16_bf16(a0, qf[ks], x0, 0, 0, 0);
            x1 = __builtin_amdgcn_mfma_f32_32x32x16_bf16(a1, qf[ks], x1, 0, 0, 0);
        }
        if (win) {
#pragma unroll
            for (int i = 0; i < 16; ++i) { const int k0 = kb + crow(i, hh), d0 = qi - k0, d1 = d0 - 32;
                if (d0 > 128 || d0 < -128) x0[i] = -1e30f; if (d1 > 128 || d1 < -128) x1[i] = -1e30f; }
        }
        float mx = x0[0];
#pragma unroll
        for (int i = 0; i < 16; ++i) { mx = fmaxf(mx, x0[i]); mx = fmaxf(mx, x1[i]); }
        mx = fmaxf(mx, __shfl_xor(mx, 32));
        const float m_new = fmaxf(m_run, mx), alpha = fexp2(m_run - m_new);
        float ps = 0.f;
#pragma unroll
        for (int i = 0; i < 16; ++i) { x0[i] = fexp2(x0[i] - m_new); x1[i] = fexp2(x1[i] - m_new); ps += x0[i] + x1[i]; o0[i] *= alpha; o1[i] *= alpha; }
        l_run = l_run * alpha + ps; m_run = m_new;
#pragma unroll
        for (int kt = 0; kt < 2; ++kt)
#pragma unroll
            for (int s = 0; s < 2; ++s) {
                const f32x16& x = kt ? x1 : x0;
                u32x4 w; w.x = pk(x[8 * s], x[8 * s + 1]); w.y = pk(x[8 * s + 2], x[8 * s + 3]); w.z = pk(x[8 * s + 4], x[8 * s + 5]); w.w = pk(x[8 * s + 6], x[8 * s + 7]);
                const bf16x8 pb = __builtin_bit_cast(bf16x8, w);
                const int ko = kt * 32 + 16 * s + 4 * hh;
                const s16x4 l0 = *(const LAS s16x4*)(Vt + r * 72 + ko), h0 = *(const LAS s16x4*)(Vt + r * 72 + ko + 8);
                const s16x4 l1 = *(const LAS s16x4*)(Vt + (32 + r) * 72 + ko), h1 = *(const LAS s16x4*)(Vt + (32 + r) * 72 + ko + 8);
                o0 = __builtin_amdgcn_mfma_f32_32x32x16_bf16(__builtin_shufflevector(l0, h0, 0, 1, 2, 3, 4, 5, 6, 7), pb, o0, 0, 0, 0);
                o1 = __builtin_amdgcn_mfma_f32_32x32x16_bf16(__builtin_shufflevector(l1, h1, 0, 1, 2, 3, 4, 5, 6, 7), pb, o1, 0, 0, 0);
            }
    }
    const float inv = frcp(l_run + __shfl_xor(l_run, 32));
    bf16* op = YA + tq * 512 + hq * 64 + 4 * hh;
#pragma unroll
    for (int i4 = 0; i4 < 4; ++i4) {
        u32x2 w0, w1; w0.x = pk(o0[4 * i4] * inv, o0[4 * i4 + 1] * inv); w0.y = pk(o0[4 * i4 + 2] * inv, o0[4 * i4 + 3] * inv);
        w1.x = pk(o1[4 * i4] * inv, o1[4 * i4 + 1] * inv); w1.y = pk(o1[4 * i4 + 2] * inv, o1[4 * i4 + 3] * inv);
        *(u32x2*)(op + 8 * i4) = w0; *(u32x2*)(op + 32 + 8 * i4) = w1;
    }
}
DI void attn_loop(const Ctx& C0, int l) {
    const Ctx C = rectx(C0);
    unsigned* ctr = WSP(unsigned, WS_CTL) + 64 * (l + 1);
    volatile LAS unsigned* slot = (volatile LAS unsigned*)(C.lds + 32768);
    const unsigned NU = 2048u + (l == 0 ? 256u : 0u);
    for (;;) {
        __syncthreads();
        if (C.tid == 0) *slot = atomicAdd(ctr, 1u);
        __syncthreads();
        const unsigned u = *slot;
        if (u >= NU) break;
        if (u < 2048u) attn_unit(C, l, (int)(u >> 6), (int)((u >> 5) & 1), (int)(u & 31), false);
        else { const unsigned v = u - 2048u; attn_unit(C, l, (int)(v >> 3), (int)((v >> 2) & 1), (int)(v & 3), true); }
    }
}


#ifdef DBG
DI float exp_f(float x) { return fexp2(x * LOG2E); }
DI unsigned hsh(unsigned x) { x ^= x >> 16; x *= 0x7feb352du; x ^= x >> 15; x *= 0x846ca68bu; x ^= x >> 16; return x; }
DI void dbg_put(const Ctx& C, int k, float got, float ref, float S) {
    float err = fabsf(got - ref) / (fabsf(ref) + S); if (!(err == err)) err = 1e9f;
    atomicMax(WSP(unsigned, WS_CTL) + 1024 + k, __builtin_bit_cast(unsigned, err));
}
DI float ndot(const bf16* a, const bf16* b, int K) { float s = 0.f; for (int k = 0; k < K; ++k) s += bf2f(a[k]) * bf2f(b[k]); return s; }
DI void dbg_check(const Ctx& C0, int stage, int l) {
    if (C0.bid != 0 || l != 0) return;
    const Ctx C = rectx(C0);
    const unsigned h1 = hsh(C.tid * 3u + 17u + stage * 1000u), h2 = hsh(h1 + 0x9e3779b9u), h3 = hsh(h2 + 77u);
    const Params& P = C.P;
    if (stage == 0) {
        {
            const int n = h1 % 2432, k = h2 % 1024; int src = -1;
            if (n < 512) src = 1152 + n; else if (n < 640) src = 1664 + (n - 512); else if (n < 768) src = 1792 + (n - 640); else if (n >= 1280) src = n - 1280;
            if (src >= 0) dbg_put(C, 0, bf2f(WL(bf16, 0, WL_IN)[(size_t)n * 1024 + k]), bf2f(f2bf(P.in[10 + C.z][(size_t)k * IN_COLS + src])), 1e-6f);
            const int ng = h3 % 3072;
            dbg_put(C, 0, bf2f(WL(bf16, 0, WL_G)[(size_t)ng * 1024 + k]), bf2f(f2bf(P.in[10 + C.z][(size_t)k * IN_COLS + 2176 + ng])), 1e-6f);
            const int nu = h3 % 5632, pn = nu >> 8, bj = (nu >> 7) & 1, j = nu & 127;
            dbg_put(C, 0, bf2f(WL(bf16, 0, WL_UP)[(size_t)nu * 1024 + k]), bf2f(f2bf(P.in[30 + C.z][(size_t)k * 5632 + bj * DFF + pn * 128 + j])), 1e-6f);
            const int nd = h1 % 1024, kd = h3 % DFF;
            dbg_put(C, 0, bf2f(WL(bf16, 0, WL_DN)[(size_t)nd * DFF + kd]), bf2f(f2bf(P.in[33 + C.z][(size_t)kd * 1024 + nd])), 1e-6f);
            dbg_put(C, 0, bf2f(WL(bf16, 0, WL_O)[(size_t)nd * 1024 + k]), bf2f(f2bf(P.in[29 + C.z][(size_t)k * 1024 + nd])), 1e-6f);
            dbg_put(C, 0, bf2f(WL(bf16, 0, WL_BA)[(size_t)nd * 512 + (k & 511)]), bf2f(f2bf(P.in[27 + C.z][(size_t)(k & 511) * 1024 + nd])), 1e-6f);
            dbg_put(C, 0, bf2f(WL(bf16, 0, WL_BR)[(size_t)nd * 256 + (k & 255)]), bf2f(f2bf(P.in[26 + C.z][(size_t)(k & 255) * 1024 + nd])), 1e-6f);
        }
        {
            const int r = h1 % 33, j = h2 % 6144; float a = P.in[5 + C.z][j];
            for (int k = 0; k < 1024; ++k) { const float cv = (r < 32) ? P.in[1 + C.z][r * 1024 + k] : P.in[3 + C.z][k]; a += cv / (1.f + exp_f(-cv)) * P.in[4 + C.z][(size_t)k * 6144 + j]; }
            dbg_put(C, 1, WSP(float, WS_MOD)[(size_t)r * 6144 + j], a, 0.01f);
        }
    } else if (stage == 1) {
        const int tok = h1 % NT, col = h2 % 1024; const bool lat = tok < NLAT; const float* hp = lat ? P.in[0 + C.z] + (size_t)tok * DM : P.in[2 + C.z] + (size_t)(tok - NLAT) * DM;
        float ss = 0.f; for (int k = 0; k < 1024; ++k) ss += hp[k] * hp[k];
        const float* mp = WSP(float, WS_MOD) + (size_t)(lat ? tok / TL : 32) * 6144;
        const float ref = hp[col] * rsqrtf(ss / 1024.f + 1e-6f) * P.in[6 + C.z][col] * (1.f + mp[1024 + col]) + mp[col];
        dbg_put(C, 2, bf2f(WSP(bf16, WS_A)[(size_t)tok * DM + col]), ref, 0.05f);
    } else if (stage == 2) {
        const int tok = h1 % NT, n = h2 % 2432; const float ref = ndot(WSP(bf16, WS_A) + (size_t)tok * DM, WL(bf16, 0, WL_IN) + (size_t)n * 1024, 1024);
        float got; int k;
        if (n < 768) { got = bf2f(WSP(bf16, WS_X + X_QKV)[(size_t)tok * 768 + n]); k = 3; }
        else if (n < 1280) { const int sn = (n - 768) >> 8, ch = (n - 768) & 255; k = 4;
            if (tok < NLAT) got = bf2f(WSP(bf16, WS_X + X_ZT)[((size_t)(tok / TL) * 256 + ch) * 4096 + sn * 2048 + (tok % TL)]);
            else got = bf2f(WSP(bf16, WS_X + X_ZTC)[((size_t)((tok - NLAT) / TC) * 256 + ch) * 512 + sn * 256 + ((tok - NLAT) % TC)]); }
        else { got = bf2f(WSP(bf16, WS_X + X_UR)[(size_t)tok * RW + n - 1280]); k = 5; }
        dbg_put(C, k, got, ref, 0.1f);
    } else if (stage == 3) {
        const int b = h1 % 32, t = 1 + h2 % 2046, c = h3 % 256; const size_t tok = (size_t)b * TL + t; const bf16* UR = WSP(bf16, WS_X + X_UR);
        const float u = bf2f(UR[tok * RW + c]), up = bf2f(UR[(tok - 1) * RW + c]), un = bf2f(UR[(tok + 1) * RW + c]);
        dbg_put(C, 7, bf2f(WSP(bf16, WS_X + X_F)[tok * 2048 + c]), u + P.in[11 + C.z][c] * (up - u) + P.in[11 + C.z][RW + c] * (un - u), 0.05f);
        float ss = 0.f; for (int k = 0; k < 64; ++k) { const float x = bf2f(WSP(bf16, WS_X + X_F)[tok * 2048 + 256 + (c & 192) + k]); ss += x * x; }
        dbg_put(C, 7, ss, 1.f, 0.f);
    } else if (stage == 4) {
        {
            LAS float* S = (LAS float*)C.lds; LAS float* sa = S + 4096; const bf16* F = WSP(bf16, WS_X + X_F); const int b = 1, h = 2;
            for (int dir = 0; dir < 2; ++dir) {
                for (int e = C.tid; e < 4096; e += NTHREADS) S[e] = 0.f;
                __syncthreads();
                for (int n = 0; n < 24; ++n) {
                    const size_t oy = (size_t)scan_tok(n, dir, b) * 256 + h * 64, o = (size_t)scan_tok(n, dir, b) * 2048 + h * 64;
                    if (C.tid < 64) { float a = 0.f; for (int k = 0; k < 64; ++k) a -= S[C.tid * 64 + k] * bf2f(F[256 + o + k]); sa[C.tid] = a; }
                    __syncthreads();
                    for (int e = C.tid; e < 4096; e += NTHREADS) { const int v = e >> 6, k = e & 63;
                        const float kk = bf2f(F[256 + o + k]), kr = bf2f(F[768 + o + k]), ee = bf2f(F[(4 + dir) * 256 + o + k]), a = bf2f(F[(6 + dir) * 256 + o + k]), vv = bf2f(F[512 + o + v]);
                        S[e] = S[e] * exp_f(-ee) + sa[v] * (kk * a) + vv * (kr * (1.f + (a - 1.f) * P.in[18 + C.z][h * 64 + k])); }
                    __syncthreads();
                    if (C.tid < 64) { float y = 0.f; for (int k = 0; k < 64; ++k) y += S[C.tid * 64 + k] * bf2f(F[o + k]);
                        dbg_put(C, 8, bf2f(WSP(bf16, WS_X + X_UR)[(size_t)dir * FSZ + oy + C.tid]), y, 0.05f); }
                    __syncthreads();
                }
            }
        }
        {
            LAS float* qs = (LAS float*)C.lds + (size_t)C.tid * 65; const bf16* QKV = WSP(bf16, WS_X + X_QKV);
            const int b = h1 % 32, t = (C.tid & 1) ? (int)(h2 % 2048) : ((C.tid & 2) ? (int)(h2 % 200) : 2047 - (int)(h2 % 200)), hq = h3 % 8, dd = (h3 >> 8) % 64, kh = hq >> 2;
            const size_t tq = (size_t)b * TL + t;
            for (int d = 0; d < 64; ++d) { const int ax = d >> 5, hf = (d >> 4) & 1, f = d & 15; const int ps = ax ? (t & 63) : (t >> 6); const float cs = WSP(float, WS_SMALL)[(ps * 16 + f) * 2], sn = WSP(float, WS_SMALL)[(ps * 16 + f) * 2 + 1];
                const float x1 = bf2f(QKV[tq * 768 + hq * 64 + ax * 32 + f]), x2 = bf2f(QKV[tq * 768 + hq * 64 + ax * 32 + 16 + f]);
                qs[d] = hf ? (x2 * cs + x1 * sn) : (x1 * cs - x2 * sn); }
            float m = P.in[25 + C.z][hq], den = 1.f, acc = 0.f;
            for (int j = 0; j < 256 + 257; ++j) {
                const bool win = j >= 256; const int kp = win ? t - 128 + (j - 256) : j; if (win && (kp < 0 || kp >= TL)) continue;
                const size_t tk = win ? (size_t)b * TL + kp : (size_t)(CTXB + b * TC + kp); float s = 0.f;
                for (int d = 0; d < 64; ++d) { float kv;
                    if (!win) kv = bf2f(QKV[tk * 768 + 512 + kh * 64 + d]);
                    else { const int ax = d >> 5, hf = (d >> 4) & 1, f = d & 15; const int ps = ax ? (kp & 63) : (kp >> 6); const float cs = WSP(float, WS_SMALL)[(ps * 16 + f) * 2], sn = WSP(float, WS_SMALL)[(ps * 16 + f) * 2 + 1];
                        const float x1 = bf2f(QKV[tk * 768 + 512 + kh * 64 + ax * 32 + f]), x2 = bf2f(QKV[tk * 768 + 512 + kh * 64 + ax * 32 + 16 + f]);
                        kv = hf ? (x2 * cs + x1 * sn) : (x1 * cs - x2 * sn); }
                    s += qs[d] * kv; }
                s *= 0.125f; const float mn = fmaxf(m, s), al = exp_f(m - mn), p = exp_f(s - mn);
                den = den * al + p; acc = acc * al + p * bf2f(QKV[tk * 768 + 640 + kh * 64 + dd]); m = mn;
            }
            dbg_put(C, 9, bf2f(WSP(bf16, WS_A)[tq * 512 + hq * 64 + dd]), acc / den, 0.03f);
        }
        __syncthreads();
        {
            LAS float* qs = (LAS float*)C.lds + (size_t)C.tid * 65; const bf16* QKV = WSP(bf16, WS_X + X_QKV);
            const int b = h2 % 32, t = h1 % 256, hq = h3 % 8, dd = (h3 >> 8) % 64, kh = hq >> 2; const size_t tq = (size_t)(CTXB + b * TC + t);
            for (int d = 0; d < 64; ++d) qs[d] = bf2f(QKV[tq * 768 + hq * 64 + d]);
            float m = P.in[25 + C.z][hq], den = 1.f, acc = 0.f;
            for (int j = 0; j < 256; ++j) { const size_t tk = (size_t)(CTXB + b * TC + j); float s = 0.f;
                for (int d = 0; d < 64; ++d) s += qs[d] * bf2f(QKV[tk * 768 + 512 + kh * 64 + d]);
                s *= 0.125f; const float mn = fmaxf(m, s), al = exp_f(m - mn), p = exp_f(s - mn); den = den * al + p; acc = acc * al + p * bf2f(QKV[tk * 768 + 640 + kh * 64 + dd]); m = mn; }
            dbg_put(C, 10, bf2f(WSP(bf16, WS_A)[tq * 512 + hq * 64 + dd]), acc / den, 0.03f);
        }
        {
            const int b = h1 % 32, tp = h2 % 2048, ch = h3 % 256;
            dbg_put(C, 11, bf2f(WSP(bf16, WS_A + (size_t)72 * MiB)[((size_t)b * TL + tp) * 256 + ch]), ndot(WSP(bf16, WS_DFT) + (size_t)tp * 4096, WSP(bf16, WS_X + X_ZT) + ((size_t)b * 256 + ch) * 4096, 4096), 0.05f);
            const int tc = h2 % 256;
            dbg_put(C, 11, bf2f(WSP(bf16, WS_A + (size_t)72 * MiB)[((size_t)CTXB + b * TC + tc) * 256 + ch]), ndot(WSP(bf16, WS_DFTC) + (size_t)tc * 512, WSP(bf16, WS_X + X_ZTC) + ((size_t)b * 256 + ch) * 512, 512), 0.05f);
        }
    } else if (stage == 5) {
        const int tok = h1 % NT, col = h2 % 1024; const bf16* PP = WSP(bf16, WS_X + X_PP);
        dbg_put(C, 13, bf2f(PP[(size_t)tok * NGATE + col]), ndot(WSP(bf16, WS_A + (size_t)108 * MiB) + (size_t)tok * 256, WL(bf16, 0, WL_BR) + (size_t)col * 256, 256), 0.05f);
        dbg_put(C, 13, bf2f(PP[(size_t)tok * NGATE + 1024 + col]), ndot(WSP(bf16, WS_A) + (size_t)tok * 512, WL(bf16, 0, WL_BA) + (size_t)col * 512, 512), 0.05f);
        dbg_put(C, 13, bf2f(PP[(size_t)tok * NGATE + 2048 + col]), ndot(WSP(bf16, WS_A + (size_t)72 * MiB) + (size_t)tok * 256, WL(bf16, 0, WL_BF) + (size_t)col * 256, 256), 0.05f);
    } else if (stage == 6) {
        const int tok = h1 % NT, col = h2 % 1024; float ref = 0.f;
        for (int br = 0; br < 3; ++br) { const float gl = ndot(WSP(bf16, WS_A) + (size_t)tok * DM, WL(bf16, 0, WL_G) + (size_t)(br * 1024 + col) * 1024, 1024); ref += bf2f(WSP(bf16, WS_X + X_PP)[(size_t)tok * NGATE + br * 1024 + col]) / (1.f + exp_f(-gl)); }
        dbg_put(C, 14, bf2f(WSP(bf16, WS_X + X_UR)[(size_t)tok * DM + col]), ref, 0.05f);
    } else if (stage == 7) {
        const int tok = h1 % NT, col = h2 % 1024;
        dbg_put(C, 15, bf2f(WSP(bf16, WS_X + X_MIX)[(size_t)tok * DM + col]), ndot(WSP(bf16, WS_X + X_UR) + (size_t)tok * DM, WL(bf16, 0, WL_O) + (size_t)col * 1024, 1024), 0.05f);
    } else if (stage == 8) {
        const int tok = h1 % NT, col = h2 % 1024; const bool lat = tok < NLAT; const float* hp = lat ? P.in[0 + C.z] + (size_t)tok * DM : P.in[2 + C.z] + (size_t)(tok - NLAT) * DM;
        const bf16* mx = WSP(bf16, WS_X + X_MIX) + (size_t)tok * DM; const float* mp = WSP(float, WS_MOD) + (size_t)(lat ? tok / TL : 32) * 6144;
        float ss = 0.f; for (int k = 0; k < 1024; ++k) ss += bf2f(mx[k]) * bf2f(mx[k]);
        const float rs = rsqrtf(ss / 1024.f + 1e-6f); float s2 = 0.f, hc = 0.f;
        for (int k = 0; k < 1024; ++k) { const float hn = hp[k] + mp[2048 + k] * bf2f(mx[k]) * rs * P.in[7 + C.z][k]; s2 += hn * hn; if (k == col) hc = hn; }
        const float* ho = lat ? C.out + (size_t)tok * DM : WSP(float, WS_HC) + (size_t)(tok - NLAT) * DM;
        dbg_put(C, 16, ho[col], hc, 0.01f);
        dbg_put(C, 16, bf2f(WSP(bf16, WS_A)[(size_t)tok * DM + col]), hc * rsqrtf(s2 / 1024.f + 1e-6f) * P.in[8 + C.z][col] * (1.f + mp[4096 + col]) + mp[3072 + col], 0.05f);
    } else if (stage == 9) {
        int tok = h1 % NT; if (C.tid & 1) tok = (tok & ~63) + ((C.tid & 2) ? 63 : 0);
        const int j = h2 % DFF; const int t = (tok < NLAT) ? (tok % TL) : ((tok - NLAT) % TC), T = (tok < NLAT) ? TL : TC;
        const bf16* A = WSP(bf16, WS_A); const bf16* wu = WL(bf16, 0, WL_UP); const int pn = j >> 7, jj = j & 127;
        const bf16* wg = wu + (size_t)(pn * 256 + jj) * 1024; const bf16* wv = wu + (size_t)(pn * 256 + 128 + jj) * 1024;
        const float zc = ndot(A + (size_t)tok * DM, wg, 1024), zp = (t > 0) ? ndot(A + (size_t)(tok - 1) * DM, wg, 1024) : 0.f, zn = (t < T - 1) ? ndot(A + (size_t)(tok + 1) * DM, wg, 1024) : 0.f, zv = ndot(A + (size_t)tok * DM, wv, 1024);
        const float z = P.in[31 + C.z][j] * zp + P.in[31 + C.z][DFF + j] * zc + P.in[31 + C.z][2 * DFF + j] * zn + P.in[32 + C.z][j];
        const float ge = 0.5f * z * (1.f + tanh_(0.7978845608028654f * (z + 0.044715f * z * z * z)));
        dbg_put(C, 17, bf2f(WSP(bf16, WS_X + X_HH)[(size_t)tok * DFF + j]), ge * zv, 0.05f);
    } else if (stage == 10) {
        const int tok = h1 % NT, col = h2 % 1024;
        dbg_put(C, 18, bf2f(WSP(bf16, WS_X + X_FFO)[(size_t)tok * DM + col]), ndot(WSP(bf16, WS_X + X_HH) + (size_t)tok * DFF, WL(bf16, 0, WL_DN) + (size_t)col * DFF, DFF), 0.05f);
    }
}
DI void dbg_report(const Ctx& C) {
    if (C.bid == 0 && threadIdx.x == 0) {
        int first = -1; for (int k = 0; k < 24; ++k) if (first < 0 && __builtin_bit_cast(float, WSP(unsigned, WS_CTL)[1024 + k]) > 0.05f) first = k;
        if (first >= 0) C.out[12345] = 1000.f * (float)(first + 1);
    }
}
#define DBGCHK(stage) do { grid.sync(); dbg_check(CK, stage, l); grid.sync(); } while (0)
#else
#define DBGCHK(stage) do { } while (0)
#endif
__global__ void __launch_bounds__(NTHREADS, 2) fwd_kernel(Params P) {
    extern __shared__ __attribute__((aligned(16))) unsigned char lds_raw[];
    cg::grid_group grid = cg::this_grid();
    const int tid_ = threadIdx.x;
    const Ctx CK{(LAS unsigned char*)lds_raw, P.ws, P, P.out, tid_, tid_ & 63, __builtin_amdgcn_readfirstlane(tid_ >> 6), (int)gridDim.x, (int)blockIdx.x, 0};
#ifdef PROBE
#define TS(k) do { if (tid_ == 0 && blockIdx.x == 0) ((volatile LAS unsigned long long*)(CK.lds + 131072))[k] = __builtin_amdgcn_s_memrealtime(); } while (0)
#else
#define TS(k) do { } while (0)
#endif
#define PH_BEGIN { const Ctx C = rectx(CK); LAS unsigned char* glds = C.lds;
#define PH_END }
#define ABUF WSP(bf16, WS_A)
#define HCB WSP(float, WS_HC)
#define MODL(ll) (WSP(float, WS_MOD) + (size_t)(ll) * 33 * 6144)
#define HIN_L ((l == 0) ? C.P.in[0 + C.z] : (const float*)C.out)
#define HIN_C ((l == 0) ? C.P.in[2 + C.z] : (const float*)HCB)
#define GEMM_STD(Aptr, Bptr, M_, N_, K_, EPI, ...) do { pg8::Gemm g{Aptr, Bptr, M_, N_, K_}; pg8::StaticOrder S; S.init(M_, N_, C.G, C.bid); EPI E{__VA_ARGS__}; pg8::gemm_phase<EPI, pg8::StaticOrder, true, true>(glds, g, S, E); } while (0)
    TS(40);
    if (blockIdx.x == 0) for (int i = tid_; i < 2048; i += NTHREADS) ((unsigned*)P.ws)[i] = 0u;
    prologue(CK);
    grid.sync(); TS(41);
    { const int l = 0; DBGCHK(0); }
    for (int l = 0; l < 2; ++l) {
        TS(l * 16 + 0);
        const int Mmix = (l == 0) ? NT : NLAT;
        if (l == 0) { PH_BEGIN rowop<false, true>(C, NT, HIN_L, HIN_C, nullptr, nullptr, nullptr, 0, nullptr, C.P.in[6 + C.z] + l * DM, 0, 1, MODL(l), MODL(l), ABUF); PH_END grid.sync(); TS(l * 16 + 1); DBGCHK(1); }
        PH_BEGIN
            GEMM_STD(ABUF, WL(bf16, l, WL_IN), NT, NIN, DM, EpiIn, WSP(bf16, WS_X + X_QKV), WSP(bf16, WS_X + X_ZT), WSP(bf16, WS_X + X_ZTC), WSP(bf16, WS_X + X_UR));
        PH_END
        grid.sync(); TS(l * 16 + 2); DBGCHK(2);
        feat1_phase(CK, l);
        grid.sync();
        PH_BEGIN GEMM_STD(WSP(bf16, WS_A), WSP(bf16, WS_WLORA + (size_t)l * 2 * MiB), NT, (l == 0 ? 1280 : NLO), KLO, EpiStore, WSP(bf16, WS_X + X_LO), NLO, 0, 0, 256); PH_END
        grid.sync();
        feat3_phase(CK, l);
        grid.sync(); TS(l * 16 + 3); DBGCHK(3);
        if (CK.bid < 256) scan_run(CK, l, CK.bid >> 3, (CK.bid >> 1) & 3, CK.bid & 1);
        __syncthreads(); TS(l * 16 + 15);
        {
            PH_BEGIN
                pg8::Gemm g{WSP(bf16, WS_DFT), WSP(bf16, WS_X + X_ZT), 2048, 8192, 4096}; pg8::StaticOrder S; S.init(2048, 8192, C.G, C.bid);
                EpiStore E{WSP(bf16, WS_A + (size_t)72 * MiB), 256, 0, 2048, 0};
                pg8::gemm_phase<EpiStore, pg8::StaticOrder, true, true>(glds, g, S, E);
            PH_END
            if (l == 0) { PH_BEGIN
                pg8::Gemm g{WSP(bf16, WS_DFTC), WSP(bf16, WS_X + X_ZTC), 256, 8192, 512}; pg8::StaticOrder S; S.init(256, 8192, C.G, C.bid);
                EpiStore E{WSP(bf16, WS_A + (size_t)72 * MiB), 256, CTXB, 256, 0};
                pg8::gemm_phase<EpiStore, pg8::StaticOrder, true, true>(glds, g, S, E);
            PH_END }
        }
        attn_loop(CK, l);
        grid.sync(); TS(l * 16 + 4); DBGCHK(4);
        readout_phase(CK, l, Mmix);
        grid.sync(); TS(l * 16 + 5);
        PH_BEGIN GEMM_STD(WSP(bf16, WS_A + (size_t)108 * MiB), WL(bf16, l, WL_BR), Mmix, 1024, 256, EpiStore, WSP(bf16, WS_X + X_PP), NGATE, 0, 0, 256); PH_END
        PH_BEGIN GEMM_STD(WSP(bf16, WS_A), WL(bf16, l, WL_BA), Mmix, 1024, 512, EpiStore, WSP(bf16, WS_X + X_PP) + 1024, NGATE, 0, 0, 256); PH_END
        PH_BEGIN GEMM_STD(WSP(bf16, WS_A + (size_t)72 * MiB), WL(bf16, l, WL_BF), Mmix, 1024, 256, EpiStore, WSP(bf16, WS_X + X_PP) + 2048, NGATE, 0, 0, 256); PH_END
        grid.sync(); TS(l * 16 + 6); DBGCHK(5);
        PH_BEGIN rowop<false, true>(C, Mmix, HIN_L, HIN_C, nullptr, nullptr, nullptr, 0, nullptr, C.P.in[6 + C.z] + l * DM, 0, 1, MODL(l), MODL(l), ABUF); PH_END
        grid.sync(); TS(l * 16 + 7);
        PH_BEGIN
            pg8::Gemm g{ABUF, WL(bf16, l, WL_G), Mmix, NGATE, DM}; GateOrder S{(Mmix / 256) * 4, C.G, C.bid};
            EpiGate E{WSP(bf16, WS_X + X_PP), WSP(bf16, WS_X + X_UR)};
            pg8::gemm_phase<EpiGate, GateOrder, true, true>(glds, g, S, E);
        PH_END
        grid.sync(); TS(l * 16 + 8); DBGCHK(6);
        PH_BEGIN GEMM_STD(WSP(bf16, WS_X + X_UR), WL(bf16, l, WL_O), Mmix, DM, DM, EpiStore, WSP(bf16, WS_X + X_MIX), DM, 0, 0, 256); PH_END
        grid.sync(); TS(l * 16 + 9); DBGCHK(7);
        PH_BEGIN rowop<true, true>(C, Mmix, HIN_L, HIN_C, C.out, HCB, WSP(bf16, WS_X + X_MIX), 2, C.P.in[7 + C.z] + l * DM, C.P.in[8 + C.z] + l * DM, 3, 4, MODL(l), MODL(l), ABUF); PH_END
        grid.sync(); TS(l * 16 + 10); DBGCHK(8);
        PH_BEGIN GEMM_STD(ABUF, WL(bf16, l, WL_UP), Mmix, 2 * DFF, DM, EpiUp, WSP(bf16, WS_X + X_HH), WSP(bf16, WS_X + X_HALO), C.P.in[31 + C.z] + (size_t)l * 3 * DFF, C.P.in[32 + C.z] + (size_t)l * DFF); PH_END
        grid.sync(); TS(l * 16 + 11);
        fixup_phase(CK, l, Mmix);
        grid.sync(); TS(l * 16 + 12); DBGCHK(9);
        PH_BEGIN GEMM_STD(WSP(bf16, WS_X + X_HH), WL(bf16, l, WL_DN), Mmix, DM, DFF, EpiStore, WSP(bf16, WS_X + X_FFO), DM, 0, 0, 256); PH_END
        grid.sync(); TS(l * 16 + 13); DBGCHK(10);
        if (l == 0) { PH_BEGIN rowop<true, true>(C, NT, C.out, HCB, C.out, HCB, WSP(bf16, WS_X + X_FFO), 5, C.P.in[9 + C.z] + l * DM, C.P.in[6 + C.z] + (l + 1) * DM, 0, 1, MODL(l), MODL(l + 1), ABUF); PH_END grid.sync(); TS(l * 16 + 14); }
        else { PH_BEGIN rowop<true, false>(C, NLAT, C.out, HCB, C.out, HCB, WSP(bf16, WS_X + X_FFO), 5, C.P.in[9 + C.z] + l * DM, nullptr, 0, 1, MODL(l), MODL(l), nullptr); PH_END }
    }
#ifdef DBG
    grid.sync(); dbg_report(CK);
#endif
#ifdef PROBE
    TS(60);
    grid.sync();
    if (blockIdx.x == 0) {
        volatile LAS unsigned long long* ts = (volatile LAS unsigned long long*)(CK.lds + 131072);
#ifdef PROBE_PRO
        unsigned long long d = (ts[60] - ts[40]) / 10ull;
#else
        unsigned long long d = 0; for (int ll = 0; ll < 2; ++ll) d += ts[ll * 16 + PROBE_B] - ts[ll * 16 + PROBE_A];
#endif
        const int n = (int)(d / 500ull);
        for (int i = tid_; i < n; i += NTHREADS) P.out[1000000 + i] += 0.15f;
    }
#endif
}


extern "C" void kernel_launch(void* const* d_in, const int* in_sizes, int n_in, void* d_out, int out_size, void* d_ws, size_t ws_size, hipStream_t stream) {
    static int grid = 0;
    if (grid == 0) {
        if (n_in != 34 || out_size != NLAT * DM || ws_size < WS_TOTAL) { fprintf(stderr, "kernel_launch: unexpected shapes (n_in %d out %d ws %zu, need %zu)\n", n_in, out_size, ws_size, (size_t)WS_TOTAL); grid = -1; return; }
        int dev = 0, cus = 0, per_cu = 0;
        hipGetDevice(&dev); hipDeviceGetAttribute(&cus, hipDeviceAttributeMultiprocessorCount, dev);
        if (hipFuncSetAttribute((const void*)fwd_kernel, hipFuncAttributeMaxDynamicSharedMemorySize, LDS_BYTES) != hipSuccess) { fprintf(stderr, "kernel_launch: hipFuncSetAttribute failed\n"); grid = -1; return; }
        hipOccupancyMaxActiveBlocksPerMultiprocessor(&per_cu, (const void*)fwd_kernel, NTHREADS, LDS_BYTES);
        (void)hipGetLastError();
        if (per_cu < 1 || cus < 256) { fprintf(stderr, "kernel_launch: occupancy %d, cus %d\n", per_cu, cus); grid = -1; return; }
        grid = 256;
    }
    if (grid < 0) return;
    Params p{};
    for (int i = 0; i < 34; ++i) p.in[i] = (const float*)d_in[i];
    p.out = (float*)d_out; p.ws = (unsigned char*)d_ws;
    void* args[] = {&p};
    hipError_t e = hipLaunchCooperativeKernel((const void*)fwd_kernel, dim3(grid), dim3(NTHREADS), args, LDS_BYTES, stream);
    if (e != hipSuccess) fprintf(stderr, "kernel_launch: cooperative launch failed: %s (grid %d)\n", hipGetErrorString(e), grid);
}
```

```cpp
#define PROBE_PRO 1

#define PROBE_A 2
#define PROBE_B 3
#include <hip/hip_runtime.h>
#include <hip/hip_cooperative_groups.h>
#include <cstdio>
#include <cstdint>
namespace cg = cooperative_groups;
__device__ __forceinline__ int otid() { int t = threadIdx.x; asm volatile("" : "+v"(t)); return t; }
namespace pg8 {
#define PG8_LAS __attribute__((address_space(3)))
typedef unsigned short bf16_t;
typedef short bf16x8 __attribute__((ext_vector_type(8)));
typedef float f32x4 __attribute__((ext_vector_type(4)));
typedef unsigned u32x4 __attribute__((ext_vector_type(4)));
constexpr int BM = 256, BK = 64, HALF = 128, HTB = HALF * BK * 2  , STAGE_BYTES = 8 * HTB, NXCD = 8, WGM = 8;

__host__ __device__ __forceinline__ int lds_byte(int r, int c) { const int st = (r >> 4) * 2 + (c >> 5), rr = r & 15, cc = c & 31, ob = rr * 64 + cc * 2; return st * 1024 + (ob ^ (((ob >> 9) & 1) << 5)); }
__host__ __device__ __forceinline__ void stage_rc(int b, int& R, int& C) { const int st = b / 1024, sb = b % 1024, swz = sb ^ (((sb >> 9) & 1) << 5); R = (st >> 1) * 16 + swz / 64; C = (st & 1) * 32 + (swz % 64) / 2; }
__host__ __device__ __forceinline__ int perm32(int rho) { const int n = rho >> 4, i = rho & 15; return 8 * (i >> 2) + 4 * n + (i & 3); }

struct Unit { int pm, pn; };
struct Gemm { const bf16_t* A; const bf16_t* Bt; int M, N, K; };

struct StaticOrder {
    int nM, nN, nwg, G, c;
    __host__ __device__ void init(int M, int N, int G_, int c_) { nM = M / BM; nN = N / BM; nwg = nM * nN; G = G_; c = c_; }
    __host__ __device__ bool next(int i, Unit& u) const {
        const long L = (long)i * G + c; if (L >= nwg) return false;
        int wgid = (int)L; { const int q = nwg / NXCD, r = nwg % NXCD, xcd = wgid % NXCD, off = wgid / NXCD; wgid = (xcd < r ? xcd * (q + 1) : r * (q + 1) + (xcd - r) * q) + off; }
        const int nig = WGM * nN, gid = wgid / nig, fm = gid * WGM, gsz = (nM - fm) < WGM ? (nM - fm) : WGM;
        u.pm = fm + ((wgid % nig) % gsz); u.pn = (wgid % nig) / gsz; return true;
    }
    __device__ __forceinline__ void a_ready(const Unit&) const {}
    __device__ __forceinline__ void done(const Unit&) const {}
};

__device__ __forceinline__ unsigned cvt_pk_bf16(float lo, float hi) { unsigned r; asm volatile("v_cvt_pk_bf16_f32 %0, %1, %2" : "=v"(r) : "v"(lo), "v"(hi)); return r; }
typedef float f32x2 __attribute__((ext_vector_type(2)));
__device__ __forceinline__ f32x2 gelu_pk(f32x2 v) {
    const f32x2 av = __builtin_elementwise_abs(v), d = av * 0.2316418882f + 1.0f;
    f32x2 t; t.x = __builtin_amdgcn_rcpf(d.x); t.y = __builtin_amdgcn_rcpf(d.y);
    f32x2 q = t * 0.5307027145f + (-0.7265760135f); q = q * t + 0.7107068705f; q = q * t + (-0.142248368f); q = q * t + 0.127414796f; q = q * t;
    const f32x2 s = (v * v) * (-0.72134752044f);
    f32x2 e; e.x = __builtin_amdgcn_exp2f(s.x); e.y = __builtin_amdgcn_exp2f(s.y);
    const f32x2 m = v * (q * e), r = v - m;
    f32x2 o; o.x = v.x < 0.f ? m.x : r.x; o.y = v.y < 0.f ? m.y : r.y; return o;
}

template <class Epi, class Sched, bool ALIGN_EPI = false, bool SP2 = false>
__device__ __forceinline__ void gemm_phase(PG8_LAS unsigned char* lds, const Gemm g, const Sched& S, const Epi& E) {
    const int tid = otid(), wid = __builtin_amdgcn_readfirstlane(tid >> 6), lane = tid & 63, wr = wid >> 2, wc = wid & 3, fr = lane & 15, fq = lane >> 4;
    const int K = g.K, nt = K / BK;
    unsigned voffA[2], voffB[2];
#pragma unroll
    for (int i = 0; i < 2; ++i) { int R, C; stage_rc(tid * 16 + i * 8192, R, C); const int Rb = Epi::PERM ? ((R & ~31) + perm32(R & 31)) : R;
        voffA[i] = (unsigned)(R * K + C) * 2u; voffB[i] = (unsigned)(Rb * K + C) * 2u; }
    const size_t kstep = (size_t)(BK * 2);
    const size_t hstep = (size_t)HALF * K * 2;
    const size_t tstep = 2 * hstep;
    const unsigned ldsw = (unsigned)wid * 1024u;
    const int aoff = lds_byte(wr * 64 + fr, fq * 8), boff = lds_byte(wc * 32 + fr, fq * 8);
#define PG8_SA(b, h) (((b) * 2 + (h)) * HTB)
#define PG8_SB(b, h) ((4 + (b) * 2 + (h)) * HTB)
#define PG8_STAGE(bufoff, gbase, voff) do { _Pragma("unroll") for (int _i = 0; _i < 2; ++_i) \
        __builtin_amdgcn_global_load_lds((const unsigned*)((const char*)(gbase) + (voff)[_i]), (PG8_LAS unsigned*)(lds + (bufoff) + ldsw + _i * 8192), 16, 0, 0); } while (0)
#define PG8_LDA(dst, b, h) do { _Pragma("unroll") for (int m = 0; m < 4; ++m) _Pragma("unroll") for (int k = 0; k < 2; ++k) dst[m][k] = *(const PG8_LAS bf16x8*)(lds + PG8_SA(b, h) + aoff + m * 2048 + k * 1024); } while (0)
#define PG8_LDB(dst, b, h) do { _Pragma("unroll") for (int n = 0; n < 2; ++n) _Pragma("unroll") for (int k = 0; k < 2; ++k) dst[n][k] = *(const PG8_LAS bf16x8*)(lds + PG8_SB(b, h) + boff + n * 2048 + k * 1024); } while (0)
#define PG8_MMA(ai, bj, At, Bt) do { __builtin_amdgcn_s_setprio(1); _Pragma("unroll") for (int m = 0; m < 4; ++m) _Pragma("unroll") for (int n = 0; n < 2; ++n) _Pragma("unroll") for (int k = 0; k < 2; ++k) \
        acc[ai][bj][m][n] = __builtin_amdgcn_mfma_f32_16x16x32_bf16(Bt[n][k], At[m][k], acc[ai][bj][m][n], 0, 0, 0); __builtin_amdgcn_s_setprio(0); } while (0)
#define PG8_WAIT_V(n) asm volatile("s_waitcnt vmcnt(" #n ")" ::: "memory")
#define PG8_WAIT_L(n) asm volatile("s_waitcnt lgkmcnt(" #n ")" ::: "memory")
#define PG8_BAR __builtin_amdgcn_s_barrier()
#define PG8_SCHED __builtin_amdgcn_sched_barrier(0)
    Unit cur, nxt; int ui = 0;
    if (!S.next(0, cur)) return;
    f32x4 acc[2][2][4][2];
#pragma unroll
    for (int a = 0; a < 2; ++a)
#pragma unroll
        for (int b = 0; b < 2; ++b)
#pragma unroll
            for (int m = 0; m < 4; ++m)
#pragma unroll
                for (int n = 0; n < 2; ++n) acc[a][b][m][n] = (f32x4){0.f, 0.f, 0.f, 0.f};
    bf16x8 At[4][2], B0[2][2], B1[2][2];
    const char* cA = (const char*)g.A + (size_t)cur.pm * tstep; const char* cB = (const char*)g.Bt + (size_t)cur.pn * tstep;
    S.a_ready(cur);
    if constexpr (SP2) {
        PG8_STAGE(PG8_SB(0, 0), cB, voffB); PG8_STAGE(PG8_SB(0, 1), cB + hstep, voffB); PG8_STAGE(PG8_SA(0, 0), cA, voffA); PG8_STAGE(PG8_SA(0, 1), cA + hstep, voffA);
        if (wr == 1) PG8_BAR;
        PG8_WAIT_V(2); PG8_BAR;
        PG8_STAGE(PG8_SB(1, 0), cB + kstep, voffB); PG8_STAGE(PG8_SA(1, 0), cA + kstep, voffA); PG8_STAGE(PG8_SB(1, 1), cB + hstep + kstep, voffB);
        PG8_WAIT_V(6); PG8_BAR;
    } else {
        PG8_STAGE(PG8_SB(0, 0), cB, voffB); PG8_STAGE(PG8_SA(0, 0), cA, voffA); PG8_STAGE(PG8_SB(0, 1), cB + hstep, voffB); PG8_STAGE(PG8_SA(0, 1), cA + hstep, voffA);
        if (wr == 1) PG8_BAR;
        PG8_WAIT_V(4); PG8_BAR;
        PG8_STAGE(PG8_SB(1, 0), cB + kstep, voffB); PG8_STAGE(PG8_SA(1, 0), cA + kstep, voffA); PG8_STAGE(PG8_SB(1, 1), cB + hstep + kstep, voffB);
        PG8_WAIT_V(6); PG8_BAR;
    }
    for (;;) {
        const bool has_next = S.next(ui + 1, nxt);
        const char* nA = has_next ? (const char*)g.A + (size_t)nxt.pm * tstep : cA; const char* nB = has_next ? (const char*)g.Bt + (size_t)nxt.pn * tstep : cB;
        for (int t = 0; t < nt; t += 2) {
            const bool last = (t == nt - 2);
            const char* a1 = cA + (size_t)(t + 1) * kstep;
            const char* a2 = last ? nA : cA + (size_t)(t + 2) * kstep; const char* b2 = last ? nB : cB + (size_t)(t + 2) * kstep;
            const char* a3 = a2 + kstep; const char* b3 = b2 + kstep;
            if (last && has_next) S.a_ready(nxt);
            if constexpr (SP2) {
            PG8_LDB(B0, 0, 0); PG8_LDB(B1, 0, 1); PG8_SCHED; PG8_LDA(At, 0, 0); PG8_STAGE(PG8_SA(1, 1), a1 + hstep, voffA);
            PG8_WAIT_V(8); PG8_WAIT_L(0); PG8_BAR; PG8_MMA(0, 0, At, B0); PG8_MMA(0, 1, At, B1); PG8_BAR; PG8_SCHED;
            PG8_LDA(At, 0, 1); PG8_STAGE(PG8_SB(0, 0), b2, voffB); PG8_STAGE(PG8_SB(0, 1), b2 + hstep, voffB); PG8_STAGE(PG8_SA(0, 0), a2, voffA);
            PG8_WAIT_V(8); PG8_WAIT_L(0); PG8_BAR; PG8_MMA(1, 0, At, B0); PG8_MMA(1, 1, At, B1); PG8_BAR; PG8_SCHED;
            PG8_LDB(B0, 1, 0); PG8_LDB(B1, 1, 1); PG8_SCHED; PG8_LDA(At, 1, 0); PG8_STAGE(PG8_SA(0, 1), a2 + hstep, voffA);
            PG8_WAIT_V(8); PG8_WAIT_L(0); PG8_BAR; PG8_MMA(0, 0, At, B0); PG8_MMA(0, 1, At, B1); PG8_BAR; PG8_SCHED;
            PG8_LDA(At, 1, 1); PG8_STAGE(PG8_SB(1, 0), b3, voffB); PG8_STAGE(PG8_SB(1, 1), b3 + hstep, voffB); PG8_STAGE(PG8_SA(1, 0), a3, voffA);
            PG8_WAIT_V(8); PG8_WAIT_L(0); PG8_BAR; PG8_MMA(1, 0, At, B0); PG8_MMA(1, 1, At, B1); PG8_BAR; PG8_SCHED;
            } else {
            PG8_LDB(B0, 0, 0); PG8_SCHED; PG8_LDA(At, 0, 0); PG8_STAGE(PG8_SA(1, 1), a1 + hstep, voffA);
            PG8_WAIT_L(8); PG8_BAR; PG8_WAIT_L(0); PG8_MMA(0, 0, At, B0); PG8_BAR; PG8_SCHED;
            PG8_LDB(B1, 0, 1); PG8_STAGE(PG8_SB(0, 0), b2, voffB);
            PG8_BAR; PG8_WAIT_L(0); PG8_MMA(0, 1, At, B1); PG8_BAR;
            PG8_LDA(At, 0, 1); PG8_STAGE(PG8_SA(0, 0), a2, voffA);
            PG8_BAR; PG8_WAIT_L(0); PG8_MMA(1, 0, At, B0); PG8_BAR; PG8_SCHED;
            PG8_STAGE(PG8_SB(0, 1), b2 + hstep, voffB);
            PG8_WAIT_V(6); PG8_BAR; PG8_MMA(1, 1, At, B1); PG8_BAR;
            PG8_LDB(B0, 1, 0); PG8_SCHED; PG8_LDA(At, 1, 0); PG8_STAGE(PG8_SA(0, 1), a2 + hstep, voffA);
            PG8_WAIT_L(8); PG8_BAR; PG8_WAIT_L(0); PG8_MMA(0, 0, At, B0); PG8_BAR; PG8_SCHED;
            PG8_LDB(B1, 1, 1); PG8_STAGE(PG8_SB(1, 0), b3, voffB);
            PG8_BAR; PG8_WAIT_L(0); PG8_MMA(0, 1, At, B1); PG8_BAR;
            PG8_LDA(At, 1, 1); PG8_STAGE(PG8_SA(1, 0), a3, voffA);
            PG8_BAR; PG8_WAIT_L(0); PG8_MMA(1, 0, At, B0); PG8_BAR; PG8_SCHED;
            PG8_STAGE(PG8_SB(1, 1), b3 + hstep, voffB);
            PG8_WAIT_V(6); PG8_BAR; PG8_MMA(1, 1, At, B1); PG8_BAR;
            }
        }
        if constexpr (ALIGN_EPI) { if (wr == 0) PG8_BAR; }
        if constexpr (!Epi::AFTER_DRAIN) { E(acc, cur, wr, wc, fr, fq); S.done(cur); }
        if (!has_next) break;
#pragma unroll
        for (int a = 0; a < 2; ++a)
#pragma unroll
            for (int b = 0; b < 2; ++b)
#pragma unroll
                for (int m = 0; m < 4; ++m)
#pragma unroll
                    for (int n = 0; n < 2; ++n) acc[a][b][m][n] = (f32x4){0.f, 0.f, 0.f, 0.f};
        cur = nxt; cA = nA; cB = nB; ++ui;
        if constexpr (ALIGN_EPI) { if (wr == 1) PG8_BAR; }
    }
    PG8_WAIT_V(0);
    if constexpr (!ALIGN_EPI) { if (wr == 0) PG8_BAR; }
    PG8_BAR;
    if constexpr (Epi::AFTER_DRAIN) { E.fused(acc, cur, wr, wc, fr, fq, lds, wid, lane); S.done(cur); }
#undef PG8_SA
#undef PG8_SB
#undef PG8_STAGE
#undef PG8_LDA
#undef PG8_LDB
#undef PG8_MMA
#undef PG8_WAIT_V
#undef PG8_WAIT_L
#undef PG8_BAR
#undef PG8_SCHED
}
}

#define DI __device__ __forceinline__
#define LAS __attribute__((address_space(3)))
typedef unsigned short bf16;
typedef float f32x4 __attribute__((ext_vector_type(4)));
typedef float f32x2 __attribute__((ext_vector_type(2)));
typedef float f32x16 __attribute__((ext_vector_type(16)));
typedef short bf16x8 __attribute__((ext_vector_type(8)));
typedef short s16x4 __attribute__((ext_vector_type(4)));
typedef unsigned u32x4 __attribute__((ext_vector_type(4)));
typedef unsigned u32x2 __attribute__((ext_vector_type(2)));
typedef __bf16 bf16x2_t __attribute__((ext_vector_type(2)));

constexpr int DM = 1024, NB = 32, TL = 2048, TC = 256, NLAT = NB * TL, NCTX = NB * TC, NT = NLAT + NCTX, CTXB = NLAT;
constexpr int DFF = 2816, RW = 1152, NIN = 2560, NGATE = 3072;
constexpr int IN_COLS = 5248;
constexpr float LOG2E = 1.4426950408889634f;
constexpr int NTHREADS = 512, NWAVES = 8;
constexpr int LDS_BYTES = 147456;

constexpr size_t MiB = 1u << 20;
constexpr size_t WS_CTL = 0;
constexpr size_t WS_MOD = 1 * MiB;
constexpr size_t WS_SMALL = 3 * MiB;
constexpr size_t WS_BON = 4 * MiB;
constexpr size_t WS_W = 6 * MiB;
constexpr size_t WL_IN = 0, WL_G = 5 * MiB, WL_BR = 11 * MiB, WL_BA = 11 * MiB + 512 * 1024, WL_BF = 12 * MiB + 512 * 1024, WL_O = 13 * MiB, WL_UP = 15 * MiB, WL_DN = 26 * MiB, WL_SIZE = 32 * MiB;
constexpr size_t WS_DFT = WS_W + 2 * WL_SIZE;
constexpr size_t WS_DFTC = WS_DFT + 16 * MiB;
constexpr size_t WS_HC = WS_DFTC + 1 * MiB;
constexpr size_t WS_A = WS_HC + 32 * MiB;
constexpr size_t WS_VF = WS_A + 144 * MiB;
constexpr size_t WS_X = WS_VF + 36 * MiB;
constexpr size_t X_F = 0;
constexpr size_t X_QKV = 288 * MiB;
constexpr size_t X_ZT = 396 * MiB;
constexpr size_t X_ZTC = 460 * MiB;
constexpr size_t X_UR = 504 * MiB;
constexpr size_t X_G = 468 * MiB;
constexpr size_t X_LO = 504 * MiB;
constexpr size_t X_END = 720 * MiB;
constexpr size_t WS_WLORA = WS_X + X_END;
constexpr int KLO = 640, NLO = 1536;
constexpr size_t X_PP = 0;
constexpr size_t X_MIX = 0;
constexpr size_t X_HH = 0;
constexpr size_t X_HALO = 396 * MiB;
constexpr size_t X_FFO = 436 * MiB;
constexpr size_t WS_TOTAL = WS_WLORA + 4 * MiB;
constexpr size_t FSZ = (size_t)NT * 256;

struct Params { const float* in[34]; float* out; unsigned char* ws; };

DI float bf2f(bf16 v) { return __builtin_bit_cast(float, (unsigned)v << 16); }
DI float lo2f(unsigned u) { return __builtin_bit_cast(float, u << 16); }
DI float hi2f(unsigned u) { return __builtin_bit_cast(float, u & 0xffff0000u); }
DI unsigned pk(float lo, float hi) { f32x2 v = {lo, hi}; bf16x2_t b = __builtin_convertvector(v, bf16x2_t); return __builtin_bit_cast(unsigned, b); }
DI bf16 f2bf(float x) { return (bf16)(pk(x, 0.f) & 0xffffu); }
DI float fexp2(float x) { return __builtin_amdgcn_exp2f(x); }
DI float frcp(float x) { return __builtin_amdgcn_rcpf(x); }
DI float sigm(float x) { return frcp(1.f + fexp2(-x * LOG2E)); }
DI float tanh_(float x) { return 2.f * sigm(2.f * x) - 1.f; }
DI float gelu_tanh(float z) { const float u = 1.5957691216057308f * (z + 0.044715f * z * z * z); return z * sigm(u); }
DI float wave_sum(float v) {
#pragma unroll
    for (int o = 1; o < 64; o <<= 1) v += __shfl_xor(v, o);
    return v;
}
template <int CTRL, bool BC> DI float dppf(float old, float src) {
    return __builtin_bit_cast(float, __builtin_amdgcn_update_dpp(__builtin_bit_cast(int, old), __builtin_bit_cast(int, src), CTRL, 0xf, 0xf, BC));
}
DI float row16_sum(float x) { x += dppf<0x128, true>(0.f, x); x += dppf<0x124, true>(0.f, x); x += dppf<0x122, true>(0.f, x); x += dppf<0x121, true>(0.f, x); return x; }
DI f32x4 bf4(u32x2 u) { return (f32x4){lo2f(u.x), hi2f(u.x), lo2f(u.y), hi2f(u.y)}; }
DI u32x2 pk4(f32x4 v) { u32x2 o; o.x = pk(v[0], v[1]); o.y = pk(v[2], v[3]); return o; }
DI float allred4(float x) {
    unsigned u = __builtin_bit_cast(unsigned, x);
    auto r = __builtin_amdgcn_permlane16_swap(u, u, false, false);
    float y = __builtin_bit_cast(float, (unsigned)r[0]) + __builtin_bit_cast(float, (unsigned)r[1]);
    unsigned v = __builtin_bit_cast(unsigned, y);
    auto s = __builtin_amdgcn_permlane32_swap(v, v, false, false);
    return __builtin_bit_cast(float, (unsigned)s[0]) + __builtin_bit_cast(float, (unsigned)s[1]);
}

DI u32x4 pack8(const f32x4& a, const f32x4& b) { u32x4 w; w.x = pk(a[0], a[1]); w.y = pk(a[2], a[3]); w.z = pk(b[0], b[1]); w.w = pk(b[2], b[3]); return w; }

struct EpiStore {
    static constexpr bool PERM = true, AFTER_DRAIN = false;
    bf16* O; int ld; int row_base, row_pn, col_pn;
    DI void operator()(const f32x4 (&acc)[2][2][4][2], const pg8::Unit& u, int wr, int wc, int fr, int fq) const {
        const int row0 = row_base + u.pn * row_pn + u.pm * 256 + wr * 64 + fr, col0 = u.pn * col_pn + wc * 32 + 8 * fq;
#pragma unroll
        for (int ai = 0; ai < 2; ++ai)
#pragma unroll
            for (int m = 0; m < 4; ++m) { bf16* rowp = O + (size_t)(row0 + ai * 128 + m * 16) * ld + col0;
#pragma unroll
                for (int bj = 0; bj < 2; ++bj) *(u32x4*)(rowp + bj * 128) = pack8(acc[ai][bj][m][0], acc[ai][bj][m][1]); }
    }
};

struct EpiIn {
    static constexpr bool PERM = true, AFTER_DRAIN = false;
    bf16 *QKV, *ZT, *ZTC, *UR;
    DI void operator()(const f32x4 (&acc)[2][2][4][2], const pg8::Unit& u, int wr, int wc, int fr, int fq) const {
        const int pn = u.pn, rl0 = wr * 64 + fr, cl = wc * 32 + 8 * fq;
        if (pn < 3) {
#pragma unroll
            for (int ai = 0; ai < 2; ++ai)
#pragma unroll
                for (int m = 0; m < 4; ++m) { bf16* rowp = QKV + (size_t)(u.pm * 256 + rl0 + ai * 128 + m * 16) * 768 + pn * 256 + cl;
#pragma unroll
                    for (int bj = 0; bj < 2; ++bj) *(u32x4*)(rowp + bj * 128) = pack8(acc[ai][bj][m][0], acc[ai][bj][m][1]); }
        } else if (pn < 5) {
            bf16* base; int stride;
            if (u.pm < 256) { const int b = u.pm >> 3, t0 = (u.pm & 7) * 256; base = ZT + (size_t)b * 256 * 4096 + (pn - 3) * 2048 + t0; stride = 4096; }
            else { const int b = u.pm - 256; base = ZTC + (size_t)b * 256 * 512 + (pn - 3) * 256; stride = 512; }
#pragma unroll
            for (int ai = 0; ai < 2; ++ai)
#pragma unroll
                for (int m = 0; m < 4; ++m) { const int rl = rl0 + ai * 128 + m * 16;
#pragma unroll
                    for (int bj = 0; bj < 2; ++bj)
#pragma unroll
                        for (int n = 0; n < 2; ++n)
#pragma unroll
                            for (int e = 0; e < 4; ++e) base[(size_t)(bj * 128 + cl + 4 * n + e) * stride + rl] = f2bf(acc[ai][bj][m][n][e]); }
        } else {
#pragma unroll
            for (int ai = 0; ai < 2; ++ai)
#pragma unroll
                for (int m = 0; m < 4; ++m) { bf16* rowp = UR + (size_t)(u.pm * 256 + rl0 + ai * 128 + m * 16) * RW + (pn - 5) * 256 + cl;
#pragma unroll
                    for (int bj = 0; bj < 2; ++bj) if ((pn - 5) * 256 + bj * 128 < RW) *(u32x4*)(rowp + bj * 128) = pack8(acc[ai][bj][m][0], acc[ai][bj][m][1]); }
        }
    }
};

struct EpiGate {
    static constexpr bool PERM = true, AFTER_DRAIN = false;
    const bf16* PP; bf16* MG;
    DI void operator()(const f32x4 (&acc)[2][2][4][2], const pg8::Unit& u, int wr, int wc, int fr, int fq) const {
        const int br = u.pn >> 2, cn = u.pn & 3, row0 = u.pm * 256 + wr * 64 + fr, col0 = cn * 256 + wc * 32 + 8 * fq;
#pragma unroll
        for (int ai = 0; ai < 2; ++ai)
#pragma unroll
            for (int m = 0; m < 4; ++m) { const size_t row = (size_t)(row0 + ai * 128 + m * 16);
#pragma unroll
                for (int bj = 0; bj < 2; ++bj) {
                    const u32x4 pp = *(const u32x4*)(PP + row * NGATE + br * 1024 + col0 + bj * 128);
                    bf16* mp = MG + row * 1024 + col0 + bj * 128;
                    f32x4 a = acc[ai][bj][m][0], b = acc[ai][bj][m][1];
                    a[0] = sigm(a[0]) * lo2f(pp.x); a[1] = sigm(a[1]) * hi2f(pp.x); a[2] = sigm(a[2]) * lo2f(pp.y); a[3] = sigm(a[3]) * hi2f(pp.y);
                    b[0] = sigm(b[0]) * lo2f(pp.z); b[1] = sigm(b[1]) * hi2f(pp.z); b[2] = sigm(b[2]) * lo2f(pp.w); b[3] = sigm(b[3]) * hi2f(pp.w);
                    if (br) { const u32x4 o = *(const u32x4*)mp;
                        a[0] += lo2f(o.x); a[1] += hi2f(o.x); a[2] += lo2f(o.y); a[3] += hi2f(o.y); b[0] += lo2f(o.z); b[1] += hi2f(o.z); b[2] += lo2f(o.w); b[3] += hi2f(o.w); }
                    *(u32x4*)mp = pack8(a, b); } }
    }
};

struct EpiUp {
    static constexpr bool PERM = true, AFTER_DRAIN = false;
    bf16* HH; bf16* HALO; const float* cw; const float* cb;
    DI void operator()(const f32x4 (&acc)[2][2][4][2], const pg8::Unit& u, int wr, int wc, int fr, int fq) const {
        const int j0 = 128 * u.pn + 32 * wc + 8 * fq;
        f32x4 w0[2], w1[2], w2[2], bb[2];
#pragma unroll
        for (int n = 0; n < 2; ++n) { w0[n] = *(const f32x4*)(cw + j0 + 4 * n); w1[n] = *(const f32x4*)(cw + DFF + j0 + 4 * n); w2[n] = *(const f32x4*)(cw + 2 * DFF + j0 + 4 * n); bb[n] = *(const f32x4*)(cb + j0 + 4 * n); }
#pragma unroll
        for (int ai = 0; ai < 2; ++ai) {
            const int grp = u.pm * 4 + ai * 2 + wr;
            bf16* hb = HALO + (size_t)grp * 6 * DFF + j0;
            if (fr < 2) { *(u32x4*)(hb + fr * DFF) = pack8(acc[ai][0][0][0], acc[ai][0][0][1]); if (fr == 0) *(u32x4*)(hb + 4 * DFF) = pack8(acc[ai][1][0][0], acc[ai][1][0][1]); }
            if (fr >= 14) { *(u32x4*)(hb + (fr - 12) * DFF) = pack8(acc[ai][0][3][0], acc[ai][0][3][1]); if (fr == 15) *(u32x4*)(hb + 5 * DFF) = pack8(acc[ai][1][3][0], acc[ai][1][3][1]); }
#pragma unroll
            for (int m = 0; m < 4; ++m) {
                f32x4 o[2];
#pragma unroll
                for (int n = 0; n < 2; ++n)
#pragma unroll
                    for (int e = 0; e < 4; ++e) {
                        const float x = acc[ai][0][m][n][e];
                        const float xm = (m > 0) ? acc[ai][0][m > 0 ? m - 1 : 0][n][e] : 0.f, xp = (m < 3) ? acc[ai][0][m < 3 ? m + 1 : 3][n][e] : 0.f;
                        const float t1 = dppf<0x121, true>(0.f, xm);
                        const float prev = dppf<0x111, false>(t1, x);
                        const float t2 = dppf<0x12F, true>(0.f, xp);
                        const float next = dppf<0x101, false>(t2, x);
                        const float z = w0[n][e] * prev + w1[n][e] * x + w2[n][e] * next + bb[n][e];
                        o[n][e] = gelu_tanh(z) * acc[ai][1][m][n][e];
                    }
                const bool edge = (m == 0 && fr == 0) || (m == 3 && fr == 15);
                if (!edge) *(u32x4*)(HH + (size_t)(u.pm * 256 + ai * 128 + wr * 64 + m * 16 + fr) * DFF + j0) = pack8(o[0], o[1]);
            }
        }
    }
};

struct GateOrder {
    int nU, G, c;
    DI bool next(int i, pg8::Unit& u) const { const int j = i / 3, br = i - 3 * j; const long L = (long)j * G + c; if (L >= nU) return false; u.pm = (int)(L >> 2); u.pn = br * 4 + (int)(L & 3); return true; }
    DI void a_ready(const pg8::Unit&) const {}
    DI void done(const pg8::Unit&) const {}
};

struct Ctx {
    LAS unsigned char* lds; unsigned char* ws; const Params& P; float* out;
    int tid, lane, wave, G, bid, z;
};
DI Ctx rectx(const Ctx& C0) { const int t = otid(); int z = 0; asm volatile("" : "+s"(z)); return Ctx{C0.lds, C0.P.ws + z, C0.P, C0.P.out + z, t, t & 63, __builtin_amdgcn_readfirstlane(t >> 6), C0.G, C0.bid, z}; }
#define WSP(T, off) ((T*)(C.ws + (off)))
#define WL(T, l, off) ((T*)(C.ws + WS_W + (size_t)(l) * WL_SIZE + (off)))

DI void tr_item(const float* src, int ldw, int k0, int n0, bf16* dst, int ldd, int drow0, LAS float* scr, int lane) {
#pragma unroll 8
    for (int i = 0; i < 32; ++i) { const int kk = 2 * i + (lane >> 5); scr[kk * 33 + (lane & 31)] = src[(size_t)(k0 + kk) * ldw + n0 + (lane & 31)]; }
    asm volatile("s_waitcnt lgkmcnt(0)" ::: "memory");
    const int c = lane & 7;
#pragma unroll
    for (int j = 0; j < 4; ++j) { const int n = (lane >> 3) + 8 * j; const LAS float* s = scr + (8 * c) * 33 + n;
        u32x4 o; o.x = pk(s[0 * 33], s[1 * 33]); o.y = pk(s[2 * 33], s[3 * 33]); o.z = pk(s[4 * 33], s[5 * 33]); o.w = pk(s[6 * 33], s[7 * 33]);
        *(u32x4*)(dst + (size_t)(drow0 + n) * ldd + k0 + 8 * c) = o; }
    asm volatile("s_waitcnt lgkmcnt(0)" ::: "memory");
}
DI void tr_matrix(const Ctx& C, const float* src, int ldw, int K, int n_src0, int ncols, bf16* dst, int drow0, LAS float* scr) {
    const int gw = C.bid * NWAVES + C.wave, NGW = C.G * NWAVES, nb = ncols / 32, nit = (K / 64) * nb;
    for (int it = gw; it < nit; it += NGW) { const int kb = it / nb, b = it % nb; tr_item(src, ldw, kb * 64, n_src0 + b * 32, dst, K, drow0 + b * 32, scr, C.lane); }
}

DI void prologue(const Ctx& C0) {
    const Ctx C = rectx(C0);
    LAS float* scr = (LAS float*)(C.lds + 49152 + C.wave * 8704);
    const int gth = C.bid * NTHREADS + C.tid, NGT = C.G * NTHREADS;
    for (int tsk = C.bid; tsk < 72; tsk += C.G) {
        const int l = tsk / 36, rem = tsk % 36, cb = rem / 3, rg = rem % 3;
        LAS float* s = (LAS float*)C.lds;
        for (int i = C.tid; i < 11 * 1024; i += NTHREADS) { const int r = rg * 11 + i / 1024, k = i % 1024; const float cv = (r < 32) ? C.P.in[1 + C.z][r * 1024 + k] : C.P.in[3 + C.z][k]; s[i] = cv * sigm(cv); }
        __syncthreads();
        const int j = cb * 512 + C.tid;
        float acc[11];
        const float bj = C.P.in[5 + C.z][l * 6144 + j];
#pragma unroll
        for (int i = 0; i < 11; ++i) acc[i] = bj;
        const float* wp = C.P.in[4 + C.z] + (size_t)l * 1024 * 6144 + j;
        for (int k = 0; k < 1024; k += 4) {
            const float w0 = wp[(size_t)k * 6144], w1 = wp[(size_t)(k + 1) * 6144], w2 = wp[(size_t)(k + 2) * 6144], w3 = wp[(size_t)(k + 3) * 6144];
#pragma unroll
            for (int i = 0; i < 11; ++i) { const f32x4 x = *(const LAS f32x4*)(s + i * 1024 + k); acc[i] += x[0] * w0 + x[1] * w1 + x[2] * w2 + x[3] * w3; }
        }
#pragma unroll
        for (int i = 0; i < 11; ++i) WSP(float, WS_MOD)[(size_t)(l * 33 + rg * 11 + i) * 6144 + j] = acc[i];
        __syncthreads();
    }
    if (C.bid == C.G - 1) for (int i = C.tid; i < 1024; i += NTHREADS) { const int p = i >> 4, f = i & 15; const float inv = powf(10000.f, -(float)f / 16.f), ang = (float)p * inv; WSP(float, WS_SMALL)[2 * i] = cosf(ang); WSP(float, WS_SMALL)[2 * i + 1] = sinf(ang); }
    for (int i = gth; i < 2048 * 4096 / 2; i += NGT) {
        const int tp = i / 2048, kk = (i % 2048) * 2; float v[2];
#pragma unroll
        for (int e = 0; e < 2; ++e) { const int k = kk + e, t = k & 2047; const int ph = (tp * t) & 2047; const float x = (float)ph * (1.f / 1024.f); v[e] = ((k < 2048) ? cospif(x) : -sinpif(x)) * 0.0027621358640099513f; }
        WSP(unsigned, WS_DFT)[i] = pk(v[0], v[1]);
    }
    for (int i = gth; i < 256 * 512 / 2; i += NGT) {
        const int tp = i / 256, kk = (i % 256) * 2; float v[2];
#pragma unroll
        for (int e = 0; e < 2; ++e) { const int k = kk + e, t = k & 255; const int ph = (tp * t) & 255; const float x = (float)ph * (1.f / 128.f); v[e] = ((k < 256) ? cospif(x) : -sinpif(x)) * 0.0078125f; }
        WSP(unsigned, WS_DFTC)[i] = pk(v[0], v[1]);
    }
    for (int l = 0; l < 2; ++l) {
        const float* win = C.P.in[10 + C.z] + (size_t)l * 1024 * IN_COLS;
        bf16* wi = WL(bf16, l, WL_IN);
        tr_matrix(C, win, IN_COLS, 1024, 1152, 512, wi, 0, scr);
        tr_matrix(C, win, IN_COLS, 1024, 1664, 128, wi, 512, scr);
        tr_matrix(C, win, IN_COLS, 1024, 1792, 128, wi, 640, scr);
        tr_matrix(C, win, IN_COLS, 1024, 0, 1152, wi, 1280, scr);
        for (int i = gth; i < 128 * 1024 / 2; i += NGT) ((unsigned*)(wi + (size_t)2432 * 1024))[i] = 0u;
        {
            LAS float* tab = (LAS float*)(C.lds + 120 * 1024);
            __syncthreads();
            if (C.tid < 64) { const float x = (float)C.tid * (1.f / 32.f); tab[C.tid] = cospif(x); tab[64 + C.tid] = sinpif(x); }
            __syncthreads();
            for (int i = gth; i < 512 * 1024; i += NGT) {
                const int k = i & 1023, np = i >> 10, sn = np >> 8, g = (np >> 6) & 3, cp = np & 63;
                const float* wr_ = win + (size_t)k * IN_COLS + 1920 + g * 64; const LAS float* tb = tab + sn * 64; float a = 0.f;
#pragma unroll 8
                for (int c = 0; c < 64; ++c) a += wr_[c] * tb[(c * cp) & 63];
                wi[(size_t)(768 + np) * 1024 + k] = f2bf(a);
            }
        }
        {
            bf16* wl = WSP(bf16, WS_WLORA + (size_t)l * 2 * MiB);
            const float* w2 = C.P.in[13 + C.z] + (size_t)l * 2 * 64 * 256; const float* a2 = C.P.in[15 + C.z] + (size_t)l * 2 * 64 * 256; const float* g2 = C.P.in[16 + C.z] + (size_t)l * 128 * 256;
            for (int i = gth; i < NLO * KLO; i += NGT) {
                const int c = i & 255, nb = (i >> 8) % 6, k = i / (256 * 6); float v = 0.f;
                if (nb == 0) { if (k < 64) v = w2[k * 256 + c]; }
                else if (nb == 1) { if (k >= 64 && k < 128) v = w2[(64 + k - 64) * 256 + c]; }
                else if (nb == 2) { if (k >= 128 && k < 192) v = a2[(k - 128) * 256 + c]; }
                else if (nb == 3) { if (k >= 192 && k < 256) v = a2[(64 + k - 192) * 256 + c]; }
                else if (nb == 4) { if (k >= 256 && k < 384) v = g2[(k - 256) * 256 + c]; }
                else if (l == 1 && k >= 384) { const float* v1 = C.P.in[23 + C.z] + (k - 384) * 32; const float* v2 = C.P.in[24 + C.z] + c; for (int j = 0; j < 32; ++j) v += v1[j] * v2[j * 256]; }
                wl[(size_t)(nb * 256 + c) * KLO + k] = f2bf(v);
            }
        }
        tr_matrix(C, win, IN_COLS, 1024, 2176, 3072, WL(bf16, l, WL_G), 0, scr);
        tr_matrix(C, C.P.in[26 + C.z] + (size_t)l * 256 * 1024, 1024, 256, 0, 1024, WL(bf16, l, WL_BR), 0, scr);
        tr_matrix(C, C.P.in[27 + C.z] + (size_t)l * 512 * 1024, 1024, 512, 0, 1024, WL(bf16, l, WL_BA), 0, scr);
        tr_matrix(C, C.P.in[28 + C.z] + (size_t)l * 256 * 1024, 1024, 256, 0, 1024, WL(bf16, l, WL_BF), 0, scr);
        tr_matrix(C, C.P.in[29 + C.z] + (size_t)l * 1024 * 1024, 1024, 1024, 0, 1024, WL(bf16, l, WL_O), 0, scr);
        {
            const float* up = C.P.in[30 + C.z] + (size_t)l * 1024 * 2 * DFF; bf16* wu = WL(bf16, l, WL_UP);
            const int gw = C.bid * NWAVES + C.wave, NGW = C.G * NWAVES, nit = 16 * 44 * 4;
            for (int it = gw; it < nit; it += NGW) { const int kb = it / 176, r = it % 176, seg = r >> 2, b = r & 3, pn = seg >> 1, bj = seg & 1;
                tr_item(up, 2 * DFF, kb * 64, bj * DFF + pn * 128 + b * 32, wu, 1024, pn * 256 + bj * 128 + b * 32, scr, C.lane); }
        }
        tr_matrix(C, C.P.in[33 + C.z] + (size_t)l * DFF * 1024, 1024, DFF, 0, 1024, WL(bf16, l, WL_DN), 0, scr);
    }
}

template <bool HAS_ADD, bool HAS_OUT>
DI void rowop(const Ctx& C0, int nrows, const float* hin_l, const float* hin_c, float* hout_l, float* hout_c, const bf16* add, int ga, const float* g_add, const float* g_out, int sh, int sc, const float* modl, const float* modo, bf16* Aout) {
    const Ctx C = rectx(C0);
    const int rpw = (nrows + C.G * NWAVES - 1) / (C.G * NWAVES), r0 = (C.bid * NWAVES + C.wave) * rpw, r1 = (r0 + rpw < nrows) ? r0 + rpw : nrows;
    if (r0 >= r1) return;
    const int c0 = 4 * C.lane;
    f32x4 gA[4], gO[4], mG[4], mS[4], mB[4];
#pragma unroll
    for (int j = 0; j < 4; ++j) { if (HAS_ADD) gA[j] = *(const f32x4*)(g_add + c0 + 256 * j); if (HAS_OUT) gO[j] = *(const f32x4*)(g_out + c0 + 256 * j); }
    int bcur = -1;
    f32x4 hn[4]; u32x2 an[4];
#define ROW_HP(t) (((t) < NLAT) ? hin_l + (size_t)(t) * DM : hin_c + (size_t)((t) - NLAT) * DM)
    { const float* hp = ROW_HP(r0);
#pragma unroll
      for (int j = 0; j < 4; ++j) { hn[j] = *(const f32x4*)(hp + c0 + 256 * j); if (HAS_ADD) an[j] = *(const u32x2*)(add + (size_t)r0 * DM + c0 + 256 * j); } }
    for (int tok = r0; tok < r1; ++tok) {
        f32x4 h[4]; u32x2 ar[4];
#pragma unroll
        for (int j = 0; j < 4; ++j) { h[j] = hn[j]; if (HAS_ADD) ar[j] = an[j]; }
        if (tok + 1 < r1) { const float* hp = ROW_HP(tok + 1);
#pragma unroll
            for (int j = 0; j < 4; ++j) { hn[j] = *(const f32x4*)(hp + c0 + 256 * j); if (HAS_ADD) an[j] = *(const u32x2*)(add + (size_t)(tok + 1) * DM + c0 + 256 * j); } }
        const bool lat = tok < NLAT; const int b = lat ? tok / TL : 32;
        if (b != bcur) { bcur = b; const float* mp = modl + (size_t)b * 6144; const float* mq = modo + (size_t)b * 6144;
#pragma unroll
            for (int j = 0; j < 4; ++j) { if (HAS_ADD) mG[j] = *(const f32x4*)(mp + ga * 1024 + c0 + 256 * j); if (HAS_OUT) { mS[j] = *(const f32x4*)(mq + sc * 1024 + c0 + 256 * j) + 1.f; mB[j] = *(const f32x4*)(mq + sh * 1024 + c0 + 256 * j); } } }
        if (HAS_ADD) {
            f32x4 a[4]; float ss = 0.f;
#pragma unroll
            for (int j = 0; j < 4; ++j) { a[j] = (f32x4){lo2f(ar[j].x), hi2f(ar[j].x), lo2f(ar[j].y), hi2f(ar[j].y)}; ss += a[j][0] * a[j][0] + a[j][1] * a[j][1] + a[j][2] * a[j][2] + a[j][3] * a[j][3]; }
            const float rstd = rsqrtf(wave_sum(ss) * (1.f / DM) + 1e-6f);
            float* op = lat ? hout_l + (size_t)tok * DM : hout_c + (size_t)(tok - NLAT) * DM;
#pragma unroll
            for (int j = 0; j < 4; ++j) { h[j] = h[j] + mG[j] * (a[j] * rstd * gA[j]); *(f32x4*)(op + c0 + 256 * j) = h[j]; }
        }
        if (HAS_OUT) {
            float ss = 0.f;
#pragma unroll
            for (int j = 0; j < 4; ++j) ss += h[j][0] * h[j][0] + h[j][1] * h[j][1] + h[j][2] * h[j][2] + h[j][3] * h[j][3];
            const float rstd = rsqrtf(wave_sum(ss) * (1.f / DM) + 1e-6f);
#pragma unroll
            for (int j = 0; j < 4; ++j) { const f32x4 y = (h[j] * rstd * gO[j]) * mS[j] + mB[j]; u32x2 o; o.x = pk(y[0], y[1]); o.y = pk(y[2], y[3]);
                *(u32x2*)(Aout + (size_t)tok * DM + c0 + 256 * j) = o; }
        }
    }
#undef ROW_HP
}

DI void feat1_phase(const Ctx& C0, int l) {
    const Ctx C = rectx(C0);
    const bf16* UR = WSP(bf16, WS_X + X_UR); bf16* F = WSP(bf16, WS_X + X_F); bf16* X2 = WSP(bf16, WS_A);
    const float* mu = C.P.in[11 + C.z] + (size_t)l * 2 * RW;
    const int gth = C.bid * NTHREADS + C.tid, NGT = C.G * NTHREADS;
    for (int idx = gth; idx < NT * 144; idx += NGT) {
        const int tok = idx / 144, pc = idx - tok * 144, cc = pc * 8;
        const int t = (tok < NLAT) ? (tok & (TL - 1)) : ((tok - NLAT) & (TC - 1)), T = (tok < NLAT) ? TL : TC;
        const bf16* up_ = UR + (size_t)tok * RW + cc;
        const u32x4 u = *(const u32x4*)up_;
        u32x4 p = {0u, 0u, 0u, 0u}, nx = {0u, 0u, 0u, 0u};
        if (t > 0) p = *(const u32x4*)(up_ - RW);
        if (t < T - 1) nx = *(const u32x4*)(up_ + RW);
        const f32x4 m0a = *(const f32x4*)(mu + cc), m0b = *(const f32x4*)(mu + cc + 4), m1a = *(const f32x4*)(mu + RW + cc), m1b = *(const f32x4*)(mu + RW + cc + 4);
        float s[8];
#pragma unroll
        for (int e = 0; e < 8; ++e) { const float uu = (e & 1) ? hi2f(u[e >> 1]) : lo2f(u[e >> 1]), pp = (e & 1) ? hi2f(p[e >> 1]) : lo2f(p[e >> 1]), nn = (e & 1) ? hi2f(nx[e >> 1]) : lo2f(nx[e >> 1]);
            const float m0 = (e < 4) ? m0a[e & 3] : m0b[e & 3], m1 = (e < 4) ? m1a[e & 3] : m1b[e & 3];
            s[e] = uu + m0 * (pp - uu) + m1 * (nn - uu); }
        if (cc >= 768 && cc < 896) {
#pragma unroll
            for (int e = 0; e < 8; ++e) s[e] = tanh_(s[e]); }
        else if (cc >= 1024) {
#pragma unroll
            for (int e = 0; e < 8; ++e) s[e] = sigm(s[e]); }
        u32x4 w; w.x = pk(s[0], s[1]); w.y = pk(s[2], s[3]); w.z = pk(s[4], s[5]); w.w = pk(s[6], s[7]);
        if (cc < 256) *(u32x4*)(F + (size_t)tok * 2048 + cc) = w;
        else if (cc < 512) *(u32x4*)(F + (size_t)tok * 2048 + 768 + cc - 256) = w;
        else if (cc < 768) { *(u32x4*)(F + (size_t)tok * 2048 + 512 + cc - 512) = w; *(u32x4*)(X2 + (size_t)tok * KLO + 384 + cc - 512) = w; }
        else *(u32x4*)(X2 + (size_t)tok * KLO + cc - 768) = w;
    }
}
DI void feat3_phase(const Ctx& C0, int l) {
    const Ctx C = rectx(C0);
    bf16* F = WSP(bf16, WS_X + X_F); bf16* Gq = WSP(bf16, WS_X + X_G); bf16* VF = WSP(bf16, WS_VF); float* BON = WSP(float, WS_BON); const bf16* LO = WSP(bf16, WS_X + X_LO);
    const int c = (C.lane >> 4) * 64 + (C.lane & 15) * 4;
    const f32x4 kkw = *(const f32x4*)(C.P.in[17 + C.z] + l * 256 + c), kaw = *(const f32x4*)(C.P.in[18 + C.z] + l * 256 + c), rkw = *(const f32x4*)(C.P.in[19 + C.z] + l * 256 + c);
    const f32x4 w0f = *(const f32x4*)(C.P.in[12 + C.z] + l * 512 + c), w0b = *(const f32x4*)(C.P.in[12 + C.z] + l * 512 + 256 + c), a0f = *(const f32x4*)(C.P.in[14 + C.z] + l * 512 + c), a0b = *(const f32x4*)(C.P.in[14 + C.z] + l * 512 + 256 + c);
    const f32x4 v0c = *(const f32x4*)(C.P.in[22 + C.z] + c);
    const int rpw = NT / (256 * NWAVES), r0 = (C.bid * NWAVES + C.wave) * rpw;
    if (C.bid >= 256) return;
    u32x2 nR, nK, nV, nVF, nL[6];
#define F3_LOAD(t) do { const size_t o_ = (size_t)(t) * 256 + c; const bf16* f_ = F + (size_t)(t) * 2048 + c; nR = *(const u32x2*)(f_); nK = *(const u32x2*)(f_ + 768); nV = *(const u32x2*)(f_ + 512); if (l == 1) nVF = *(const u32x2*)(VF + o_); \
        _Pragma("unroll") for (int q = 0; q < 6; ++q) if (q < 5 || l == 1) nL[q] = *(const u32x2*)(LO + (size_t)(t) * NLO + q * 256 + c); } while (0)
    F3_LOAD(r0);
    for (int tok = r0; tok < r0 + rpw; ++tok) {
        const u32x2 cR = nR, cK = nK, cV = nV, cVF = nVF; u32x2 cL[6];
#pragma unroll
        for (int q = 0; q < 6; ++q) cL[q] = nL[q];
        if (tok + 1 < r0 + rpw) F3_LOAD(tok + 1);
        const size_t o = (size_t)tok * 256 + c;
        const f32x4 r = bf4(cR), k = bf4(cK); f32x4 v = bf4(cV);
        if (l == 1) { const f32x4 vf = bf4(cVF), z = v0c + bf4(cL[5]);
#pragma unroll
            for (int e = 0; e < 4; ++e) v[e] = v[e] + (vf[e] - v[e]) * sigm(z[e]);
            *(u32x2*)(F + (size_t)tok * 2048 + 512 + c) = pk4(v); }
        else *(u32x2*)(VF + o) = cV;
        const f32x4 kr = k * kkw;
        const float ss = row16_sum(kr[0] * kr[0] + kr[1] * kr[1] + kr[2] * kr[2] + kr[3] * kr[3]), rn = rsqrtf(fmaxf(ss, 1e-24f));
        const f32x4 lf = w0f + bf4(cL[0]), lb = w0b + bf4(cL[1]), xf = a0f + bf4(cL[2]), xb = a0b + bf4(cL[3]);
        f32x4 ef, eb, af, ab; float bp = 0.f;
#pragma unroll
        for (int e = 0; e < 4; ++e) { ef[e] = 0.6065306597126334f * sigm(lf[e]); eb[e] = 0.6065306597126334f * sigm(lb[e]); af[e] = sigm(xf[e]); ab[e] = sigm(xb[e]);
            bp += r[e] * k[e] * (1.f + (0.5f * (af[e] + ab[e]) - 1.f) * kaw[e]) * rkw[e]; }
        const float bon = row16_sum(bp);
        if ((C.lane & 15) == 0) BON[(size_t)tok * 4 + (C.lane >> 4)] = bon;
        { bf16* f_ = F + (size_t)tok * 2048 + c; *(u32x2*)(f_ + 256) = pk4(kr * rn); *(u32x2*)(f_ + 1024) = pk4(ef); *(u32x2*)(f_ + 1280) = pk4(eb); *(u32x2*)(f_ + 1536) = pk4(af); *(u32x2*)(f_ + 1792) = pk4(ab); }
        *(u32x2*)(Gq + o) = cL[4];
    }
#undef F3_LOAD
}

struct ScanOp { bf16 r, kk, k, e, a, v; };
DI int scan_tok(int n, int dir, int b) { n = n < 2303 ? n : 2303; if (n < 256) return CTXB + b * 256 + (dir ? 255 - n : n); const int t = n - 256; return b * TL + (dir ? TL - 1 - t : t); }
DI ScanOp scan_load(const bf16* Ft, int dir, unsigned ck, unsigned cv) {
    ScanOp o; o.r = Ft[ck]; o.kk = Ft[256 + ck]; o.k = Ft[768 + ck]; o.e = (Ft + (4 + dir) * 256)[ck]; o.a = (Ft + (6 + dir) * 256)[ck]; o.v = Ft[512 + cv]; return o;
}
#define DPPT " row_mask:0xf bank_mask:0xf\n\t"
#define SOPS(S) "+v"(S[0]), "+v"(S[1]), "+v"(S[2]), "+v"(S[3]), "+v"(S[4]), "+v"(S[5]), "+v"(S[6]), "+v"(S[7]), "+v"(S[8]), "+v"(S[9]), "+v"(S[10]), "+v"(S[11]), "+v"(S[12]), "+v"(S[13]), "+v"(S[14]), "+v"(S[15])
DI void scan_step(float (&S)[16], const ScanOp& op, float ka, bf16* yp, bool wr) {
    float r = bf2f(op.r), kk = bf2f(op.kk), k = bf2f(op.k), e = bf2f(op.e), a = bf2f(op.a); const float v = bf2f(op.v);
    float w = fexp2(-e * LOG2E), kd = k * (1.f + (a - 1.f) * ka), nbd = -(kk * a);
    asm volatile("s_nop 4" : "+v"(r), "+v"(w), "+v"(kd), "+v"(nbd), "+v"(kk));
    float sa0 = 0.f, sa1 = 0.f;
    asm volatile(
        "v_fmac_f32_dpp %16, %18, %0 row_newbcast:0" DPPT "v_fmac_f32_dpp %17, %18, %1 row_newbcast:1" DPPT "v_fmac_f32_dpp %16, %18, %2 row_newbcast:2" DPPT "v_fmac_f32_dpp %17, %18, %3 row_newbcast:3" DPPT
        "v_fmac_f32_dpp %16, %18, %4 row_newbcast:4" DPPT "v_fmac_f32_dpp %17, %18, %5 row_newbcast:5" DPPT "v_fmac_f32_dpp %16, %18, %6 row_newbcast:6" DPPT "v_fmac_f32_dpp %17, %18, %7 row_newbcast:7" DPPT
        "v_fmac_f32_dpp %16, %18, %8 row_newbcast:8" DPPT "v_fmac_f32_dpp %17, %18, %9 row_newbcast:9" DPPT "v_fmac_f32_dpp %16, %18, %10 row_newbcast:10" DPPT "v_fmac_f32_dpp %17, %18, %11 row_newbcast:11" DPPT
        "v_fmac_f32_dpp %16, %18, %12 row_newbcast:12" DPPT "v_fmac_f32_dpp %17, %18, %13 row_newbcast:13" DPPT "v_fmac_f32_dpp %16, %18, %14 row_newbcast:14" DPPT "v_fmac_f32_dpp %17, %18, %15 row_newbcast:15" DPPT
        : SOPS(S), "+v"(sa0), "+v"(sa1) : "v"(kk));
    const float sa = allred4(sa0 + sa1);
#define UPM(j) "v_mul_f32_dpp %" #j ", %16, %" #j " row_newbcast:" #j DPPT
#define UPA(j) "v_fmac_f32_dpp %" #j ", %17, %19 row_newbcast:" #j DPPT
#define UPB(j) "v_fmac_f32_dpp %" #j ", %18, %20 row_newbcast:" #j DPPT
#define ALL16(M) M(0) M(1) M(2) M(3) M(4) M(5) M(6) M(7) M(8) M(9) M(10) M(11) M(12) M(13) M(14) M(15)
    asm volatile(ALL16(UPM) ALL16(UPA) ALL16(UPB) : SOPS(S) : "v"(w), "v"(nbd), "v"(kd), "v"(sa), "v"(v));
#undef UPM
#undef UPA
#undef UPB
    float y0 = 0.f, y1 = 0.f;
    asm volatile(
        "v_fmac_f32_dpp %16, %18, %0 row_newbcast:0" DPPT "v_fmac_f32_dpp %17, %18, %1 row_newbcast:1" DPPT "v_fmac_f32_dpp %16, %18, %2 row_newbcast:2" DPPT "v_fmac_f32_dpp %17, %18, %3 row_newbcast:3" DPPT
        "v_fmac_f32_dpp %16, %18, %4 row_newbcast:4" DPPT "v_fmac_f32_dpp %17, %18, %5 row_newbcast:5" DPPT "v_fmac_f32_dpp %16, %18, %6 row_newbcast:6" DPPT "v_fmac_f32_dpp %17, %18, %7 row_newbcast:7" DPPT
        "v_fmac_f32_dpp %16, %18, %8 row_newbcast:8" DPPT "v_fmac_f32_dpp %17, %18, %9 row_newbcast:9" DPPT "v_fmac_f32_dpp %16, %18, %10 row_newbcast:10" DPPT "v_fmac_f32_dpp %17, %18, %11 row_newbcast:11" DPPT
        "v_fmac_f32_dpp %16, %18, %12 row_newbcast:12" DPPT "v_fmac_f32_dpp %17, %18, %13 row_newbcast:13" DPPT "v_fmac_f32_dpp %16, %18, %14 row_newbcast:14" DPPT "v_fmac_f32_dpp %17, %18, %15 row_newbcast:15" DPPT
        : SOPS(S), "+v"(y0), "+v"(y1) : "v"(r));
    const float y = allred4(y0 + y1);
    if (wr) *yp = f2bf(y);
}
DI void scan_run(const Ctx& C0, int l, int b, int h, int dir) {
    const Ctx C = rectx(C0);
    if (C.wave >= 4) return;
    const int wv = C.wave & 3, q = C.lane >> 4, vi = C.lane & 15;
    const unsigned ck = h * 64 + C.lane, cv = h * 64 + 16 * wv + vi;
    const bf16* F = WSP(bf16, WS_X + X_F);
    bf16* YS = WSP(bf16, WS_X + X_UR) + (size_t)dir * FSZ;
    const float ka = C.P.in[18 + C.z][l * 256 + ck];
    float S[16];
#pragma unroll
    for (int j = 0; j < 16; ++j) S[j] = 0.f;
    const bool wr = (q == 0);
    size_t t0 = (size_t)scan_tok(0, dir, b) * 256, t1 = (size_t)scan_tok(1, dir, b) * 256, t2 = (size_t)scan_tok(2, dir, b) * 256, t3 = (size_t)scan_tok(3, dir, b) * 256;
    ScanOp o0 = scan_load(F + t0 * 8, dir, ck, cv), o1 = scan_load(F + t1 * 8, dir, ck, cv), o2 = scan_load(F + t2 * 8, dir, ck, cv), o3 = scan_load(F + t3 * 8, dir, ck, cv);
    for (int n = 0; n < 2304; n += 4) {
        size_t tn;
        scan_step(S, o0, ka, &(YS + t0)[cv], wr); tn = (size_t)__builtin_amdgcn_readfirstlane(scan_tok(n + 4, dir, b)) * 256; o0 = scan_load(F + tn * 8, dir, ck, cv); t0 = tn;
        scan_step(S, o1, ka, &(YS + t1)[cv], wr); tn = (size_t)__builtin_amdgcn_readfirstlane(scan_tok(n + 5, dir, b)) * 256; o1 = scan_load(F + tn * 8, dir, ck, cv); t1 = tn;
        scan_step(S, o2, ka, &(YS + t2)[cv], wr); tn = (size_t)__builtin_amdgcn_readfirstlane(scan_tok(n + 6, dir, b)) * 256; o2 = scan_load(F + tn * 8, dir, ck, cv); t2 = tn;
        scan_step(S, o3, ka, &(YS + t3)[cv], wr); tn = (size_t)__builtin_amdgcn_readfirstlane(scan_tok(n + 7, dir, b)) * 256; o3 = scan_load(F + tn * 8, dir, ck, cv); t3 = tn;
    }
}

DI void readout_phase(const Ctx& C0, int l, int nrows) {
    const Ctx C = rectx(C0);
    const bf16* F = WSP(bf16, WS_X + X_F); const bf16* Gq = WSP(bf16, WS_X + X_G); const bf16* YS = WSP(bf16, WS_X + X_UR); const float* BON = WSP(float, WS_BON);
    bf16* YR = WSP(bf16, WS_A + (size_t)108 * MiB);
    const int c = (C.lane >> 4) * 64 + (C.lane & 15) * 4;
    const f32x4 lw = *(const f32x4*)(C.P.in[20 + C.z] + l * 256 + c), lb = *(const f32x4*)(C.P.in[21 + C.z] + l * 256 + c);
    const int rpw = (nrows + C.G * NWAVES - 1) / (C.G * NWAVES), r0 = (C.bid * NWAVES + C.wave) * rpw, r1 = (r0 + rpw < nrows) ? r0 + rpw : nrows;
    if (r0 >= r1) return;
    u32x2 nF, nB, nV, nG; float nBon;
#define RO_LOAD(t) do { const size_t o_ = (size_t)(t) * 256 + c; nF = *(const u32x2*)(YS + o_); nB = *(const u32x2*)(YS + FSZ + o_); nV = *(const u32x2*)(F + (size_t)(t) * 2048 + 512 + c); nG = *(const u32x2*)(Gq + o_); nBon = BON[(size_t)(t) * 4 + (C.lane >> 4)]; } while (0)
    RO_LOAD(r0);
    for (int tok = r0; tok < r1; ++tok) {
        const u32x2 cF = nF, cB = nB, cV = nV, cG = nG; const float bon = nBon;
        if (tok + 1 < r1) RO_LOAD(tok + 1);
        const f32x4 y = bf4(cF) + bf4(cB);
        const float mean = row16_sum(y[0] + y[1] + y[2] + y[3]) * (1.f / 64.f);
        const f32x4 d = y - mean;
        const float var = row16_sum(d[0] * d[0] + d[1] * d[1] + d[2] * d[2] + d[3] * d[3]) * (1.f / 64.f);
        const f32x4 yn = d * rsqrtf(var + 64e-5f) * lw + lb;
        *(u32x2*)(YR + (size_t)tok * 256 + c) = pk4((yn + bf4(cV) * bon) * bf4(cG));
    }
#undef RO_LOAD
}

DI void fixup_phase(const Ctx& C0, int l, int nrows) {
    const Ctx C = rectx(C0);
    const int gw = C.bid * NWAVES + C.wave, NGW = C.G * NWAVES, nitem = (nrows / 64) * 2;
    const bf16* HALO = WSP(bf16, WS_X + X_HALO); bf16* HH = WSP(bf16, WS_X + X_HH);
    const float* cw = C.P.in[31 + C.z] + (size_t)l * 3 * DFF; const float* cb = C.P.in[32 + C.z] + (size_t)l * DFF;
    for (int it = gw; it < nitem; it += NGW) {
        const int grp = it >> 1, last = it & 1, row = grp * 64 + (last ? 63 : 0);
        const int t = (row < NLAT) ? (row & (TL - 1)) : ((row - NLAT) & (TC - 1)), T = (row < NLAT) ? TL : TC;
        const bf16* hb = HALO + (size_t)grp * 6 * DFF;
        const bf16 *pp, *pc, *pn, *pv; bool zp = false, zn = false;
        if (!last) { pc = hb; pn = hb + DFF; pv = hb + 4 * DFF; zp = (t == 0); pp = zp ? hb : hb - 6 * DFF + 3 * DFF; }
        else { pp = hb + 2 * DFF; pc = hb + 3 * DFF; pv = hb + 5 * DFF; zn = (t == T - 1); pn = zn ? hb : hb + 6 * DFF; }
        for (int p = C.lane; p < DFF / 8; p += 64) { const int j = p * 8;
            const u32x4 a = *(const u32x4*)(pp + j), bq = *(const u32x4*)(pc + j), cq = *(const u32x4*)(pn + j), vq = *(const u32x4*)(pv + j);
            float o[8];
#pragma unroll
            for (int e = 0; e < 8; ++e) { const unsigned ua = a[e >> 1], ub = bq[e >> 1], uc = cq[e >> 1], uv = vq[e >> 1];
                const float xp = zp ? 0.f : ((e & 1) ? hi2f(ua) : lo2f(ua)), xc = (e & 1) ? hi2f(ub) : lo2f(ub), xn = zn ? 0.f : ((e & 1) ? hi2f(uc) : lo2f(uc)), xv = (e & 1) ? hi2f(uv) : lo2f(uv);
                const float z = cw[j + e] * xp + cw[DFF + j + e] * xc + cw[2 * DFF + j + e] * xn + cb[j + e]; o[e] = gelu_tanh(z) * xv; }
            u32x4 w; w.x = pk(o[0], o[1]); w.y = pk(o[2], o[3]); w.z = pk(o[4], o[5]); w.w = pk(o[6], o[7]);
            *(u32x4*)(HH + (size_t)row * DFF + j) = w; }
    }
}

DI int crow(int i, int hh) { return (i & 3) + 8 * (i >> 2) + 4 * hh; }
DI void attn_unit(const Ctx& C, int l, int b, int kh, int qblk, bool isctx) {
    LAS bf16* Ks = (LAS bf16*)C.lds; LAS bf16* Vt = Ks + 64 * 72;
    const bf16* QKV = WSP(bf16, WS_X + X_QKV); bf16* YA = WSP(bf16, WS_A); const float* RT = WSP(float, WS_SMALL);
    const int g = C.wave >> 1, qt = C.wave & 1, hq = kh * 4 + g, r = C.lane & 31, hh = C.lane >> 5;
    const int qi = qblk * 64 + qt * 32 + r;
    const size_t tq = isctx ? (size_t)(CTXB + b * TC + qi) : (size_t)(b * TL + qi);
    bf16x8 qf[4];
    {
        float qv[4][8]; const bf16* qp = QKV + tq * 768 + hq * 64 + 8 * hh;
#pragma unroll
        for (int ks = 0; ks < 4; ++ks) { const u32x4 u = *(const u32x4*)(qp + 16 * ks);
#pragma unroll
            for (int e = 0; e < 4; ++e) { qv[ks][2 * e] = lo2f(u[e]); qv[ks][2 * e + 1] = hi2f(u[e]); } }
        if (!isctx) { const int rid = qi >> 6, cid = qi & 63;
#pragma unroll
            for (int j = 0; j < 8; ++j) { const int f = 8 * hh + j;
                const float c0 = RT[(rid * 16 + f) * 2], s0 = RT[(rid * 16 + f) * 2 + 1], c1 = RT[(cid * 16 + f) * 2], s1 = RT[(cid * 16 + f) * 2 + 1];
                const float a1 = qv[0][j], a2 = qv[1][j], b1 = qv[2][j], b2 = qv[3][j];
                qv[0][j] = a1 * c0 - a2 * s0; qv[1][j] = a2 * c0 + a1 * s0; qv[2][j] = b1 * c1 - b2 * s1; qv[3][j] = b2 * c1 + b1 * s1; } }
        const float sc = 0.125f * LOG2E;
#pragma unroll
        for (int ks = 0; ks < 4; ++ks) { u32x4 w; w.x = pk(qv[ks][0] * sc, qv[ks][1] * sc); w.y = pk(qv[ks][2] * sc, qv[ks][3] * sc); w.z = pk(qv[ks][4] * sc, qv[ks][5] * sc); w.w = pk(qv[ks][6] * sc, qv[ks][7] * sc); qf[ks] = __builtin_bit_cast(bf16x8, w); }
    }
    float m_run = C.P.in[25 + C.z][l * 8 + hq] * LOG2E, l_run = hh == 0 ? 1.f : 0.f;
    f32x16 o0, o1;
#pragma unroll
    for (int i = 0; i < 16; ++i) { o0[i] = 0.f; o1[i] = 0.f; }
    const int nch = isctx ? 4 : 9, skey = C.tid >> 3, oct = C.tid & 7;
    for (int ch = 0; ch < nch; ++ch) {
        const bool win = ch >= 4; int kb = 0; size_t ktok0;
        if (!win) ktok0 = (size_t)(CTXB + b * TC + ch * 64);
        else { kb = qblk * 64 - 128 + (ch - 4) * 64; if (kb < 0 || kb >= TL) continue; ktok0 = (size_t)(b * TL + kb); }
        __syncthreads();
        {
            const bf16* kp = QKV + (ktok0 + skey) * 768 + 512 + kh * 64; const bf16* vp = kp + 128;
            u32x4 ku = *(const u32x4*)(kp + 8 * oct);
            if (win) { const u32x4 pu = *(const u32x4*)(kp + 8 * (oct ^ 2));
                const int p = kb + skey, pos = (oct >> 2) ? (p & 63) : (p >> 6), fb = 8 * (oct & 1); const bool isx1 = (oct & 2) == 0;
                float o[8];
#pragma unroll
                for (int e = 0; e < 8; ++e) { const float own = (e & 1) ? hi2f(ku[e >> 1]) : lo2f(ku[e >> 1]), par = (e & 1) ? hi2f(pu[e >> 1]) : lo2f(pu[e >> 1]);
                    const float cc = RT[(pos * 16 + fb + e) * 2], ss = RT[(pos * 16 + fb + e) * 2 + 1];
                    o[e] = isx1 ? (own * cc - par * ss) : (own * cc + par * ss); }
                ku.x = pk(o[0], o[1]); ku.y = pk(o[2], o[3]); ku.z = pk(o[4], o[5]); ku.w = pk(o[6], o[7]); }
            *(LAS u32x4*)(Ks + skey * 72 + 8 * oct) = ku;
            const u32x4 vu = *(const u32x4*)(vp + 8 * oct);
#pragma unroll
            for (int e = 0; e < 8; ++e) Vt[(8 * oct + e) * 72 + skey] = (bf16)((e & 1) ? (vu[e >> 1] >> 16) : (vu[e >> 1] & 0xffffu));
        }
        __syncthreads();
        f32x16 x0, x1;
#pragma unroll
        for (int i = 0; i < 16; ++i) { x0[i] = 0.f; x1[i] = 0.f; }
#pragma unroll
        for (int ks = 0; ks < 4; ++ks) {
            const bf16x8 a0 = *(const LAS bf16x8*)(Ks + r * 72 + 16 * ks + 8 * hh), a1 = *(const LAS bf16x8*)(Ks + (32 + r) * 72 + 16 * ks + 8 * hh);
            x0 = __builtin_amdgcn_mfma_f32_32x32x16_bf16(a0, qf[ks], x0, 0, 0, 0);
            x1 = __builtin_amdgcn_mfma_f32_32x32x16_bf16(a1, qf[ks], x1, 0, 0, 0);
        }
        if (win) {
#pragma unroll
            for (int i = 0; i < 16; ++i) { const int k0 = kb + crow(i, hh), d0 = qi - k0, d1 = d0 - 32;
                if (d0 > 128 || d0 < -128) x0[i] = -1e30f; if (d1 > 128 || d1 < -128) x1[i] = -1e30f; }
        }
        float mx = x0[0];
#pragma unroll
        for (int i = 0; i < 16; ++i) { mx = fmaxf(mx, x0[i]); mx = fmaxf(mx, x1[i]); }
        mx = fmaxf(mx, __shfl_xor(mx, 32));
        const float m_new = fmaxf(m_run, mx), alpha = fexp2(m_run - m_new);
        float ps = 0.f;
#pragma unroll
        for (int i = 0; i < 16; ++i) { x0[i] = fexp2(x0[i] - m_new); x1[i] = fexp2(x1[i] - m_new); ps += x0[i] + x1[i]; o0[i] *= alpha; o1[i] *= alpha; }
        l_run = l_run * alpha + ps; m_run = m_new;
#pragma unroll
        for (int kt = 0; kt < 2; ++kt)
#pragma unroll
            for (int s = 0; s < 2; ++s) {
                const f32x16& x = kt ? x1 : x0;
                u32x4 w; w.x = pk(x[8 * s], x[8 * s + 1]); w.y = pk(x[8 * s + 2], x[8 * s + 3]); w.z = pk(x[8 * s + 4], x[8 * s + 5]); w.w = pk(x[8 * s + 6], x[8 * s + 7]);
                const bf16x8 pb = __builtin_bit_cast(bf16x8, w);
                const int ko = kt * 32 + 16 * s + 4 * hh;
                const s16x4 l0 = *(const LAS s16x4*)(Vt + r * 72 + ko), h0 = *(const LAS s16x4*)(Vt + r * 72 + ko + 8);
                const s16x4 l1 = *(const LAS s16x4*)(Vt + (32 + r) * 72 + ko), h1 = *(const LAS s16x4*)(Vt + (32 + r) * 72 + ko + 8);
                o0 = __builtin_amdgcn_mfma_f32_32x32x16_bf16(__builtin_shufflevector(l0, h0, 0, 1, 2, 3, 4, 5, 6, 7), pb, o0, 0, 0, 0);
                o1 = __builtin_amdgcn_mfma_f32_32x32x16_bf16(__builtin_shufflevector(l1, h1, 0, 1, 2, 3, 4, 5, 6, 7), pb, o1, 0, 0, 0);
            }
    }
    const float inv = frcp(l_run + __shfl_xor(l_run, 32));
    bf16* op = YA + tq * 512 + hq * 64 + 4 * hh;
#pragma unroll
    for (int i4 = 0; i4 < 4; ++i4) {
        u32x2 w0, w1; w0.x = pk(o0[4 * i4] * inv, o0[4 * i4 + 1] * inv); w0.y = pk(o0[4 * i4 + 2] * inv, o0[4 * i4 + 3] * inv);
        w1.x = pk(o1[4 * i4] * inv, o1[4 * i4 + 1] * inv); w1.y = pk(o1[4 * i4 + 2] * inv, o1[4 * i4 + 3] * inv);
        *(u32x2*)(op + 8 * i4) = w0; *(u32x2*)(op + 32 + 8 * i4) = w1;
    }
}
DI void attn_loop(const Ctx& C0, int l) {
    const Ctx C = rectx(C0);
    unsigned* ctr = WSP(unsigned, WS_CTL) + 64 * (l + 1);
    volatile LAS unsigned* slot = (volatile LAS unsigned*)(C.lds + 32768);
    const unsigned NU = 2048u + (l == 0 ? 256u : 0u);
    for (;;) {
        __syncthreads();
        if (C.tid == 0) *slot = atomicAdd(ctr, 1u);
        __syncthreads();
        const unsigned u = *slot;
        if (u >= NU) break;
        if (u < 2048u) attn_unit(C, l, (int)(u >> 6), (int)((u >> 5) & 1), (int)(u & 31), false);
        else { const unsigned v = u - 2048u; attn_unit(C, l, (int)(v >> 3), (int)((v >> 2) & 1), (int)(v & 3), true); }
    }
}


#ifdef DBG
DI float exp_f(float x) { return fexp2(x * LOG2E); }
DI unsigned hsh(unsigned x) { x ^= x >> 16; x *= 0x7feb352du; x ^= x >> 15; x *= 0x846ca68bu; x ^= x >> 16; return x; }
DI void dbg_put(const Ctx& C, int k, float got, float ref, float S) {
    float err = fabsf(got - ref) / (fabsf(ref) + S); if (!(err == err)) err = 1e9f;
    atomicMax(WSP(unsigned, WS_CTL) + 1024 + k, __builtin_bit_cast(unsigned, err));
}
DI float ndot(const bf16* a, const bf16* b, int K) { float s = 0.f; for (int k = 0; k < K; ++k) s += bf2f(a[k]) * bf2f(b[k]); return s; }
DI void dbg_check(const Ctx& C0, int stage, int l) {
    if (C0.bid != 0 || l != 0) return;
    const Ctx C = rectx(C0);
    const unsigned h1 = hsh(C.tid * 3u + 17u + stage * 1000u), h2 = hsh(h1 + 0x9e3779b9u), h3 = hsh(h2 + 77u);
    const Params& P = C.P;
    if (stage == 0) {
        {
            const int n = h1 % 2432, k = h2 % 1024; int src = -1;
            if (n < 512) src = 1152 + n; else if (n < 640) src = 1664 + (n - 512); else if (n < 768) src = 1792 + (n - 640); else if (n >= 1280) src = n - 1280;
            if (src >= 0) dbg_put(C, 0, bf2f(WL(bf16, 0, WL_IN)[(size_t)n * 1024 + k]), bf2f(f2bf(P.in[10 + C.z][(size_t)k * IN_COLS + src])), 1e-6f);
            const int ng = h3 % 3072;
            dbg_put(C, 0, bf2f(WL(bf16, 0, WL_G)[(size_t)ng * 1024 + k]), bf2f(f2bf(P.in[10 + C.z][(size_t)k * IN_COLS + 2176 + ng])), 1e-6f);
            const int nu = h3 % 5632, pn = nu >> 8, bj = (nu >> 7) & 1, j = nu & 127;
            dbg_put(C, 0, bf2f(WL(bf16, 0, WL_UP)[(size_t)nu * 1024 + k]), bf2f(f2bf(P.in[30 + C.z][(size_t)k * 5632 + bj * DFF + pn * 128 + j])), 1e-6f);
            const int nd = h1 % 1024, kd = h3 % DFF;
            dbg_put(C, 0, bf2f(WL(bf16, 0, WL_DN)[(size_t)nd * DFF + kd]), bf2f(f2bf(P.in[33 + C.z][(size_t)kd * 1024 + nd])), 1e-6f);
            dbg_put(C, 0, bf2f(WL(bf16, 0, WL_O)[(size_t)nd * 1024 + k]), bf2f(f2bf(P.in[29 + C.z][(size_t)k * 1024 + nd])), 1e-6f);
            dbg_put(C, 0, bf2f(WL(bf16, 0, WL_BA)[(size_t)nd * 512 + (k & 511)]), bf2f(f2bf(P.in[27 + C.z][(size_t)(k & 511) * 1024 + nd])), 1e-6f);
            dbg_put(C, 0, bf2f(WL(bf16, 0, WL_BR)[(size_t)nd * 256 + (k & 255)]), bf2f(f2bf(P.in[26 + C.z][(size_t)(k & 255) * 1024 + nd])), 1e-6f);
        }
        {
            const int r = h1 % 33, j = h2 % 6144; float a = P.in[5 + C.z][j];
            for (int k = 0; k < 1024; ++k) { const float cv = (r < 32) ? P.in[1 + C.z][r * 1024 + k] : P.in[3 + C.z][k]; a += cv / (1.f + exp_f(-cv)) * P.in[4 + C.z][(size_t)k * 6144 + j]; }
            dbg_put(C, 1, WSP(float, WS_MOD)[(size_t)r * 6144 + j], a, 0.01f);
        }
    } else if (stage == 1) {
        const int tok = h1 % NT, col = h2 % 1024; const bool lat = tok < NLAT; const float* hp = lat ? P.in[0 + C.z] + (size_t)tok * DM : P.in[2 + C.z] + (size_t)(tok - NLAT) * DM;
        float ss = 0.f; for (int k = 0; k < 1024; ++k) ss += hp[k] * hp[k];
        const float* mp = WSP(float, WS_MOD) + (size_t)(lat ? tok / TL : 32) * 6144;
        const float ref = hp[col] * rsqrtf(ss / 1024.f + 1e-6f) * P.in[6 + C.z][col] * (1.f + mp[1024 + col]) + mp[col];
        dbg_put(C, 2, bf2f(WSP(bf16, WS_A)[(size_t)tok * DM + col]), ref, 0.05f);
    } else if (stage == 2) {
        const int tok = h1 % NT, n = h2 % 2432; const float ref = ndot(WSP(bf16, WS_A) + (size_t)tok * DM, WL(bf16, 0, WL_IN) + (size_t)n * 1024, 1024);
        float got; int k;
        if (n < 768) { got = bf2f(WSP(bf16, WS_X + X_QKV)[(size_t)tok * 768 + n]); k = 3; }
        else if (n < 1280) { const int sn = (n - 768) >> 8, ch = (n - 768) & 255; k = 4;
            if (tok < NLAT) got = bf2f(WSP(bf16, WS_X + X_ZT)[((size_t)(tok / TL) * 256 + ch) * 4096 + sn * 2048 + (tok % TL)]);
            else got = bf2f(WSP(bf16, WS_X + X_ZTC)[((size_t)((tok - NLAT) / TC) * 256 + ch) * 512 + sn * 256 + ((tok - NLAT) % TC)]); }
        else { got = bf2f(WSP(bf16, WS_X + X_UR)[(size_t)tok * RW + n - 1280]); k = 5; }
        dbg_put(C, k, got, ref, 0.1f);
    } else if (stage == 3) {
        const int b = h1 % 32, t = 1 + h2 % 2046, c = h3 % 256; const size_t tok = (size_t)b * TL + t; const bf16* UR = WSP(bf16, WS_X + X_UR);
        const float u = bf2f(UR[tok * RW + c]), up = bf2f(UR[(tok - 1) * RW + c]), un = bf2f(UR[(tok + 1) * RW + c]);
        dbg_put(C, 7, bf2f(WSP(bf16, WS_X + X_F)[tok * 2048 + c]), u + P.in[11 + C.z][c] * (up - u) + P.in[11 + C.z][RW + c] * (un - u), 0.05f);
        float ss = 0.f; for (int k = 0; k < 64; ++k) { const float x = bf2f(WSP(bf16, WS_X + X_F)[tok * 2048 + 256 + (c & 192) + k]); ss += x * x; }
        dbg_put(C, 7, ss, 1.f, 0.f);
    } else if (stage == 4) {
        {
            LAS float* S = (LAS float*)C.lds; LAS float* sa = S + 4096; const bf16* F = WSP(bf16, WS_X + X_F); const int b = 1, h = 2;
            for (int dir = 0; dir < 2; ++dir) {
                for (int e = C.tid; e < 4096; e += NTHREADS) S[e] = 0.f;
                __syncthreads();
                for (int n = 0; n < 24; ++n) {
                    const size_t oy = (size_t)scan_tok(n, dir, b) * 256 + h * 64, o = (size_t)scan_tok(n, dir, b) * 2048 + h * 64;
                    if (C.tid < 64) { float a = 0.f; for (int k = 0; k < 64; ++k) a -= S[C.tid * 64 + k] * bf2f(F[256 + o + k]); sa[C.tid] = a; }
                    __syncthreads();
                    for (int e = C.tid; e < 4096; e += NTHREADS) { const int v = e >> 6, k = e & 63;
                        const float kk = bf2f(F[256 + o + k]), kr = bf2f(F[768 + o + k]), ee = bf2f(F[(4 + dir) * 256 + o + k]), a = bf2f(F[(6 + dir) * 256 + o + k]), vv = bf2f(F[512 + o + v]);
                        S[e] = S[e] * exp_f(-ee) + sa[v] * (kk * a) + vv * (kr * (1.f + (a - 1.f) * P.in[18 + C.z][h * 64 + k])); }
                    __syncthreads();
                    if (C.tid < 64) { float y = 0.f; for (int k = 0; k < 64; ++k) y += S[C.tid * 64 + k] * bf2f(F[o + k]);
                        dbg_put(C, 8, bf2f(WSP(bf16, WS_X + X_UR)[(size_t)dir * FSZ + oy + C.tid]), y, 0.05f); }
                    __syncthreads();
                }
            }
        }
        {
            LAS float* qs = (LAS float*)C.lds + (size_t)C.tid * 65; const bf16* QKV = WSP(bf16, WS_X + X_QKV);
            const int b = h1 % 32, t = (C.tid & 1) ? (int)(h2 % 2048) : ((C.tid & 2) ? (int)(h2 % 200) : 2047 - (int)(h2 % 200)), hq = h3 % 8, dd = (h3 >> 8) % 64, kh = hq >> 2;
            const size_t tq = (size_t)b * TL + t;
            for (int d = 0; d < 64; ++d) { const int ax = d >> 5, hf = (d >> 4) & 1, f = d & 15; const int ps = ax ? (t & 63) : (t >> 6); const float cs = WSP(float, WS_SMALL)[(ps * 16 + f) * 2], sn = WSP(float, WS_SMALL)[(ps * 16 + f) * 2 + 1];
                const float x1 = bf2f(QKV[tq * 768 + hq * 64 + ax * 32 + f]), x2 = bf2f(QKV[tq * 768 + hq * 64 + ax * 32 + 16 + f]);
                qs[d] = hf ? (x2 * cs + x1 * sn) : (x1 * cs - x2 * sn); }
            float m = P.in[25 + C.z][hq], den = 1.f, acc = 0.f;
            for (int j = 0; j < 256 + 257; ++j) {
                const bool win = j >= 256; const int kp = win ? t - 128 + (j - 256) : j; if (win && (kp < 0 || kp >= TL)) continue;
                const size_t tk = win ? (size_t)b * TL + kp : (size_t)(CTXB + b * TC + kp); float s = 0.f;
                for (int d = 0; d < 64; ++d) { float kv;
                    if (!win) kv = bf2f(QKV[tk * 768 + 512 + kh * 64 + d]);
                    else { const int ax = d >> 5, hf = (d >> 4) & 1, f = d & 15; const int ps = ax ? (kp & 63) : (kp >> 6); const float cs = WSP(float, WS_SMALL)[(ps * 16 + f) * 2], sn = WSP(float, WS_SMALL)[(ps * 16 + f) * 2 + 1];
                        const float x1 = bf2f(QKV[tk * 768 + 512 + kh * 64 + ax * 32 + f]), x2 = bf2f(QKV[tk * 768 + 512 + kh * 64 + ax * 32 + 16 + f]);
                        kv = hf ? (x2 * cs + x1 * sn) : (x1 * cs - x2 * sn); }
                    s += qs[d] * kv; }
                s *= 0.125f; const float mn = fmaxf(m, s), al = exp_f(m - mn), p = exp_f(s - mn);
                den = den * al + p; acc = acc * al + p * bf2f(QKV[tk * 768 + 640 + kh * 64 + dd]); m = mn;
            }
            dbg_put(C, 9, bf2f(WSP(bf16, WS_A)[tq * 512 + hq * 64 + dd]), acc / den, 0.03f);
        }
        __syncthreads();
        {
            LAS float* qs = (LAS float*)C.lds + (size_t)C.tid * 65; const bf16* QKV = WSP(bf16, WS_X + X_QKV);
            const int b = h2 % 32, t = h1 % 256, hq = h3 % 8, dd = (h3 >> 8) % 64, kh = hq >> 2; const size_t tq = (size_t)(CTXB + b * TC + t);
            for (int d = 0; d < 64; ++d) qs[d] = bf2f(QKV[tq * 768 + hq * 64 + d]);
            float m = P.in[25 + C.z][hq], den = 1.f, acc = 0.f;
            for (int j = 0; j < 256; ++j) { const size_t tk = (size_t)(CTXB + b * TC + j); float s = 0.f;
                for (int d = 0; d < 64; ++d) s += qs[d] * bf2f(QKV[tk * 768 + 512 + kh * 64 + d]);
                s *= 0.125f; const float mn = fmaxf(m, s), al = exp_f(m - mn), p = exp_f(s - mn); den = den * al + p; acc = acc * al + p * bf2f(QKV[tk * 768 + 640 + kh * 64 + dd]); m = mn; }
            dbg_put(C, 10, bf2f(WSP(bf16, WS_A)[tq * 512 + hq * 64 + dd]), acc / den, 0.03f);
        }
        {
            const int b = h1 % 32, tp = h2 % 2048, ch = h3 % 256;
            dbg_put(C, 11, bf2f(WSP(bf16, WS_A + (size_t)72 * MiB)[((size_t)b * TL + tp) * 256 + ch]), ndot(WSP(bf16, WS_DFT) + (size_t)tp * 4096, WSP(bf16, WS_X + X_ZT) + ((size_t)b * 256 + ch) * 4096, 4096), 0.05f);
            const int tc = h2 % 256;
            dbg_put(C, 11, bf2f(WSP(bf16, WS_A + (size_t)72 * MiB)[((size_t)CTXB + b * TC + tc) * 256 + ch]), ndot(WSP(bf16, WS_DFTC) + (size_t)tc * 512, WSP(bf16, WS_X + X_ZTC) + ((size_t)b * 256 + ch) * 512, 512), 0.05f);
        }
    } else if (stage == 5) {
        const int tok = h1 % NT, col = h2 % 1024; const bf16* PP = WSP(bf16, WS_X + X_PP);
        dbg_put(C, 13, bf2f(PP[(size_t)tok * NGATE + col]), ndot(WSP(bf16, WS_A + (size_t)108 * MiB) + (size_t)tok * 256, WL(bf16, 0, WL_BR) + (size_t)col * 256, 256), 0.05f);
        dbg_put(C, 13, bf2f(PP[(size_t)tok * NGATE + 1024 + col]), ndot(WSP(bf16, WS_A) + (size_t)tok * 512, WL(bf16, 0, WL_BA) + (size_t)col * 512, 512), 0.05f);
        dbg_put(C, 13, bf2f(PP[(size_t)tok * NGATE + 2048 + col]), ndot(WSP(bf16, WS_A + (size_t)72 * MiB) + (size_t)tok * 256, WL(bf16, 0, WL_BF) + (size_t)col * 256, 256), 0.05f);
    } else if (stage == 6) {
        const int tok = h1 % NT, col = h2 % 1024; float ref = 0.f;
        for (int br = 0; br < 3; ++br) { const float gl = ndot(WSP(bf16, WS_A) + (size_t)tok * DM, WL(bf16, 0, WL_G) + (size_t)(br * 1024 + col) * 1024, 1024); ref += bf2f(WSP(bf16, WS_X + X_PP)[(size_t)tok * NGATE + br * 1024 + col]) / (1.f + exp_f(-gl)); }
        dbg_put(C, 14, bf2f(WSP(bf16, WS_X + X_UR)[(size_t)tok * DM + col]), ref, 0.05f);
    } else if (stage == 7) {
        const int tok = h1 % NT, col = h2 % 1024;
        dbg_put(C, 15, bf2f(WSP(bf16, WS_X + X_MIX)[(size_t)tok * DM + col]), ndot(WSP(bf16, WS_X + X_UR) + (size_t)tok * DM, WL(bf16, 0, WL_O) + (size_t)col * 1024, 1024), 0.05f);
    } else if (stage == 8) {
        const int tok = h1 % NT, col = h2 % 1024; const bool lat = tok < NLAT; const float* hp = lat ? P.in[0 + C.z] + (size_t)tok * DM : P.in[2 + C.z] + (size_t)(tok - NLAT) * DM;
        const bf16* mx = WSP(bf16, WS_X + X_MIX) + (size_t)tok * DM; const float* mp = WSP(float, WS_MOD) + (size_t)(lat ? tok / TL : 32) * 6144;
        float ss = 0.f; for (int k = 0; k < 1024; ++k) ss += bf2f(mx[k]) * bf2f(mx[k]);
        const float rs = rsqrtf(ss / 1024.f + 1e-6f); float s2 = 0.f, hc = 0.f;
        for (int k = 0; k < 1024; ++k) { const float hn = hp[k] + mp[2048 + k] * bf2f(mx[k]) * rs * P.in[7 + C.z][k]; s2 += hn * hn; if (k == col) hc = hn; }
        const float* ho = lat ? C.out + (size_t)tok * DM : WSP(float, WS_HC) + (size_t)(tok - NLAT) * DM;
        dbg_put(C, 16, ho[col], hc, 0.01f);
        dbg_put(C, 16, bf2f(WSP(bf16, WS_A)[(size_t)tok * DM + col]), hc * rsqrtf(s2 / 1024.f + 1e-6f) * P.in[8 + C.z][col] * (1.f + mp[4096 + col]) + mp[3072 + col], 0.05f);
    } else if (stage == 9) {
        int tok = h1 % NT; if (C.tid & 1) tok = (tok & ~63) + ((C.tid & 2) ? 63 : 0);
        const int j = h2 % DFF; const int t = (tok < NLAT) ? (tok % TL) : ((tok - NLAT) % TC), T = (tok < NLAT) ? TL : TC;
        const bf16* A = WSP(bf16, WS_A); const bf16* wu = WL(bf16, 0, WL_UP); const int pn = j >> 7, jj = j & 127;
        const bf16* wg = wu + (size_t)(pn * 256 + jj) * 1024; const bf16* wv = wu + (size_t)(pn * 256 + 128 + jj) * 1024;
        const float zc = ndot(A + (size_t)tok * DM, wg, 1024), zp = (t > 0) ? ndot(A + (size_t)(tok - 1) * DM, wg, 1024) : 0.f, zn = (t < T - 1) ? ndot(A + (size_t)(tok + 1) * DM, wg, 1024) : 0.f, zv = ndot(A + (size_t)tok * DM, wv, 1024);
        const float z = P.in[31 + C.z][j] * zp + P.in[31 + C.z][DFF + j] * zc + P.in[31 + C.z][2 * DFF + j] * zn + P.in[32 + C.z][j];
        const float ge = 0.5f * z * (1.f + tanh_(0.7978845608028654f * (z + 0.044715f * z * z * z)));
        dbg_put(C, 17, bf2f(WSP(bf16, WS_X + X_HH)[(size_t)tok * DFF + j]), ge * zv, 0.05f);
    } else if (stage == 10) {
        const int tok = h1 % NT, col = h2 % 1024;
        dbg_put(C, 18, bf2f(WSP(bf16, WS_X + X_FFO)[(size_t)tok * DM + col]), ndot(WSP(bf16, WS_X + X_HH) + (size_t)tok * DFF, WL(bf16, 0, WL_DN) + (size_t)col * DFF, DFF), 0.05f);
    }
}
DI void dbg_report(const Ctx& C) {
    if (C.bid == 0 && threadIdx.x == 0) {
        int first = -1; for (int k = 0; k < 24; ++k) if (first < 0 && __builtin_bit_cast(float, WSP(unsigned, WS_CTL)[1024 + k]) > 0.05f) first = k;
        if (first >= 0) C.out[12345] = 1000.f * (float)(first + 1);
    }
}
#define DBGCHK(stage) do { grid.sync(); dbg_check(CK, stage, l); grid.sync(); } while (0)
#else
#define DBGCHK(stage) do { } while (0)
#endif
#define XB_TMO      128
#define XB_XCNT(j)  (256  + 64 * (j))
#define XB_XSUB(j)  (1280 + 64 * (j))
#define XB_XGEN(j)  (2304 + 64 * (j))
#define XB_TOP      3328
#define XB_TOPGEN   3392
#define XCD_BAR_WORDS 3456
#define XB_SPIN_CAP (1u << 18)

__device__ __forceinline__ unsigned xb_ld(unsigned* p)              { return __hip_atomic_load(p, __ATOMIC_RELAXED, __HIP_MEMORY_SCOPE_AGENT); }
__device__ __forceinline__ unsigned xb_add(unsigned* p, unsigned v) { return __hip_atomic_fetch_add(p, v, __ATOMIC_RELAXED, __HIP_MEMORY_SCOPE_AGENT); }
__device__ __forceinline__ unsigned xb_xcc_id() { return (unsigned)__builtin_amdgcn_s_getreg((3 << 11) | 20) & 0xFu; }
#define XB_SPIN(cond, bar) do { unsigned _sp = 0; while (cond) { __builtin_amdgcn_s_sleep(1); \
    if ((++_sp & 255u) == 0u) { if (xb_ld(&(bar)[XB_TMO])) break; if (_sp > XB_SPIN_CAP) { atomicAdd(&(bar)[XB_TMO], 1u); break; } } } } while (0)

struct XcdBarrier {
    unsigned* bar; unsigned x;
    volatile LAS unsigned* st;
};

__device__ __forceinline__ XcdBarrier xcd_barrier_post(unsigned* bar, volatile LAS unsigned* st) {
    XcdBarrier b; b.bar = bar; b.x = xb_xcc_id(); b.st = st;
    if (threadIdx.x == 0) (void)xb_add(&bar[XB_XCNT(b.x)], 1u);
    return b;
}
__device__ __forceinline__ void xcd_barrier_complete(unsigned* bar, unsigned x, unsigned& nloc, unsigned& nx) {
    const unsigned G = gridDim.x * gridDim.y * gridDim.z;
    unsigned sum, cnt, mine, sp = 0u;
    for (;;) {
        sum = 0u; cnt = 0u; mine = 0u;
#pragma unroll
        for (unsigned j = 0; j < 16; ++j) { const unsigned c = xb_ld(&bar[XB_XCNT(j)]); sum += c; cnt += (c > 0u) ? 1u : 0u; mine = (j == x) ? c : mine; }
        if (sum == G) break;
        __builtin_amdgcn_s_sleep(1);
        if ((++sp & 255u) == 0u) { if (xb_ld(&bar[XB_TMO])) break; if (sp > XB_SPIN_CAP) { atomicAdd(&bar[XB_TMO], 1u); break; } }
    }
    nloc = mine > 0u ? mine : 1u; nx = cnt > 0u ? cnt : 1u;
}

__device__ __forceinline__ void xcd_barrier(const XcdBarrier& b) {
    asm volatile("s_waitcnt vmcnt(0)" ::: "memory");
    __syncthreads();
    if (threadIdx.x == 0) {
        unsigned* bar = b.bar;
        __builtin_amdgcn_s_waitcnt(0);
        unsigned nloc = b.st[0], nx = b.st[1];
        if (nloc == 0u) { xcd_barrier_complete(bar, b.x, nloc, nx); b.st[0] = nloc; b.st[1] = nx; }
        const unsigned old = xb_add(&bar[XB_XSUB(b.x)], 1u);
        const unsigned gen = old / nloc;
        if (old + 1u == (gen + 1u) * nloc) {
            __builtin_amdgcn_fence(__ATOMIC_RELEASE, "agent");
            asm volatile("s_waitcnt vmcnt(0)" ::: "memory");
            const unsigned og = xb_add(&bar[XB_TOP], 1u);
            const unsigned tg = og / nx;
            if (og + 1u == (tg + 1u) * nx) xb_add(&bar[XB_TOPGEN], 1u);
            else XB_SPIN(xb_ld(&bar[XB_TOPGEN]) == tg, bar);
            __builtin_amdgcn_fence(__ATOMIC_ACQUIRE, "agent");
            xb_add(&bar[XB_XGEN(b.x)], 1u);
            asm volatile("s_waitcnt vmcnt(0)" ::: "memory");
        } else {
            XB_SPIN(xb_ld(&bar[XB_XGEN(b.x)]) == gen, bar);
            __builtin_amdgcn_fence(__ATOMIC_ACQUIRE, "agent");
            asm volatile("s_waitcnt vmcnt(0)" ::: "memory");
        }
    }
    __syncthreads();
}

__global__ void __launch_bounds__(NTHREADS, 2) fwd_kernel(Params P) {
    extern __shared__ __attribute__((aligned(16))) unsigned char lds_raw[];
    cg::grid_group grid = cg::this_grid();
    const int tid_ = threadIdx.x;
    const Ctx CK{(LAS unsigned char*)lds_raw, P.ws, P, P.out, tid_, tid_ & 63, __builtin_amdgcn_readfirstlane(tid_ >> 6), (int)gridDim.x, (int)blockIdx.x, 0};
    volatile LAS unsigned* xb_st = (volatile LAS unsigned*)(CK.lds + 139264);
    if (tid_ < 2) xb_st[tid_] = 0u;
    __syncthreads();
    const XcdBarrier xbar = xcd_barrier_post((unsigned*)P.ws + 4096, xb_st);
#define GSYNC() xcd_barrier(xbar)
#ifdef PROBE
#define TS(k) do { if (tid_ == 0 && blockIdx.x == 0) ((volatile LAS unsigned long long*)(CK.lds + 131072))[k] = __builtin_amdgcn_s_memrealtime(); } while (0)
#else
#define TS(k) do { } while (0)
#endif
#define PH_BEGIN { const Ctx C = rectx(CK); LAS unsigned char* glds = C.lds;
#define PH_END }
#define ABUF WSP(bf16, WS_A)
#define HCB WSP(float, WS_HC)
#define MODL(ll) (WSP(float, WS_MOD) + (size_t)(ll) * 33 * 6144)
#define HIN_L ((l == 0) ? C.P.in[0 + C.z] : (const float*)C.out)
#define HIN_C ((l == 0) ? C.P.in[2 + C.z] : (const float*)HCB)
#define GEMM_STD(Aptr, Bptr, M_, N_, K_, EPI, ...) do { pg8::Gemm g{Aptr, Bptr, M_, N_, K_}; pg8::StaticOrder S; S.init(M_, N_, C.G, C.bid); EPI E{__VA_ARGS__}; pg8::gemm_phase<EPI, pg8::StaticOrder, true, true>(glds, g, S, E); } while (0)
    TS(40);
    prologue(CK);
    grid.sync(); TS(41);
    { const int l = 0; DBGCHK(0); }
    for (int l = 0; l < 2; ++l) {
        TS(l * 16 + 0);
        const int Mmix = (l == 0) ? NT : NLAT;
        if (l == 0) { PH_BEGIN rowop<false, true>(C, NT, HIN_L, HIN_C, nullptr, nullptr, nullptr, 0, nullptr, C.P.in[6 + C.z] + l * DM, 0, 1, MODL(l), MODL(l), ABUF); PH_END GSYNC(); TS(l * 16 + 1); DBGCHK(1); }
        PH_BEGIN
            GEMM_STD(ABUF, WL(bf16, l, WL_IN), NT, NIN, DM, EpiIn, WSP(bf16, WS_X + X_QKV), WSP(bf16, WS_X + X_ZT), WSP(bf16, WS_X + X_ZTC), WSP(bf16, WS_X + X_UR));
        PH_END
        GSYNC(); TS(l * 16 + 2); DBGCHK(2);
        feat1_phase(CK, l);
        GSYNC();
        PH_BEGIN GEMM_STD(WSP(bf16, WS_A), WSP(bf16, WS_WLORA + (size_t)l * 2 * MiB), NT, (l == 0 ? 1280 : NLO), KLO, EpiStore, WSP(bf16, WS_X + X_LO), NLO, 0, 0, 256); PH_END
        GSYNC();
        feat3_phase(CK, l);
        GSYNC(); TS(l * 16 + 3); DBGCHK(3);
        if (CK.bid < 256) scan_run(CK, l, CK.bid >> 3, (CK.bid >> 1) & 3, CK.bid & 1);
        __syncthreads(); TS(l * 16 + 15);
        {
            PH_BEGIN
                pg8::Gemm g{WSP(bf16, WS_DFT), WSP(bf16, WS_X + X_ZT), 2048, 8192, 4096}; pg8::StaticOrder S; S.init(2048, 8192, C.G, C.bid);
                EpiStore E{WSP(bf16, WS_A + (size_t)72 * MiB), 256, 0, 2048, 0};
                pg8::gemm_phase<EpiStore, pg8::StaticOrder, true, true>(glds, g, S, E);
            PH_END
            if (l == 0) { PH_BEGIN
                pg8::Gemm g{WSP(bf16, WS_DFTC), WSP(bf16, WS_X + X_ZTC), 256, 8192, 512}; pg8::StaticOrder S; S.init(256, 8192, C.G, C.bid);
                EpiStore E{WSP(bf16, WS_A + (size_t)72 * MiB), 256, CTXB, 256, 0};
                pg8::gemm_phase<EpiStore, pg8::StaticOrder, true, true>(glds, g, S, E);
            PH_END }
        }
        attn_loop(CK, l);
        GSYNC(); TS(l * 16 + 4); DBGCHK(4);
        readout_phase(CK, l, Mmix);
        GSYNC(); TS(l * 16 + 5);
        PH_BEGIN GEMM_STD(WSP(bf16, WS_A + (size_t)108 * MiB), WL(bf16, l, WL_BR), Mmix, 1024, 256, EpiStore, WSP(bf16, WS_X + X_PP), NGATE, 0, 0, 256); PH_END
        PH_BEGIN GEMM_STD(WSP(bf16, WS_A), WL(bf16, l, WL_BA), Mmix, 1024, 512, EpiStore, WSP(bf16, WS_X + X_PP) + 1024, NGATE, 0, 0, 256); PH_END
        PH_BEGIN GEMM_STD(WSP(bf16, WS_A + (size_t)72 * MiB), WL(bf16, l, WL_BF), Mmix, 1024, 256, EpiStore, WSP(bf16, WS_X + X_PP) + 2048, NGATE, 0, 0, 256); PH_END
        GSYNC(); TS(l * 16 + 6); DBGCHK(5);
        PH_BEGIN rowop<false, true>(C, Mmix, HIN_L, HIN_C, nullptr, nullptr, nullptr, 0, nullptr, C.P.in[6 + C.z] + l * DM, 0, 1, MODL(l), MODL(l), ABUF); PH_END
        GSYNC(); TS(l * 16 + 7);
        PH_BEGIN
            pg8::Gemm g{ABUF, WL(bf16, l, WL_G), Mmix, NGATE, DM}; GateOrder S{(Mmix / 256) * 4, C.G, C.bid};
            EpiGate E{WSP(bf16, WS_X + X_PP), WSP(bf16, WS_X + X_UR)};
            pg8::gemm_phase<EpiGate, GateOrder, true, true>(glds, g, S, E);
        PH_END
        GSYNC(); TS(l * 16 + 8); DBGCHK(6);
        PH_BEGIN GEMM_STD(WSP(bf16, WS_X + X_UR), WL(bf16, l, WL_O), Mmix, DM, DM, EpiStore, WSP(bf16, WS_X + X_MIX), DM, 0, 0, 256); PH_END
        GSYNC(); TS(l * 16 + 9); DBGCHK(7);
        PH_BEGIN rowop<true, true>(C, Mmix, HIN_L, HIN_C, C.out, HCB, WSP(bf16, WS_X + X_MIX), 2, C.P.in[7 + C.z] + l * DM, C.P.in[8 + C.z] + l * DM, 3, 4, MODL(l), MODL(l), ABUF); PH_END
        GSYNC(); TS(l * 16 + 10); DBGCHK(8);
        PH_BEGIN GEMM_STD(ABUF, WL(bf16, l, WL_UP), Mmix, 2 * DFF, DM, EpiUp, WSP(bf16, WS_X + X_HH), WSP(bf16, WS_X + X_HALO), C.P.in[31 + C.z] + (size_t)l * 3 * DFF, C.P.in[32 + C.z] + (size_t)l * DFF); PH_END
        GSYNC(); TS(l * 16 + 11);
        fixup_phase(CK, l, Mmix);
        GSYNC(); TS(l * 16 + 12); DBGCHK(9);
        PH_BEGIN GEMM_STD(WSP(bf16, WS_X + X_HH), WL(bf16, l, WL_DN), Mmix, DM, DFF, EpiStore, WSP(bf16, WS_X + X_FFO), DM, 0, 0, 256); PH_END
        GSYNC(); TS(l * 16 + 13); DBGCHK(10);
        if (l == 0) { PH_BEGIN rowop<true, true>(C, NT, C.out, HCB, C.out, HCB, WSP(bf16, WS_X + X_FFO), 5, C.P.in[9 + C.z] + l * DM, C.P.in[6 + C.z] + (l + 1) * DM, 0, 1, MODL(l), MODL(l + 1), ABUF); PH_END GSYNC(); TS(l * 16 + 14); }
        else { PH_BEGIN rowop<true, false>(C, NLAT, C.out, HCB, C.out, HCB, WSP(bf16, WS_X + X_FFO), 5, C.P.in[9 + C.z] + l * DM, nullptr, 0, 1, MODL(l), MODL(l), nullptr); PH_END }
    }
#ifdef DBG
    grid.sync(); dbg_report(CK);
#endif
#ifdef PROBE
    grid.sync(); TS(60);
    for (int i = 0; i < 20; ++i) GSYNC();
    TS(61);
    grid.sync();
    if (blockIdx.x == 0) {
        volatile LAS unsigned long long* ts = (volatile LAS unsigned long long*)(CK.lds + 131072);
#ifdef PROBE_PRO
        unsigned long long d = (ts[61] - ts[60]) * 5ull;
#else
        unsigned long long d = 0; for (int ll = 0; ll < 2; ++ll) d += ts[ll * 16 + PROBE_B] - ts[ll * 16 + PROBE_A];
#endif
        const int n = (int)(d / 500ull);
        for (int i = tid_; i < n; i += NTHREADS) P.out[1000000 + i] += 0.15f;
    }
#endif
}


extern "C" void kernel_launch(void* const* d_in, const int* in_sizes, int n_in, void* d_out, int out_size, void* d_ws, size_t ws_size, hipStream_t stream) {
    static int grid = 0;
    if (grid == 0) {
        if (n_in != 34 || out_size != NLAT * DM || ws_size < WS_TOTAL) { fprintf(stderr, "kernel_launch: unexpected shapes (n_in %d out %d ws %zu, need %zu)\n", n_in, out_size, ws_size, (size_t)WS_TOTAL); grid = -1; return; }
        int dev = 0, cus = 0, per_cu = 0;
        hipGetDevice(&dev); hipDeviceGetAttribute(&cus, hipDeviceAttributeMultiprocessorCount, dev);
        if (hipFuncSetAttribute((const void*)fwd_kernel, hipFuncAttributeMaxDynamicSharedMemorySize, LDS_BYTES) != hipSuccess) { fprintf(stderr, "kernel_launch: hipFuncSetAttribute failed\n"); grid = -1; return; }
        hipOccupancyMaxActiveBlocksPerMultiprocessor(&per_cu, (const void*)fwd_kernel, NTHREADS, LDS_BYTES);
        (void)hipGetLastError();
        if (per_cu < 1 || cus < 256) { fprintf(stderr, "kernel_launch: occupancy %d, cus %d\n", per_cu, cus); grid = -1; return; }
        grid = 256;
    }
    if (grid < 0) return;
    (void)hipMemsetAsync((char*)d_ws + WS_CTL, 0, 65536, stream);
    Params p{};
    for (int i = 0; i < 34; ++i) p.in[i] = (const float*)d_in[i];
    p.out = (float*)d_out; p.ws = (unsigned char*)d_ws;
    void* args[] = {&p};
    hipError_t e = hipLaunchCooperativeKernel((const void*)fwd_kernel, dim3(grid), dim3(NTHREADS), args, LDS_BYTES, stream);
    if (e != hipSuccess) fprintf(stderr, "kernel_launch: cooperative launch failed: %s (grid %d)\n", hipGetErrorString(e), grid);
}
```

```cpp
#define PROBE_A 3
#define PROBE_B 4
#include <hip/hip_runtime.h>
#include <hip/hip_cooperative_groups.h>
#include <cstdio>
#include <cstdint>
namespace cg = cooperative_groups;
__device__ __forceinline__ int otid() { int t = threadIdx.x; asm volatile("" : "+v"(t)); return t; }
namespace pg8 {
#define PG8_LAS __attribute__((address_space(3)))
typedef unsigned short bf16_t;
typedef short bf16x8 __attribute__((ext_vector_type(8)));
typedef float f32x4 __attribute__((ext_vector_type(4)));
typedef unsigned u32x4 __attribute__((ext_vector_type(4)));
constexpr int BM = 256, BK = 64, HALF = 128, HTB = HALF * BK * 2  , STAGE_BYTES = 8 * HTB, NXCD = 8, WGM = 8;

__host__ __device__ __forceinline__ int lds_byte(int r, int c) { const int st = (r >> 4) * 2 + (c >> 5), rr = r & 15, cc = c & 31, ob = rr * 64 + cc * 2; return st * 1024 + (ob ^ (((ob >> 9) & 1) << 5)); }
__host__ __device__ __forceinline__ void stage_rc(int b, int& R, int& C) { const int st = b / 1024, sb = b % 1024, swz = sb ^ (((sb >> 9) & 1) << 5); R = (st >> 1) * 16 + swz / 64; C = (st & 1) * 32 + (swz % 64) / 2; }
__host__ __device__ __forceinline__ int perm32(int rho) { const int n = rho >> 4, i = rho & 15; return 8 * (i >> 2) + 4 * n + (i & 3); }

struct Unit { int pm, pn; };
struct Gemm { const bf16_t* A; const bf16_t* Bt; int M, N, K; };

struct StaticOrder {
    int nM, nN, nwg, G, c;
    __host__ __device__ void init(int M, int N, int G_, int c_) { nM = M / BM; nN = N / BM; nwg = nM * nN; G = G_; c = c_; }
    __host__ __device__ bool next(int i, Unit& u) const {
        const long L = (long)i * G + c; if (L >= nwg) return false;
        int wgid = (int)L; { const int q = nwg / NXCD, r = nwg % NXCD, xcd = wgid % NXCD, off = wgid / NXCD; wgid = (xcd < r ? xcd * (q + 1) : r * (q + 1) + (xcd - r) * q) + off; }
        const int nig = WGM * nN, gid = wgid / nig, fm = gid * WGM, gsz = (nM - fm) < WGM ? (nM - fm) : WGM;
        u.pm = fm + ((wgid % nig) % gsz); u.pn = (wgid % nig) / gsz; return true;
    }
    __device__ __forceinline__ void a_ready(const Unit&) const {}
    __device__ __forceinline__ void done(const Unit&) const {}
};

__device__ __forceinline__ unsigned cvt_pk_bf16(float lo, float hi) { unsigned r; asm volatile("v_cvt_pk_bf16_f32 %0, %1, %2" : "=v"(r) : "v"(lo), "v"(hi)); return r; }
typedef float f32x2 __attribute__((ext_vector_type(2)));
__device__ __forceinline__ f32x2 gelu_pk(f32x2 v) {
    const f32x2 av = __builtin_elementwise_abs(v), d = av * 0.2316418882f + 1.0f;
    f32x2 t; t.x = __builtin_amdgcn_rcpf(d.x); t.y = __builtin_amdgcn_rcpf(d.y);
    f32x2 q = t * 0.5307027145f + (-0.7265760135f); q = q * t + 0.7107068705f; q = q * t + (-0.142248368f); q = q * t + 0.127414796f; q = q * t;
    const f32x2 s = (v * v) * (-0.72134752044f);
    f32x2 e; e.x = __builtin_amdgcn_exp2f(s.x); e.y = __builtin_amdgcn_exp2f(s.y);
    const f32x2 m = v * (q * e), r = v - m;
    f32x2 o; o.x = v.x < 0.f ? m.x : r.x; o.y = v.y < 0.f ? m.y : r.y; return o;
}

template <class Epi, class Sched, bool ALIGN_EPI = false, bool SP2 = false>
__device__ __forceinline__ void gemm_phase(PG8_LAS unsigned char* lds, const Gemm g, const Sched& S, const Epi& E) {
    const int tid = otid(), wid = __builtin_amdgcn_readfirstlane(tid >> 6), lane = tid & 63, wr = wid >> 2, wc = wid & 3, fr = lane & 15, fq = lane >> 4;
    const int K = g.K, nt = K / BK;
    unsigned voffA[2], voffB[2];
#pragma unroll
    for (int i = 0; i < 2; ++i) { int R, C; stage_rc(tid * 16 + i * 8192, R, C); const int Rb = Epi::PERM ? ((R & ~31) + perm32(R & 31)) : R;
        const int Ra = Epi::PERMA ? ((R & 64) + 4 * (R & 15) + ((R >> 4) & 3)) : R;
        voffA[i] = (unsigned)(Ra * K + C) * 2u; voffB[i] = (unsigned)(Rb * K + C) * 2u; }
    const size_t kstep = (size_t)(BK * 2);
    const size_t hstep = (size_t)HALF * K * 2;
    const size_t tstep = 2 * hstep;
    const unsigned ldsw = (unsigned)wid * 1024u;
    const int aoff = lds_byte(wr * 64 + fr, fq * 8), boff = lds_byte(wc * 32 + fr, fq * 8);
#define PG8_SA(b, h) (((b) * 2 + (h)) * HTB)
#define PG8_SB(b, h) ((4 + (b) * 2 + (h)) * HTB)
#define PG8_STAGE(bufoff, gbase, voff) do { _Pragma("unroll") for (int _i = 0; _i < 2; ++_i) \
        __builtin_amdgcn_global_load_lds((const unsigned*)((const char*)(gbase) + (voff)[_i]), (PG8_LAS unsigned*)(lds + (bufoff) + ldsw + _i * 8192), 16, 0, 0); } while (0)
#define PG8_LDA(dst, b, h) do { _Pragma("unroll") for (int m = 0; m < 4; ++m) _Pragma("unroll") for (int k = 0; k < 2; ++k) dst[m][k] = *(const PG8_LAS bf16x8*)(lds + PG8_SA(b, h) + aoff + m * 2048 + k * 1024); } while (0)
#define PG8_LDB(dst, b, h) do { _Pragma("unroll") for (int n = 0; n < 2; ++n) _Pragma("unroll") for (int k = 0; k < 2; ++k) dst[n][k] = *(const PG8_LAS bf16x8*)(lds + PG8_SB(b, h) + boff + n * 2048 + k * 1024); } while (0)
#define PG8_MMA(ai, bj, At, Bt) do { __builtin_amdgcn_s_setprio(1); _Pragma("unroll") for (int m = 0; m < 4; ++m) _Pragma("unroll") for (int n = 0; n < 2; ++n) _Pragma("unroll") for (int k = 0; k < 2; ++k) \
        acc[ai][bj][m][n] = __builtin_amdgcn_mfma_f32_16x16x32_bf16(Bt[n][k], At[m][k], acc[ai][bj][m][n], 0, 0, 0); __builtin_amdgcn_s_setprio(0); } while (0)
#define PG8_WAIT_V(n) asm volatile("s_waitcnt vmcnt(" #n ")" ::: "memory")
#define PG8_WAIT_L(n) asm volatile("s_waitcnt lgkmcnt(" #n ")" ::: "memory")
#define PG8_BAR __builtin_amdgcn_s_barrier()
#define PG8_SCHED __builtin_amdgcn_sched_barrier(0)
    Unit cur, nxt; int ui = 0;
    if (!S.next(0, cur)) return;
    f32x4 acc[2][2][4][2];
#pragma unroll
    for (int a = 0; a < 2; ++a)
#pragma unroll
        for (int b = 0; b < 2; ++b)
#pragma unroll
            for (int m = 0; m < 4; ++m)
#pragma unroll
                for (int n = 0; n < 2; ++n) acc[a][b][m][n] = (f32x4){0.f, 0.f, 0.f, 0.f};
    bf16x8 At[4][2], B0[2][2], B1[2][2];
    const char* cA = (const char*)g.A + (size_t)cur.pm * tstep; const char* cB = (const char*)g.Bt + (size_t)cur.pn * tstep;
    S.a_ready(cur);
    if constexpr (SP2) {
        PG8_STAGE(PG8_SB(0, 0), cB, voffB); PG8_STAGE(PG8_SB(0, 1), cB + hstep, voffB); PG8_STAGE(PG8_SA(0, 0), cA, voffA); PG8_STAGE(PG8_SA(0, 1), cA + hstep, voffA);
        if (wr == 1) PG8_BAR;
        PG8_WAIT_V(2); PG8_BAR;
        PG8_STAGE(PG8_SB(1, 0), cB + kstep, voffB); PG8_STAGE(PG8_SA(1, 0), cA + kstep, voffA); PG8_STAGE(PG8_SB(1, 1), cB + hstep + kstep, voffB);
        PG8_WAIT_V(6); PG8_BAR;
    } else {
        PG8_STAGE(PG8_SB(0, 0), cB, voffB); PG8_STAGE(PG8_SA(0, 0), cA, voffA); PG8_STAGE(PG8_SB(0, 1), cB + hstep, voffB); PG8_STAGE(PG8_SA(0, 1), cA + hstep, voffA);
        if (wr == 1) PG8_BAR;
        PG8_WAIT_V(4); PG8_BAR;
        PG8_STAGE(PG8_SB(1, 0), cB + kstep, voffB); PG8_STAGE(PG8_SA(1, 0), cA + kstep, voffA); PG8_STAGE(PG8_SB(1, 1), cB + hstep + kstep, voffB);
        PG8_WAIT_V(6); PG8_BAR;
    }
    for (;;) {
        const bool has_next = S.next(ui + 1, nxt);
        const char* nA = has_next ? (const char*)g.A + (size_t)nxt.pm * tstep : cA; const char* nB = has_next ? (const char*)g.Bt + (size_t)nxt.pn * tstep : cB;
        for (int t = 0; t < nt; t += 2) {
            const bool last = (t == nt - 2);
            const char* a1 = cA + (size_t)(t + 1) * kstep;
            const char* a2 = last ? nA : cA + (size_t)(t + 2) * kstep; const char* b2 = last ? nB : cB + (size_t)(t + 2) * kstep;
            const char* a3 = a2 + kstep; const char* b3 = b2 + kstep;
            if (last && has_next) S.a_ready(nxt);
            if constexpr (SP2) {
            PG8_LDB(B0, 0, 0); PG8_LDB(B1, 0, 1); PG8_SCHED; PG8_LDA(At, 0, 0); PG8_STAGE(PG8_SA(1, 1), a1 + hstep, voffA);
            PG8_WAIT_V(8); PG8_WAIT_L(0); PG8_BAR; PG8_MMA(0, 0, At, B0); PG8_MMA(0, 1, At, B1); PG8_BAR; PG8_SCHED;
            PG8_LDA(At, 0, 1); PG8_STAGE(PG8_SB(0, 0), b2, voffB); PG8_STAGE(PG8_SB(0, 1), b2 + hstep, voffB); PG8_STAGE(PG8_SA(0, 0), a2, voffA);
            PG8_WAIT_V(8); PG8_WAIT_L(0); PG8_BAR; PG8_MMA(1, 0, At, B0); PG8_MMA(1, 1, At, B1); PG8_BAR; PG8_SCHED;
            PG8_LDB(B0, 1, 0); PG8_LDB(B1, 1, 1); PG8_SCHED; PG8_LDA(At, 1, 0); PG8_STAGE(PG8_SA(0, 1), a2 + hstep, voffA);
            PG8_WAIT_V(8); PG8_WAIT_L(0); PG8_BAR; PG8_MMA(0, 0, At, B0); PG8_MMA(0, 1, At, B1); PG8_BAR; PG8_SCHED;
            PG8_LDA(At, 1, 1); PG8_STAGE(PG8_SB(1, 0), b3, voffB); PG8_STAGE(PG8_SB(1, 1), b3 + hstep, voffB); PG8_STAGE(PG8_SA(1, 0), a3, voffA);
            PG8_WAIT_V(8); PG8_WAIT_L(0); PG8_BAR; PG8_MMA(1, 0, At, B0); PG8_MMA(1, 1, At, B1); PG8_BAR; PG8_SCHED;
            } else {
            PG8_LDB(B0, 0, 0); PG8_SCHED; PG8_LDA(At, 0, 0); PG8_STAGE(PG8_SA(1, 1), a1 + hstep, voffA);
            PG8_WAIT_L(8); PG8_BAR; PG8_WAIT_L(0); PG8_MMA(0, 0, At, B0); PG8_BAR; PG8_SCHED;
            PG8_LDB(B1, 0, 1); PG8_STAGE(PG8_SB(0, 0), b2, voffB);
            PG8_BAR; PG8_WAIT_L(0); PG8_MMA(0, 1, At, B1); PG8_BAR;
            PG8_LDA(At, 0, 1); PG8_STAGE(PG8_SA(0, 0), a2, voffA);
            PG8_BAR; PG8_WAIT_L(0); PG8_MMA(1, 0, At, B0); PG8_BAR; PG8_SCHED;
            PG8_STAGE(PG8_SB(0, 1), b2 + hstep, voffB);
            PG8_WAIT_V(6); PG8_BAR; PG8_MMA(1, 1, At, B1); PG8_BAR;
            PG8_LDB(B0, 1, 0); PG8_SCHED; PG8_LDA(At, 1, 0); PG8_STAGE(PG8_SA(0, 1), a2 + hstep, voffA);
            PG8_WAIT_L(8); PG8_BAR; PG8_WAIT_L(0); PG8_MMA(0, 0, At, B0); PG8_BAR; PG8_SCHED;
            PG8_LDB(B1, 1, 1); PG8_STAGE(PG8_SB(1, 0), b3, voffB);
            PG8_BAR; PG8_WAIT_L(0); PG8_MMA(0, 1, At, B1); PG8_BAR;
            PG8_LDA(At, 1, 1); PG8_STAGE(PG8_SA(1, 0), a3, voffA);
            PG8_BAR; PG8_WAIT_L(0); PG8_MMA(1, 0, At, B0); PG8_BAR; PG8_SCHED;
            PG8_STAGE(PG8_SB(1, 1), b3 + hstep, voffB);
            PG8_WAIT_V(6); PG8_BAR; PG8_MMA(1, 1, At, B1); PG8_BAR;
            }
        }
        if constexpr (ALIGN_EPI) { if (wr == 0) PG8_BAR; }
        if constexpr (!Epi::AFTER_DRAIN) { E(acc, cur, wr, wc, fr, fq); S.done(cur); }
        if (!has_next) break;
#pragma unroll
        for (int a = 0; a < 2; ++a)
#pragma unroll
            for (int b = 0; b < 2; ++b)
#pragma unroll
                for (int m = 0; m < 4; ++m)
#pragma unroll
                    for (int n = 0; n < 2; ++n) acc[a][b][m][n] = (f32x4){0.f, 0.f, 0.f, 0.f};
        cur = nxt; cA = nA; cB = nB; ++ui;
        if constexpr (ALIGN_EPI) { if (wr == 1) PG8_BAR; }
    }
    PG8_WAIT_V(0);
    if constexpr (!ALIGN_EPI) { if (wr == 0) PG8_BAR; }
    PG8_BAR;
    if constexpr (Epi::AFTER_DRAIN) { E.fused(acc, cur, wr, wc, fr, fq, lds, wid, lane); S.done(cur); }
#undef PG8_SA
#undef PG8_SB
#undef PG8_STAGE
#undef PG8_LDA
#undef PG8_LDB
#undef PG8_MMA
#undef PG8_WAIT_V
#undef PG8_WAIT_L
#undef PG8_BAR
#undef PG8_SCHED
}
}

#define DI __device__ __forceinline__
#define LAS __attribute__((address_space(3)))
typedef unsigned short bf16;
typedef float f32x4 __attribute__((ext_vector_type(4)));
typedef float f32x2 __attribute__((ext_vector_type(2)));
typedef float f32x16 __attribute__((ext_vector_type(16)));
typedef short bf16x8 __attribute__((ext_vector_type(8)));
typedef short s16x4 __attribute__((ext_vector_type(4)));
typedef unsigned u32x4 __attribute__((ext_vector_type(4)));
typedef unsigned u32x2 __attribute__((ext_vector_type(2)));
typedef __bf16 bf16x2_t __attribute__((ext_vector_type(2)));

constexpr int DM = 1024, NB = 32, TL = 2048, TC = 256, NLAT = NB * TL, NCTX = NB * TC, NT = NLAT + NCTX, CTXB = NLAT;
constexpr int DFF = 2816, RW = 1152, NIN = 2560, NGATE = 3072;
constexpr int IN_COLS = 5248;
constexpr float LOG2E = 1.4426950408889634f;
constexpr int NTHREADS = 512, NWAVES = 8;
constexpr int LDS_BYTES = 147456;

constexpr size_t MiB = 1u << 20;
constexpr size_t WS_CTL = 0;
constexpr size_t WS_MOD = 1 * MiB;
constexpr size_t WS_SMALL = 3 * MiB;
constexpr size_t WS_BON = 4 * MiB;
constexpr size_t WS_W = 6 * MiB;
constexpr size_t WL_IN = 0, WL_G = 5 * MiB, WL_BR = 11 * MiB, WL_BA = 11 * MiB + 512 * 1024, WL_BF = 12 * MiB + 512 * 1024, WL_O = 13 * MiB, WL_UP = 15 * MiB, WL_DN = 26 * MiB, WL_SIZE = 32 * MiB;
constexpr size_t WS_DFT = WS_W + 2 * WL_SIZE;
constexpr size_t WS_DFTC = WS_DFT + 16 * MiB;
constexpr size_t WS_HC = WS_DFTC + 1 * MiB;
constexpr size_t WS_A = WS_HC + 32 * MiB;
constexpr size_t WS_VF = WS_A + 144 * MiB;
constexpr size_t WS_X = WS_VF + 36 * MiB;
constexpr size_t X_F = 0;
constexpr size_t X_QKV = 288 * MiB;
constexpr size_t X_ZT = 396 * MiB;
constexpr size_t X_ZTC = 460 * MiB;
constexpr size_t X_UR = 504 * MiB;
constexpr size_t X_G = 468 * MiB;
constexpr size_t X_LO = 504 * MiB;
constexpr size_t X_END = 720 * MiB;
constexpr size_t WS_WLORA = WS_X + X_END;
constexpr int KLO = 640, NLO = 1536;
constexpr size_t X_PP = 0;
constexpr size_t X_MIX = 0;
constexpr size_t X_HH = 0;
constexpr size_t X_HALO = 396 * MiB;
constexpr size_t X_FFO = 436 * MiB;
constexpr size_t WS_TOTAL = WS_WLORA + 4 * MiB;
constexpr size_t FSZ = (size_t)NT * 256;

struct Params { const float* in[34]; float* out; unsigned char* ws; };

DI float bf2f(bf16 v) { return __builtin_bit_cast(float, (unsigned)v << 16); }
DI float lo2f(unsigned u) { return __builtin_bit_cast(float, u << 16); }
DI float hi2f(unsigned u) { return __builtin_bit_cast(float, u & 0xffff0000u); }
DI unsigned pk(float lo, float hi) { f32x2 v = {lo, hi}; bf16x2_t b = __builtin_convertvector(v, bf16x2_t); return __builtin_bit_cast(unsigned, b); }
DI bf16 f2bf(float x) { return (bf16)(pk(x, 0.f) & 0xffffu); }
DI float fexp2(float x) { return __builtin_amdgcn_exp2f(x); }
DI float frcp(float x) { return __builtin_amdgcn_rcpf(x); }
DI float sigm(float x) { return frcp(1.f + fexp2(-x * LOG2E)); }
DI f32x2 sigm2(f32x2 x) { const f32x2 t = x * (-LOG2E); f32x2 e; e.x = fexp2(t.x); e.y = fexp2(t.y); const f32x2 d = e + 1.f; f32x2 r; r.x = frcp(d.x); r.y = frcp(d.y); return r; }
DI float tanh_(float x) { return 2.f * sigm(2.f * x) - 1.f; }
DI float gelu_tanh(float z) { const float u = 1.5957691216057308f * (z + 0.044715f * z * z * z); return z * sigm(u); }
DI float wave_sum(float v) {
#pragma unroll
    for (int o = 1; o < 64; o <<= 1) v += __shfl_xor(v, o);
    return v;
}
template <int CTRL, bool BC> DI float dppf(float old, float src) {
    return __builtin_bit_cast(float, __builtin_amdgcn_update_dpp(__builtin_bit_cast(int, old), __builtin_bit_cast(int, src), CTRL, 0xf, 0xf, BC));
}
DI float row16_sum(float x) { x += dppf<0x128, true>(0.f, x); x += dppf<0x124, true>(0.f, x); x += dppf<0x122, true>(0.f, x); x += dppf<0x121, true>(0.f, x); return x; }
DI f32x4 bf4(u32x2 u) { return (f32x4){lo2f(u.x), hi2f(u.x), lo2f(u.y), hi2f(u.y)}; }
DI u32x2 pk4(f32x4 v) { u32x2 o; o.x = pk(v[0], v[1]); o.y = pk(v[2], v[3]); return o; }
DI float allred4(float x) {
    unsigned u = __builtin_bit_cast(unsigned, x);
    auto r = __builtin_amdgcn_permlane16_swap(u, u, false, false);
    float y = __builtin_bit_cast(float, (unsigned)r[0]) + __builtin_bit_cast(float, (unsigned)r[1]);
    unsigned v = __builtin_bit_cast(unsigned, y);
    auto s = __builtin_amdgcn_permlane32_swap(v, v, false, false);
    return __builtin_bit_cast(float, (unsigned)s[0]) + __builtin_bit_cast(float, (unsigned)s[1]);
}

DI u32x4 pack8(const f32x4& a, const f32x4& b) { u32x4 w; w.x = pk(a[0], a[1]); w.y = pk(a[2], a[3]); w.z = pk(b[0], b[1]); w.w = pk(b[2], b[3]); return w; }

struct EpiStore {
    static constexpr bool PERM = true, AFTER_DRAIN = false, PERMA = false;
    bf16* O; int ld; int row_base, row_pn, col_pn;
    DI void operator()(const f32x4 (&acc)[2][2][4][2], const pg8::Unit& u, int wr, int wc, int fr, int fq) const {
        const int row0 = row_base + u.pn * row_pn + u.pm * 256 + wr * 64 + fr, col0 = u.pn * col_pn + wc * 32 + 8 * fq;
#pragma unroll
        for (int ai = 0; ai < 2; ++ai)
#pragma unroll
            for (int m = 0; m < 4; ++m) { bf16* rowp = O + (size_t)(row0 + ai * 128 + m * 16) * ld + col0;
#pragma unroll
                for (int bj = 0; bj < 2; ++bj) *(u32x4*)(rowp + bj * 128) = pack8(acc[ai][bj][m][0], acc[ai][bj][m][1]); }
    }
};

struct EpiIn {
    static constexpr bool PERM = true, AFTER_DRAIN = false, PERMA = false;
    bf16 *QKV, *ZT, *ZTC, *UR;
    DI void operator()(const f32x4 (&acc)[2][2][4][2], const pg8::Unit& u, int wr, int wc, int fr, int fq) const {
        const int pn = u.pn, rl0 = wr * 64 + fr, cl = wc * 32 + 8 * fq;
        if (pn < 3) {
#pragma unroll
            for (int ai = 0; ai < 2; ++ai)
#pragma unroll
                for (int m = 0; m < 4; ++m) { bf16* rowp = QKV + (size_t)(u.pm * 256 + rl0 + ai * 128 + m * 16) * 768 + pn * 256 + cl;
#pragma unroll
                    for (int bj = 0; bj < 2; ++bj) *(u32x4*)(rowp + bj * 128) = pack8(acc[ai][bj][m][0], acc[ai][bj][m][1]); }
        } else if (pn < 5) {
            bf16* base; int stride;
            if (u.pm < 256) { const int b = u.pm >> 3, t0 = (u.pm & 7) * 256; base = ZT + (size_t)b * 256 * 4096 + (pn - 3) * 2048 + t0; stride = 4096; }
            else { const int b = u.pm - 256; base = ZTC + (size_t)b * 256 * 512 + (pn - 3) * 256; stride = 512; }
#pragma unroll
            for (int ai = 0; ai < 2; ++ai)
#pragma unroll
                for (int m = 0; m < 4; ++m) { const int rl = rl0 + ai * 128 + m * 16;
#pragma unroll
                    for (int bj = 0; bj < 2; ++bj)
#pragma unroll
                        for (int n = 0; n < 2; ++n)
#pragma unroll
                            for (int e = 0; e < 4; ++e) base[(size_t)(bj * 128 + cl + 4 * n + e) * stride + rl] = f2bf(acc[ai][bj][m][n][e]); }
        } else {
#pragma unroll
            for (int ai = 0; ai < 2; ++ai)
#pragma unroll
                for (int m = 0; m < 4; ++m) { bf16* rowp = UR + (size_t)(u.pm * 256 + rl0 + ai * 128 + m * 16) * RW + (pn - 5) * 256 + cl;
#pragma unroll
                    for (int bj = 0; bj < 2; ++bj) if ((pn - 5) * 256 + bj * 128 < RW) *(u32x4*)(rowp + bj * 128) = pack8(acc[ai][bj][m][0], acc[ai][bj][m][1]); }
        }
    }
};

struct EpiGate {
    static constexpr bool PERM = true, AFTER_DRAIN = false, PERMA = false;
    const bf16* PP; bf16* MG;
    DI void operator()(const f32x4 (&acc)[2][2][4][2], const pg8::Unit& u, int wr, int wc, int fr, int fq) const {
        const int br = u.pn >> 2, cn = u.pn & 3, row0 = u.pm * 256 + wr * 64 + fr, col0 = cn * 256 + wc * 32 + 8 * fq;
#pragma unroll
        for (int ai = 0; ai < 2; ++ai)
#pragma unroll
            for (int m = 0; m < 4; ++m) { const size_t row = (size_t)(row0 + ai * 128 + m * 16);
#pragma unroll
                for (int bj = 0; bj < 2; ++bj) {
                    const u32x4 pp = *(const u32x4*)(PP + row * NGATE + br * 1024 + col0 + bj * 128);
                    bf16* mp = MG + row * 1024 + col0 + bj * 128;
                    f32x4 a = acc[ai][bj][m][0], b = acc[ai][bj][m][1];
                    { const f32x2 s0 = sigm2((f32x2){a[0], a[1]}) * (f32x2){lo2f(pp.x), hi2f(pp.x)}, s1 = sigm2((f32x2){a[2], a[3]}) * (f32x2){lo2f(pp.y), hi2f(pp.y)}, s2 = sigm2((f32x2){b[0], b[1]}) * (f32x2){lo2f(pp.z), hi2f(pp.z)}, s3 = sigm2((f32x2){b[2], b[3]}) * (f32x2){lo2f(pp.w), hi2f(pp.w)};
                      a = (f32x4){s0.x, s0.y, s1.x, s1.y}; b = (f32x4){s2.x, s2.y, s3.x, s3.y}; }
                    if (br) { const u32x4 o = *(const u32x4*)mp;
                        a[0] += lo2f(o.x); a[1] += hi2f(o.x); a[2] += lo2f(o.y); a[3] += hi2f(o.y); b[0] += lo2f(o.z); b[1] += hi2f(o.z); b[2] += lo2f(o.w); b[3] += hi2f(o.w); }
                    *(u32x4*)mp = pack8(a, b); } }
    }
};

DI f32x2 gelu2(f32x2 z) {
    const f32x2 u = z * (z * z * 0.044715f + 1.f), t = u * (-1.5957691216057308f * LOG2E);
    f32x2 e; e.x = fexp2(t.x); e.y = fexp2(t.y);
    const f32x2 d = e + 1.f; f32x2 r; r.x = frcp(d.x); r.y = frcp(d.y);
    return z * r;
}
struct EpiUp {
    static constexpr bool PERM = true, AFTER_DRAIN = false, PERMA = true;
    bf16* HH; bf16* HALO; const float* cw; const float* cb;
    DI void operator()(const f32x4 (&acc)[2][2][4][2], const pg8::Unit& u, int wr, int wc, int fr, int fq) const {
        const int j0 = 128 * u.pn + 32 * wc + 8 * fq;
        f32x4 w0[2], w1[2], w2[2], bb[2];
#pragma unroll
        for (int n = 0; n < 2; ++n) { w0[n] = *(const f32x4*)(cw + j0 + 4 * n); w1[n] = *(const f32x4*)(cw + DFF + j0 + 4 * n); w2[n] = *(const f32x4*)(cw + 2 * DFF + j0 + 4 * n); bb[n] = *(const f32x4*)(cb + j0 + 4 * n); }
#pragma unroll
        for (int ai = 0; ai < 2; ++ai) {
            const int grp = u.pm * 4 + ai * 2 + wr;
            bf16* hb = HALO + (size_t)grp * 6 * DFF + j0;
            if (fr == 0) { *(u32x4*)(hb) = pack8(acc[ai][0][0][0], acc[ai][0][0][1]); *(u32x4*)(hb + DFF) = pack8(acc[ai][0][1][0], acc[ai][0][1][1]); *(u32x4*)(hb + 4 * DFF) = pack8(acc[ai][1][0][0], acc[ai][1][0][1]); }
            if (fr == 15) { *(u32x4*)(hb + 2 * DFF) = pack8(acc[ai][0][2][0], acc[ai][0][2][1]); *(u32x4*)(hb + 3 * DFF) = pack8(acc[ai][0][3][0], acc[ai][0][3][1]); *(u32x4*)(hb + 5 * DFF) = pack8(acc[ai][1][3][0], acc[ai][1][3][1]); }
            f32x4 o[4][2];
#pragma unroll
            for (int n = 0; n < 2; ++n)
#pragma unroll
                for (int ep = 0; ep < 2; ++ep) {
                    f32x2 x[4];
#pragma unroll
                    for (int m = 0; m < 4; ++m) x[m] = (f32x2){acc[ai][0][m][n][2 * ep], acc[ai][0][m][n][2 * ep + 1]};
                    f32x2 pv, nx;
                    pv.x = dppf<0x111, true>(0.f, x[3].x); pv.y = dppf<0x111, true>(0.f, x[3].y);
                    nx.x = dppf<0x101, true>(0.f, x[0].x); nx.y = dppf<0x101, true>(0.f, x[0].y);
                    const f32x2 c0 = {w0[n][2 * ep], w0[n][2 * ep + 1]}, c1 = {w1[n][2 * ep], w1[n][2 * ep + 1]}, c2 = {w2[n][2 * ep], w2[n][2 * ep + 1]}, cb2 = {bb[n][2 * ep], bb[n][2 * ep + 1]};
#pragma unroll
                    for (int m = 0; m < 4; ++m) {
                        const f32x2 prev = m ? x[m ? m - 1 : 0] : pv, next = (m < 3) ? x[m < 3 ? m + 1 : 3] : nx;
                        const f32x2 z = c0 * prev + c1 * x[m] + c2 * next + cb2;
                        const f32x2 zv = {acc[ai][1][m][n][2 * ep], acc[ai][1][m][n][2 * ep + 1]};
                        const f32x2 g = gelu2(z) * zv;
                        o[m][n][2 * ep] = g.x; o[m][n][2 * ep + 1] = g.y;
                    }
                }
#pragma unroll
            for (int m = 0; m < 4; ++m) {
                const bool edge = (m == 0 && fr == 0) || (m == 3 && fr == 15);
                if (!edge) *(u32x4*)(HH + (size_t)(u.pm * 256 + ai * 128 + wr * 64 + 4 * fr + m) * DFF + j0) = pack8(o[m][0], o[m][1]);
            }
        }
    }
};

struct GateOrder {
    int nU, G, c;
    DI bool next(int i, pg8::Unit& u) const { const int j = i / 3, br = i - 3 * j; const long L = (long)j * G + c; if (L >= nU) return false; u.pm = (int)(L >> 2); u.pn = br * 4 + (int)(L & 3); return true; }
    DI void a_ready(const pg8::Unit&) const {}
    DI void done(const pg8::Unit&) const {}
};

struct Ctx {
    LAS unsigned char* lds; unsigned char* ws; const Params& P; float* out;
    int tid, lane, wave, G, bid, z;
};
DI Ctx rectx(const Ctx& C0) { const int t = otid(); int z = 0; asm volatile("" : "+s"(z)); return Ctx{C0.lds, C0.P.ws + z, C0.P, C0.P.out + z, t, t & 63, __builtin_amdgcn_readfirstlane(t >> 6), C0.G, C0.bid, z}; }
#define WSP(T, off) ((T*)(C.ws + (off)))
#define WL(T, l, off) ((T*)(C.ws + WS_W + (size_t)(l) * WL_SIZE + (off)))

DI void tr_item(const float* src, int ldw, int k0, int n0, bf16* dst, int ldd, int drow0, LAS float* scr, int lane) {
#pragma unroll 8
    for (int i = 0; i < 32; ++i) { const int kk = 2 * i + (lane >> 5); scr[kk * 33 + (lane & 31)] = src[(size_t)(k0 + kk) * ldw + n0 + (lane & 31)]; }
    asm volatile("s_waitcnt lgkmcnt(0)" ::: "memory");
    const int c = lane & 7;
#pragma unroll
    for (int j = 0; j < 4; ++j) { const int n = (lane >> 3) + 8 * j; const LAS float* s = scr + (8 * c) * 33 + n;
        u32x4 o; o.x = pk(s[0 * 33], s[1 * 33]); o.y = pk(s[2 * 33], s[3 * 33]); o.z = pk(s[4 * 33], s[5 * 33]); o.w = pk(s[6 * 33], s[7 * 33]);
        *(u32x4*)(dst + (size_t)(drow0 + n) * ldd + k0 + 8 * c) = o; }
    asm volatile("s_waitcnt lgkmcnt(0)" ::: "memory");
}
DI void tr_matrix(const Ctx& C, int gw, int NGW, const float* src, int ldw, int K, int n_src0, int ncols, bf16* dst, int drow0, LAS float* scr) {
    const int nb = ncols / 32, nit = (K / 64) * nb;
    for (int it = gw; it < nit; it += NGW) { const int kb = it / nb, b = it % nb; tr_item(src, ldw, kb * 64, n_src0 + b * 32, dst, K, drow0 + b * 32, scr, C.lane); }
}

DI void weights_tr(const Ctx& C, int l, int gw, int NGW, LAS float* scr) {
    const float* win = C.P.in[10 + C.z] + (size_t)l * 1024 * IN_COLS;
    bf16* wi = WL(bf16, l, WL_IN);
    tr_matrix(C, gw, NGW, win, IN_COLS, 1024, 1152, 512, wi, 0, scr);
    tr_matrix(C, gw, NGW, win, IN_COLS, 1024, 1664, 128, wi, 512, scr);
    tr_matrix(C, gw, NGW, win, IN_COLS, 1024, 1792, 128, wi, 640, scr);
    tr_matrix(C, gw, NGW, win, IN_COLS, 1024, 0, 1152, wi, 1280, scr);
    tr_matrix(C, gw, NGW, win, IN_COLS, 1024, 2176, 3072, WL(bf16, l, WL_G), 0, scr);
    tr_matrix(C, gw, NGW, C.P.in[26 + C.z] + (size_t)l * 256 * 1024, 1024, 256, 0, 1024, WL(bf16, l, WL_BR), 0, scr);
    tr_matrix(C, gw, NGW, C.P.in[27 + C.z] + (size_t)l * 512 * 1024, 1024, 512, 0, 1024, WL(bf16, l, WL_BA), 0, scr);
    tr_matrix(C, gw, NGW, C.P.in[28 + C.z] + (size_t)l * 256 * 1024, 1024, 256, 0, 1024, WL(bf16, l, WL_BF), 0, scr);
    tr_matrix(C, gw, NGW, C.P.in[29 + C.z] + (size_t)l * 1024 * 1024, 1024, 1024, 0, 1024, WL(bf16, l, WL_O), 0, scr);
    {
        const float* up = C.P.in[30 + C.z] + (size_t)l * 1024 * 2 * DFF; bf16* wu = WL(bf16, l, WL_UP);
        for (int it = gw; it < 16 * 44 * 4; it += NGW) { const int kb = it / 176, r = it % 176, seg = r >> 2, b = r & 3, pn = seg >> 1, bj = seg & 1;
            tr_item(up, 2 * DFF, kb * 64, bj * DFF + pn * 128 + b * 32, wu, 1024, pn * 256 + bj * 128 + b * 32, scr, C.lane); }
    }
    tr_matrix(C, gw, NGW, C.P.in[33 + C.z] + (size_t)l * DFF * 1024, 1024, DFF, 0, 1024, WL(bf16, l, WL_DN), 0, scr);
}
DI void prologue(const Ctx& C0) {
    const Ctx C = rectx(C0);
    LAS float* scr = (LAS float*)(C.lds + 49152 + C.wave * 8704);
    const int gth = C.bid * NTHREADS + C.tid, NGT = C.G * NTHREADS;
    for (int tsk = C.bid; tsk < 72; tsk += C.G) {
        const int l = tsk / 36, rem = tsk % 36, cb = rem / 3, rg = rem % 3;
        LAS float* s = (LAS float*)C.lds;
        for (int i = C.tid; i < 11 * 1024; i += NTHREADS) { const int r = rg * 11 + i / 1024, k = i % 1024; const float cv = (r < 32) ? C.P.in[1 + C.z][r * 1024 + k] : C.P.in[3 + C.z][k]; s[i] = cv * sigm(cv); }
        __syncthreads();
        const int j = cb * 512 + C.tid;
        float acc[11];
        const float bj = C.P.in[5 + C.z][l * 6144 + j];
#pragma unroll
        for (int i = 0; i < 11; ++i) acc[i] = bj;
        const float* wp = C.P.in[4 + C.z] + (size_t)l * 1024 * 6144 + j;
        for (int k = 0; k < 1024; k += 4) {
            const float w0 = wp[(size_t)k * 6144], w1 = wp[(size_t)(k + 1) * 6144], w2 = wp[(size_t)(k + 2) * 6144], w3 = wp[(size_t)(k + 3) * 6144];
#pragma unroll
            for (int i = 0; i < 11; ++i) { const f32x4 x = *(const LAS f32x4*)(s + i * 1024 + k); acc[i] += x[0] * w0 + x[1] * w1 + x[2] * w2 + x[3] * w3; }
        }
#pragma unroll
        for (int i = 0; i < 11; ++i) WSP(float, WS_MOD)[(size_t)(l * 33 + rg * 11 + i) * 6144 + j] = acc[i];
        __syncthreads();
    }
    if (C.bid == C.G - 1) for (int i = C.tid; i < 1024; i += NTHREADS) { const int p = i >> 4, f = i & 15; const float inv = powf(10000.f, -(float)f / 16.f), ang = (float)p * inv; WSP(float, WS_SMALL)[2 * i] = cosf(ang); WSP(float, WS_SMALL)[2 * i + 1] = sinf(ang); }
    for (int i = gth; i < 2048 * 4096 / 2; i += NGT) {
        const int tp = i / 2048, kk = (i % 2048) * 2; float v[2];
#pragma unroll
        for (int e = 0; e < 2; ++e) { const int k = kk + e, t = k & 2047; const int ph = (tp * t) & 2047; const float x = (float)ph * (1.f / 1024.f); v[e] = ((k < 2048) ? cospif(x) : -sinpif(x)) * 0.0027621358640099513f; }
        WSP(unsigned, WS_DFT)[i] = pk(v[0], v[1]);
    }
    for (int i = gth; i < 256 * 512 / 2; i += NGT) {
        const int tp = i / 256, kk = (i % 256) * 2; float v[2];
#pragma unroll
        for (int e = 0; e < 2; ++e) { const int k = kk + e, t = k & 255; const int ph = (tp * t) & 255; const float x = (float)ph * (1.f / 128.f); v[e] = ((k < 256) ? cospif(x) : -sinpif(x)) * 0.0078125f; }
        WSP(unsigned, WS_DFTC)[i] = pk(v[0], v[1]);
    }
    weights_tr(C, 0, C.bid * NWAVES + C.wave, C.G * NWAVES, scr);
    for (int l = 0; l < 2; ++l) {
        const float* win = C.P.in[10 + C.z] + (size_t)l * 1024 * IN_COLS;
        bf16* wi = WL(bf16, l, WL_IN);
        for (int i = gth; i < 128 * 1024 / 2; i += NGT) ((unsigned*)(wi + (size_t)2432 * 1024))[i] = 0u;
        {
            LAS float* tab = (LAS float*)(C.lds + 120 * 1024);
            __syncthreads();
            if (C.tid < 64) { const float x = (float)C.tid * (1.f / 32.f); tab[C.tid] = cospif(x); tab[64 + C.tid] = sinpif(x); }
            __syncthreads();
            for (int i = gth; i < 512 * 1024; i += NGT) {
                const int k = i & 1023, np = i >> 10, sn = np >> 8, g = (np >> 6) & 3, cp = np & 63;
                const float* wr_ = win + (size_t)k * IN_COLS + 1920 + g * 64; const LAS float* tb = tab + sn * 64; float a = 0.f;
#pragma unroll 8
                for (int c = 0; c < 64; ++c) a += wr_[c] * tb[(c * cp) & 63];
                wi[(size_t)(768 + np) * 1024 + k] = f2bf(a);
            }
        }
        {
            bf16* wl = WSP(bf16, WS_WLORA + (size_t)l * 2 * MiB);
            const float* w2 = C.P.in[13 + C.z] + (size_t)l * 2 * 64 * 256; const float* a2 = C.P.in[15 + C.z] + (size_t)l * 2 * 64 * 256; const float* g2 = C.P.in[16 + C.z] + (size_t)l * 128 * 256;
            const int kl = (l == 0) ? 384 : KLO;
            for (int i = gth; i < NLO * kl; i += NGT) {
                const int c = i & 255, nb = (i >> 8) % 6, k = i / (256 * 6); float v = 0.f;
                if (nb == 0) { if (k < 64) v = w2[k * 256 + c]; }
                else if (nb == 1) { if (k >= 64 && k < 128) v = w2[(64 + k - 64) * 256 + c]; }
                else if (nb == 2) { if (k >= 128 && k < 192) v = a2[(k - 128) * 256 + c]; }
                else if (nb == 3) { if (k >= 192 && k < 256) v = a2[(64 + k - 192) * 256 + c]; }
                else if (nb == 4) { if (k >= 256 && k < 384) v = g2[(k - 256) * 256 + c]; }
                else if (l == 1 && k >= 384) { const float* v1 = C.P.in[23 + C.z] + (k - 384) * 32; const float* v2 = C.P.in[24 + C.z] + c; for (int j = 0; j < 32; ++j) v += v1[j] * v2[j * 256]; }
                wl[(size_t)(nb * 256 + c) * kl + k] = f2bf(v);
            }
        }
    }
}

template <bool HAS_ADD, bool HAS_OUT>
DI void rowop(const Ctx& C0, int nrows, const float* hin_l, const float* hin_c, float* hout_l, float* hout_c, const bf16* add, int ga, const float* g_add, const float* g_out, int sh, int sc, const float* modl, const float* modo, bf16* Aout) {
    const Ctx C = rectx(C0);
    const int rpw = (nrows + C.G * NWAVES - 1) / (C.G * NWAVES), r0 = (C.bid * NWAVES + C.wave) * rpw, r1 = (r0 + rpw < nrows) ? r0 + rpw : nrows;
    if (r0 >= r1) return;
    const int c0 = 4 * C.lane;
    f32x4 gA[4], gO[4], mG[4], mS[4], mB[4];
#pragma unroll
    for (int j = 0; j < 4; ++j) { if (HAS_ADD) gA[j] = *(const f32x4*)(g_add + c0 + 256 * j); if (HAS_OUT) gO[j] = *(const f32x4*)(g_out + c0 + 256 * j); }
    int bcur = -1;
    f32x4 hn[4]; u32x2 an[4];
#define ROW_HP(t) (((t) < NLAT) ? hin_l + (size_t)(t) * DM : hin_c + (size_t)((t) - NLAT) * DM)
    { const float* hp = ROW_HP(r0);
#pragma unroll
      for (int j = 0; j < 4; ++j) { hn[j] = *(const f32x4*)(hp + c0 + 256 * j); if (HAS_ADD) an[j] = *(const u32x2*)(add + (size_t)r0 * DM + c0 + 256 * j); } }
    for (int tok = r0; tok < r1; ++tok) {
        f32x4 h[4]; u32x2 ar[4];
#pragma unroll
        for (int j = 0; j < 4; ++j) { h[j] = hn[j]; if (HAS_ADD) ar[j] = an[j]; }
        if (tok + 1 < r1) { const float* hp = ROW_HP(tok + 1);
#pragma unroll
            for (int j = 0; j < 4; ++j) { hn[j] = *(const f32x4*)(hp + c0 + 256 * j); if (HAS_ADD) an[j] = *(const u32x2*)(add + (size_t)(tok + 1) * DM + c0 + 256 * j); } }
        const bool lat = tok < NLAT; const int b = lat ? tok / TL : 32;
        if (b != bcur) { bcur = b; const float* mp = modl + (size_t)b * 6144; const float* mq = modo + (size_t)b * 6144;
#pragma unroll
            for (int j = 0; j < 4; ++j) { if (HAS_ADD) mG[j] = *(const f32x4*)(mp + ga * 1024 + c0 + 256 * j); if (HAS_OUT) { mS[j] = *(const f32x4*)(mq + sc * 1024 + c0 + 256 * j) + 1.f; mB[j] = *(const f32x4*)(mq + sh * 1024 + c0 + 256 * j); } } }
        if (HAS_ADD) {
            f32x4 a[4]; float ss = 0.f;
#pragma unroll
            for (int j = 0; j < 4; ++j) { a[j] = (f32x4){lo2f(ar[j].x), hi2f(ar[j].x), lo2f(ar[j].y), hi2f(ar[j].y)}; ss += a[j][0] * a[j][0] + a[j][1] * a[j][1] + a[j][2] * a[j][2] + a[j][3] * a[j][3]; }
            const float rstd = rsqrtf(wave_sum(ss) * (1.f / DM) + 1e-6f);
            float* op = lat ? hout_l + (size_t)tok * DM : hout_c + (size_t)(tok - NLAT) * DM;
#pragma unroll
            for (int j = 0; j < 4; ++j) { h[j] = h[j] + mG[j] * (a[j] * rstd * gA[j]); *(f32x4*)(op + c0 + 256 * j) = h[j]; }
        }
        if (HAS_OUT) {
            float ss = 0.f;
#pragma unroll
            for (int j = 0; j < 4; ++j) ss += h[j][0] * h[j][0] + h[j][1] * h[j][1] + h[j][2] * h[j][2] + h[j][3] * h[j][3];
            const float rstd = rsqrtf(wave_sum(ss) * (1.f / DM) + 1e-6f);
#pragma unroll
            for (int j = 0; j < 4; ++j) { const f32x4 y = (h[j] * rstd * gO[j]) * mS[j] + mB[j]; u32x2 o; o.x = pk(y[0], y[1]); o.y = pk(y[2], y[3]);
                *(u32x2*)(Aout + (size_t)tok * DM + c0 + 256 * j) = o; }
        }
    }
#undef ROW_HP
}

DI void feat1_phase(const Ctx& C0, int l) {
    const Ctx C = rectx(C0);
    const bf16* UR = WSP(bf16, WS_X + X_UR); bf16* F = WSP(bf16, WS_X + X_F); bf16* X2 = WSP(bf16, WS_A);
    const float* mu = C.P.in[11 + C.z] + (size_t)l * 2 * RW;
    const int gth = C.bid * NTHREADS + C.tid, NGT = C.G * NTHREADS, kl = (l == 0) ? 384 : KLO;
    for (int idx = gth; idx < NT * 144; idx += NGT) {
        const int tok = idx / 144, pc = idx - tok * 144, cc = pc * 8;
        const int t = (tok < NLAT) ? (tok & (TL - 1)) : ((tok - NLAT) & (TC - 1)), T = (tok < NLAT) ? TL : TC;
        const bf16* up_ = UR + (size_t)tok * RW + cc;
        const u32x4 u = *(const u32x4*)up_;
        u32x4 p = {0u, 0u, 0u, 0u}, nx = {0u, 0u, 0u, 0u};
        if (t > 0) p = *(const u32x4*)(up_ - RW);
        if (t < T - 1) nx = *(const u32x4*)(up_ + RW);
        const f32x4 m0a = *(const f32x4*)(mu + cc), m0b = *(const f32x4*)(mu + cc + 4), m1a = *(const f32x4*)(mu + RW + cc), m1b = *(const f32x4*)(mu + RW + cc + 4);
        float s[8];
#pragma unroll
        for (int e = 0; e < 8; ++e) { const float uu = (e & 1) ? hi2f(u[e >> 1]) : lo2f(u[e >> 1]), pp = (e & 1) ? hi2f(p[e >> 1]) : lo2f(p[e >> 1]), nn = (e & 1) ? hi2f(nx[e >> 1]) : lo2f(nx[e >> 1]);
            const float m0 = (e < 4) ? m0a[e & 3] : m0b[e & 3], m1 = (e < 4) ? m1a[e & 3] : m1b[e & 3];
            s[e] = uu + m0 * (pp - uu) + m1 * (nn - uu); }
        if (cc >= 768 && cc < 896) {
#pragma unroll
            for (int e = 0; e < 8; ++e) s[e] = tanh_(s[e]); }
        else if (cc >= 1024) {
#pragma unroll
            for (int e = 0; e < 8; ++e) s[e] = sigm(s[e]); }
        u32x4 w; w.x = pk(s[0], s[1]); w.y = pk(s[2], s[3]); w.z = pk(s[4], s[5]); w.w = pk(s[6], s[7]);
        if (cc < 256) *(u32x4*)(F + (size_t)tok * 2048 + cc) = w;
        else if (cc < 512) *(u32x4*)(F + (size_t)tok * 2048 + 768 + cc - 256) = w;
        else if (cc < 768) { *(u32x4*)(F + (size_t)tok * 2048 + 512 + cc - 512) = w; if (l == 1) *(u32x4*)(X2 + (size_t)tok * kl + 384 + cc - 512) = w; }
        else *(u32x4*)(X2 + (size_t)tok * kl + cc - 768) = w;
    }
}
DI void feat3_phase(const Ctx& C0, int l) {
    const Ctx C = rectx(C0);
    bf16* F = WSP(bf16, WS_X + X_F); bf16* Gq = WSP(bf16, WS_X + X_G); bf16* VF = WSP(bf16, WS_VF); float* BON = WSP(float, WS_BON); const bf16* LO = WSP(bf16, WS_X + X_LO);
    const int c = (C.lane >> 4) * 64 + (C.lane & 15) * 4;
    const f32x4 kkw = *(const f32x4*)(C.P.in[17 + C.z] + l * 256 + c), kaw = *(const f32x4*)(C.P.in[18 + C.z] + l * 256 + c), rkw = *(const f32x4*)(C.P.in[19 + C.z] + l * 256 + c);
    const f32x4 w0f = *(const f32x4*)(C.P.in[12 + C.z] + l * 512 + c), w0b = *(const f32x4*)(C.P.in[12 + C.z] + l * 512 + 256 + c), a0f = *(const f32x4*)(C.P.in[14 + C.z] + l * 512 + c), a0b = *(const f32x4*)(C.P.in[14 + C.z] + l * 512 + 256 + c);
    const f32x4 v0c = *(const f32x4*)(C.P.in[22 + C.z] + c);
    const int rpw = NT / (256 * NWAVES), r0 = (C.bid * NWAVES + C.wave) * rpw;
    if (C.bid >= 256) return;
    u32x2 nR, nK, nV, nVF, nL[6];
#define F3_LOAD(t) do { const size_t o_ = (size_t)(t) * 256 + c; const bf16* f_ = F + (size_t)(t) * 2048 + c; nR = *(const u32x2*)(f_); nK = *(const u32x2*)(f_ + 768); nV = *(const u32x2*)(f_ + 512); if (l == 1) nVF = *(const u32x2*)(VF + o_); \
        _Pragma("unroll") for (int q = 0; q < 6; ++q) if (q < 5 || l == 1) nL[q] = *(const u32x2*)(LO + (size_t)(t) * NLO + q * 256 + c); } while (0)
    F3_LOAD(r0);
    for (int tok = r0; tok < r0 + rpw; ++tok) {
        const u32x2 cR = nR, cK = nK, cV = nV, cVF = nVF; u32x2 cL[6];
#pragma unroll
        for (int q = 0; q < 6; ++q) cL[q] = nL[q];
        if (tok + 1 < r0 + rpw) F3_LOAD(tok + 1);
        const size_t o = (size_t)tok * 256 + c;
        const f32x4 r = bf4(cR), k = bf4(cK); f32x4 v = bf4(cV);
        if (l == 1) { const f32x4 vf = bf4(cVF), z = v0c + bf4(cL[5]);
#pragma unroll
            for (int e = 0; e < 4; ++e) v[e] = v[e] + (vf[e] - v[e]) * sigm(z[e]);
            *(u32x2*)(F + (size_t)tok * 2048 + 512 + c) = pk4(v); }
        else *(u32x2*)(VF + o) = cV;
        const f32x4 kr = k * kkw;
        const float ss = row16_sum(kr[0] * kr[0] + kr[1] * kr[1] + kr[2] * kr[2] + kr[3] * kr[3]), rn = rsqrtf(fmaxf(ss, 1e-24f));
        const f32x4 lf = w0f + bf4(cL[0]), lb = w0b + bf4(cL[1]), xf = a0f + bf4(cL[2]), xb = a0b + bf4(cL[3]);
        f32x4 ef, eb, af, ab; float bp = 0.f;
#pragma unroll
        for (int e = 0; e < 4; ++e) { ef[e] = 0.6065306597126334f * sigm(lf[e]); eb[e] = 0.6065306597126334f * sigm(lb[e]); af[e] = sigm(xf[e]); ab[e] = sigm(xb[e]);
            bp += r[e] * k[e] * (1.f + (0.5f * (af[e] + ab[e]) - 1.f) * kaw[e]) * rkw[e]; }
        const float bon = row16_sum(bp);
        if ((C.lane & 15) == 0) BON[(size_t)tok * 4 + (C.lane >> 4)] = bon;
        { bf16* f_ = F + (size_t)tok * 2048 + c; *(u32x2*)(f_ + 256) = pk4(kr * rn); *(u32x2*)(f_ + 1024) = pk4(ef); *(u32x2*)(f_ + 1280) = pk4(eb); *(u32x2*)(f_ + 1536) = pk4(af); *(u32x2*)(f_ + 1792) = pk4(ab); }
        *(u32x2*)(Gq + o) = cL[4];
    }
#undef F3_LOAD
}

struct ScanOp { bf16 r, kk, k, e, a, v; };
DI int scan_tok(int n, int dir, int b) { n = n < 2303 ? n : 2303; if (n < 256) return CTXB + b * 256 + (dir ? 255 - n : n); const int t = n - 256; return b * TL + (dir ? TL - 1 - t : t); }
DI ScanOp scan_load(const bf16* Ft, int dir, unsigned ck, unsigned cv) {
    ScanOp o; o.r = Ft[ck]; o.kk = Ft[256 + ck]; o.k = Ft[768 + ck]; o.e = (Ft + (4 + dir) * 256)[ck]; o.a = (Ft + (6 + dir) * 256)[ck]; o.v = Ft[512 + cv]; return o;
}
#define DPPT " row_mask:0xf bank_mask:0xf\n\t"
#define SOPS(S) "+v"(S[0]), "+v"(S[1]), "+v"(S[2]), "+v"(S[3]), "+v"(S[4]), "+v"(S[5]), "+v"(S[6]), "+v"(S[7]), "+v"(S[8]), "+v"(S[9]), "+v"(S[10]), "+v"(S[11]), "+v"(S[12]), "+v"(S[13]), "+v"(S[14]), "+v"(S[15])
DI void scan_step(float (&S)[16], float& sa, const ScanOp& op, const ScanOp& nxt, float ka, bf16* yp, bool wr) {
    float r = bf2f(op.r), kk = bf2f(op.kk), k = bf2f(op.k), e = bf2f(op.e), a = bf2f(op.a), kkn = bf2f(nxt.kk); const float v = bf2f(op.v);
    float w = fexp2(-e * LOG2E), kd = k * (1.f + (a - 1.f) * ka), nbd = -(kk * a);
    asm volatile("s_nop 1" : "+v"(r), "+v"(w), "+v"(kd), "+v"(nbd), "+v"(kkn));
#define UPM(j) "v_mul_f32_dpp %" #j ", %16, %" #j " row_newbcast:" #j DPPT
#define UPA(j) "v_fmac_f32_dpp %" #j ", %17, %19 row_newbcast:" #j DPPT
#define UPB(j) "v_fmac_f32_dpp %" #j ", %18, %20 row_newbcast:" #j DPPT
#define ALL16(M) M(0) M(1) M(2) M(3) M(4) M(5) M(6) M(7) M(8) M(9) M(10) M(11) M(12) M(13) M(14) M(15)
    asm volatile(ALL16(UPM) ALL16(UPA) ALL16(UPB) : SOPS(S) : "v"(w), "v"(nbd), "v"(kd), "v"(sa), "v"(v));
#undef UPM
#undef UPA
#undef UPB
    float y0, y1, s0, s1;
    asm volatile(
        "v_mul_f32_dpp %0, %20, %4 row_newbcast:0" DPPT "v_mul_f32_dpp %2, %21, %4 row_newbcast:0" DPPT "v_mul_f32_dpp %1, %20, %5 row_newbcast:1" DPPT "v_mul_f32_dpp %3, %21, %5 row_newbcast:1" DPPT
        "v_fmac_f32_dpp %0, %20, %6 row_newbcast:2" DPPT "v_fmac_f32_dpp %2, %21, %6 row_newbcast:2" DPPT
        "v_fmac_f32_dpp %1, %20, %7 row_newbcast:3" DPPT "v_fmac_f32_dpp %3, %21, %7 row_newbcast:3" DPPT
        "v_fmac_f32_dpp %0, %20, %8 row_newbcast:4" DPPT "v_fmac_f32_dpp %2, %21, %8 row_newbcast:4" DPPT
        "v_fmac_f32_dpp %1, %20, %9 row_newbcast:5" DPPT "v_fmac_f32_dpp %3, %21, %9 row_newbcast:5" DPPT
        "v_fmac_f32_dpp %0, %20, %10 row_newbcast:6" DPPT "v_fmac_f32_dpp %2, %21, %10 row_newbcast:6" DPPT
        "v_fmac_f32_dpp %1, %20, %11 row_newbcast:7" DPPT "v_fmac_f32_dpp %3, %21, %11 row_newbcast:7" DPPT
        "v_fmac_f32_dpp %0, %20, %12 row_newbcast:8" DPPT "v_fmac_f32_dpp %2, %21, %12 row_newbcast:8" DPPT
        "v_fmac_f32_dpp %1, %20, %13 row_newbcast:9" DPPT "v_fmac_f32_dpp %3, %21, %13 row_newbcast:9" DPPT
        "v_fmac_f32_dpp %0, %20, %14 row_newbcast:10" DPPT "v_fmac_f32_dpp %2, %21, %14 row_newbcast:10" DPPT
        "v_fmac_f32_dpp %1, %20, %15 row_newbcast:11" DPPT "v_fmac_f32_dpp %3, %21, %15 row_newbcast:11" DPPT
        "v_fmac_f32_dpp %0, %20, %16 row_newbcast:12" DPPT "v_fmac_f32_dpp %2, %21, %16 row_newbcast:12" DPPT
        "v_fmac_f32_dpp %1, %20, %17 row_newbcast:13" DPPT "v_fmac_f32_dpp %3, %21, %17 row_newbcast:13" DPPT
        "v_fmac_f32_dpp %0, %20, %18 row_newbcast:14" DPPT "v_fmac_f32_dpp %2, %21, %18 row_newbcast:14" DPPT
        "v_fmac_f32_dpp %1, %20, %19 row_newbcast:15" DPPT "v_fmac_f32_dpp %3, %21, %19 row_newbcast:15" DPPT
        : "=&v"(y0), "=&v"(y1), "=&v"(s0), "=&v"(s1)
        : "v"(S[0]), "v"(S[1]), "v"(S[2]), "v"(S[3]), "v"(S[4]), "v"(S[5]), "v"(S[6]), "v"(S[7]), "v"(S[8]), "v"(S[9]), "v"(S[10]), "v"(S[11]), "v"(S[12]), "v"(S[13]), "v"(S[14]), "v"(S[15]), "v"(r), "v"(kkn));
    const float y = allred4(y0 + y1); sa = allred4(s0 + s1);
    if (wr) *yp = f2bf(y);
}
DI void scan_run(const Ctx& C0, int l, int b, int h, int dir) {
    const Ctx C = rectx(C0);
    if (C.wave >= 4) {
        if (l == 0) weights_tr(C, 1, C.bid * 4 + (C.wave - 4), C.G * 4, (LAS float*)(C.lds + 49152 + C.wave * 8704));
        return; }
    const int wv = C.wave & 3, q = C.lane >> 4, vi = C.lane & 15;
    const unsigned ck = h * 64 + C.lane, cv = h * 64 + 16 * wv + vi;
    const bf16* F = WSP(bf16, WS_X + X_F);
    bf16* YS = WSP(bf16, WS_X + X_UR) + (size_t)dir * FSZ;
    const float ka = C.P.in[18 + C.z][l * 256 + ck];
    float S[16];
#pragma unroll
    for (int j = 0; j < 16; ++j) S[j] = 0.f;
    const bool wr = (q == 0);
    size_t t0 = (size_t)scan_tok(0, dir, b) * 256, t1 = (size_t)scan_tok(1, dir, b) * 256, t2 = (size_t)scan_tok(2, dir, b) * 256, t3 = (size_t)scan_tok(3, dir, b) * 256;
    ScanOp o0 = scan_load(F + t0 * 8, dir, ck, cv), o1 = scan_load(F + t1 * 8, dir, ck, cv), o2 = scan_load(F + t2 * 8, dir, ck, cv), o3 = scan_load(F + t3 * 8, dir, ck, cv);
    float sa = 0.f;
    for (int n = 0; n < 2304; n += 4) {
        size_t tn;
        scan_step(S, sa, o0, o1, ka, &(YS + t0)[cv], wr); tn = (size_t)__builtin_amdgcn_readfirstlane(scan_tok(n + 4, dir, b)) * 256; o0 = scan_load(F + tn * 8, dir, ck, cv); t0 = tn;
        scan_step(S, sa, o1, o2, ka, &(YS + t1)[cv], wr); tn = (size_t)__builtin_amdgcn_readfirstlane(scan_tok(n + 5, dir, b)) * 256; o1 = scan_load(F + tn * 8, dir, ck, cv); t1 = tn;
        scan_step(S, sa, o2, o3, ka, &(YS + t2)[cv], wr); tn = (size_t)__builtin_amdgcn_readfirstlane(scan_tok(n + 6, dir, b)) * 256; o2 = scan_load(F + tn * 8, dir, ck, cv); t2 = tn;
        scan_step(S, sa, o3, o0, ka, &(YS + t3)[cv], wr); tn = (size_t)__builtin_amdgcn_readfirstlane(scan_tok(n + 7, dir, b)) * 256; o3 = scan_load(F + tn * 8, dir, ck, cv); t3 = tn;
    }
}

DI void readout_phase(const Ctx& C0, int l, int nrows) {
    const Ctx C = rectx(C0);
    const bf16* F = WSP(bf16, WS_X + X_F); const bf16* Gq = WSP(bf16, WS_X + X_G); const bf16* YS = WSP(bf16, WS_X + X_UR); const float* BON = WSP(float, WS_BON);
    bf16* YR = WSP(bf16, WS_A + (size_t)108 * MiB);
    const int c = (C.lane >> 4) * 64 + (C.lane & 15) * 4;
    const f32x4 lw = *(const f32x4*)(C.P.in[20 + C.z] + l * 256 + c), lb = *(const f32x4*)(C.P.in[21 + C.z] + l * 256 + c);
    const int rpw = (nrows + C.G * NWAVES - 1) / (C.G * NWAVES), r0 = (C.bid * NWAVES + C.wave) * rpw, r1 = (r0 + rpw < nrows) ? r0 + rpw : nrows;
    if (r0 >= r1) return;
    u32x2 nF, nB, nV, nG; float nBon;
#define RO_LOAD(t) do { const size_t o_ = (size_t)(t) * 256 + c; nF = *(const u32x2*)(YS + o_); nB = *(const u32x2*)(YS + FSZ + o_); nV = *(const u32x2*)(F + (size_t)(t) * 2048 + 512 + c); nG = *(const u32x2*)(Gq + o_); nBon = BON[(size_t)(t) * 4 + (C.lane >> 4)]; } while (0)
    RO_LOAD(r0);
    for (int tok = r0; tok < r1; ++tok) {
        const u32x2 cF = nF, cB = nB, cV = nV, cG = nG; const float bon = nBon;
        if (tok + 1 < r1) RO_LOAD(tok + 1);
        const f32x4 y = bf4(cF) + bf4(cB);
        const float mean = row16_sum(y[0] + y[1] + y[2] + y[3]) * (1.f / 64.f);
        const f32x4 d = y - mean;
        const float var = row16_sum(d[0] * d[0] + d[1] * d[1] + d[2] * d[2] + d[3] * d[3]) * (1.f / 64.f);
        const f32x4 yn = d * rsqrtf(var + 64e-5f) * lw + lb;
        *(u32x2*)(YR + (size_t)tok * 256 + c) = pk4((yn + bf4(cV) * bon) * bf4(cG));
    }
#undef RO_LOAD
}

DI void fixup_phase(const Ctx& C0, int l, int nrows) {
    const Ctx C = rectx(C0);
    const int gw = C.bid * NWAVES + C.wave, NGW = C.G * NWAVES, nitem = (nrows / 64) * 2;
    const bf16* HALO = WSP(bf16, WS_X + X_HALO); bf16* HH = WSP(bf16, WS_X + X_HH);
    const float* cw = C.P.in[31 + C.z] + (size_t)l * 3 * DFF; const float* cb = C.P.in[32 + C.z] + (size_t)l * DFF;
    for (int it = gw; it < nitem; it += NGW) {
        const int grp = it >> 1, last = it & 1, row = grp * 64 + (last ? 63 : 0);
        const int t = (row < NLAT) ? (row & (TL - 1)) : ((row - NLAT) & (TC - 1)), T = (row < NLAT) ? TL : TC;
        const bf16* hb = HALO + (size_t)grp * 6 * DFF;
        const bf16 *pp, *pc, *pn, *pv; bool zp = false, zn = false;
        if (!last) { pc = hb; pn = hb + DFF; pv = hb + 4 * DFF; zp = (t == 0); pp = zp ? hb : hb - 6 * DFF + 3 * DFF; }
        else { pp = hb + 2 * DFF; pc = hb + 3 * DFF; pv = hb + 5 * DFF; zn = (t == T - 1); pn = zn ? hb : hb + 6 * DFF; }
        for (int p = C.lane; p < DFF / 8; p += 64) { const int j = p * 8;
            const u32x4 a = *(const u32x4*)(pp + j), bq = *(const u32x4*)(pc + j), cq = *(const u32x4*)(pn + j), vq = *(const u32x4*)(pv + j);
            float o[8];
#pragma unroll
            for (int e = 0; e < 8; ++e) { const unsigned ua = a[e >> 1], ub = bq[e >> 1], uc = cq[e >> 1], uv = vq[e >> 1];
                const float xp = zp ? 0.f : ((e & 1) ? hi2f(ua) : lo2f(ua)), xc = (e & 1) ? hi2f(ub) : lo2f(ub), xn = zn ? 0.f : ((e & 1) ? hi2f(uc) : lo2f(uc)), xv = (e & 1) ? hi2f(uv) : lo2f(uv);
                const float z = cw[j + e] * xp + cw[DFF + j + e] * xc + cw[2 * DFF + j + e] * xn + cb[j + e]; o[e] = gelu_tanh(z) * xv; }
            u32x4 w; w.x = pk(o[0], o[1]); w.y = pk(o[2], o[3]); w.z = pk(o[4], o[5]); w.w = pk(o[6], o[7]);
            *(u32x4*)(HH + (size_t)row * DFF + j) = w; }
    }
}

DI int crow(int i, int hh) { return (i & 3) + 8 * (i >> 2) + 4 * hh; }
DI void attn_unit(const Ctx& C, int l, int b, int kh, int qblk, bool isctx) {
    LAS bf16* Ks = (LAS bf16*)C.lds; LAS bf16* Vt = Ks + 64 * 72;
    const bf16* QKV = WSP(bf16, WS_X + X_QKV); bf16* YA = WSP(bf16, WS_A); const float* RT = WSP(float, WS_SMALL);
    const int g = C.wave >> 1, qt = C.wave & 1, hq = kh * 4 + g, r = C.lane & 31, hh = C.lane >> 5;
    const int qi = qblk * 64 + qt * 32 + r;
    const size_t tq = isctx ? (size_t)(CTXB + b * TC + qi) : (size_t)(b * TL + qi);
    bf16x8 qf[4];
    {
        float qv[4][8]; const bf16* qp = QKV + tq * 768 + hq * 64 + 8 * hh;
#pragma unroll
        for (int ks = 0; ks < 4; ++ks) { const u32x4 u = *(const u32x4*)(qp + 16 * ks);
#pragma unroll
            for (int e = 0; e < 4; ++e) { qv[ks][2 * e] = lo2f(u[e]); qv[ks][2 * e + 1] = hi2f(u[e]); } }
        if (!isctx) { const int rid = qi >> 6, cid = qi & 63;
#pragma unroll
            for (int j = 0; j < 8; ++j) { const int f = 8 * hh + j;
                const float c0 = RT[(rid * 16 + f) * 2], s0 = RT[(rid * 16 + f) * 2 + 1], c1 = RT[(cid * 16 + f) * 2], s1 = RT[(cid * 16 + f) * 2 + 1];
                const float a1 = qv[0][j], a2 = qv[1][j], b1 = qv[2][j], b2 = qv[3][j];
                qv[0][j] = a1 * c0 - a2 * s0; qv[1][j] = a2 * c0 + a1 * s0; qv[2][j] = b1 * c1 - b2 * s1; qv[3][j] = b2 * c1 + b1 * s1; } }
        const float sc = 0.125f * LOG2E;
#pragma unroll
        for (int ks = 0; ks < 4; ++ks) { u32x4 w; w.x = pk(qv[ks][0] * sc, qv[ks][1] * sc); w.y = pk(qv[ks][2] * sc, qv[ks][3] * sc); w.z = pk(qv[ks][4] * sc, qv[ks][5] * sc); w.w = pk(qv[ks][6] * sc, qv[ks][7] * sc); qf[ks] = __builtin_bit_cast(bf16x8, w); }
    }
    float m_run = C.P.in[25 + C.z][l * 8 + hq] * LOG2E, l_run = hh == 0 ? 1.f : 0.f;
    f32x16 o0, o1;
#pragma unroll
    for (int i = 0; i < 16; ++i) { o0[i] = 0.f; o1[i] = 0.f; }
    const int nch = isctx ? 4 : 9, skey = C.tid >> 3, oct = C.tid & 7;
#define ATT_VALID(c_) ((c_) < 4 || (qblk * 64 - 128 + ((c_) - 4) * 64 >= 0 && qblk * 64 - 128 + ((c_) - 4) * 64 < TL))
#define ATT_LOAD(c_) do { const size_t kt_ = ((c_) < 4) ? (size_t)(CTXB + b * TC + (c_) * 64) : (size_t)(b * TL + qblk * 64 - 128 + ((c_) - 4) * 64); \
        const bf16* kp_ = QKV + (kt_ + skey) * 768 + 512 + kh * 64; pk_u = *(const u32x4*)(kp_ + 8 * oct); pk_p = *(const u32x4*)(kp_ + 8 * (oct ^ 2)); pk_v = *(const u32x4*)(kp_ + 128 + 8 * oct); } while (0)
    u32x4 pk_u, pk_p, pk_v;
    int ch = 0;
    ATT_LOAD(0);
    while (ch < nch) {
        const bool win = ch >= 4; const int kb = win ? qblk * 64 - 128 + (ch - 4) * 64 : 0;
        __syncthreads();
        {
            u32x4 ku = pk_u;
            if (win) { const u32x4 pu = pk_p;
                const int p = kb + skey, pos = (oct >> 2) ? (p & 63) : (p >> 6), fb = 8 * (oct & 1); const bool isx1 = (oct & 2) == 0;
                float o[8];
#pragma unroll
                for (int e = 0; e < 8; ++e) { const float own = (e & 1) ? hi2f(ku[e >> 1]) : lo2f(ku[e >> 1]), par = (e & 1) ? hi2f(pu[e >> 1]) : lo2f(pu[e >> 1]);
                    const float cc = RT[(pos * 16 + fb + e) * 2], ss = RT[(pos * 16 + fb + e) * 2 + 1];
                    o[e] = isx1 ? (own * cc - par * ss) : (own * cc + par * ss); }
                ku.x = pk(o[0], o[1]); ku.y = pk(o[2], o[3]); ku.z = pk(o[4], o[5]); ku.w = pk(o[6], o[7]); }
            *(LAS u32x4*)(Ks + skey * 72 + 8 * oct) = ku;
            const u32x4 vu = pk_v;
#pragma unroll
            for (int e = 0; e < 8; ++e) Vt[(8 * oct + e) * 72 + skey] = (bf16)((e & 1) ? (vu[e >> 1] >> 16) : (vu[e >> 1] & 0xffffu));
        }
        __syncthreads();
        int nxc = ch + 1;
        while (nxc < nch && !ATT_VALID(nxc)) ++nxc;
        if (nxc < nch) ATT_LOAD(nxc);
        f32x16 x0, x1;
#pragma unroll
        for (int i = 0; i < 16; ++i) { x0[i] = 0.f; x1[i] = 0.f; }
#pragma unroll
        for (int ks = 0; ks < 4; ++ks) {
            const bf16x8 a0 = *(const LAS bf16x8*)(Ks + r * 72 + 16 * ks + 8 * hh), a1 = *(const LAS bf16x8*)(Ks + (32 + r) * 72 + 16 * ks + 8 * hh);
            x0 = __builtin_amdgcn_mfma_f32_32x32x16_bf16(a0, qf[ks], x0, 0, 0, 0);
            x1 = __builtin_amdgcn_mfma_f32_32x32x16_bf16(a1, qf[ks], x1, 0, 0, 0);
        }
        if (win) {
#pragma unroll
            for (int i = 0; i < 16; ++i) { const int k0 = kb + crow(i, hh), d0 = qi - k0, d1 = d0 - 32;
                if (d0 > 128 || d0 < -128) x0[i] = -1e30f; if (d1 > 128 || d1 < -128) x1[i] = -1e30f; }
        }
        float mx = x0[0];
#pragma unroll
        for (int i = 0; i < 16; ++i) { mx = fmaxf(mx, x0[i]); mx = fmaxf(mx, x1[i]); }
        mx = fmaxf(mx, __shfl_xor(mx, 32));
        const float m_new = fmaxf(m_run, mx), alpha = fexp2(m_run - m_new);
        float ps = 0.f;
#pragma unroll
        for (int i = 0; i < 16; ++i) { x0[i] = fexp2(x0[i] - m_new); x1[i] = fexp2(x1[i] - m_new); ps += x0[i] + x1[i]; o0[i] *= alpha; o1[i] *= alpha; }
        l_run = l_run * alpha + ps; m_run = m_new;
#pragma unroll
        for (int kt = 0; kt < 2; ++kt)
#pragma unroll
            for (int s = 0; s < 2; ++s) {
                const f32x16& x = kt ? x1 : x0;
                u32x4 w; w.x = pk(x[8 * s], x[8 * s + 1]); w.y = pk(x[8 * s + 2], x[8 * s + 3]); w.z = pk(x[8 * s + 4], x[8 * s + 5]); w.w = pk(x[8 * s + 6], x[8 * s + 7]);
                const bf16x8 pb = __builtin_bit_cast(bf16x8, w);
                const int ko = kt * 32 + 16 * s + 4 * hh;
                const s16x4 l0 = *(const LAS s16x4*)(Vt + r * 72 + ko), h0 = *(const LAS s16x4*)(Vt + r * 72 + ko + 8);
                const s16x4 l1 = *(const LAS s16x4*)(Vt + (32 + r) * 72 + ko), h1 = *(const LAS s16x4*)(Vt + (32 + r) * 72 + ko + 8);
                o0 = __builtin_amdgcn_mfma_f32_32x32x16_bf16(__builtin_shufflevector(l0, h0, 0, 1, 2, 3, 4, 5, 6, 7), pb, o0, 0, 0, 0);
                o1 = __builtin_amdgcn_mfma_f32_32x32x16_bf16(__builtin_shufflevector(l1, h1, 0, 1, 2, 3, 4, 5, 6, 7), pb, o1, 0, 0, 0);
            }
        ch = nxc;
    }
#undef ATT_VALID
#undef ATT_LOAD
    const float inv = frcp(l_run + __shfl_xor(l_run, 32));
    bf16* op = YA + tq * 512 + hq * 64 + 4 * hh;
#pragma unroll
    for (int i4 = 0; i4 < 4; ++i4) {
        u32x2 w0, w1; w0.x = pk(o0[4 * i4] * inv, o0[4 * i4 + 1] * inv); w0.y = pk(o0[4 * i4 + 2] * inv, o0[4 * i4 + 3] * inv);
        w1.x = pk(o1[4 * i4] * inv, o1[4 * i4 + 1] * inv); w1.y = pk(o1[4 * i4 + 2] * inv, o1[4 * i4 + 3] * inv);
        *(u32x2*)(op + 8 * i4) = w0; *(u32x2*)(op + 32 + 8 * i4) = w1;
    }
}
DI void attn_loop(const Ctx& C0, int l) {
    const Ctx C = rectx(C0);
    unsigned* ctr = WSP(unsigned, WS_CTL) + 64 * (l + 1);
    volatile LAS unsigned* slot = (volatile LAS unsigned*)(C.lds + 32768);
    const unsigned NU = 2048u + (l == 0 ? 256u : 0u);
    for (;;) {
        __syncthreads();
        if (C.tid == 0) *slot = atomicAdd(ctr, 1u);
        __syncthreads();
        const unsigned u = *slot;
        if (u >= NU) break;
        if (u < 2048u) attn_unit(C, l, (int)(u >> 6), (int)((u >> 5) & 1), (int)(u & 31), false);
        else { const unsigned v = u - 2048u; attn_unit(C, l, (int)(v >> 3), (int)((v >> 2) & 1), (int)(v & 3), true); }
    }
}


#ifdef DBG
DI float exp_f(float x) { return fexp2(x * LOG2E); }
DI unsigned hsh(unsigned x) { x ^= x >> 16; x *= 0x7feb352du; x ^= x >> 15; x *= 0x846ca68bu; x ^= x >> 16; return x; }
DI void dbg_put(const Ctx& C, int k, float got, float ref, float S) {
    float err = fabsf(got - ref) / (fabsf(ref) + S); if (!(err == err)) err = 1e9f;
    atomicMax(WSP(unsigned, WS_CTL) + 1024 + k, __builtin_bit_cast(unsigned, err));
}
DI float ndot(const bf16* a, const bf16* b, int K) { float s = 0.f; for (int k = 0; k < K; ++k) s += bf2f(a[k]) * bf2f(b[k]); return s; }
DI void dbg_check(const Ctx& C0, int stage, int l) {
    if (C0.bid != 0 || l != 0) return;
    const Ctx C = rectx(C0);
    const unsigned h1 = hsh(C.tid * 3u + 17u + stage * 1000u), h2 = hsh(h1 + 0x9e3779b9u), h3 = hsh(h2 + 77u);
    const Params& P = C.P;
    if (stage == 0) {
        {
            const int n = h1 % 2432, k = h2 % 1024; int src = -1;
            if (n < 512) src = 1152 + n; else if (n < 640) src = 1664 + (n - 512); else if (n < 768) src = 1792 + (n - 640); else if (n >= 1280) src = n - 1280;
            if (src >= 0) dbg_put(C, 0, bf2f(WL(bf16, 0, WL_IN)[(size_t)n * 1024 + k]), bf2f(f2bf(P.in[10 + C.z][(size_t)k * IN_COLS + src])), 1e-6f);
            const int ng = h3 % 3072;
            dbg_put(C, 0, bf2f(WL(bf16, 0, WL_G)[(size_t)ng * 1024 + k]), bf2f(f2bf(P.in[10 + C.z][(size_t)k * IN_COLS + 2176 + ng])), 1e-6f);
            const int nu = h3 % 5632, pn = nu >> 8, bj = (nu >> 7) & 1, j = nu & 127;
            dbg_put(C, 0, bf2f(WL(bf16, 0, WL_UP)[(size_t)nu * 1024 + k]), bf2f(f2bf(P.in[30 + C.z][(size_t)k * 5632 + bj * DFF + pn * 128 + j])), 1e-6f);
            const int nd = h1 % 1024, kd = h3 % DFF;
            dbg_put(C, 0, bf2f(WL(bf16, 0, WL_DN)[(size_t)nd * DFF + kd]), bf2f(f2bf(P.in[33 + C.z][(size_t)kd * 1024 + nd])), 1e-6f);
            dbg_put(C, 0, bf2f(WL(bf16, 0, WL_O)[(size_t)nd * 1024 + k]), bf2f(f2bf(P.in[29 + C.z][(size_t)k * 1024 + nd])), 1e-6f);
            dbg_put(C, 0, bf2f(WL(bf16, 0, WL_BA)[(size_t)nd * 512 + (k & 511)]), bf2f(f2bf(P.in[27 + C.z][(size_t)(k & 511) * 1024 + nd])), 1e-6f);
            dbg_put(C, 0, bf2f(WL(bf16, 0, WL_BR)[(size_t)nd * 256 + (k & 255)]), bf2f(f2bf(P.in[26 + C.z][(size_t)(k & 255) * 1024 + nd])), 1e-6f);
        }
        {
            const int r = h1 % 33, j = h2 % 6144; float a = P.in[5 + C.z][j];
            for (int k = 0; k < 1024; ++k) { const float cv = (r < 32) ? P.in[1 + C.z][r * 1024 + k] : P.in[3 + C.z][k]; a += cv / (1.f + exp_f(-cv)) * P.in[4 + C.z][(size_t)k * 6144 + j]; }
            dbg_put(C, 1, WSP(float, WS_MOD)[(size_t)r * 6144 + j], a, 0.01f);
        }
    } else if (stage == 1) {
        const int tok = h1 % NT, col = h2 % 1024; const bool lat = tok < NLAT; const float* hp = lat ? P.in[0 + C.z] + (size_t)tok * DM : P.in[2 + C.z] + (size_t)(tok - NLAT) * DM;
        float ss = 0.f; for (int k = 0; k < 1024; ++k) ss += hp[k] * hp[k];
        const float* mp = WSP(float, WS_MOD) + (size_t)(lat ? tok / TL : 32) * 6144;
        const float ref = hp[col] * rsqrtf(ss / 1024.f + 1e-6f) * P.in[6 + C.z][col] * (1.f + mp[1024 + col]) + mp[col];
        dbg_put(C, 2, bf2f(WSP(bf16, WS_A)[(size_t)tok * DM + col]), ref, 0.05f);
    } else if (stage == 2) {
        const int tok = h1 % NT, n = h2 % 2432; const float ref = ndot(WSP(bf16, WS_A) + (size_t)tok * DM, WL(bf16, 0, WL_IN) + (size_t)n * 1024, 1024);
        float got; int k;
        if (n < 768) { got = bf2f(WSP(bf16, WS_X + X_QKV)[(size_t)tok * 768 + n]); k = 3; }
        else if (n < 1280) { const int sn = (n - 768) >> 8, ch = (n - 768) & 255; k = 4;
            if (tok < NLAT) got = bf2f(WSP(bf16, WS_X + X_ZT)[((size_t)(tok / TL) * 256 + ch) * 4096 + sn * 2048 + (tok % TL)]);
            else got = bf2f(WSP(bf16, WS_X + X_ZTC)[((size_t)((tok - NLAT) / TC) * 256 + ch) * 512 + sn * 256 + ((tok - NLAT) % TC)]); }
        else { got = bf2f(WSP(bf16, WS_X + X_UR)[(size_t)tok * RW + n - 1280]); k = 5; }
        dbg_put(C, k, got, ref, 0.1f);
    } else if (stage == 3) {
        const int b = h1 % 32, t = 1 + h2 % 2046, c = h3 % 256; const size_t tok = (size_t)b * TL + t; const bf16* UR = WSP(bf16, WS_X + X_UR);
        const float u = bf2f(UR[tok * RW + c]), up = bf2f(UR[(tok - 1) * RW + c]), un = bf2f(UR[(tok + 1) * RW + c]);
        dbg_put(C, 7, bf2f(WSP(bf16, WS_X + X_F)[tok * 2048 + c]), u + P.in[11 + C.z][c] * (up - u) + P.in[11 + C.z][RW + c] * (un - u), 0.05f);
        float ss = 0.f; for (int k = 0; k < 64; ++k) { const float x = bf2f(WSP(bf16, WS_X + X_F)[tok * 2048 + 256 + (c & 192) + k]); ss += x * x; }
        dbg_put(C, 7, ss, 1.f, 0.f);
    } else if (stage == 4) {
        {
            LAS float* S = (LAS float*)C.lds; LAS float* sa = S + 4096; const bf16* F = WSP(bf16, WS_X + X_F); const int b = 1, h = 2;
            for (int dir = 0; dir < 2; ++dir) {
                for (int e = C.tid; e < 4096; e += NTHREADS) S[e] = 0.f;
                __syncthreads();
                for (int n = 0; n < 24; ++n) {
                    const size_t oy = (size_t)scan_tok(n, dir, b) * 256 + h * 64, o = (size_t)scan_tok(n, dir, b) * 2048 + h * 64;
                    if (C.tid < 64) { float a = 0.f; for (int k = 0; k < 64; ++k) a -= S[C.tid * 64 + k] * bf2f(F[256 + o + k]); sa[C.tid] = a; }
                    __syncthreads();
                    for (int e = C.tid; e < 4096; e += NTHREADS) { const int v = e >> 6, k = e & 63;
                        const float kk = bf2f(F[256 + o + k]), kr = bf2f(F[768 + o + k]), ee = bf2f(F[(4 + dir) * 256 + o + k]), a = bf2f(F[(6 + dir) * 256 + o + k]), vv = bf2f(F[512 + o + v]);
                        S[e] = S[e] * exp_f(-ee) + sa[v] * (kk * a) + vv * (kr * (1.f + (a - 1.f) * P.in[18 + C.z][h * 64 + k])); }
                    __syncthreads();
                    if (C.tid < 64) { float y = 0.f; for (int k = 0; k < 64; ++k) y += S[C.tid * 64 + k] * bf2f(F[o + k]);
                        dbg_put(C, 8, bf2f(WSP(bf16, WS_X + X_UR)[(size_t)dir * FSZ + oy + C.tid]), y, 0.05f); }
                    __syncthreads();
                }
            }
        }
        {
            LAS float* qs = (LAS float*)C.lds + (size_t)C.tid * 65; const bf16* QKV = WSP(bf16, WS_X + X_QKV);
            const int b = h1 % 32, t = (C.tid & 1) ? (int)(h2 % 2048) : ((C.tid & 2) ? (int)(h2 % 200) : 2047 - (int)(h2 % 200)), hq = h3 % 8, dd = (h3 >> 8) % 64, kh = hq >> 2;
            const size_t tq = (size_t)b * TL + t;
            for (int d = 0; d < 64; ++d) { const int ax = d >> 5, hf = (d >> 4) & 1, f = d & 15; const int ps = ax ? (t & 63) : (t >> 6); const float cs = WSP(float, WS_SMALL)[(ps * 16 + f) * 2], sn = WSP(float, WS_SMALL)[(ps * 16 + f) * 2 + 1];
                const float x1 = bf2f(QKV[tq * 768 + hq * 64 + ax * 32 + f]), x2 = bf2f(QKV[tq * 768 + hq * 64 + ax * 32 + 16 + f]);
                qs[d] = hf ? (x2 * cs + x1 * sn) : (x1 * cs - x2 * sn); }
            float m = P.in[25 + C.z][hq], den = 1.f, acc = 0.f;
            for (int j = 0; j < 256 + 257; ++j) {
                const bool win = j >= 256; const int kp = win ? t - 128 + (j - 256) : j; if (win && (kp < 0 || kp >= TL)) continue;
                const size_t tk = win ? (size_t)b * TL + kp : (size_t)(CTXB + b * TC + kp); float s = 0.f;
                for (int d = 0; d < 64; ++d) { float kv;
                    if (!win) kv = bf2f(QKV[tk * 768 + 512 + kh * 64 + d]);
                    else { const int ax = d >> 5, hf = (d >> 4) & 1, f = d & 15; const int ps = ax ? (kp & 63) : (kp >> 6); const float cs = WSP(float, WS_SMALL)[(ps * 16 + f) * 2], sn = WSP(float, WS_SMALL)[(ps * 16 + f) * 2 + 1];
                        const float x1 = bf2f(QKV[tk * 768 + 512 + kh * 64 + ax * 32 + f]), x2 = bf2f(QKV[tk * 768 + 512 + kh * 64 + ax * 32 + 16 + f]);
                        kv = hf ? (x2 * cs + x1 * sn) : (x1 * cs - x2 * sn); }
                    s += qs[d] * kv; }
                s *= 0.125f; const float mn = fmaxf(m, s), al = exp_f(m - mn), p = exp_f(s - mn);
                den = den * al + p; acc = acc * al + p * bf2f(QKV[tk * 768 + 640 + kh * 64 + dd]); m = mn;
            }
            dbg_put(C, 9, bf2f(WSP(bf16, WS_A)[tq * 512 + hq * 64 + dd]), acc / den, 0.03f);
        }
        __syncthreads();
        {
            LAS float* qs = (LAS float*)C.lds + (size_t)C.tid * 65; const bf16* QKV = WSP(bf16, WS_X + X_QKV);
            const int b = h2 % 32, t = h1 % 256, hq = h3 % 8, dd = (h3 >> 8) % 64, kh = hq >> 2; const size_t tq = (size_t)(CTXB + b * TC + t);
            for (int d = 0; d < 64; ++d) qs[d] = bf2f(QKV[tq * 768 + hq * 64 + d]);
            float m = P.in[25 + C.z][hq], den = 1.f, acc = 0.f;
            for (int j = 0; j < 256; ++j) { const size_t tk = (size_t)(CTXB + b * TC + j); float s = 0.f;
                for (int d = 0; d < 64; ++d) s += qs[d] * bf2f(QKV[tk * 768 + 512 + kh * 64 + d]);
                s *= 0.125f; const float mn = fmaxf(m, s), al = exp_f(m - mn), p = exp_f(s - mn); den = den * al + p; acc = acc * al + p * bf2f(QKV[tk * 768 + 640 + kh * 64 + dd]); m = mn; }
            dbg_put(C, 10, bf2f(WSP(bf16, WS_A)[tq * 512 + hq * 64 + dd]), acc / den, 0.03f);
        }
        {
            const int b = h1 % 32, tp = h2 % 2048, ch = h3 % 256;
            dbg_put(C, 11, bf2f(WSP(bf16, WS_A + (size_t)72 * MiB)[((size_t)b * TL + tp) * 256 + ch]), ndot(WSP(bf16, WS_DFT) + (size_t)tp * 4096, WSP(bf16, WS_X + X_ZT) + ((size_t)b * 256 + ch) * 4096, 4096), 0.05f);
            const int tc = h2 % 256;
            dbg_put(C, 11, bf2f(WSP(bf16, WS_A + (size_t)72 * MiB)[((size_t)CTXB + b * TC + tc) * 256 + ch]), ndot(WSP(bf16, WS_DFTC) + (size_t)tc * 512, WSP(bf16, WS_X + X_ZTC) + ((size_t)b * 256 + ch) * 512, 512), 0.05f);
        }
    } else if (stage == 5) {
        const int tok = h1 % NT, col = h2 % 1024; const bf16* PP = WSP(bf16, WS_X + X_PP);
        dbg_put(C, 13, bf2f(PP[(size_t)tok * NGATE + col]), ndot(WSP(bf16, WS_A + (size_t)108 * MiB) + (size_t)tok * 256, WL(bf16, 0, WL_BR) + (size_t)col * 256, 256), 0.05f);
        dbg_put(C, 13, bf2f(PP[(size_t)tok * NGATE + 1024 + col]), ndot(WSP(bf16, WS_A) + (size_t)tok * 512, WL(bf16, 0, WL_BA) + (size_t)col * 512, 512), 0.05f);
        dbg_put(C, 13, bf2f(PP[(size_t)tok * NGATE + 2048 + col]), ndot(WSP(bf16, WS_A + (size_t)72 * MiB) + (size_t)tok * 256, WL(bf16, 0, WL_BF) + (size_t)col * 256, 256), 0.05f);
    } else if (stage == 6) {
        const int tok = h1 % NT, col = h2 % 1024; float ref = 0.f;
        for (int br = 0; br < 3; ++br) { const float gl = ndot(WSP(bf16, WS_A) + (size_t)tok * DM, WL(bf16, 0, WL_G) + (size_t)(br * 1024 + col) * 1024, 1024); ref += bf2f(WSP(bf16, WS_X + X_PP)[(size_t)tok * NGATE + br * 1024 + col]) / (1.f + exp_f(-gl)); }
        dbg_put(C, 14, bf2f(WSP(bf16, WS_X + X_UR)[(size_t)tok * DM + col]), ref, 0.05f);
    } else if (stage == 7) {
        const int tok = h1 % NT, col = h2 % 1024;
        dbg_put(C, 15, bf2f(WSP(bf16, WS_X + X_MIX)[(size_t)tok * DM + col]), ndot(WSP(bf16, WS_X + X_UR) + (size_t)tok * DM, WL(bf16, 0, WL_O) + (size_t)col * 1024, 1024), 0.05f);
    } else if (stage == 8) {
        const int tok = h1 % NT, col = h2 % 1024; const bool lat = tok < NLAT; const float* hp = lat ? P.in[0 + C.z] + (size_t)tok * DM : P.in[2 + C.z] + (size_t)(tok - NLAT) * DM;
        const bf16* mx = WSP(bf16, WS_X + X_MIX) + (size_t)tok * DM; const float* mp = WSP(float, WS_MOD) + (size_t)(lat ? tok / TL : 32) * 6144;
        float ss = 0.f; for (int k = 0; k < 1024; ++k) ss += bf2f(mx[k]) * bf2f(mx[k]);
        const float rs = rsqrtf(ss / 1024.f + 1e-6f); float s2 = 0.f, hc = 0.f;
        for (int k = 0; k < 1024; ++k) { const float hn = hp[k] + mp[2048 + k] * bf2f(mx[k]) * rs * P.in[7 + C.z][k]; s2 += hn * hn; if (k == col) hc = hn; }
        const float* ho = lat ? C.out + (size_t)tok * DM : WSP(float, WS_HC) + (size_t)(tok - NLAT) * DM;
        dbg_put(C, 16, ho[col], hc, 0.01f);
        dbg_put(C, 16, bf2f(WSP(bf16, WS_A)[(size_t)tok * DM + col]), hc * rsqrtf(s2 / 1024.f + 1e-6f) * P.in[8 + C.z][col] * (1.f + mp[4096 + col]) + mp[3072 + col], 0.05f);
    } else if (stage == 9) {
        int tok = h1 % NT; if (C.tid & 1) tok = (tok & ~63) + ((C.tid & 2) ? 63 : 0);
        const int j = h2 % DFF; const int t = (tok < NLAT) ? (tok % TL) : ((tok - NLAT) % TC), T = (tok < NLAT) ? TL : TC;
        const bf16* A = WSP(bf16, WS_A); const bf16* wu = WL(bf16, 0, WL_UP); const int pn = j >> 7, jj = j & 127;
        const bf16* wg = wu + (size_t)(pn * 256 + jj) * 1024; const bf16* wv = wu + (size_t)(pn * 256 + 128 + jj) * 1024;
        const float zc = ndot(A + (size_t)tok * DM, wg, 1024), zp = (t > 0) ? ndot(A + (size_t)(tok - 1) * DM, wg, 1024) : 0.f, zn = (t < T - 1) ? ndot(A + (size_t)(tok + 1) * DM, wg, 1024) : 0.f, zv = ndot(A + (size_t)tok * DM, wv, 1024);
        const float z = P.in[31 + C.z][j] * zp + P.in[31 + C.z][DFF + j] * zc + P.in[31 + C.z][2 * DFF + j] * zn + P.in[32 + C.z][j];
        const float ge = 0.5f * z * (1.f + tanh_(0.7978845608028654f * (z + 0.044715f * z * z * z)));
        dbg_put(C, 17, bf2f(WSP(bf16, WS_X + X_HH)[(size_t)tok * DFF + j]), ge * zv, 0.05f);
    } else if (stage == 10) {
        const int tok = h1 % NT, col = h2 % 1024;
        dbg_put(C, 18, bf2f(WSP(bf16, WS_X + X_FFO)[(size_t)tok * DM + col]), ndot(WSP(bf16, WS_X + X_HH) + (size_t)tok * DFF, WL(bf16, 0, WL_DN) + (size_t)col * DFF, DFF), 0.05f);
    }
}
DI void dbg_report(const Ctx& C) {
    if (C.bid == 0 && threadIdx.x == 0) {
        int first = -1; for (int k = 0; k < 24; ++k) if (first < 0 && __builtin_bit_cast(float, WSP(unsigned, WS_CTL)[1024 + k]) > 0.05f) first = k;
        if (first >= 0) C.out[12345] = 1000.f * (float)(first + 1);
    }
}
#define DBGCHK(stage) do { grid.sync(); dbg_check(CK, stage, l); grid.sync(); } while (0)
#else
#define DBGCHK(stage) do { } while (0)
#endif
#define XB_TMO      128
#define XB_XCNT(j)  (256  + 64 * (j))
#define XB_XSUB(j)  (1280 + 64 * (j))
#define XB_XGEN(j)  (2304 + 64 * (j))
#define XB_TOP      3328
#define XB_TOPGEN   3392
#define XCD_BAR_WORDS 3456
#define XB_SPIN_CAP (1u << 18)

__device__ __forceinline__ unsigned xb_ld(unsigned* p)              { return __hip_atomic_load(p, __ATOMIC_RELAXED, __HIP_MEMORY_SCOPE_AGENT); }
__device__ __forceinline__ unsigned xb_add(unsigned* p, unsigned v) { return __hip_atomic_fetch_add(p, v, __ATOMIC_RELAXED, __HIP_MEMORY_SCOPE_AGENT); }
__device__ __forceinline__ unsigned xb_xcc_id() { return (unsigned)__builtin_amdgcn_s_getreg((3 << 11) | 20) & 0xFu; }
#define XB_SPIN(cond, bar) do { unsigned _sp = 0; while (cond) { __builtin_amdgcn_s_sleep(1); \
    if ((++_sp & 255u) == 0u) { if (xb_ld(&(bar)[XB_TMO])) break; if (_sp > XB_SPIN_CAP) { atomicAdd(&(bar)[XB_TMO], 1u); break; } } } } while (0)

struct XcdBarrier {
    unsigned* bar; unsigned x;
    volatile LAS unsigned* st;
};

__device__ __forceinline__ XcdBarrier xcd_barrier_post(unsigned* bar, volatile LAS unsigned* st) {
    XcdBarrier b; b.bar = bar; b.x = xb_xcc_id(); b.st = st;
    if (threadIdx.x == 0) (void)xb_add(&bar[XB_XCNT(b.x)], 1u);
    return b;
}
__device__ __forceinline__ void xcd_barrier_complete(unsigned* bar, unsigned x, unsigned& nloc, unsigned& nx) {
    const unsigned G = gridDim.x * gridDim.y * gridDim.z;
    unsigned sum, cnt, mine, sp = 0u;
    for (;;) {
        sum = 0u; cnt = 0u; mine = 0u;
#pragma unroll
        for (unsigned j = 0; j < 16; ++j) { const unsigned c = xb_ld(&bar[XB_XCNT(j)]); sum += c; cnt += (c > 0u) ? 1u : 0u; mine = (j == x) ? c : mine; }
        if (sum == G) break;
        __builtin_amdgcn_s_sleep(1);
        if ((++sp & 255u) == 0u) { if (xb_ld(&bar[XB_TMO])) break; if (sp > XB_SPIN_CAP) { atomicAdd(&bar[XB_TMO], 1u); break; } }
    }
    nloc = mine > 0u ? mine : 1u; nx = cnt > 0u ? cnt : 1u;
}

__device__ __forceinline__ void xcd_barrier(const XcdBarrier& b) {
    asm volatile("s_waitcnt vmcnt(0)" ::: "memory");
    __syncthreads();
    if (threadIdx.x == 0) {
        unsigned* bar = b.bar;
        __builtin_amdgcn_s_waitcnt(0);
        unsigned nloc = b.st[0], nx = b.st[1];
        if (nloc == 0u) { xcd_barrier_complete(bar, b.x, nloc, nx); b.st[0] = nloc; b.st[1] = nx; }
        const unsigned old = xb_add(&bar[XB_XSUB(b.x)], 1u);
        const unsigned gen = old / nloc;
        if (old + 1u == (gen + 1u) * nloc) {
            __builtin_amdgcn_fence(__ATOMIC_RELEASE, "agent");
            asm volatile("s_waitcnt vmcnt(0)" ::: "memory");
            const unsigned og = xb_add(&bar[XB_TOP], 1u);
            const unsigned tg = og / nx;
            if (og + 1u == (tg + 1u) * nx) xb_add(&bar[XB_TOPGEN], 1u);
            else XB_SPIN(xb_ld(&bar[XB_TOPGEN]) == tg, bar);
            __builtin_amdgcn_fence(__ATOMIC_ACQUIRE, "agent");
            xb_add(&bar[XB_XGEN(b.x)], 1u);
            asm volatile("s_waitcnt vmcnt(0)" ::: "memory");
        } else {
            XB_SPIN(xb_ld(&bar[XB_XGEN(b.x)]) == gen, bar);
            __builtin_amdgcn_fence(__ATOMIC_ACQUIRE, "agent");
            asm volatile("s_waitcnt vmcnt(0)" ::: "memory");
        }
    }
    __syncthreads();
}

__global__ void __launch_bounds__(NTHREADS, 2) fwd_kernel(Params P) {
    extern __shared__ __attribute__((aligned(16))) unsigned char lds_raw[];
    cg::grid_group grid = cg::this_grid();
    const int tid_ = threadIdx.x;
    const Ctx CK{(LAS unsigned char*)lds_raw, P.ws, P, P.out, tid_, tid_ & 63, __builtin_amdgcn_readfirstlane(tid_ >> 6), (int)gridDim.x, (int)blockIdx.x, 0};
    volatile LAS unsigned* xb_st = (volatile LAS unsigned*)(CK.lds + 139264);
    if (tid_ < 2) xb_st[tid_] = 0u;
    __syncthreads();
    const XcdBarrier xbar = xcd_barrier_post((unsigned*)P.ws + 4096, xb_st);
#define GSYNC() xcd_barrier(xbar)
#ifdef PROBE
#define TS(k) do { if (tid_ == 0 && blockIdx.x == 0) ((volatile LAS unsigned long long*)(CK.lds + 131072))[k] = __builtin_amdgcn_s_memrealtime(); } while (0)
#else
#define TS(k) do { } while (0)
#endif
#define PH_BEGIN { const Ctx C = rectx(CK); LAS unsigned char* glds = C.lds;
#define PH_END }
#define ABUF WSP(bf16, WS_A)
#define HCB WSP(float, WS_HC)
#define MODL(ll) (WSP(float, WS_MOD) + (size_t)(ll) * 33 * 6144)
#define HIN_L ((l == 0) ? C.P.in[0 + C.z] : (const float*)C.out)
#define HIN_C ((l == 0) ? C.P.in[2 + C.z] : (const float*)HCB)
#define GEMM_STD(Aptr, Bptr, M_, N_, K_, EPI, ...) do { pg8::Gemm g{Aptr, Bptr, M_, N_, K_}; pg8::StaticOrder S; S.init(M_, N_, C.G, C.bid); EPI E{__VA_ARGS__}; pg8::gemm_phase<EPI, pg8::StaticOrder, true, true>(glds, g, S, E); } while (0)
    TS(40);
    prologue(CK);
    grid.sync(); TS(41);
    { const int l = 0; DBGCHK(0); }
    for (int l = 0; l < 2; ++l) {
        TS(l * 16 + 0);
        const int Mmix = (l == 0) ? NT : NLAT;
        if (l == 0) { PH_BEGIN rowop<false, true>(C, NT, HIN_L, HIN_C, nullptr, nullptr, nullptr, 0, nullptr, C.P.in[6 + C.z] + l * DM, 0, 1, MODL(l), MODL(l), ABUF); PH_END GSYNC(); TS(l * 16 + 1); DBGCHK(1); }
        PH_BEGIN
            GEMM_STD(ABUF, WL(bf16, l, WL_IN), NT, NIN, DM, EpiIn, WSP(bf16, WS_X + X_QKV), WSP(bf16, WS_X + X_ZT), WSP(bf16, WS_X + X_ZTC), WSP(bf16, WS_X + X_UR));
        PH_END
        GSYNC(); TS(l * 16 + 2); DBGCHK(2);
        feat1_phase(CK, l);
        GSYNC();
        PH_BEGIN GEMM_STD(WSP(bf16, WS_A), WSP(bf16, WS_WLORA + (size_t)l * 2 * MiB), NT, (l == 0 ? 1280 : NLO), (l == 0 ? 384 : KLO), EpiStore, WSP(bf16, WS_X + X_LO), NLO, 0, 0, 256); PH_END
        GSYNC();
        feat3_phase(CK, l);
        GSYNC(); TS(l * 16 + 3); DBGCHK(3);
        if (CK.bid < 256) scan_run(CK, l, CK.bid >> 3, (CK.bid >> 1) & 3, CK.bid & 1);
        __syncthreads(); TS(l * 16 + 15);
        {
            PH_BEGIN
                pg8::Gemm g{WSP(bf16, WS_DFT), WSP(bf16, WS_X + X_ZT), 2048, 8192, 4096}; pg8::StaticOrder S; S.init(2048, 8192, C.G, C.bid);
                EpiStore E{WSP(bf16, WS_A + (size_t)72 * MiB), 256, 0, 2048, 0};
                pg8::gemm_phase<EpiStore, pg8::StaticOrder, true, true>(glds, g, S, E);
            PH_END
            if (l == 0) { PH_BEGIN
                pg8::Gemm g{WSP(bf16, WS_DFTC), WSP(bf16, WS_X + X_ZTC), 256, 8192, 512}; pg8::StaticOrder S; S.init(256, 8192, C.G, C.bid);
                EpiStore E{WSP(bf16, WS_A + (size_t)72 * MiB), 256, CTXB, 256, 0};
                pg8::gemm_phase<EpiStore, pg8::StaticOrder, true, true>(glds, g, S, E);
            PH_END }
        }
        attn_loop(CK, l);
        GSYNC(); TS(l * 16 + 4); DBGCHK(4);
        readout_phase(CK, l, Mmix);
        GSYNC(); TS(l * 16 + 5);
        PH_BEGIN GEMM_STD(WSP(bf16, WS_A + (size_t)108 * MiB), WL(bf16, l, WL_BR), Mmix, 1024, 256, EpiStore, WSP(bf16, WS_X + X_PP), NGATE, 0, 0, 256); PH_END
        PH_BEGIN GEMM_STD(WSP(bf16, WS_A), WL(bf16, l, WL_BA), Mmix, 1024, 512, EpiStore, WSP(bf16, WS_X + X_PP) + 1024, NGATE, 0, 0, 256); PH_END
        PH_BEGIN GEMM_STD(WSP(bf16, WS_A + (size_t)72 * MiB), WL(bf16, l, WL_BF), Mmix, 1024, 256, EpiStore, WSP(bf16, WS_X + X_PP) + 2048, NGATE, 0, 0, 256); PH_END
        GSYNC(); TS(l * 16 + 6); DBGCHK(5);
        PH_BEGIN rowop<false, true>(C, Mmix, HIN_L, HIN_C, nullptr, nullptr, nullptr, 0, nullptr, C.P.in[6 + C.z] + l * DM, 0, 1, MODL(l), MODL(l), ABUF); PH_END
        GSYNC(); TS(l * 16 + 7);
        PH_BEGIN
            pg8::Gemm g{ABUF, WL(bf16, l, WL_G), Mmix, NGATE, DM}; GateOrder S{(Mmix / 256) * 4, C.G, C.bid};
            EpiGate E{WSP(bf16, WS_X + X_PP), WSP(bf16, WS_X + X_UR)};
            pg8::gemm_phase<EpiGate, GateOrder, true, true>(glds, g, S, E);
        PH_END
        GSYNC(); TS(l * 16 + 8); DBGCHK(6);
        PH_BEGIN GEMM_STD(WSP(bf16, WS_X + X_UR), WL(bf16, l, WL_O), Mmix, DM, DM, EpiStore, WSP(bf16, WS_X + X_MIX), DM, 0, 0, 256); PH_END
        GSYNC(); TS(l * 16 + 9); DBGCHK(7);
        PH_BEGIN rowop<true, true>(C, Mmix, HIN_L, HIN_C, C.out, HCB, WSP(bf16, WS_X + X_MIX), 2, C.P.in[7 + C.z] + l * DM, C.P.in[8 + C.z] + l * DM, 3, 4, MODL(l), MODL(l), ABUF); PH_END
        GSYNC(); TS(l * 16 + 10); DBGCHK(8);
        PH_BEGIN GEMM_STD(ABUF, WL(bf16, l, WL_UP), Mmix, 2 * DFF, DM, EpiUp, WSP(bf16, WS_X + X_HH), WSP(bf16, WS_X + X_HALO), C.P.in[31 + C.z] + (size_t)l * 3 * DFF, C.P.in[32 + C.z] + (size_t)l * DFF); PH_END
        GSYNC(); TS(l * 16 + 11);
        fixup_phase(CK, l, Mmix);
        GSYNC(); TS(l * 16 + 12); DBGCHK(9);
        PH_BEGIN GEMM_STD(WSP(bf16, WS_X + X_HH), WL(bf16, l, WL_DN), Mmix, DM, DFF, EpiStore, WSP(bf16, WS_X + X_FFO), DM, 0, 0, 256); PH_END
        GSYNC(); TS(l * 16 + 13); DBGCHK(10);
        if (l == 0) { PH_BEGIN rowop<true, true>(C, NT, C.out, HCB, C.out, HCB, WSP(bf16, WS_X + X_FFO), 5, C.P.in[9 + C.z] + l * DM, C.P.in[6 + C.z] + (l + 1) * DM, 0, 1, MODL(l), MODL(l + 1), ABUF); PH_END GSYNC(); TS(l * 16 + 14); }
        else { PH_BEGIN rowop<true, false>(C, NLAT, C.out, HCB, C.out, HCB, WSP(bf16, WS_X + X_FFO), 5, C.P.in[9 + C.z] + l * DM, nullptr, 0, 1, MODL(l), MODL(l), nullptr); PH_END }
    }
#ifdef DBG
    grid.sync(); dbg_report(CK);
#endif
#ifdef PROBE
    grid.sync(); TS(60);
    TS(61);
    grid.sync();
    if (blockIdx.x == 0) {
        volatile LAS unsigned long long* ts = (volatile LAS unsigned long long*)(CK.lds + 131072);
#ifdef PROBE_PRO
        unsigned long long d = (ts[60] - ts[40]) / 10ull;
#else
        unsigned long long d = 0; for (int ll = 0; ll < 2; ++ll) d += ts[ll * 16 + PROBE_B] - ts[ll * 16 + PROBE_A];
#endif
        const int n = (int)(d / 500ull);
        for (int i = tid_; i < n; i += NTHREADS) P.out[1000000 + i] += 0.15f;
    }
#endif
}


extern "C" void kernel_launch(void* const* d_in, const int* in_sizes, int n_in, void* d_out, int out_size, void* d_ws, size_t ws_size, hipStream_t stream) {
    static int grid = 0;
    if (grid == 0) {
        if (n_in != 34 || out_size != NLAT * DM || ws_size < WS_TOTAL) { fprintf(stderr, "kernel_launch: unexpected shapes (n_in %d out %d ws %zu, need %zu)\n", n_in, out_size, ws_size, (size_t)WS_TOTAL); grid = -1; return; }
        int dev = 0, cus = 0, per_cu = 0;
        hipGetDevice(&dev); hipDeviceGetAttribute(&cus, hipDeviceAttributeMultiprocessorCount, dev);
        if (hipFuncSetAttribute((const void*)fwd_kernel, hipFuncAttributeMaxDynamicSharedMemorySize, LDS_BYTES) != hipSuccess) { fprintf(stderr, "kernel_launch: hipFuncSetAttribute failed\n"); grid = -1; return; }
        hipOccupancyMaxActiveBlocksPerMultiprocessor(&per_cu, (const void*)fwd_kernel, NTHREADS, LDS_BYTES);
        (void)hipGetLastError();
        if (per_cu < 1 || cus < 256) { fprintf(stderr, "kernel_launch: occupancy %d, cus %d\n", per_cu, cus); grid = -1; return; }
        grid = 256;
    }
    if (grid < 0) return;
    (void)hipMemsetAsync((char*)d_ws + WS_CTL, 0, 65536, stream);
    Params p{};
    for (int i = 0; i < 34; ++i) p.in[i] = (const float*)d_in[i];
    p.out = (float*)d_out; p.ws = (unsigned char*)d_ws;
    void* args[] = {&p};
    hipError_t e = hipLaunchCooperativeKernel((const void*)fwd_kernel, dim3(grid), dim3(NTHREADS), args, LDS_BYTES, stream);
    if (e != hipSuccess) fprintf(stderr, "kernel_launch: cooperative launch failed: %s (grid %d)\n", hipGetErrorString(e), grid);
}
```

```cpp
#define PROBE_A 3
#define PROBE_B 4
#include <hip/hip_runtime.h>
#include <hip/hip_cooperative_groups.h>
#include <cstdio>
#include <cstdint>
namespace cg = cooperative_groups;
__device__ __forceinline__ int otid() { int t = threadIdx.x; asm volatile("" : "+v"(t)); return t; }
namespace pg8 {
#define PG8_LAS __attribute__((address_space(3)))
typedef unsigned short bf16_t;
typedef short bf16x8 __attribute__((ext_vector_type(8)));
typedef float f32x4 __attribute__((ext_vector_type(4)));
typedef unsigned u32x4 __attribute__((ext_vector_type(4)));
constexpr int BM = 256, BK = 64, HALF = 128, HTB = HALF * BK * 2  , STAGE_BYTES = 8 * HTB, NXCD = 8, WGM = 8;

__host__ __device__ __forceinline__ int lds_byte(int r, int c) { const int st = (r >> 4) * 2 + (c >> 5), rr = r & 15, cc = c & 31, ob = rr * 64 + cc * 2; return st * 1024 + (ob ^ (((ob >> 9) & 1) << 5)); }
__host__ __device__ __forceinline__ void stage_rc(int b, int& R, int& C) { const int st = b / 1024, sb = b % 1024, swz = sb ^ (((sb >> 9) & 1) << 5); R = (st >> 1) * 16 + swz / 64; C = (st & 1) * 32 + (swz % 64) / 2; }
__host__ __device__ __forceinline__ int perm32(int rho) { const int n = rho >> 4, i = rho & 15; return 8 * (i >> 2) + 4 * n + (i & 3); }

struct Unit { int pm, pn; };
struct Gemm { const bf16_t* A; const bf16_t* Bt; int M, N, K; };

struct StaticOrder {
    int nM, nN, nwg, G, c;
    __host__ __device__ void init(int M, int N, int G_, int c_) { nM = M / BM; nN = N / BM; nwg = nM * nN; G = G_; c = c_; }
    __host__ __device__ bool next(int i, Unit& u) const {
        const long L = (long)i * G + c; if (L >= nwg) return false;
        int wgid = (int)L; { const int q = nwg / NXCD, r = nwg % NXCD, xcd = wgid % NXCD, off = wgid / NXCD; wgid = (xcd < r ? xcd * (q + 1) : r * (q + 1) + (xcd - r) * q) + off; }
        const int nig = WGM * nN, gid = wgid / nig, fm = gid * WGM, gsz = (nM - fm) < WGM ? (nM - fm) : WGM;
        u.pm = fm + ((wgid % nig) % gsz); u.pn = (wgid % nig) / gsz; return true;
    }
    __device__ __forceinline__ void a_ready(const Unit&) const {}
    __device__ __forceinline__ void done(const Unit&) const {}
};

__device__ __forceinline__ unsigned cvt_pk_bf16(float lo, float hi) { unsigned r; asm volatile("v_cvt_pk_bf16_f32 %0, %1, %2" : "=v"(r) : "v"(lo), "v"(hi)); return r; }
typedef float f32x2 __attribute__((ext_vector_type(2)));
__device__ __forceinline__ f32x2 gelu_pk(f32x2 v) {
    const f32x2 av = __builtin_elementwise_abs(v), d = av * 0.2316418882f + 1.0f;
    f32x2 t; t.x = __builtin_amdgcn_rcpf(d.x); t.y = __builtin_amdgcn_rcpf(d.y);
    f32x2 q = t * 0.5307027145f + (-0.7265760135f); q = q * t + 0.7107068705f; q = q * t + (-0.142248368f); q = q * t + 0.127414796f; q = q * t;
    const f32x2 s = (v * v) * (-0.72134752044f);
    f32x2 e; e.x = __builtin_amdgcn_exp2f(s.x); e.y = __builtin_amdgcn_exp2f(s.y);
    const f32x2 m = v * (q * e), r = v - m;
    f32x2 o; o.x = v.x < 0.f ? m.x : r.x; o.y = v.y < 0.f ? m.y : r.y; return o;
}

template <class Epi, class Sched, bool ALIGN_EPI = false, bool SP2 = false>
__device__ __forceinline__ void gemm_phase(PG8_LAS unsigned char* lds, const Gemm g, const Sched& S, const Epi& E) {
    const int tid = otid(), wid = __builtin_amdgcn_readfirstlane(tid >> 6), lane = tid & 63, wr = wid >> 2, wc = wid & 3, fr = lane & 15, fq = lane >> 4;
    const int K = g.K, nt = K / BK;
    unsigned voffA[2], voffB[2];
#pragma unroll
    for (int i = 0; i < 2; ++i) { int R, C; stage_rc(tid * 16 + i * 8192, R, C); const int Rb = Epi::PERM ? ((R & ~31) + perm32(R & 31)) : R;
        const int Ra = Epi::PERMA ? ((R & 64) + 4 * (R & 15) + ((R >> 4) & 3)) : R;
        voffA[i] = (unsigned)(Ra * K + C) * 2u; voffB[i] = (unsigned)(Rb * K + C) * 2u; }
    const size_t kstep = (size_t)(BK * 2);
    const size_t hstep = (size_t)HALF * K * 2;
    const size_t tstep = 2 * hstep;
    const unsigned ldsw = (unsigned)wid * 1024u;
    const int aoff = lds_byte(wr * 64 + fr, fq * 8), boff = lds_byte(wc * 32 + fr, fq * 8);
#define PG8_SA(b, h) (((b) * 2 + (h)) * HTB)
#define PG8_SB(b, h) ((4 + (b) * 2 + (h)) * HTB)
#define PG8_STAGE(bufoff, gbase, voff) do { _Pragma("unroll") for (int _i = 0; _i < 2; ++_i) \
        __builtin_amdgcn_global_load_lds((const unsigned*)((const char*)(gbase) + (voff)[_i]), (PG8_LAS unsigned*)(lds + (bufoff) + ldsw + _i * 8192), 16, 0, 0); } while (0)
#define PG8_LDA(dst, b, h) do { _Pragma("unroll") for (int m = 0; m < 4; ++m) _Pragma("unroll") for (int k = 0; k < 2; ++k) dst[m][k] = *(const PG8_LAS bf16x8*)(lds + PG8_SA(b, h) + aoff + m * 2048 + k * 1024); } while (0)
#define PG8_LDB(dst, b, h) do { _Pragma("unroll") for (int n = 0; n < 2; ++n) _Pragma("unroll") for (int k = 0; k < 2; ++k) dst[n][k] = *(const PG8_LAS bf16x8*)(lds + PG8_SB(b, h) + boff + n * 2048 + k * 1024); } while (0)
#define PG8_MMA(ai, bj, At, Bt) do { __builtin_amdgcn_s_setprio(1); _Pragma("unroll") for (int m = 0; m < 4; ++m) _Pragma("unroll") for (int n = 0; n < 2; ++n) _Pragma("unroll") for (int k = 0; k < 2; ++k) \
        acc[ai][bj][m][n] = __builtin_amdgcn_mfma_f32_16x16x32_bf16(Bt[n][k], At[m][k], acc[ai][bj][m][n], 0, 0, 0); __builtin_amdgcn_s_setprio(0); } while (0)
#define PG8_WAIT_V(n) asm volatile("s_waitcnt vmcnt(" #n ")" ::: "memory")
#define PG8_WAIT_L(n) asm volatile("s_waitcnt lgkmcnt(" #n ")" ::: "memory")
#define PG8_BAR __builtin_amdgcn_s_barrier()
#define PG8_SCHED __builtin_amdgcn_sched_barrier(0)
    Unit cur, nxt; int ui = 0;
    if (!S.next(0, cur)) return;
    f32x4 acc[2][2][4][2];
#pragma unroll
    for (int a = 0; a < 2; ++a)
#pragma unroll
        for (int b = 0; b < 2; ++b)
#pragma unroll
            for (int m = 0; m < 4; ++m)
#pragma unroll
                for (int n = 0; n < 2; ++n) acc[a][b][m][n] = (f32x4){0.f, 0.f, 0.f, 0.f};
    bf16x8 At[4][2], B0[2][2], B1[2][2];
    const char* cA = (const char*)g.A + (size_t)cur.pm * tstep; const char* cB = (const char*)g.Bt + (size_t)cur.pn * tstep;
    S.a_ready(cur);
    if constexpr (SP2) {
        PG8_STAGE(PG8_SB(0, 0), cB, voffB); PG8_STAGE(PG8_SB(0, 1), cB + hstep, voffB); PG8_STAGE(PG8_SA(0, 0), cA, voffA); PG8_STAGE(PG8_SA(0, 1), cA + hstep, voffA);
        if (wr == 1) PG8_BAR;
        PG8_WAIT_V(2); PG8_BAR;
        PG8_STAGE(PG8_SB(1, 0), cB + kstep, voffB); PG8_STAGE(PG8_SA(1, 0), cA + kstep, voffA); PG8_STAGE(PG8_SB(1, 1), cB + hstep + kstep, voffB);
        PG8_WAIT_V(6); PG8_BAR;
    } else {
        PG8_STAGE(PG8_SB(0, 0), cB, voffB); PG8_STAGE(PG8_SA(0, 0), cA, voffA); PG8_STAGE(PG8_SB(0, 1), cB + hstep, voffB); PG8_STAGE(PG8_SA(0, 1), cA + hstep, voffA);
        if (wr == 1) PG8_BAR;
        PG8_WAIT_V(4); PG8_BAR;
        PG8_STAGE(PG8_SB(1, 0), cB + kstep, voffB); PG8_STAGE(PG8_SA(1, 0), cA + kstep, voffA); PG8_STAGE(PG8_SB(1, 1), cB + hstep + kstep, voffB);
        PG8_WAIT_V(6); PG8_BAR;
    }
    for (;;) {
        const bool has_next = S.next(ui + 1, nxt);
        const char* nA = has_next ? (const char*)g.A + (size_t)nxt.pm * tstep : cA; const char* nB = has_next ? (const char*)g.Bt + (size_t)nxt.pn * tstep : cB;
        for (int t = 0; t < nt; t += 2) {
            const bool last = (t == nt - 2);
            const char* a1 = cA + (size_t)(t + 1) * kstep;
            const char* a2 = last ? nA : cA + (size_t)(t + 2) * kstep; const char* b2 = last ? nB : cB + (size_t)(t + 2) * kstep;
            const char* a3 = a2 + kstep; const char* b3 = b2 + kstep;
            if (last && has_next) S.a_ready(nxt);
            if constexpr (SP2) {
            PG8_LDB(B0, 0, 0); PG8_LDB(B1, 0, 1); PG8_SCHED; PG8_LDA(At, 0, 0); PG8_STAGE(PG8_SA(1, 1), a1 + hstep, voffA);
            PG8_WAIT_V(8); PG8_WAIT_L(0); PG8_BAR; PG8_MMA(0, 0, At, B0); PG8_MMA(0, 1, At, B1); PG8_BAR; PG8_SCHED;
            PG8_LDA(At, 0, 1); PG8_STAGE(PG8_SB(0, 0), b2, voffB); PG8_STAGE(PG8_SB(0, 1), b2 + hstep, voffB); PG8_STAGE(PG8_SA(0, 0), a2, voffA);
            PG8_WAIT_V(8); PG8_WAIT_L(0); PG8_BAR; PG8_MMA(1, 0, At, B0); PG8_MMA(1, 1, At, B1); PG8_BAR; PG8_SCHED;
            PG8_LDB(B0, 1, 0); PG8_LDB(B1, 1, 1); PG8_SCHED; PG8_LDA(At, 1, 0); PG8_STAGE(PG8_SA(0, 1), a2 + hstep, voffA);
            PG8_WAIT_V(8); PG8_WAIT_L(0); PG8_BAR; PG8_MMA(0, 0, At, B0); PG8_MMA(0, 1, At, B1); PG8_BAR; PG8_SCHED;
            PG8_LDA(At, 1, 1); PG8_STAGE(PG8_SB(1, 0), b3, voffB); PG8_STAGE(PG8_SB(1, 1), b3 + hstep, voffB); PG8_STAGE(PG8_SA(1, 0), a3, voffA);
            PG8_WAIT_V(8); PG8_WAIT_L(0); PG8_BAR; PG8_MMA(1, 0, At, B0); PG8_MMA(1, 1, At, B1); PG8_BAR; PG8_SCHED;
            } else {
            PG8_LDB(B0, 0, 0); PG8_SCHED; PG8_LDA(At, 0, 0); PG8_STAGE(PG8_SA(1, 1), a1 + hstep, voffA);
            PG8_WAIT_L(8); PG8_BAR; PG8_WAIT_L(0); PG8_MMA(0, 0, At, B0); PG8_BAR; PG8_SCHED;
            PG8_LDB(B1, 0, 1); PG8_STAGE(PG8_SB(0, 0), b2, voffB);
            PG8_BAR; PG8_WAIT_L(0); PG8_MMA(0, 1, At, B1); PG8_BAR;
            PG8_LDA(At, 0, 1); PG8_STAGE(PG8_SA(0, 0), a2, voffA);
            PG8_BAR; PG8_WAIT_L(0); PG8_MMA(1, 0, At, B0); PG8_BAR; PG8_SCHED;
            PG8_STAGE(PG8_SB(0, 1), b2 + hstep, voffB);
            PG8_WAIT_V(6); PG8_BAR; PG8_MMA(1, 1, At, B1); PG8_BAR;
            PG8_LDB(B0, 1, 0); PG8_SCHED; PG8_LDA(At, 1, 0); PG8_STAGE(PG8_SA(0, 1), a2 + hstep, voffA);
            PG8_WAIT_L(8); PG8_BAR; PG8_WAIT_L(0); PG8_MMA(0, 0, At, B0); PG8_BAR; PG8_SCHED;
            PG8_LDB(B1, 1, 1); PG8_STAGE(PG8_SB(1, 0), b3, voffB);
            PG8_BAR; PG8_WAIT_L(0); PG8_MMA(0, 1, At, B1); PG8_BAR;
            PG8_LDA(At, 1, 1); PG8_STAGE(PG8_SA(1, 0), a3, voffA);
            PG8_BAR; PG8_WAIT_L(0); PG8_MMA(1, 0, At, B0); PG8_BAR; PG8_SCHED;
            PG8_STAGE(PG8_SB(1, 1), b3 + hstep, voffB);
            PG8_WAIT_V(6); PG8_BAR; PG8_MMA(1, 1, At, B1); PG8_BAR;
            }
        }
        if constexpr (ALIGN_EPI) { if (wr == 0) PG8_BAR; }
        if constexpr (!Epi::AFTER_DRAIN) { E(acc, cur, wr, wc, fr, fq); S.done(cur); }
        if (!has_next) break;
#pragma unroll
        for (int a = 0; a < 2; ++a)
#pragma unroll
            for (int b = 0; b < 2; ++b)
#pragma unroll
                for (int m = 0; m < 4; ++m)
#pragma unroll
                    for (int n = 0; n < 2; ++n) acc[a][b][m][n] = (f32x4){0.f, 0.f, 0.f, 0.f};
        cur = nxt; cA = nA; cB = nB; ++ui;
        if constexpr (ALIGN_EPI) { if (wr == 1) PG8_BAR; }
    }
    PG8_WAIT_V(0);
    if constexpr (!ALIGN_EPI) { if (wr == 0) PG8_BAR; }
    PG8_BAR;
    if constexpr (Epi::AFTER_DRAIN) { E.fused(acc, cur, wr, wc, fr, fq, lds, wid, lane); S.done(cur); }
#undef PG8_SA
#undef PG8_SB
#undef PG8_STAGE
#undef PG8_LDA
#undef PG8_LDB
#undef PG8_MMA
#undef PG8_WAIT_V
#undef PG8_WAIT_L
#undef PG8_BAR
#undef PG8_SCHED
}
}

#define DI __device__ __forceinline__
#define LAS __attribute__((address_space(3)))
typedef unsigned short bf16;
typedef float f32x4 __attribute__((ext_vector_type(4)));
typedef float f32x2 __attribute__((ext_vector_type(2)));
typedef float f32x16 __attribute__((ext_vector_type(16)));
typedef short bf16x8 __attribute__((ext_vector_type(8)));
typedef short s16x4 __attribute__((ext_vector_type(4)));
typedef unsigned u32x4 __attribute__((ext_vector_type(4)));
typedef unsigned u32x2 __attribute__((ext_vector_type(2)));
typedef __bf16 bf16x2_t __attribute__((ext_vector_type(2)));

constexpr int DM = 1024, NB = 32, TL = 2048, TC = 256, NLAT = NB * TL, NCTX = NB * TC, NT = NLAT + NCTX, CTXB = NLAT;
constexpr int DFF = 2816, RW = 1152, NIN = 2560, NGATE = 3072;
constexpr int IN_COLS = 5248;
constexpr float LOG2E = 1.4426950408889634f;
constexpr int NTHREADS = 512, NWAVES = 8;
constexpr int LDS_BYTES = 147456;

constexpr size_t MiB = 1u << 20;
constexpr size_t WS_CTL = 0;
constexpr size_t WS_MOD = 1 * MiB;
constexpr size_t WS_SMALL = 3 * MiB;
constexpr size_t WS_BON = 4 * MiB;
constexpr size_t WS_W = 6 * MiB;
constexpr size_t WL_IN = 0, WL_G = 5 * MiB, WL_BR = 11 * MiB, WL_BA = 11 * MiB + 512 * 1024, WL_BF = 12 * MiB + 512 * 1024, WL_O = 13 * MiB, WL_UP = 15 * MiB, WL_DN = 26 * MiB, WL_SIZE = 32 * MiB;
constexpr size_t WS_DFT = WS_W + 2 * WL_SIZE;
constexpr size_t WS_DFTC = WS_DFT + 16 * MiB;
constexpr size_t WS_HC = WS_DFTC + 1 * MiB;
constexpr size_t WS_A = WS_HC + 32 * MiB;
constexpr size_t WS_VF = WS_A + 144 * MiB;
constexpr size_t WS_X = WS_VF + 36 * MiB;
constexpr size_t X_F = 0;
constexpr size_t X_QKV = 288 * MiB;
constexpr size_t X_ZT = 396 * MiB;
constexpr size_t X_ZTC = 460 * MiB;
constexpr size_t X_UR = 504 * MiB;
constexpr size_t X_G = 468 * MiB;
constexpr size_t X_LO = 504 * MiB;
constexpr size_t X_END = 720 * MiB;
constexpr size_t WS_WLORA = WS_X + X_END;
constexpr int KLO = 640, NLO = 1536;
constexpr size_t X_PP = 0;
constexpr size_t X_MIX = 0;
constexpr size_t X_HH = 0;
constexpr size_t X_HALO = 396 * MiB;
constexpr size_t X_FFO = 436 * MiB;
constexpr size_t WS_TOTAL = WS_WLORA + 4 * MiB;
constexpr size_t FSZ = (size_t)NT * 256;

struct Params { const float* in[34]; float* out; unsigned char* ws; };

DI float bf2f(bf16 v) { return __builtin_bit_cast(float, (unsigned)v << 16); }
DI float lo2f(unsigned u) { return __builtin_bit_cast(float, u << 16); }
DI float hi2f(unsigned u) { return __builtin_bit_cast(float, u & 0xffff0000u); }
DI unsigned pk(float lo, float hi) { f32x2 v = {lo, hi}; bf16x2_t b = __builtin_convertvector(v, bf16x2_t); return __builtin_bit_cast(unsigned, b); }
DI bf16 f2bf(float x) { return (bf16)(pk(x, 0.f) & 0xffffu); }
DI float fexp2(float x) { return __builtin_amdgcn_exp2f(x); }
DI float frcp(float x) { return __builtin_amdgcn_rcpf(x); }
DI float sigm(float x) { return frcp(1.f + fexp2(-x * LOG2E)); }
DI f32x2 sigm2(f32x2 x) { const f32x2 t = x * (-LOG2E); f32x2 e; e.x = fexp2(t.x); e.y = fexp2(t.y); const f32x2 d = e + 1.f; f32x2 r; r.x = frcp(d.x); r.y = frcp(d.y); return r; }
DI float tanh_(float x) { return 2.f * sigm(2.f * x) - 1.f; }
DI float gelu_tanh(float z) { const float u = 1.5957691216057308f * (z + 0.044715f * z * z * z); return z * sigm(u); }
DI float wave_sum(float v) {
#pragma unroll
    for (int o = 1; o < 64; o <<= 1) v += __shfl_xor(v, o);
    return v;
}
template <int CTRL, bool BC> DI float dppf(float old, float src) {
    return __builtin_bit_cast(float, __builtin_amdgcn_update_dpp(__builtin_bit_cast(int, old), __builtin_bit_cast(int, src), CTRL, 0xf, 0xf, BC));
}
DI float row16_sum(float x) { x += dppf<0x128, true>(0.f, x); x += dppf<0x124, true>(0.f, x); x += dppf<0x122, true>(0.f, x); x += dppf<0x121, true>(0.f, x); return x; }
DI f32x4 bf4(u32x2 u) { return (f32x4){lo2f(u.x), hi2f(u.x), lo2f(u.y), hi2f(u.y)}; }
DI u32x2 pk4(f32x4 v) { u32x2 o; o.x = pk(v[0], v[1]); o.y = pk(v[2], v[3]); return o; }
DI float allred4(float x) {
    unsigned u = __builtin_bit_cast(unsigned, x);
    auto r = __builtin_amdgcn_permlane16_swap(u, u, false, false);
    float y = __builtin_bit_cast(float, (unsigned)r[0]) + __builtin_bit_cast(float, (unsigned)r[1]);
    unsigned v = __builtin_bit_cast(unsigned, y);
    auto s = __builtin_amdgcn_permlane32_swap(v, v, false, false);
    return __builtin_bit_cast(float, (unsigned)s[0]) + __builtin_bit_cast(float, (unsigned)s[1]);
}

DI u32x4 pack8(const f32x4& a, const f32x4& b) { u32x4 w; w.x = pk(a[0], a[1]); w.y = pk(a[2], a[3]); w.z = pk(b[0], b[1]); w.w = pk(b[2], b[3]); return w; }

struct EpiStore {
    static constexpr bool PERM = true, AFTER_DRAIN = false, PERMA = false;
    bf16* O; int ld; int row_base, row_pn, col_pn;
    DI void operator()(const f32x4 (&acc)[2][2][4][2], const pg8::Unit& u, int wr, int wc, int fr, int fq) const {
        const int row0 = row_base + u.pn * row_pn + u.pm * 256 + wr * 64 + fr, col0 = u.pn * col_pn + wc * 32 + 8 * fq;
#pragma unroll
        for (int ai = 0; ai < 2; ++ai)
#pragma unroll
            for (int m = 0; m < 4; ++m) { bf16* rowp = O + (size_t)(row0 + ai * 128 + m * 16) * ld + col0;
#pragma unroll
                for (int bj = 0; bj < 2; ++bj) *(u32x4*)(rowp + bj * 128) = pack8(acc[ai][bj][m][0], acc[ai][bj][m][1]); }
    }
};

struct EpiIn {
    static constexpr bool PERM = true, AFTER_DRAIN = false, PERMA = false;
    bf16 *QKV, *ZT, *ZTC, *UR;
    DI void operator()(const f32x4 (&acc)[2][2][4][2], const pg8::Unit& u, int wr, int wc, int fr, int fq) const {
        const int pn = u.pn, rl0 = wr * 64 + fr, cl = wc * 32 + 8 * fq;
        if (pn < 3) {
#pragma unroll
            for (int ai = 0; ai < 2; ++ai)
#pragma unroll
                for (int m = 0; m < 4; ++m) { bf16* rowp = QKV + (size_t)(u.pm * 256 + rl0 + ai * 128 + m * 16) * 768 + pn * 256 + cl;
#pragma unroll
                    for (int bj = 0; bj < 2; ++bj) *(u32x4*)(rowp + bj * 128) = pack8(acc[ai][bj][m][0], acc[ai][bj][m][1]); }
        } else if (pn < 5) {
            bf16* base; int stride;
            if (u.pm < 256) { const int b = u.pm >> 3, t0 = (u.pm & 7) * 256; base = ZT + (size_t)b * 256 * 4096 + (pn - 3) * 2048 + t0; stride = 4096; }
            else { const int b = u.pm - 256; base = ZTC + (size_t)b * 256 * 512 + (pn - 3) * 256; stride = 512; }
#pragma unroll
            for (int ai = 0; ai < 2; ++ai)
#pragma unroll
                for (int m = 0; m < 4; ++m) { const int rl = rl0 + ai * 128 + m * 16;
#pragma unroll
                    for (int bj = 0; bj < 2; ++bj)
#pragma unroll
                        for (int n = 0; n < 2; ++n)
#pragma unroll
                            for (int e = 0; e < 4; ++e) base[(size_t)(bj * 128 + cl + 4 * n + e) * stride + rl] = f2bf(acc[ai][bj][m][n][e]); }
        } else {
#pragma unroll
            for (int ai = 0; ai < 2; ++ai)
#pragma unroll
                for (int m = 0; m < 4; ++m) { bf16* rowp = UR + (size_t)(u.pm * 256 + rl0 + ai * 128 + m * 16) * RW + (pn - 5) * 256 + cl;
#pragma unroll
                    for (int bj = 0; bj < 2; ++bj) if ((pn - 5) * 256 + bj * 128 < RW) *(u32x4*)(rowp + bj * 128) = pack8(acc[ai][bj][m][0], acc[ai][bj][m][1]); }
        }
    }
};

struct EpiGate {
    static constexpr bool PERM = true, AFTER_DRAIN = false, PERMA = false;
    const bf16* PP; bf16* MG;
    DI void operator()(const f32x4 (&acc)[2][2][4][2], const pg8::Unit& u, int wr, int wc, int fr, int fq) const {
        const int br = u.pn >> 2, cn = u.pn & 3, row0 = u.pm * 256 + wr * 64 + fr, col0 = cn * 256 + wc * 32 + 8 * fq;
#pragma unroll
        for (int ai = 0; ai < 2; ++ai)
#pragma unroll
            for (int m = 0; m < 4; ++m) { const size_t row = (size_t)(row0 + ai * 128 + m * 16);
#pragma unroll
                for (int bj = 0; bj < 2; ++bj) {
                    const u32x4 pp = *(const u32x4*)(PP + row * NGATE + br * 1024 + col0 + bj * 128);
                    bf16* mp = MG + row * 1024 + col0 + bj * 128;
                    f32x4 a = acc[ai][bj][m][0], b = acc[ai][bj][m][1];
                    { const f32x2 s0 = sigm2((f32x2){a[0], a[1]}) * (f32x2){lo2f(pp.x), hi2f(pp.x)}, s1 = sigm2((f32x2){a[2], a[3]}) * (f32x2){lo2f(pp.y), hi2f(pp.y)}, s2 = sigm2((f32x2){b[0], b[1]}) * (f32x2){lo2f(pp.z), hi2f(pp.z)}, s3 = sigm2((f32x2){b[2], b[3]}) * (f32x2){lo2f(pp.w), hi2f(pp.w)};
                      a = (f32x4){s0.x, s0.y, s1.x, s1.y}; b = (f32x4){s2.x, s2.y, s3.x, s3.y}; }
                    if (br) { const u32x4 o = *(const u32x4*)mp;
                        a[0] += lo2f(o.x); a[1] += hi2f(o.x); a[2] += lo2f(o.y); a[3] += hi2f(o.y); b[0] += lo2f(o.z); b[1] += hi2f(o.z); b[2] += lo2f(o.w); b[3] += hi2f(o.w); }
                    *(u32x4*)mp = pack8(a, b); } }
    }
};

DI f32x2 gelu2(f32x2 z) {
    const f32x2 u = z * (z * z * 0.044715f + 1.f), t = u * (-1.5957691216057308f * LOG2E);
    f32x2 e; e.x = fexp2(t.x); e.y = fexp2(t.y);
    const f32x2 d = e + 1.f; f32x2 r; r.x = frcp(d.x); r.y = frcp(d.y);
    return z * r;
}
struct EpiUp {
    static constexpr bool PERM = true, AFTER_DRAIN = false, PERMA = true;
    bf16* HH; bf16* HALO; const float* cw; const float* cb;
    DI void operator()(const f32x4 (&acc)[2][2][4][2], const pg8::Unit& u, int wr, int wc, int fr, int fq) const {
        const int j0 = 128 * u.pn + 32 * wc + 8 * fq;
        f32x4 w0[2], w1[2], w2[2], bb[2];
#pragma unroll
        for (int n = 0; n < 2; ++n) { w0[n] = *(const f32x4*)(cw + j0 + 4 * n); w1[n] = *(const f32x4*)(cw + DFF + j0 + 4 * n); w2[n] = *(const f32x4*)(cw + 2 * DFF + j0 + 4 * n); bb[n] = *(const f32x4*)(cb + j0 + 4 * n); }
#pragma unroll
        for (int ai = 0; ai < 2; ++ai) {
            const int grp = u.pm * 4 + ai * 2 + wr;
            bf16* hb = HALO + (size_t)grp * 6 * DFF + j0;
            if (fr == 0) { *(u32x4*)(hb) = pack8(acc[ai][0][0][0], acc[ai][0][0][1]); *(u32x4*)(hb + DFF) = pack8(acc[ai][0][1][0], acc[ai][0][1][1]); *(u32x4*)(hb + 4 * DFF) = pack8(acc[ai][1][0][0], acc[ai][1][0][1]); }
            if (fr == 15) { *(u32x4*)(hb + 2 * DFF) = pack8(acc[ai][0][2][0], acc[ai][0][2][1]); *(u32x4*)(hb + 3 * DFF) = pack8(acc[ai][0][3][0], acc[ai][0][3][1]); *(u32x4*)(hb + 5 * DFF) = pack8(acc[ai][1][3][0], acc[ai][1][3][1]); }
            f32x4 o[4][2];
#pragma unroll
            for (int n = 0; n < 2; ++n)
#pragma unroll
                for (int ep = 0; ep < 2; ++ep) {
                    f32x2 x[4];
#pragma unroll
                    for (int m = 0; m < 4; ++m) x[m] = (f32x2){acc[ai][0][m][n][2 * ep], acc[ai][0][m][n][2 * ep + 1]};
                    f32x2 pv, nx;
                    pv.x = dppf<0x111, true>(0.f, x[3].x); pv.y = dppf<0x111, true>(0.f, x[3].y);
                    nx.x = dppf<0x101, true>(0.f, x[0].x); nx.y = dppf<0x101, true>(0.f, x[0].y);
                    const f32x2 c0 = {w0[n][2 * ep], w0[n][2 * ep + 1]}, c1 = {w1[n][2 * ep], w1[n][2 * ep + 1]}, c2 = {w2[n][2 * ep], w2[n][2 * ep + 1]}, cb2 = {bb[n][2 * ep], bb[n][2 * ep + 1]};
#pragma unroll
                    for (int m = 0; m < 4; ++m) {
                        const f32x2 prev = m ? x[m ? m - 1 : 0] : pv, next = (m < 3) ? x[m < 3 ? m + 1 : 3] : nx;
                        const f32x2 z = c0 * prev + c1 * x[m] + c2 * next + cb2;
                        const f32x2 zv = {acc[ai][1][m][n][2 * ep], acc[ai][1][m][n][2 * ep + 1]};
                        const f32x2 g = gelu2(z) * zv;
                        o[m][n][2 * ep] = g.x; o[m][n][2 * ep + 1] = g.y;
                    }
                }
#pragma unroll
            for (int m = 0; m < 4; ++m) {
                const bool edge = (m == 0 && fr == 0) || (m == 3 && fr == 15);
                if (!edge) *(u32x4*)(HH + (size_t)(u.pm * 256 + ai * 128 + wr * 64 + 4 * fr + m) * DFF + j0) = pack8(o[m][0], o[m][1]);
            }
        }
    }
};

struct GateOrder {
    int nU, G, c;
    DI bool next(int i, pg8::Unit& u) const { const int j = i / 3, br = i - 3 * j; const long L = (long)j * G + c; if (L >= nU) return false; u.pm = (int)(L >> 2); u.pn = br * 4 + (int)(L & 3); return true; }
    DI void a_ready(const pg8::Unit&) const {}
    DI void done(const pg8::Unit&) const {}
};

struct Ctx {
    LAS unsigned char* lds; unsigned char* ws; const Params& P; float* out;
    int tid, lane, wave, G, bid, z;
};
DI Ctx rectx(const Ctx& C0) { const int t = otid(); int z = 0; asm volatile("" : "+s"(z)); return Ctx{C0.lds, C0.P.ws + z, C0.P, C0.P.out + z, t, t & 63, __builtin_amdgcn_readfirstlane(t >> 6), C0.G, C0.bid, z}; }
#define WSP(T, off) ((T*)(C.ws + (off)))
#define WL(T, l, off) ((T*)(C.ws + WS_W + (size_t)(l) * WL_SIZE + (off)))

DI void tr_item(const float* src, int ldw, int k0, int n0, bf16* dst, int ldd, int drow0, LAS float* scr, int lane) {
#pragma unroll 8
    for (int i = 0; i < 32; ++i) { const int kk = 2 * i + (lane >> 5); scr[kk * 33 + (lane & 31)] = src[(size_t)(k0 + kk) * ldw + n0 + (lane & 31)]; }
    asm volatile("s_waitcnt lgkmcnt(0)" ::: "memory");
    const int c = lane & 7;
#pragma unroll
    for (int j = 0; j < 4; ++j) { const int n = (lane >> 3) + 8 * j; const LAS float* s = scr + (8 * c) * 33 + n;
        u32x4 o; o.x = pk(s[0 * 33], s[1 * 33]); o.y = pk(s[2 * 33], s[3 * 33]); o.z = pk(s[4 * 33], s[5 * 33]); o.w = pk(s[6 * 33], s[7 * 33]);
        *(u32x4*)(dst + (size_t)(drow0 + n) * ldd + k0 + 8 * c) = o; }
    asm volatile("s_waitcnt lgkmcnt(0)" ::: "memory");
}
DI void tr_matrix(const Ctx& C, int gw, int NGW, const float* src, int ldw, int K, int n_src0, int ncols, bf16* dst, int drow0, LAS float* scr) {
    const int nb = ncols / 32, nit = (K / 64) * nb;
    for (int it = gw; it < nit; it += NGW) { const int kb = it / nb, b = it % nb; tr_item(src, ldw, kb * 64, n_src0 + b * 32, dst, K, drow0 + b * 32, scr, C.lane); }
}

DI void weights_tr(const Ctx& C, int l, int gw, int NGW, LAS float* scr) {
    const float* win = C.P.in[10 + C.z] + (size_t)l * 1024 * IN_COLS;
    bf16* wi = WL(bf16, l, WL_IN);
    tr_matrix(C, gw, NGW, win, IN_COLS, 1024, 1152, 512, wi, 0, scr);
    tr_matrix(C, gw, NGW, win, IN_COLS, 1024, 1664, 128, wi, 512, scr);
    tr_matrix(C, gw, NGW, win, IN_COLS, 1024, 1792, 128, wi, 640, scr);
    tr_matrix(C, gw, NGW, win, IN_COLS, 1024, 0, 1152, wi, 1280, scr);
    tr_matrix(C, gw, NGW, win, IN_COLS, 1024, 2176, 3072, WL(bf16, l, WL_G), 0, scr);
    tr_matrix(C, gw, NGW, C.P.in[26 + C.z] + (size_t)l * 256 * 1024, 1024, 256, 0, 1024, WL(bf16, l, WL_BR), 0, scr);
    tr_matrix(C, gw, NGW, C.P.in[27 + C.z] + (size_t)l * 512 * 1024, 1024, 512, 0, 1024, WL(bf16, l, WL_BA), 0, scr);
    tr_matrix(C, gw, NGW, C.P.in[28 + C.z] + (size_t)l * 256 * 1024, 1024, 256, 0, 1024, WL(bf16, l, WL_BF), 0, scr);
    tr_matrix(C, gw, NGW, C.P.in[29 + C.z] + (size_t)l * 1024 * 1024, 1024, 1024, 0, 1024, WL(bf16, l, WL_O), 0, scr);
    {
        const float* up = C.P.in[30 + C.z] + (size_t)l * 1024 * 2 * DFF; bf16* wu = WL(bf16, l, WL_UP);
        for (int it = gw; it < 16 * 44 * 4; it += NGW) { const int kb = it / 176, r = it % 176, seg = r >> 2, b = r & 3, pn = seg >> 1, bj = seg & 1;
            tr_item(up, 2 * DFF, kb * 64, bj * DFF + pn * 128 + b * 32, wu, 1024, pn * 256 + bj * 128 + b * 32, scr, C.lane); }
    }
    tr_matrix(C, gw, NGW, C.P.in[33 + C.z] + (size_t)l * DFF * 1024, 1024, DFF, 0, 1024, WL(bf16, l, WL_DN), 0, scr);
}
DI void prologue(const Ctx& C0) {
    const Ctx C = rectx(C0);
    LAS float* scr = (LAS float*)(C.lds + 49152 + C.wave * 8704);
    const int gth = C.bid * NTHREADS + C.tid, NGT = C.G * NTHREADS;
    for (int tsk = C.bid; tsk < 72; tsk += C.G) {
        const int l = tsk / 36, rem = tsk % 36, cb = rem / 3, rg = rem % 3;
        LAS float* s = (LAS float*)C.lds;
        for (int i = C.tid; i < 11 * 1024; i += NTHREADS) { const int r = rg * 11 + i / 1024, k = i % 1024; const float cv = (r < 32) ? C.P.in[1 + C.z][r * 1024 + k] : C.P.in[3 + C.z][k]; s[i] = cv * sigm(cv); }
        __syncthreads();
        const int j = cb * 512 + C.tid;
        float acc[11];
        const float bj = C.P.in[5 + C.z][l * 6144 + j];
#pragma unroll
        for (int i = 0; i < 11; ++i) acc[i] = bj;
        const float* wp = C.P.in[4 + C.z] + (size_t)l * 1024 * 6144 + j;
        for (int k = 0; k < 1024; k += 4) {
            const float w0 = wp[(size_t)k * 6144], w1 = wp[(size_t)(k + 1) * 6144], w2 = wp[(size_t)(k + 2) * 6144], w3 = wp[(size_t)(k + 3) * 6144];
#pragma unroll
            for (int i = 0; i < 11; ++i) { const f32x4 x = *(const LAS f32x4*)(s + i * 1024 + k); acc[i] += x[0] * w0 + x[1] * w1 + x[2] * w2 + x[3] * w3; }
        }
#pragma unroll
        for (int i = 0; i < 11; ++i) WSP(float, WS_MOD)[(size_t)(l * 33 + rg * 11 + i) * 6144 + j] = acc[i];
        __syncthreads();
    }
    if (C.bid == C.G - 1) for (int i = C.tid; i < 1024; i += NTHREADS) { const int p = i >> 4, f = i & 15; const float inv = powf(10000.f, -(float)f / 16.f), ang = (float)p * inv; WSP(float, WS_SMALL)[2 * i] = cosf(ang); WSP(float, WS_SMALL)[2 * i + 1] = sinf(ang); }
    for (int i = gth; i < 2048 * 4096 / 2; i += NGT) {
        const int tp = i / 2048, kk = (i % 2048) * 2; float v[2];
#pragma unroll
        for (int e = 0; e < 2; ++e) { const int k = kk + e, t = k & 2047; const int ph = (tp * t) & 2047; const float x = (float)ph * (1.f / 1024.f); v[e] = ((k < 2048) ? cospif(x) : -sinpif(x)) * 0.0027621358640099513f; }
        WSP(unsigned, WS_DFT)[i] = pk(v[0], v[1]);
    }
    for (int i = gth; i < 256 * 512 / 2; i += NGT) {
        const int tp = i / 256, kk = (i % 256) * 2; float v[2];
#pragma unroll
        for (int e = 0; e < 2; ++e) { const int k = kk + e, t = k & 255; const int ph = (tp * t) & 255; const float x = (float)ph * (1.f / 128.f); v[e] = ((k < 256) ? cospif(x) : -sinpif(x)) * 0.0078125f; }
        WSP(unsigned, WS_DFTC)[i] = pk(v[0], v[1]);
    }
    weights_tr(C, 0, C.bid * NWAVES + C.wave, C.G * NWAVES, scr);
    for (int l = 0; l < 2; ++l) {
        const float* win = C.P.in[10 + C.z] + (size_t)l * 1024 * IN_COLS;
        bf16* wi = WL(bf16, l, WL_IN);
        for (int i = gth; i < 128 * 1024 / 2; i += NGT) ((unsigned*)(wi + (size_t)2432 * 1024))[i] = 0u;
        {
            LAS float* tab = (LAS float*)(C.lds + 120 * 1024);
            __syncthreads();
            if (C.tid < 64) { const float x = (float)C.tid * (1.f / 32.f); tab[C.tid] = cospif(x); tab[64 + C.tid] = sinpif(x); }
            __syncthreads();
            for (int i = gth; i < 512 * 1024; i += NGT) {
                const int k = i & 1023, np = i >> 10, sn = np >> 8, g = (np >> 6) & 3, cp = np & 63;
                const float* wr_ = win + (size_t)k * IN_COLS + 1920 + g * 64; const LAS float* tb = tab + sn * 64; float a = 0.f;
#pragma unroll 8
                for (int c = 0; c < 64; ++c) a += wr_[c] * tb[(c * cp) & 63];
                wi[(size_t)(768 + np) * 1024 + k] = f2bf(a);
            }
        }
        {
            bf16* wl = WSP(bf16, WS_WLORA + (size_t)l * 2 * MiB);
            const float* w2 = C.P.in[13 + C.z] + (size_t)l * 2 * 64 * 256; const float* a2 = C.P.in[15 + C.z] + (size_t)l * 2 * 64 * 256; const float* g2 = C.P.in[16 + C.z] + (size_t)l * 128 * 256;
            const int kl = (l == 0) ? 384 : KLO;
            for (int i = gth; i < NLO * kl; i += NGT) {
                const int c = i & 255, nb = (i >> 8) % 6, k = i / (256 * 6); float v = 0.f;
                if (nb == 0) { if (k < 64) v = w2[k * 256 + c]; }
                else if (nb == 1) { if (k >= 64 && k < 128) v = w2[(64 + k - 64) * 256 + c]; }
                else if (nb == 2) { if (k >= 128 && k < 192) v = a2[(k - 128) * 256 + c]; }
                else if (nb == 3) { if (k >= 192 && k < 256) v = a2[(64 + k - 192) * 256 + c]; }
                else if (nb == 4) { if (k >= 256 && k < 384) v = g2[(k - 256) * 256 + c]; }
                else if (l == 1 && k >= 384) { const float* v1 = C.P.in[23 + C.z] + (k - 384) * 32; const float* v2 = C.P.in[24 + C.z] + c; for (int j = 0; j < 32; ++j) v += v1[j] * v2[j * 256]; }
                wl[(size_t)(nb * 256 + c) * kl + k] = f2bf(v);
            }
        }
    }
}

template <bool HAS_ADD, bool HAS_OUT>
DI void rowop(const Ctx& C0, int nrows, const float* hin_l, const float* hin_c, float* hout_l, float* hout_c, const bf16* add, int ga, const float* g_add, const float* g_out, int sh, int sc, const float* modl, const float* modo, bf16* Aout) {
    const Ctx C = rectx(C0);
    const int rpw = (nrows + C.G * NWAVES - 1) / (C.G * NWAVES), r0 = (C.bid * NWAVES + C.wave) * rpw, r1 = (r0 + rpw < nrows) ? r0 + rpw : nrows;
    if (r0 >= r1) return;
    const int c0 = 4 * C.lane;
    f32x4 gA[4], gO[4], mG[4], mS[4], mB[4];
#pragma unroll
    for (int j = 0; j < 4; ++j) { if (HAS_ADD) gA[j] = *(const f32x4*)(g_add + c0 + 256 * j); if (HAS_OUT) gO[j] = *(const f32x4*)(g_out + c0 + 256 * j); }
    int bcur = -1;
    f32x4 hn[4]; u32x2 an[4];
#define ROW_HP(t) (((t) < NLAT) ? hin_l + (size_t)(t) * DM : hin_c + (size_t)((t) - NLAT) * DM)
    { const float* hp = ROW_HP(r0);
#pragma unroll
      for (int j = 0; j < 4; ++j) { hn[j] = *(const f32x4*)(hp + c0 + 256 * j); if (HAS_ADD) an[j] = *(const u32x2*)(add + (size_t)r0 * DM + c0 + 256 * j); } }
    for (int tok = r0; tok < r1; ++tok) {
        f32x4 h[4]; u32x2 ar[4];
#pragma unroll
        for (int j = 0; j < 4; ++j) { h[j] = hn[j]; if (HAS_ADD) ar[j] = an[j]; }
        if (tok + 1 < r1) { const float* hp = ROW_HP(tok + 1);
#pragma unroll
            for (int j = 0; j < 4; ++j) { hn[j] = *(const f32x4*)(hp + c0 + 256 * j); if (HAS_ADD) an[j] = *(const u32x2*)(add + (size_t)(tok + 1) * DM + c0 + 256 * j); } }
        const bool lat = tok < NLAT; const int b = lat ? tok / TL : 32;
        if (b != bcur) { bcur = b; const float* mp = modl + (size_t)b * 6144; const float* mq = modo + (size_t)b * 6144;
#pragma unroll
            for (int j = 0; j < 4; ++j) { if (HAS_ADD) mG[j] = *(const f32x4*)(mp + ga * 1024 + c0 + 256 * j); if (HAS_OUT) { mS[j] = *(const f32x4*)(mq + sc * 1024 + c0 + 256 * j) + 1.f; mB[j] = *(const f32x4*)(mq + sh * 1024 + c0 + 256 * j); } } }
        if (HAS_ADD) {
            f32x4 a[4]; float ss = 0.f;
#pragma unroll
            for (int j = 0; j < 4; ++j) { a[j] = (f32x4){lo2f(ar[j].x), hi2f(ar[j].x), lo2f(ar[j].y), hi2f(ar[j].y)}; ss += a[j][0] * a[j][0] + a[j][1] * a[j][1] + a[j][2] * a[j][2] + a[j][3] * a[j][3]; }
            const float rstd = rsqrtf(wave_sum(ss) * (1.f / DM) + 1e-6f);
            float* op = lat ? hout_l + (size_t)tok * DM : hout_c + (size_t)(tok - NLAT) * DM;
#pragma unroll
            for (int j = 0; j < 4; ++j) { h[j] = h[j] + mG[j] * (a[j] * rstd * gA[j]); *(f32x4*)(op + c0 + 256 * j) = h[j]; }
        }
        if (HAS_OUT) {
            float ss = 0.f;
#pragma unroll
            for (int j = 0; j < 4; ++j) ss += h[j][0] * h[j][0] + h[j][1] * h[j][1] + h[j][2] * h[j][2] + h[j][3] * h[j][3];
            const float rstd = rsqrtf(wave_sum(ss) * (1.f / DM) + 1e-6f);
#pragma unroll
            for (int j = 0; j < 4; ++j) { const f32x4 y = (h[j] * rstd * gO[j]) * mS[j] + mB[j]; u32x2 o; o.x = pk(y[0], y[1]); o.y = pk(y[2], y[3]);
                *(u32x2*)(Aout + (size_t)tok * DM + c0 + 256 * j) = o; }
        }
    }
#undef ROW_HP
}

DI void feat1_phase(const Ctx& C0, int l) {
    const Ctx C = rectx(C0);
    const bf16* UR = WSP(bf16, WS_X + X_UR); bf16* F = WSP(bf16, WS_X + X_F); bf16* X2 = WSP(bf16, WS_A);
    const float* mu = C.P.in[11 + C.z] + (size_t)l * 2 * RW;
    const int gth = C.bid * NTHREADS + C.tid, NGT = C.G * NTHREADS, kl = (l == 0) ? 384 : KLO;
    for (int idx = gth; idx < NT * 144; idx += NGT) {
        const int tok = idx / 144, pc = idx - tok * 144, cc = pc * 8;
        const int t = (tok < NLAT) ? (tok & (TL - 1)) : ((tok - NLAT) & (TC - 1)), T = (tok < NLAT) ? TL : TC;
        const bf16* up_ = UR + (size_t)tok * RW + cc;
        const u32x4 u = *(const u32x4*)up_;
        u32x4 p = {0u, 0u, 0u, 0u}, nx = {0u, 0u, 0u, 0u};
        if (t > 0) p = *(const u32x4*)(up_ - RW);
        if (t < T - 1) nx = *(const u32x4*)(up_ + RW);
        const f32x4 m0a = *(const f32x4*)(mu + cc), m0b = *(const f32x4*)(mu + cc + 4), m1a = *(const f32x4*)(mu + RW + cc), m1b = *(const f32x4*)(mu + RW + cc + 4);
        float s[8];
#pragma unroll
        for (int e = 0; e < 8; ++e) { const float uu = (e & 1) ? hi2f(u[e >> 1]) : lo2f(u[e >> 1]), pp = (e & 1) ? hi2f(p[e >> 1]) : lo2f(p[e >> 1]), nn = (e & 1) ? hi2f(nx[e >> 1]) : lo2f(nx[e >> 1]);
            const float m0 = (e < 4) ? m0a[e & 3] : m0b[e & 3], m1 = (e < 4) ? m1a[e & 3] : m1b[e & 3];
            s[e] = uu + m0 * (pp - uu) + m1 * (nn - uu); }
        if (cc >= 768 && cc < 896) {
#pragma unroll
            for (int e = 0; e < 8; ++e) s[e] = tanh_(s[e]); }
        else if (cc >= 1024) {
#pragma unroll
            for (int e = 0; e < 8; ++e) s[e] = sigm(s[e]); }
        u32x4 w; w.x = pk(s[0], s[1]); w.y = pk(s[2], s[3]); w.z = pk(s[4], s[5]); w.w = pk(s[6], s[7]);
        if (cc < 256) *(u32x4*)(F + (size_t)tok * 2048 + cc) = w;
        else if (cc < 512) *(u32x4*)(F + (size_t)tok * 2048 + 768 + cc - 256) = w;
        else if (cc < 768) { *(u32x4*)(F + (size_t)tok * 2048 + 512 + cc - 512) = w; if (l == 1) *(u32x4*)(X2 + (size_t)tok * kl + 384 + cc - 512) = w; }
        else *(u32x4*)(X2 + (size_t)tok * kl + cc - 768) = w;
    }
}
DI void feat3_phase(const Ctx& C0, int l) {
    const Ctx C = rectx(C0);
    bf16* F = WSP(bf16, WS_X + X_F); bf16* Gq = WSP(bf16, WS_X + X_G); bf16* VF = WSP(bf16, WS_VF); float* BON = WSP(float, WS_BON); const bf16* LO = WSP(bf16, WS_X + X_LO);
    const int c = (C.lane >> 4) * 64 + (C.lane & 15) * 4;
    const f32x4 kkw = *(const f32x4*)(C.P.in[17 + C.z] + l * 256 + c), kaw = *(const f32x4*)(C.P.in[18 + C.z] + l * 256 + c), rkw = *(const f32x4*)(C.P.in[19 + C.z] + l * 256 + c);
    const f32x4 w0f = *(const f32x4*)(C.P.in[12 + C.z] + l * 512 + c), w0b = *(const f32x4*)(C.P.in[12 + C.z] + l * 512 + 256 + c), a0f = *(const f32x4*)(C.P.in[14 + C.z] + l * 512 + c), a0b = *(const f32x4*)(C.P.in[14 + C.z] + l * 512 + 256 + c);
    const f32x4 v0c = *(const f32x4*)(C.P.in[22 + C.z] + c);
    const int rpw = NT / (256 * NWAVES), r0 = (C.bid * NWAVES + C.wave) * rpw;
    if (C.bid >= 256) return;
    u32x2 nR, nK, nV, nVF, nL[6];
#define F3_LOAD(t) do { const size_t o_ = (size_t)(t) * 256 + c; const bf16* f_ = F + (size_t)(t) * 2048 + c; nR = *(const u32x2*)(f_); nK = *(const u32x2*)(f_ + 768); nV = *(const u32x2*)(f_ + 512); if (l == 1) nVF = *(const u32x2*)(VF + o_); \
        _Pragma("unroll") for (int q = 0; q < 6; ++q) if (q < 5 || l == 1) nL[q] = *(const u32x2*)(LO + (size_t)(t) * NLO + q * 256 + c); } while (0)
    F3_LOAD(r0);
    for (int tok = r0; tok < r0 + rpw; ++tok) {
        const u32x2 cR = nR, cK = nK, cV = nV, cVF = nVF; u32x2 cL[6];
#pragma unroll
        for (int q = 0; q < 6; ++q) cL[q] = nL[q];
        if (tok + 1 < r0 + rpw) F3_LOAD(tok + 1);
        const size_t o = (size_t)tok * 256 + c;
        const f32x4 r = bf4(cR), k = bf4(cK); f32x4 v = bf4(cV);
        if (l == 1) { const f32x4 vf = bf4(cVF), z = v0c + bf4(cL[5]);
#pragma unroll
            for (int e = 0; e < 4; ++e) v[e] = v[e] + (vf[e] - v[e]) * sigm(z[e]);
            *(u32x2*)(F + (size_t)tok * 2048 + 512 + c) = pk4(v); }
        else *(u32x2*)(VF + o) = cV;
        const f32x4 kr = k * kkw;
        const float ss = row16_sum(kr[0] * kr[0] + kr[1] * kr[1] + kr[2] * kr[2] + kr[3] * kr[3]), rn = rsqrtf(fmaxf(ss, 1e-24f));
        const f32x4 lf = w0f + bf4(cL[0]), lb = w0b + bf4(cL[1]), xf = a0f + bf4(cL[2]), xb = a0b + bf4(cL[3]);
        f32x4 ef, eb, af, ab; float bp = 0.f;
#pragma unroll
        for (int e = 0; e < 4; ++e) { ef[e] = 0.6065306597126334f * sigm(lf[e]); eb[e] = 0.6065306597126334f * sigm(lb[e]); af[e] = sigm(xf[e]); ab[e] = sigm(xb[e]);
            bp += r[e] * k[e] * (1.f + (0.5f * (af[e] + ab[e]) - 1.f) * kaw[e]) * rkw[e]; }
        const float bon = row16_sum(bp);
        if ((C.lane & 15) == 0) BON[(size_t)tok * 4 + (C.lane >> 4)] = bon;
        { bf16* f_ = F + (size_t)tok * 2048 + c; *(u32x2*)(f_ + 256) = pk4(kr * rn); *(u32x2*)(f_ + 1024) = pk4(ef); *(u32x2*)(f_ + 1280) = pk4(eb); *(u32x2*)(f_ + 1536) = pk4(af); *(u32x2*)(f_ + 1792) = pk4(ab); }
        *(u32x2*)(Gq + o) = cL[4];
    }
#undef F3_LOAD
}

struct ScanOp { bf16 r, kk, k, e, a, v; };
DI int scan_tok(int n, int dir, int b) { n = n < 2303 ? n : 2303; if (n < 256) return CTXB + b * 256 + (dir ? 255 - n : n); const int t = n - 256; return b * TL + (dir ? TL - 1 - t : t); }
DI ScanOp scan_load(const bf16* Ft, int dir, unsigned ck, unsigned cv) {
    ScanOp o; o.r = Ft[ck]; o.kk = Ft[256 + ck]; o.k = Ft[768 + ck]; o.e = (Ft + (4 + dir) * 256)[ck]; o.a = (Ft + (6 + dir) * 256)[ck]; o.v = Ft[512 + cv]; return o;
}
#define DPPT " row_mask:0xf bank_mask:0xf\n\t"
#define SOPS(S) "+v"(S[0]), "+v"(S[1]), "+v"(S[2]), "+v"(S[3]), "+v"(S[4]), "+v"(S[5]), "+v"(S[6]), "+v"(S[7]), "+v"(S[8]), "+v"(S[9]), "+v"(S[10]), "+v"(S[11]), "+v"(S[12]), "+v"(S[13]), "+v"(S[14]), "+v"(S[15])
struct ScanVec { float w, kd, nbd, r, v; };
DI ScanVec scan_conv(const ScanOp& op, float ka, float& kk_out) {
    const float kk = bf2f(op.kk), k = bf2f(op.k), e = bf2f(op.e), a = bf2f(op.a);
    ScanVec c; c.r = bf2f(op.r); c.v = bf2f(op.v); c.w = fexp2(-e * LOG2E); c.kd = k * (1.f + (a - 1.f) * ka); c.nbd = -(kk * a); kk_out = kk; return c;
}
DI void scan_step(float (&S)[16], float& sa, ScanVec& cur, const ScanOp& nxt, float ka, bf16* yp, bool wr) {
    const float w = cur.w, nbd = cur.nbd, kd = cur.kd, v = cur.v;
#define UPM(j) "v_mul_f32_dpp %" #j ", %16, %" #j " row_newbcast:" #j DPPT
#define UPA(j) "v_fmac_f32_dpp %" #j ", %17, %19 row_newbcast:" #j DPPT
#define UPB(j) "v_fmac_f32_dpp %" #j ", %18, %20 row_newbcast:" #j DPPT
#define ALL16(M) M(0) M(1) M(2) M(3) M(4) M(5) M(6) M(7) M(8) M(9) M(10) M(11) M(12) M(13) M(14) M(15)
    asm volatile(ALL16(UPM) ALL16(UPA) ALL16(UPB) : SOPS(S) : "v"(w), "v"(nbd), "v"(kd), "v"(sa), "v"(v));
#undef UPM
#undef UPA
#undef UPB
    float kkn; ScanVec nx = scan_conv(nxt, ka, kkn);
    float r = cur.r;
    asm volatile("s_nop 1" : "+v"(r), "+v"(kkn), "+v"(nx.w), "+v"(nx.kd), "+v"(nx.nbd), "+v"(nx.r));
    float y0, y1, s0, s1;
    asm volatile(
        "v_mul_f32_dpp %0, %20, %4 row_newbcast:0" DPPT "v_mul_f32_dpp %2, %21, %4 row_newbcast:0" DPPT "v_mul_f32_dpp %1, %20, %5 row_newbcast:1" DPPT "v_mul_f32_dpp %3, %21, %5 row_newbcast:1" DPPT
        "v_fmac_f32_dpp %0, %20, %6 row_newbcast:2" DPPT "v_fmac_f32_dpp %2, %21, %6 row_newbcast:2" DPPT
        "v_fmac_f32_dpp %1, %20, %7 row_newbcast:3" DPPT "v_fmac_f32_dpp %3, %21, %7 row_newbcast:3" DPPT
        "v_fmac_f32_dpp %0, %20, %8 row_newbcast:4" DPPT "v_fmac_f32_dpp %2, %21, %8 row_newbcast:4" DPPT
        "v_fmac_f32_dpp %1, %20, %9 row_newbcast:5" DPPT "v_fmac_f32_dpp %3, %21, %9 row_newbcast:5" DPPT
        "v_fmac_f32_dpp %0, %20, %10 row_newbcast:6" DPPT "v_fmac_f32_dpp %2, %21, %10 row_newbcast:6" DPPT
        "v_fmac_f32_dpp %1, %20, %11 row_newbcast:7" DPPT "v_fmac_f32_dpp %3, %21, %11 row_newbcast:7" DPPT
        "v_fmac_f32_dpp %0, %20, %12 row_newbcast:8" DPPT "v_fmac_f32_dpp %2, %21, %12 row_newbcast:8" DPPT
        "v_fmac_f32_dpp %1, %20, %13 row_newbcast:9" DPPT "v_fmac_f32_dpp %3, %21, %13 row_newbcast:9" DPPT
        "v_fmac_f32_dpp %0, %20, %14 row_newbcast:10" DPPT "v_fmac_f32_dpp %2, %21, %14 row_newbcast:10" DPPT
        "v_fmac_f32_dpp %1, %20, %15 row_newbcast:11" DPPT "v_fmac_f32_dpp %3, %21, %15 row_newbcast:11" DPPT
        "v_fmac_f32_dpp %0, %20, %16 row_newbcast:12" DPPT "v_fmac_f32_dpp %2, %21, %16 row_newbcast:12" DPPT
        "v_fmac_f32_dpp %1, %20, %17 row_newbcast:13" DPPT "v_fmac_f32_dpp %3, %21, %17 row_newbcast:13" DPPT
        "v_fmac_f32_dpp %0, %20, %18 row_newbcast:14" DPPT "v_fmac_f32_dpp %2, %21, %18 row_newbcast:14" DPPT
        "v_fmac_f32_dpp %1, %20, %19 row_newbcast:15" DPPT "v_fmac_f32_dpp %3, %21, %19 row_newbcast:15" DPPT
        : "=&v"(y0), "=&v"(y1), "=&v"(s0), "=&v"(s1)
        : "v"(S[0]), "v"(S[1]), "v"(S[2]), "v"(S[3]), "v"(S[4]), "v"(S[5]), "v"(S[6]), "v"(S[7]), "v"(S[8]), "v"(S[9]), "v"(S[10]), "v"(S[11]), "v"(S[12]), "v"(S[13]), "v"(S[14]), "v"(S[15]), "v"(r), "v"(kkn));
    const float y = allred4(y0 + y1); sa = allred4(s0 + s1);
    if (wr) *yp = f2bf(y);
    cur = nx;
}
DI void scan_run(const Ctx& C0, int l, int b, int h, int dir) {
    const Ctx C = rectx(C0);
    if (C.wave >= 4) {
        if (l == 0) weights_tr(C, 1, C.bid * 4 + (C.wave - 4), C.G * 4, (LAS float*)(C.lds + 49152 + C.wave * 8704));
        return; }
    const int wv = C.wave & 3, q = C.lane >> 4, vi = C.lane & 15;
    const unsigned ck = h * 64 + C.lane, cv = h * 64 + 16 * wv + vi;
    const bf16* F = WSP(bf16, WS_X + X_F);
    bf16* YS = WSP(bf16, WS_X + X_UR) + (size_t)dir * FSZ;
    const float ka = C.P.in[18 + C.z][l * 256 + ck];
    float S[16];
#pragma unroll
    for (int j = 0; j < 16; ++j) S[j] = 0.f;
    const bool wr = (q == 0);
    size_t t0 = (size_t)scan_tok(0, dir, b) * 256, t1 = (size_t)scan_tok(1, dir, b) * 256, t2 = (size_t)scan_tok(2, dir, b) * 256, t3 = (size_t)scan_tok(3, dir, b) * 256;
    ScanOp o0 = scan_load(F + t0 * 8, dir, ck, cv), o1 = scan_load(F + t1 * 8, dir, ck, cv), o2 = scan_load(F + t2 * 8, dir, ck, cv), o3 = scan_load(F + t3 * 8, dir, ck, cv);
    float sa = 0.f, kk0_; ScanVec cur = scan_conv(o0, ka, kk0_);
    asm volatile("s_nop 1" : "+v"(cur.w), "+v"(cur.kd), "+v"(cur.nbd), "+v"(cur.r));
    for (int n = 0; n < 2304; n += 4) {
        size_t tn;
        scan_step(S, sa, cur, o1, ka, &(YS + t0)[cv], wr); tn = (size_t)__builtin_amdgcn_readfirstlane(scan_tok(n + 4, dir, b)) * 256; o0 = scan_load(F + tn * 8, dir, ck, cv); t0 = tn;
        scan_step(S, sa, cur, o2, ka, &(YS + t1)[cv], wr); tn = (size_t)__builtin_amdgcn_readfirstlane(scan_tok(n + 5, dir, b)) * 256; o1 = scan_load(F + tn * 8, dir, ck, cv); t1 = tn;
        scan_step(S, sa, cur, o3, ka, &(YS + t2)[cv], wr); tn = (size_t)__builtin_amdgcn_readfirstlane(scan_tok(n + 6, dir, b)) * 256; o2 = scan_load(F + tn * 8, dir, ck, cv); t2 = tn;
        scan_step(S, sa, cur, o0, ka, &(YS + t3)[cv], wr); tn = (size_t)__builtin_amdgcn_readfirstlane(scan_tok(n + 7, dir, b)) * 256; o3 = scan_load(F + tn * 8, dir, ck, cv); t3 = tn;
    }
}

DI void readout_phase(const Ctx& C0, int l, int nrows) {
    const Ctx C = rectx(C0);
    const bf16* F = WSP(bf16, WS_X + X_F); const bf16* Gq = WSP(bf16, WS_X + X_G); const bf16* YS = WSP(bf16, WS_X + X_UR); const float* BON = WSP(float, WS_BON);
    bf16* YR = WSP(bf16, WS_A + (size_t)108 * MiB);
    const int c = (C.lane >> 4) * 64 + (C.lane & 15) * 4;
    const f32x4 lw = *(const f32x4*)(C.P.in[20 + C.z] + l * 256 + c), lb = *(const f32x4*)(C.P.in[21 + C.z] + l * 256 + c);
    const int rpw = (nrows + C.G * NWAVES - 1) / (C.G * NWAVES), r0 = (C.bid * NWAVES + C.wave) * rpw, r1 = (r0 + rpw < nrows) ? r0 + rpw : nrows;
    if (r0 >= r1) return;
    u32x2 nF, nB, nV, nG; float nBon;
#define RO_LOAD(t) do { const size_t o_ = (size_t)(t) * 256 + c; nF = *(const u32x2*)(YS + o_); nB = *(const u32x2*)(YS + FSZ + o_); nV = *(const u32x2*)(F + (size_t)(t) * 2048 + 512 + c); nG = *(const u32x2*)(Gq + o_); nBon = BON[(size_t)(t) * 4 + (C.lane >> 4)]; } while (0)
    RO_LOAD(r0);
    for (int tok = r0; tok < r1; ++tok) {
        const u32x2 cF = nF, cB = nB, cV = nV, cG = nG; const float bon = nBon;
        if (tok + 1 < r1) RO_LOAD(tok + 1);
        const f32x4 y = bf4(cF) + bf4(cB);
        const float mean = row16_sum(y[0] + y[1] + y[2] + y[3]) * (1.f / 64.f);
        const f32x4 d = y - mean;
        const float var = row16_sum(d[0] * d[0] + d[1] * d[1] + d[2] * d[2] + d[3] * d[3]) * (1.f / 64.f);
        const f32x4 yn = d * rsqrtf(var + 64e-5f) * lw + lb;
        *(u32x2*)(YR + (size_t)tok * 256 + c) = pk4((yn + bf4(cV) * bon) * bf4(cG));
    }
#undef RO_LOAD
}

DI void fixup_phase(const Ctx& C0, int l, int nrows) {
    const Ctx C = rectx(C0);
    const int gw = C.bid * NWAVES + C.wave, NGW = C.G * NWAVES, nitem = (nrows / 64) * 2;
    const bf16* HALO = WSP(bf16, WS_X + X_HALO); bf16* HH = WSP(bf16, WS_X + X_HH);
    const float* cw = C.P.in[31 + C.z] + (size_t)l * 3 * DFF; const float* cb = C.P.in[32 + C.z] + (size_t)l * DFF;
    for (int it = gw; it < nitem; it += NGW) {
        const int grp = it >> 1, last = it & 1, row = grp * 64 + (last ? 63 : 0);
        const int t = (row < NLAT) ? (row & (TL - 1)) : ((row - NLAT) & (TC - 1)), T = (row < NLAT) ? TL : TC;
        const bf16* hb = HALO + (size_t)grp * 6 * DFF;
        const bf16 *pp, *pc, *pn, *pv; bool zp = false, zn = false;
        if (!last) { pc = hb; pn = hb + DFF; pv = hb + 4 * DFF; zp = (t == 0); pp = zp ? hb : hb - 6 * DFF + 3 * DFF; }
        else { pp = hb + 2 * DFF; pc = hb + 3 * DFF; pv = hb + 5 * DFF; zn = (t == T - 1); pn = zn ? hb : hb + 6 * DFF; }
        for (int p = C.lane; p < DFF / 8; p += 64) { const int j = p * 8;
            const u32x4 a = *(const u32x4*)(pp + j), bq = *(const u32x4*)(pc + j), cq = *(const u32x4*)(pn + j), vq = *(const u32x4*)(pv + j);
            float o[8];
#pragma unroll
            for (int e = 0; e < 8; ++e) { const unsigned ua = a[e >> 1], ub = bq[e >> 1], uc = cq[e >> 1], uv = vq[e >> 1];
                const float xp = zp ? 0.f : ((e & 1) ? hi2f(ua) : lo2f(ua)), xc = (e & 1) ? hi2f(ub) : lo2f(ub), xn = zn ? 0.f : ((e & 1) ? hi2f(uc) : lo2f(uc)), xv = (e & 1) ? hi2f(uv) : lo2f(uv);
                const float z = cw[j + e] * xp + cw[DFF + j + e] * xc + cw[2 * DFF + j + e] * xn + cb[j + e]; o[e] = gelu_tanh(z) * xv; }
            u32x4 w; w.x = pk(o[0], o[1]); w.y = pk(o[2], o[3]); w.z = pk(o[4], o[5]); w.w = pk(o[6], o[7]);
            *(u32x4*)(HH + (size_t)row * DFF + j) = w; }
    }
}

DI int crow(int i, int hh) { return (i & 3) + 8 * (i >> 2) + 4 * hh; }
DI void attn_unit(const Ctx& C, int l, int b, int kh, int qblk, bool isctx) {
    LAS bf16* Ks = (LAS bf16*)C.lds; LAS bf16* Vt = Ks + 64 * 72;
    const bf16* QKV = WSP(bf16, WS_X + X_QKV); bf16* YA = WSP(bf16, WS_A); const float* RT = WSP(float, WS_SMALL);
    const int g = C.wave >> 1, qt = C.wave & 1, hq = kh * 4 + g, r = C.lane & 31, hh = C.lane >> 5;
    const int qi = qblk * 64 + qt * 32 + r;
    const size_t tq = isctx ? (size_t)(CTXB + b * TC + qi) : (size_t)(b * TL + qi);
    bf16x8 qf[4];
    {
        float qv[4][8]; const bf16* qp = QKV + tq * 768 + hq * 64 + 8 * hh;
#pragma unroll
        for (int ks = 0; ks < 4; ++ks) { const u32x4 u = *(const u32x4*)(qp + 16 * ks);
#pragma unroll
            for (int e = 0; e < 4; ++e) { qv[ks][2 * e] = lo2f(u[e]); qv[ks][2 * e + 1] = hi2f(u[e]); } }
        if (!isctx) { const int rid = qi >> 6, cid = qi & 63;
#pragma unroll
            for (int j = 0; j < 8; ++j) { const int f = 8 * hh + j;
                const float c0 = RT[(rid * 16 + f) * 2], s0 = RT[(rid * 16 + f) * 2 + 1], c1 = RT[(cid * 16 + f) * 2], s1 = RT[(cid * 16 + f) * 2 + 1];
                const float a1 = qv[0][j], a2 = qv[1][j], b1 = qv[2][j], b2 = qv[3][j];
                qv[0][j] = a1 * c0 - a2 * s0; qv[1][j] = a2 * c0 + a1 * s0; qv[2][j] = b1 * c1 - b2 * s1; qv[3][j] = b2 * c1 + b1 * s1; } }
        const float sc = 0.125f * LOG2E;
#pragma unroll
        for (int ks = 0; ks < 4; ++ks) { u32x4 w; w.x = pk(qv[ks][0] * sc, qv[ks][1] * sc); w.y = pk(qv[ks][2] * sc, qv[ks][3] * sc); w.z = pk(qv[ks][4] * sc, qv[ks][5] * sc); w.w = pk(qv[ks][6] * sc, qv[ks][7] * sc); qf[ks] = __builtin_bit_cast(bf16x8, w); }
    }
    float m_run = C.P.in[25 + C.z][l * 8 + hq] * LOG2E, l_run = hh == 0 ? 1.f : 0.f;
    f32x16 o0, o1;
#pragma unroll
    for (int i = 0; i < 16; ++i) { o0[i] = 0.f; o1[i] = 0.f; }
    const int nch = isctx ? 4 : 9, skey = C.tid >> 3, oct = C.tid & 7;
#define ATT_VALID(c_) ((c_) < 4 || (qblk * 64 - 128 + ((c_) - 4) * 64 >= 0 && qblk * 64 - 128 + ((c_) - 4) * 64 < TL))
#define ATT_LOAD(c_) do { const size_t kt_ = ((c_) < 4) ? (size_t)(CTXB + b * TC + (c_) * 64) : (size_t)(b * TL + qblk * 64 - 128 + ((c_) - 4) * 64); \
        const bf16* kp_ = QKV + (kt_ + skey) * 768 + 512 + kh * 64; pk_u = *(const u32x4*)(kp_ + 8 * oct); pk_p = *(const u32x4*)(kp_ + 8 * (oct ^ 2)); pk_v = *(const u32x4*)(kp_ + 128 + 8 * oct); } while (0)
    u32x4 pk_u, pk_p, pk_v;
    int ch = 0;
    ATT_LOAD(0);
    while (ch < nch) {
        const bool win = ch >= 4; const int kb = win ? qblk * 64 - 128 + (ch - 4) * 64 : 0;
        __syncthreads();
        {
            u32x4 ku = pk_u;
            if (win) { const u32x4 pu = pk_p;
                const int p = kb + skey, pos = (oct >> 2) ? (p & 63) : (p >> 6), fb = 8 * (oct & 1); const bool isx1 = (oct & 2) == 0;
                float o[8];
#pragma unroll
                for (int e = 0; e < 8; ++e) { const float own = (e & 1) ? hi2f(ku[e >> 1]) : lo2f(ku[e >> 1]), par = (e & 1) ? hi2f(pu[e >> 1]) : lo2f(pu[e >> 1]);
                    const float cc = RT[(pos * 16 + fb + e) * 2], ss = RT[(pos * 16 + fb + e) * 2 + 1];
                    o[e] = isx1 ? (own * cc - par * ss) : (own * cc + par * ss); }
                ku.x = pk(o[0], o[1]); ku.y = pk(o[2], o[3]); ku.z = pk(o[4], o[5]); ku.w = pk(o[6], o[7]); }
            *(LAS u32x4*)(Ks + skey * 72 + 8 * oct) = ku;
            const u32x4 vu = pk_v;
#pragma unroll
            for (int e = 0; e < 8; ++e) Vt[(8 * oct + e) * 72 + skey] = (bf16)((e & 1) ? (vu[e >> 1] >> 16) : (vu[e >> 1] & 0xffffu));
        }
        __syncthreads();
        int nxc = ch + 1;
        while (nxc < nch && !ATT_VALID(nxc)) ++nxc;
        if (nxc < nch) ATT_LOAD(nxc);
        f32x16 x0, x1;
#pragma unroll
        for (int i = 0; i < 16; ++i) { x0[i] = 0.f; x1[i] = 0.f; }
#pragma unroll
        for (int ks = 0; ks < 4; ++ks) {
            const bf16x8 a0 = *(const LAS bf16x8*)(Ks + r * 72 + 16 * ks + 8 * hh), a1 = *(const LAS bf16x8*)(Ks + (32 + r) * 72 + 16 * ks + 8 * hh);
            x0 = __builtin_amdgcn_mfma_f32_32x32x16_bf16(a0, qf[ks], x0, 0, 0, 0);
            x1 = __builtin_amdgcn_mfma_f32_32x32x16_bf16(a1, qf[ks], x1, 0, 0, 0);
        }
        if (win) {
#pragma unroll
            for (int i = 0; i < 16; ++i) { const int k0 = kb + crow(i, hh), d0 = qi - k0, d1 = d0 - 32;
                if (d0 > 128 || d0 < -128) x0[i] = -1e30f; if (d1 > 128 || d1 < -128) x1[i] = -1e30f; }
        }
        float mx = x0[0];
#pragma unroll
        for (int i = 0; i < 16; ++i) { mx = fmaxf(mx, x0[i]); mx = fmaxf(mx, x1[i]); }
        mx = fmaxf(mx, __shfl_xor(mx, 32));
        const float m_new = fmaxf(m_run, mx), alpha = fexp2(m_run - m_new);
        float ps = 0.f;
#pragma unroll
        for (int i = 0; i < 16; ++i) { x0[i] = fexp2(x0[i] - m_new); x1[i] = fexp2(x1[i] - m_new); ps += x0[i] + x1[i]; o0[i] *= alpha; o1[i] *= alpha; }
        l_run = l_run * alpha + ps; m_run = m_new;
#pragma unroll
        for (int kt = 0; kt < 2; ++kt)
#pragma unroll
            for (int s = 0; s < 2; ++s) {
                const f32x16& x = kt ? x1 : x0;
                u32x4 w; w.x = pk(x[8 * s], x[8 * s + 1]); w.y = pk(x[8 * s + 2], x[8 * s + 3]); w.z = pk(x[8 * s + 4], x[8 * s + 5]); w.w = pk(x[8 * s + 6], x[8 * s + 7]);
                const bf16x8 pb = __builtin_bit_cast(bf16x8, w);
                const int ko = kt * 32 + 16 * s + 4 * hh;
                const s16x4 l0 = *(const LAS s16x4*)(Vt + r * 72 + ko), h0 = *(const LAS s16x4*)(Vt + r * 72 + ko + 8);
                const s16x4 l1 = *(const LAS s16x4*)(Vt + (32 + r) * 72 + ko), h1 = *(const LAS s16x4*)(Vt + (32 + r) * 72 + ko + 8);
                o0 = __builtin_amdgcn_mfma_f32_32x32x16_bf16(__builtin_shufflevector(l0, h0, 0, 1, 2, 3, 4, 5, 6, 7), pb, o0, 0, 0, 0);
                o1 = __builtin_amdgcn_mfma_f32_32x32x16_bf16(__builtin_shufflevector(l1, h1, 0, 1, 2, 3, 4, 5, 6, 7), pb, o1, 0, 0, 0);
            }
        ch = nxc;
    }
#undef ATT_VALID
#undef ATT_LOAD
    const float inv = frcp(l_run + __shfl_xor(l_run, 32));
    bf16* op = YA + tq * 512 + hq * 64 + 4 * hh;
#pragma unroll
    for (int i4 = 0; i4 < 4; ++i4) {
        u32x2 w0, w1; w0.x = pk(o0[4 * i4] * inv, o0[4 * i4 + 1] * inv); w0.y = pk(o0[4 * i4 + 2] * inv, o0[4 * i4 + 3] * inv);
        w1.x = pk(o1[4 * i4] * inv, o1[4 * i4 + 1] * inv); w1.y = pk(o1[4 * i4 + 2] * inv, o1[4 * i4 + 3] * inv);
        *(u32x2*)(op + 8 * i4) = w0; *(u32x2*)(op + 32 + 8 * i4) = w1;
    }
}
DI void attn_loop(const Ctx& C0, int l) {
    const Ctx C = rectx(C0);
    unsigned* ctr = WSP(unsigned, WS_CTL) + 64 * (l + 1);
    volatile LAS unsigned* slot = (volatile LAS unsigned*)(C.lds + 32768);
    const unsigned NU = 2048u + (l == 0 ? 256u : 0u);
    for (;;) {
        __syncthreads();
        if (C.tid == 0) *slot = atomicAdd(ctr, 1u);
        __syncthreads();
        const unsigned u = *slot;
        if (u >= NU) break;
        if (u < 2048u) attn_unit(C, l, (int)(u >> 6), (int)((u >> 5) & 1), (int)(u & 31), false);
        else { const unsigned v = u - 2048u; attn_unit(C, l, (int)(v >> 3), (int)((v >> 2) & 1), (int)(v & 3), true); }
    }
}


#ifdef DBG
DI float exp_f(float x) { return fexp2(x * LOG2E); }
DI unsigned hsh(unsigned x) { x ^= x >> 16; x *= 0x7feb352du; x ^= x >> 15; x *= 0x846ca68bu; x ^= x >> 16; return x; }
DI void dbg_put(const Ctx& C, int k, float got, float ref, float S) {
    float err = fabsf(got - ref) / (fabsf(ref) + S); if (!(err == err)) err = 1e9f;
    atomicMax(WSP(unsigned, WS_CTL) + 1024 + k, __builtin_bit_cast(unsigned, err));
}
DI float ndot(const bf16* a, const bf16* b, int K) { float s = 0.f; for (int k = 0; k < K; ++k) s += bf2f(a[k]) * bf2f(b[k]); return s; }
DI void dbg_check(const Ctx& C0, int stage, int l) {
    if (C0.bid != 0 || l != 0) return;
    const Ctx C = rectx(C0);
    const unsigned h1 = hsh(C.tid * 3u + 17u + stage * 1000u), h2 = hsh(h1 + 0x9e3779b9u), h3 = hsh(h2 + 77u);
    const Params& P = C.P;
    if (stage == 0) {
        {
            const int n = h1 % 2432, k = h2 % 1024; int src = -1;
            if (n < 512) src = 1152 + n; else if (n < 640) src = 1664 + (n - 512); else if (n < 768) src = 1792 + (n - 640); else if (n >= 1280) src = n - 1280;
            if (src >= 0) dbg_put(C, 0, bf2f(WL(bf16, 0, WL_IN)[(size_t)n * 1024 + k]), bf2f(f2bf(P.in[10 + C.z][(size_t)k * IN_COLS + src])), 1e-6f);
            const int ng = h3 % 3072;
            dbg_put(C, 0, bf2f(WL(bf16, 0, WL_G)[(size_t)ng * 1024 + k]), bf2f(f2bf(P.in[10 + C.z][(size_t)k * IN_COLS + 2176 + ng])), 1e-6f);
            const int nu = h3 % 5632, pn = nu >> 8, bj = (nu >> 7) & 1, j = nu & 127;
            dbg_put(C, 0, bf2f(WL(bf16, 0, WL_UP)[(size_t)nu * 1024 + k]), bf2f(f2bf(P.in[30 + C.z][(size_t)k * 5632 + bj * DFF + pn * 128 + j])), 1e-6f);
            const int nd = h1 % 1024, kd = h3 % DFF;
            dbg_put(C, 0, bf2f(WL(bf16, 0, WL_DN)[(size_t)nd * DFF + kd]), bf2f(f2bf(P.in[33 + C.z][(size_t)kd * 1024 + nd])), 1e-6f);
            dbg_put(C, 0, bf2f(WL(bf16, 0, WL_O)[(size_t)nd * 1024 + k]), bf2f(f2bf(P.in[29 + C.z][(size_t)k * 1024 + nd])), 1e-6f);
            dbg_put(C, 0, bf2f(WL(bf16, 0, WL_BA)[(size_t)nd * 512 + (k & 511)]), bf2f(f2bf(P.in[27 + C.z][(size_t)(k & 511) * 1024 + nd])), 1e-6f);
            dbg_put(C, 0, bf2f(WL(bf16, 0, WL_BR)[(size_t)nd * 256 + (k & 255)]), bf2f(f2bf(P.in[26 + C.z][(size_t)(k & 255) * 1024 + nd])), 1e-6f);
        }
        {
            const int r = h1 % 33, j = h2 % 6144; float a = P.in[5 + C.z][j];
            for (int k = 0; k < 1024; ++k) { const float cv = (r < 32) ? P.in[1 + C.z][r * 1024 + k] : P.in[3 + C.z][k]; a += cv / (1.f + exp_f(-cv)) * P.in[4 + C.z][(size_t)k * 6144 + j]; }
            dbg_put(C, 1, WSP(float, WS_MOD)[(size_t)r * 6144 + j], a, 0.01f);
        }
    } else if (stage == 1) {
        const int tok = h1 % NT, col = h2 % 1024; const bool lat = tok < NLAT; const float* hp = lat ? P.in[0 + C.z] + (size_t)tok * DM : P.in[2 + C.z] + (size_t)(tok - NLAT) * DM;
        float ss = 0.f; for (int k = 0; k < 1024; ++k) ss += hp[k] * hp[k];
        const float* mp = WSP(float, WS_MOD) + (size_t)(lat ? tok / TL : 32) * 6144;
        const float ref = hp[col] * rsqrtf(ss / 1024.f + 1e-6f) * P.in[6 + C.z][col] * (1.f + mp[1024 + col]) + mp[col];
        dbg_put(C, 2, bf2f(WSP(bf16, WS_A)[(size_t)tok * DM + col]), ref, 0.05f);
    } else if (stage == 2) {
        const int tok = h1 % NT, n = h2 % 2432; const float ref = ndot(WSP(bf16, WS_A) + (size_t)tok * DM, WL(bf16, 0, WL_IN) + (size_t)n * 1024, 1024);
        float got; int k;
        if (n < 768) { got = bf2f(WSP(bf16, WS_X + X_QKV)[(size_t)tok * 768 + n]); k = 3; }
        else if (n < 1280) { const int sn = (n - 768) >> 8, ch = (n - 768) & 255; k = 4;
            if (tok < NLAT) got = bf2f(WSP(bf16, WS_X + X_ZT)[((size_t)(tok / TL) * 256 + ch) * 4096 + sn * 2048 + (tok % TL)]);
            else got = bf2f(WSP(bf16, WS_X + X_ZTC)[((size_t)((tok - NLAT) / TC) * 256 + ch) * 512 + sn * 256 + ((tok - NLAT) % TC)]); }
        else { got = bf2f(WSP(bf16, WS_X + X_UR)[(size_t)tok * RW + n - 1280]); k = 5; }
        dbg_put(C, k, got, ref, 0.1f);
    } else if (stage == 3) {
        const int b = h1 % 32, t = 1 + h2 % 2046, c = h3 % 256; const size_t tok = (size_t)b * TL + t; const bf16* UR = WSP(bf16, WS_X + X_UR);
        const float u = bf2f(UR[tok * RW + c]), up = bf2f(UR[(tok - 1) * RW + c]), un = bf2f(UR[(tok + 1) * RW + c]);
        dbg_put(C, 7, bf2f(WSP(bf16, WS_X + X_F)[tok * 2048 + c]), u + P.in[11 + C.z][c] * (up - u) + P.in[11 + C.z][RW + c] * (un - u), 0.05f);
        float ss = 0.f; for (int k = 0; k < 64; ++k) { const float x = bf2f(WSP(bf16, WS_X + X_F)[tok * 2048 + 256 + (c & 192) + k]); ss += x * x; }
        dbg_put(C, 7, ss, 1.f, 0.f);
    } else if (stage == 4) {
        {
            LAS float* S = (LAS float*)C.lds; LAS float* sa = S + 4096; const bf16* F = WSP(bf16, WS_X + X_F); const int b = 1, h = 2;
            for (int dir = 0; dir < 2; ++dir) {
                for (int e = C.tid; e < 4096; e += NTHREADS) S[e] = 0.f;
                __syncthreads();
                for (int n = 0; n < 24; ++n) {
                    const size_t oy = (size_t)scan_tok(n, dir, b) * 256 + h * 64, o = (size_t)scan_tok(n, dir, b) * 2048 + h * 64;
                    if (C.tid < 64) { float a = 0.f; for (int k = 0; k < 64; ++k) a -= S[C.tid * 64 + k] * bf2f(F[256 + o + k]); sa[C.tid] = a; }
                    __syncthreads();
                    for (int e = C.tid; e < 4096; e += NTHREADS) { const int v = e >> 6, k = e & 63;
                        const float kk = bf2f(F[256 + o + k]), kr = bf2f(F[768 + o + k]), ee = bf2f(F[(4 + dir) * 256 + o + k]), a = bf2f(F[(6 + dir) * 256 + o + k]), vv = bf2f(F[512 + o + v]);
                        S[e] = S[e] * exp_f(-ee) + sa[v] * (kk * a) + vv * (kr * (1.f + (a - 1.f) * P.in[18 + C.z][h * 64 + k])); }
                    __syncthreads();
                    if (C.tid < 64) { float y = 0.f; for (int k = 0; k < 64; ++k) y += S[C.tid * 64 + k] * bf2f(F[o + k]);
                        dbg_put(C, 8, bf2f(WSP(bf16, WS_X + X_UR)[(size_t)dir * FSZ + oy + C.tid]), y, 0.05f); }
                    __syncthreads();
                }
            }
        }
        {
            LAS float* qs = (LAS float*)C.lds + (size_t)C.tid * 65; const bf16* QKV = WSP(bf16, WS_X + X_QKV);
            const int b = h1 % 32, t = (C.tid & 1) ? (int)(h2 % 2048) : ((C.tid & 2) ? (int)(h2 % 200) : 2047 - (int)(h2 % 200)), hq = h3 % 8, dd = (h3 >> 8) % 64, kh = hq >> 2;
            const size_t tq = (size_t)b * TL + t;
            for (int d = 0; d < 64; ++d) { const int ax = d >> 5, hf = (d >> 4) & 1, f = d & 15; const int ps = ax ? (t & 63) : (t >> 6); const float cs = WSP(float, WS_SMALL)[(ps * 16 + f) * 2], sn = WSP(float, WS_SMALL)[(ps * 16 + f) * 2 + 1];
                const float x1 = bf2f(QKV[tq * 768 + hq * 64 + ax * 32 + f]), x2 = bf2f(QKV[tq * 768 + hq * 64 + ax * 32 + 16 + f]);
                qs[d] = hf ? (x2 * cs + x1 * sn) : (x1 * cs - x2 * sn); }
            float m = P.in[25 + C.z][hq], den = 1.f, acc = 0.f;
            for (int j = 0; j < 256 + 257; ++j) {
                const bool win = j >= 256; const int kp = win ? t - 128 + (j - 256) : j; if (win && (kp < 0 || kp >= TL)) continue;
                const size_t tk = win ? (size_t)b * TL + kp : (size_t)(CTXB + b * TC + kp); float s = 0.f;
                for (int d = 0; d < 64; ++d) { float kv;
                    if (!win) kv = bf2f(QKV[tk * 768 + 512 + kh * 64 + d]);
                    else { const int ax = d >> 5, hf = (d >> 4) & 1, f = d & 15; const int ps = ax ? (kp & 63) : (kp >> 6); const float cs = WSP(float, WS_SMALL)[(ps * 16 + f) * 2], sn = WSP(float, WS_SMALL)[(ps * 16 + f) * 2 + 1];
                        const float x1 = bf2f(QKV[tk * 768 + 512 + kh * 64 + ax * 32 + f]), x2 = bf2f(QKV[tk * 768 + 512 + kh * 64 + ax * 32 + 16 + f]);
                        kv = hf ? (x2 * cs + x1 * sn) : (x1 * cs - x2 * sn); }
                    s += qs[d] * kv; }
                s *= 0.125f; const float mn = fmaxf(m, s), al = exp_f(m - mn), p = exp_f(s - mn);
                den = den * al + p; acc = acc * al + p * bf2f(QKV[tk * 768 + 640 + kh * 64 + dd]); m = mn;
            }
            dbg_put(C, 9, bf2f(WSP(bf16, WS_A)[tq * 512 + hq * 64 + dd]), acc / den, 0.03f);
        }
        __syncthreads();
        {
            LAS float* qs = (LAS float*)C.lds + (size_t)C.tid * 65; const bf16* QKV = WSP(bf16, WS_X + X_QKV);
            const int b = h2 % 32, t = h1 % 256, hq = h3 % 8, dd = (h3 >> 8) % 64, kh = hq >> 2; const size_t tq = (size_t)(CTXB + b * TC + t);
            for (int d = 0; d < 64; ++d) qs[d] = bf2f(QKV[tq * 768 + hq * 64 + d]);
            float m = P.in[25 + C.z][hq], den = 1.f, acc = 0.f;
            for (int j = 0; j < 256; ++j) { const size_t tk = (size_t)(CTXB + b * TC + j); float s = 0.f;
                for (int d = 0; d < 64; ++d) s += qs[d] * bf2f(QKV[tk * 768 + 512 + kh * 64 + d]);
                s *= 0.125f; const float mn = fmaxf(m, s), al = exp_f(m - mn), p = exp_f(s - mn); den = den * al + p; acc = acc * al + p * bf2f(QKV[tk * 768 + 640 + kh * 64 + dd]); m = mn; }
            dbg_put(C, 10, bf2f(WSP(bf16, WS_A)[tq * 512 + hq * 64 + dd]), acc / den, 0.03f);
        }
        {
            const int b = h1 % 32, tp = h2 % 2048, ch = h3 % 256;
            dbg_put(C, 11, bf2f(WSP(bf16, WS_A + (size_t)72 * MiB)[((size_t)b * TL + tp) * 256 + ch]), ndot(WSP(bf16, WS_DFT) + (size_t)tp * 4096, WSP(bf16, WS_X + X_ZT) + ((size_t)b * 256 + ch) * 4096, 4096), 0.05f);
            const int tc = h2 % 256;
            dbg_put(C, 11, bf2f(WSP(bf16, WS_A + (size_t)72 * MiB)[((size_t)CTXB + b * TC + tc) * 256 + ch]), ndot(WSP(bf16, WS_DFTC) + (size_t)tc * 512, WSP(bf16, WS_X + X_ZTC) + ((size_t)b * 256 + ch) * 512, 512), 0.05f);
        }
    } else if (stage == 5) {
        const int tok = h1 % NT, col = h2 % 1024; const bf16* PP = WSP(bf16, WS_X + X_PP);
        dbg_put(C, 13, bf2f(PP[(size_t)tok * NGATE + col]), ndot(WSP(bf16, WS_A + (size_t)108 * MiB) + (size_t)tok * 256, WL(bf16, 0, WL_BR) + (size_t)col * 256, 256), 0.05f);
        dbg_put(C, 13, bf2f(PP[(size_t)tok * NGATE + 1024 + col]), ndot(WSP(bf16, WS_A) + (size_t)tok * 512, WL(bf16, 0, WL_BA) + (size_t)col * 512, 512), 0.05f);
        dbg_put(C, 13, bf2f(PP[(size_t)tok * NGATE + 2048 + col]), ndot(WSP(bf16, WS_A + (size_t)72 * MiB) + (size_t)tok * 256, WL(bf16, 0, WL_BF) + (size_t)col * 256, 256), 0.05f);
    } else if (stage == 6) {
        const int tok = h1 % NT, col = h2 % 1024; float ref = 0.f;
        for (int br = 0; br < 3; ++br) { const float gl = ndot(WSP(bf16, WS_A) + (size_t)tok * DM, WL(bf16, 0, WL_G) + (size_t)(br * 1024 + col) * 1024, 1024); ref += bf2f(WSP(bf16, WS_X + X_PP)[(size_t)tok * NGATE + br * 1024 + col]) / (1.f + exp_f(-gl)); }
        dbg_put(C, 14, bf2f(WSP(bf16, WS_X + X_UR)[(size_t)tok * DM + col]), ref, 0.05f);
    } else if (stage == 7) {
        const int tok = h1 % NT, col = h2 % 1024;
        dbg_put(C, 15, bf2f(WSP(bf16, WS_X + X_MIX)[(size_t)tok * DM + col]), ndot(WSP(bf16, WS_X + X_UR) + (size_t)tok * DM, WL(bf16, 0, WL_O) + (size_t)col * 1024, 1024), 0.05f);
    } else if (stage == 8) {
        const int tok = h1 % NT, col = h2 % 1024; const bool lat = tok < NLAT; const float* hp = lat ? P.in[0 + C.z] + (size_t)tok * DM : P.in[2 + C.z] + (size_t)(tok - NLAT) * DM;
        const bf16* mx = WSP(bf16, WS_X + X_MIX) + (size_t)tok * DM; const float* mp = WSP(float, WS_MOD) + (size_t)(lat ? tok / TL : 32) * 6144;
        float ss = 0.f; for (int k = 0; k < 1024; ++k) ss += bf2f(mx[k]) * bf2f(mx[k]);
        const float rs = rsqrtf(ss / 1024.f + 1e-6f); float s2 = 0.f, hc = 0.f;
        for (int k = 0; k < 1024; ++k) { const float hn = hp[k] + mp[2048 + k] * bf2f(mx[k]) * rs * P.in[7 + C.z][k]; s2 += hn * hn; if (k == col) hc = hn; }
        const float* ho = lat ? C.out + (size_t)tok * DM : WSP(float, WS_HC) + (size_t)(tok - NLAT) * DM;
        dbg_put(C, 16, ho[col], hc, 0.01f);
        dbg_put(C, 16, bf2f(WSP(bf16, WS_A)[(size_t)tok * DM + col]), hc * rsqrtf(s2 / 1024.f + 1e-6f) * P.in[8 + C.z][col] * (1.f + mp[4096 + col]) + mp[3072 + col], 0.05f);
    } else if (stage == 9) {
        int tok = h1 % NT; if (C.tid & 1) tok = (tok & ~63) + ((C.tid & 2) ? 63 : 0);
        const int j = h2 % DFF; const int t = (tok < NLAT) ? (tok % TL) : ((tok - NLAT) % TC), T = (tok < NLAT) ? TL : TC;
        const bf16* A = WSP(bf16, WS_A); const bf16* wu = WL(bf16, 0, WL_UP); const int pn = j >> 7, jj = j & 127;
        const bf16* wg = wu + (size_t)(pn * 256 + jj) * 1024; const bf16* wv = wu + (size_t)(pn * 256 + 128 + jj) * 1024;
        const float zc = ndot(A + (size_t)tok * DM, wg, 1024), zp = (t > 0) ? ndot(A + (size_t)(tok - 1) * DM, wg, 1024) : 0.f, zn = (t < T - 1) ? ndot(A + (size_t)(tok + 1) * DM, wg, 1024) : 0.f, zv = ndot(A + (size_t)tok * DM, wv, 1024);
        const float z = P.in[31 + C.z][j] * zp + P.in[31 + C.z][DFF + j] * zc + P.in[31 + C.z][2 * DFF + j] * zn + P.in[32 + C.z][j];
        const float ge = 0.5f * z * (1.f + tanh_(0.7978845608028654f * (z + 0.044715f * z * z * z)));
        dbg_put(C, 17, bf2f(WSP(bf16, WS_X + X_HH)[(size_t)tok * DFF + j]), ge * zv, 0.05f);
    } else if (stage == 10) {
        const int tok = h1 % NT, col = h2 % 1024;
        dbg_put(C, 18, bf2f(WSP(bf16, WS_X + X_FFO)[(size_t)tok * DM + col]), ndot(WSP(bf16, WS_X + X_HH) + (size_t)tok * DFF, WL(bf16, 0, WL_DN) + (size_t)col * DFF, DFF), 0.05f);
    }
}
DI void dbg_report(const Ctx& C) {
    if (C.bid == 0 && threadIdx.x == 0) {
        int first = -1; for (int k = 0; k < 24; ++k) if (first < 0 && __builtin_bit_cast(float, WSP(unsigned, WS_CTL)[1024 + k]) > 0.05f) first = k;
        if (first >= 0) C.out[12345] = 1000.f * (float)(first + 1);
    }
}
#define DBGCHK(stage) do { grid.sync(); dbg_check(CK, stage, l); grid.sync(); } while (0)
#else
#define DBGCHK(stage) do { } while (0)
#endif
#define XB_TMO      128
#define XB_XCNT(j)  (256  + 64 * (j))
#define XB_XSUB(j)  (1280 + 64 * (j))
#define XB_XGEN(j)  (2304 + 64 * (j))
#define XB_TOP      3328
#define XB_TOPGEN   3392
#define XCD_BAR_WORDS 3456
#define XB_SPIN_CAP (1u << 18)

__device__ __forceinline__ unsigned xb_ld(unsigned* p)              { return __hip_atomic_load(p, __ATOMIC_RELAXED, __HIP_MEMORY_SCOPE_AGENT); }
__device__ __forceinline__ unsigned xb_add(unsigned* p, unsigned v) { return __hip_atomic_fetch_add(p, v, __ATOMIC_RELAXED, __HIP_MEMORY_SCOPE_AGENT); }
__device__ __forceinline__ unsigned xb_xcc_id() { return (unsigned)__builtin_amdgcn_s_getreg((3 << 11) | 20) & 0xFu; }
#define XB_SPIN(cond, bar) do { unsigned _sp = 0; while (cond) { __builtin_amdgcn_s_sleep(1); \
    if ((++_sp & 255u) == 0u) { if (xb_ld(&(bar)[XB_TMO])) break; if (_sp > XB_SPIN_CAP) { atomicAdd(&(bar)[XB_TMO], 1u); break; } } } } while (0)

struct XcdBarrier {
    unsigned* bar; unsigned x;
    volatile LAS unsigned* st;
};

__device__ __forceinline__ XcdBarrier xcd_barrier_post(unsigned* bar, volatile LAS unsigned* st) {
    XcdBarrier b; b.bar = bar; b.x = xb_xcc_id(); b.st = st;
    if (threadIdx.x == 0) (void)xb_add(&bar[XB_XCNT(b.x)], 1u);
    return b;
}
__device__ __forceinline__ void xcd_barrier_complete(unsigned* bar, unsigned x, unsigned& nloc, unsigned& nx) {
    const unsigned G = gridDim.x * gridDim.y * gridDim.z;
    unsigned sum, cnt, mine, sp = 0u;
    for (;;) {
        sum = 0u; cnt = 0u; mine = 0u;
#pragma unroll
        for (unsigned j = 0; j < 16; ++j) { const unsigned c = xb_ld(&bar[XB_XCNT(j)]); sum += c; cnt += (c > 0u) ? 1u : 0u; mine = (j == x) ? c : mine; }
        if (sum == G) break;
        __builtin_amdgcn_s_sleep(1);
        if ((++sp & 255u) == 0u) { if (xb_ld(&bar[XB_TMO])) break; if (sp > XB_SPIN_CAP) { atomicAdd(&bar[XB_TMO], 1u); break; } }
    }
    nloc = mine > 0u ? mine : 1u; nx = cnt > 0u ? cnt : 1u;
}

__device__ __forceinline__ void xcd_barrier(const XcdBarrier& b) {
    asm volatile("s_waitcnt vmcnt(0)" ::: "memory");
    __syncthreads();
    if (threadIdx.x == 0) {
        unsigned* bar = b.bar;
        __builtin_amdgcn_s_waitcnt(0);
        unsigned nloc = b.st[0], nx = b.st[1];
        if (nloc == 0u) { xcd_barrier_complete(bar, b.x, nloc, nx); b.st[0] = nloc; b.st[1] = nx; }
        const unsigned old = xb_add(&bar[XB_XSUB(b.x)], 1u);
        const unsigned gen = old / nloc;
        if (old + 1u == (gen + 1u) * nloc) {
            __builtin_amdgcn_fence(__ATOMIC_RELEASE, "agent");
            asm volatile("s_waitcnt vmcnt(0)" ::: "memory");
            const unsigned og = xb_add(&bar[XB_TOP], 1u);
            const unsigned tg = og / nx;
            if (og + 1u == (tg + 1u) * nx) xb_add(&bar[XB_TOPGEN], 1u);
            else XB_SPIN(xb_ld(&bar[XB_TOPGEN]) == tg, bar);
            __builtin_amdgcn_fence(__ATOMIC_ACQUIRE, "agent");
            xb_add(&bar[XB_XGEN(b.x)], 1u);
            asm volatile("s_waitcnt vmcnt(0)" ::: "memory");
        } else {
            XB_SPIN(xb_ld(&bar[XB_XGEN(b.x)]) == gen, bar);
            __builtin_amdgcn_fence(__ATOMIC_ACQUIRE, "agent");
            asm volatile("s_waitcnt vmcnt(0)" ::: "memory");
        }
    }
    __syncthreads();
}

__global__ void __launch_bounds__(NTHREADS, 2) fwd_kernel(Params P) {
    extern __shared__ __attribute__((aligned(16))) unsigned char lds_raw[];
    cg::grid_group grid = cg::this_grid();
    const int tid_ = threadIdx.x;
    const Ctx CK{(LAS unsigned char*)lds_raw, P.ws, P, P.out, tid_, tid_ & 63, __builtin_amdgcn_readfirstlane(tid_ >> 6), (int)gridDim.x, (int)blockIdx.x, 0};
    volatile LAS unsigned* xb_st = (volatile LAS unsigned*)(CK.lds + 139264);
    if (tid_ < 2) xb_st[tid_] = 0u;
    __syncthreads();
    const XcdBarrier xbar = xcd_barrier_post((unsigned*)P.ws + 4096, xb_st);
#define GSYNC() xcd_barrier(xbar)
#ifdef PROBE
#define TS(k) do { if (tid_ == 0 && blockIdx.x == 0) ((volatile LAS unsigned long long*)(CK.lds + 131072))[k] = __builtin_amdgcn_s_memrealtime(); } while (0)
#else
#define TS(k) do { } while (0)
#endif
#define PH_BEGIN { const Ctx C = rectx(CK); LAS unsigned char* glds = C.lds;
#define PH_END }
#define ABUF WSP(bf16, WS_A)
#define HCB WSP(float, WS_HC)
#define MODL(ll) (WSP(float, WS_MOD) + (size_t)(ll) * 33 * 6144)
#define HIN_L ((l == 0) ? C.P.in[0 + C.z] : (const float*)C.out)
#define HIN_C ((l == 0) ? C.P.in[2 + C.z] : (const float*)HCB)
#define GEMM_STD(Aptr, Bptr, M_, N_, K_, EPI, ...) do { pg8::Gemm g{Aptr, Bptr, M_, N_, K_}; pg8::StaticOrder S; S.init(M_, N_, C.G, C.bid); EPI E{__VA_ARGS__}; pg8::gemm_phase<EPI, pg8::StaticOrder, true, true>(glds, g, S, E); } while (0)
    TS(40);
    prologue(CK);
    grid.sync(); TS(41);
    { const int l = 0; DBGCHK(0); }
    for (int l = 0; l < 2; ++l) {
        TS(l * 16 + 0);
        const int Mmix = (l == 0) ? NT : NLAT;
        if (l == 0) { PH_BEGIN rowop<false, true>(C, NT, HIN_L, HIN_C, nullptr, nullptr, nullptr, 0, nullptr, C.P.in[6 + C.z] + l * DM, 0, 1, MODL(l), MODL(l), ABUF); PH_END GSYNC(); TS(l * 16 + 1); DBGCHK(1); }
        PH_BEGIN
            GEMM_STD(ABUF, WL(bf16, l, WL_IN), NT, NIN, DM, EpiIn, WSP(bf16, WS_X + X_QKV), WSP(bf16, WS_X + X_ZT), WSP(bf16, WS_X + X_ZTC), WSP(bf16, WS_X + X_UR));
        PH_END
        GSYNC(); TS(l * 16 + 2); DBGCHK(2);
        feat1_phase(CK, l);
        GSYNC();
        PH_BEGIN GEMM_STD(WSP(bf16, WS_A), WSP(bf16, WS_WLORA + (size_t)l * 2 * MiB), NT, (l == 0 ? 1280 : NLO), (l == 0 ? 384 : KLO), EpiStore, WSP(bf16, WS_X + X_LO), NLO, 0, 0, 256); PH_END
        GSYNC();
        feat3_phase(CK, l);
        GSYNC(); TS(l * 16 + 3); DBGCHK(3);
        if (CK.bid < 256) scan_run(CK, l, CK.bid >> 3, (CK.bid >> 1) & 3, CK.bid & 1);
        __syncthreads(); TS(l * 16 + 15);
        {
            PH_BEGIN
                pg8::Gemm g{WSP(bf16, WS_DFT), WSP(bf16, WS_X + X_ZT), 2048, 8192, 4096}; pg8::StaticOrder S; S.init(2048, 8192, C.G, C.bid);
                EpiStore E{WSP(bf16, WS_A + (size_t)72 * MiB), 256, 0, 2048, 0};
                pg8::gemm_phase<EpiStore, pg8::StaticOrder, true, true>(glds, g, S, E);
            PH_END
            if (l == 0) { PH_BEGIN
                pg8::Gemm g{WSP(bf16, WS_DFTC), WSP(bf16, WS_X + X_ZTC), 256, 8192, 512}; pg8::StaticOrder S; S.init(256, 8192, C.G, C.bid);
                EpiStore E{WSP(bf16, WS_A + (size_t)72 * MiB), 256, CTXB, 256, 0};
                pg8::gemm_phase<EpiStore, pg8::StaticOrder, true, true>(glds, g, S, E);
            PH_END }
        }
        attn_loop(CK, l);
        GSYNC(); TS(l * 16 + 4); DBGCHK(4);
        readout_phase(CK, l, Mmix);
        GSYNC(); TS(l * 16 + 5);
        PH_BEGIN GEMM_STD(WSP(bf16, WS_A + (size_t)108 * MiB), WL(bf16, l, WL_BR), Mmix, 1024, 256, EpiStore, WSP(bf16, WS_X + X_PP), NGATE, 0, 0, 256); PH_END
        PH_BEGIN GEMM_STD(WSP(bf16, WS_A), WL(bf16, l, WL_BA), Mmix, 1024, 512, EpiStore, WSP(bf16, WS_X + X_PP) + 1024, NGATE, 0, 0, 256); PH_END
        PH_BEGIN GEMM_STD(WSP(bf16, WS_A + (size_t)72 * MiB), WL(bf16, l, WL_BF), Mmix, 1024, 256, EpiStore, WSP(bf16, WS_X + X_PP) + 2048, NGATE, 0, 0, 256); PH_END
        GSYNC(); TS(l * 16 + 6); DBGCHK(5);
        PH_BEGIN rowop<false, true>(C, Mmix, HIN_L, HIN_C, nullptr, nullptr, nullptr, 0, nullptr, C.P.in[6 + C.z] + l * DM, 0, 1, MODL(l), MODL(l), ABUF); PH_END
        GSYNC(); TS(l * 16 + 7);
        PH_BEGIN
            pg8::Gemm g{ABUF, WL(bf16, l, WL_G), Mmix, NGATE, DM}; GateOrder S{(Mmix / 256) * 4, C.G, C.bid};
            EpiGate E{WSP(bf16, WS_X + X_PP), WSP(bf16, WS_X + X_UR)};
            pg8::gemm_phase<EpiGate, GateOrder, true, true>(glds, g, S, E);
        PH_END
        GSYNC(); TS(l * 16 + 8); DBGCHK(6);
        PH_BEGIN GEMM_STD(WSP(bf16, WS_X + X_UR), WL(bf16, l, WL_O), Mmix, DM, DM, EpiStore, WSP(bf16, WS_X + X_MIX), DM, 0, 0, 256); PH_END
        GSYNC(); TS(l * 16 + 9); DBGCHK(7);
        PH_BEGIN rowop<true, true>(C, Mmix, HIN_L, HIN_C, C.out, HCB, WSP(bf16, WS_X + X_MIX), 2, C.P.in[7 + C.z] + l * DM, C.P.in[8 + C.z] + l * DM, 3, 4, MODL(l), MODL(l), ABUF); PH_END
        GSYNC(); TS(l * 16 + 10); DBGCHK(8);
        PH_BEGIN GEMM_STD(ABUF, WL(bf16, l, WL_UP), Mmix, 2 * DFF, DM, EpiUp, WSP(bf16, WS_X + X_HH), WSP(bf16, WS_X + X_HALO), C.P.in[31 + C.z] + (size_t)l * 3 * DFF, C.P.in[32 + C.z] + (size_t)l * DFF); PH_END
        GSYNC(); TS(l * 16 + 11);
        fixup_phase(CK, l, Mmix);
        GSYNC(); TS(l * 16 + 12); DBGCHK(9);
        PH_BEGIN GEMM_STD(WSP(bf16, WS_X + X_HH), WL(bf16, l, WL_DN), Mmix, DM, DFF, EpiStore, WSP(bf16, WS_X + X_FFO), DM, 0, 0, 256); PH_END
        GSYNC(); TS(l * 16 + 13); DBGCHK(10);
        if (l == 0) { PH_BEGIN rowop<true, true>(C, NT, C.out, HCB, C.out, HCB, WSP(bf16, WS_X + X_FFO), 5, C.P.in[9 + C.z] + l * DM, C.P.in[6 + C.z] + (l + 1) * DM, 0, 1, MODL(l), MODL(l + 1), ABUF); PH_END GSYNC(); TS(l * 16 + 14); }
        else { PH_BEGIN rowop<true, false>(C, NLAT, C.out, HCB, C.out, HCB, WSP(bf16, WS_X + X_FFO), 5, C.P.in[9 + C.z] + l * DM, nullptr, 0, 1, MODL(l), MODL(l), nullptr); PH_END }
    }
#ifdef DBG
    grid.sync(); dbg_report(CK);
#endif
#ifdef PROBE
    grid.sync(); TS(60);
    TS(61);
    grid.sync();
    if (blockIdx.x == 0) {
        volatile LAS unsigned long long* ts = (volatile LAS unsigned long long*)(CK.lds + 131072);
#ifdef PROBE_PRO
        unsigned long long d = (ts[60] - ts[40]) / 10ull;
#else
        unsigned long long d = 0; for (int ll = 0; ll < 2; ++ll) d += ts[ll * 16 + PROBE_B] - ts[ll * 16 + PROBE_A];
#endif
        const int n = (int)(d / 500ull);
        for (int i = tid_; i < n; i += NTHREADS) P.out[1000000 + i] += 0.15f;
    }
#endif
}


extern "C" void kernel_launch(void* const* d_in, const int* in_sizes, int n_in, void* d_out, int out_size, void* d_ws, size_t ws_size, hipStream_t stream) {
    static int grid = 0;
    if (grid == 0) {
        if (n_in != 34 || out_size != NLAT * DM || ws_size < WS_TOTAL) { fprintf(stderr, "kernel_launch: unexpected shapes (n_in %d out %d ws %zu, need %zu)\n", n_in, out_size, ws_size, (size_t)WS_TOTAL); grid = -1; return; }
        int dev = 0, cus = 0, per_cu = 0;
        hipGetDevice(&dev); hipDeviceGetAttribute(&cus, hipDeviceAttributeMultiprocessorCount, dev);
        if (hipFuncSetAttribute((const void*)fwd_kernel, hipFuncAttributeMaxDynamicSharedMemorySize, LDS_BYTES) != hipSuccess) { fprintf(stderr, "kernel_launch: hipFuncSetAttribute failed\n"); grid = -1; return; }
        hipOccupancyMaxActiveBlocksPerMultiprocessor(&per_cu, (const void*)fwd_kernel, NTHREADS, LDS_BYTES);
        (void)hipGetLastError();
        if (per_cu < 1 || cus < 256) { fprintf(stderr, "kernel_launch: occupancy %d, cus %d\n", per_cu, cus); grid = -1; return; }
        grid = 256;
    }
    if (grid < 0) return;
    (void)hipMemsetAsync((char*)d_ws + WS_CTL, 0, 65536, stream);
    Params p{};
    for (int i = 0; i < 34; ++i) p.in[i] = (const float*)d_in[i];
    p.out = (float*)d_out; p.ws = (unsigned char*)d_ws;
    void* args[] = {&p};
    hipError_t e = hipLaunchCooperativeKernel((const void*)fwd_kernel, dim3(grid), dim3(NTHREADS), args, LDS_BYTES, stream);
    if (e != hipSuccess) fprintf(stderr, "kernel_launch: cooperative launch failed: %s (grid %d)\n", hipGetErrorString(e), grid);
}
```

```cpp
#define PROBE_A 3
#define PROBE_B 4
#include <hip/hip_runtime.h>
#include <hip/hip_cooperative_groups.h>
#include <cstdio>
#include <cstdint>
namespace cg = cooperative_groups;
__device__ __forceinline__ int otid() { int t = threadIdx.x; asm volatile("" : "+v"(t)); return t; }
namespace pg8 {
#define PG8_LAS __attribute__((address_space(3)))
typedef unsigned short bf16_t;
typedef short bf16x8 __attribute__((ext_vector_type(8)));
typedef float f32x4 __attribute__((ext_vector_type(4)));
typedef unsigned u32x4 __attribute__((ext_vector_type(4)));
constexpr int BM = 256, BK = 64, HALF = 128, HTB = HALF * BK * 2  , STAGE_BYTES = 8 * HTB, NXCD = 8, WGM = 4;

__host__ __device__ __forceinline__ int lds_byte(int r, int c) { const int st = (r >> 4) * 2 + (c >> 5), rr = r & 15, cc = c & 31, ob = rr * 64 + cc * 2; return st * 1024 + (ob ^ (((ob >> 9) & 1) << 5)); }
__host__ __device__ __forceinline__ void stage_rc(int b, int& R, int& C) { const int st = b / 1024, sb = b % 1024, swz = sb ^ (((sb >> 9) & 1) << 5); R = (st >> 1) * 16 + swz / 64; C = (st & 1) * 32 + (swz % 64) / 2; }
__host__ __device__ __forceinline__ int perm32(int rho) { const int n = rho >> 4, i = rho & 15; return 8 * (i >> 2) + 4 * n + (i & 3); }

struct Unit { int pm, pn; };
struct Gemm { const bf16_t* A; const bf16_t* Bt; int M, N, K; };

struct StaticOrder {
    int nM, nN, nwg, G, c;
    __host__ __device__ void init(int M, int N, int G_, int c_) { nM = M / BM; nN = N / BM; nwg = nM * nN; G = G_; c = c_; }
    __host__ __device__ bool next(int i, Unit& u) const {
        const long L = (long)i * G + c; if (L >= nwg) return false;
        int wgid = (int)L; { const int q = nwg / NXCD, r = nwg % NXCD, xcd = wgid % NXCD, off = wgid / NXCD; wgid = (xcd < r ? xcd * (q + 1) : r * (q + 1) + (xcd - r) * q) + off; }
        const int nig = WGM * nN, gid = wgid / nig, fm = gid * WGM, gsz = (nM - fm) < WGM ? (nM - fm) : WGM;
        u.pm = fm + ((wgid % nig) % gsz); u.pn = (wgid % nig) / gsz; return true;
    }
    __device__ __forceinline__ void a_ready(const Unit&) const {}
    __device__ __forceinline__ void done(const Unit&) const {}
};

__device__ __forceinline__ unsigned cvt_pk_bf16(float lo, float hi) { unsigned r; asm volatile("v_cvt_pk_bf16_f32 %0, %1, %2" : "=v"(r) : "v"(lo), "v"(hi)); return r; }
typedef float f32x2 __attribute__((ext_vector_type(2)));
__device__ __forceinline__ f32x2 gelu_pk(f32x2 v) {
    const f32x2 av = __builtin_elementwise_abs(v), d = av * 0.2316418882f + 1.0f;
    f32x2 t; t.x = __builtin_amdgcn_rcpf(d.x); t.y = __builtin_amdgcn_rcpf(d.y);
    f32x2 q = t * 0.5307027145f + (-0.7265760135f); q = q * t + 0.7107068705f; q = q * t + (-0.142248368f); q = q * t + 0.127414796f; q = q * t;
    const f32x2 s = (v * v) * (-0.72134752044f);
    f32x2 e; e.x = __builtin_amdgcn_exp2f(s.x); e.y = __builtin_amdgcn_exp2f(s.y);
    const f32x2 m = v * (q * e), r = v - m;
    f32x2 o; o.x = v.x < 0.f ? m.x : r.x; o.y = v.y < 0.f ? m.y : r.y; return o;
}

template <class Epi, class Sched, bool ALIGN_EPI = false, bool SP2 = false>
__device__ __forceinline__ void gemm_phase(PG8_LAS unsigned char* lds, const Gemm g, const Sched& S, const Epi& E) {
    const int tid = otid(), wid = __builtin_amdgcn_readfirstlane(tid >> 6), lane = tid & 63, wr = wid >> 2, wc = wid & 3, fr = lane & 15, fq = lane >> 4;
    const int K = g.K, nt = K / BK;
    unsigned voffA[2], voffB[2];
#pragma unroll
    for (int i = 0; i < 2; ++i) { int R, C; stage_rc(tid * 16 + i * 8192, R, C); const int Rb = Epi::PERM ? ((R & ~31) + perm32(R & 31)) : R;
        const int Ra = Epi::PERMA ? ((R & 64) + 4 * (R & 15) + ((R >> 4) & 3)) : R;
        voffA[i] = (unsigned)(Ra * K + C) * 2u; voffB[i] = (unsigned)(Rb * K + C) * 2u; }
    const size_t kstep = (size_t)(BK * 2);
    const size_t hstep = (size_t)HALF * K * 2;
    const size_t tstep = 2 * hstep;
    const unsigned ldsw = (unsigned)wid * 1024u;
    const int aoff = lds_byte(wr * 64 + fr, fq * 8), boff = lds_byte(wc * 32 + fr, fq * 8);
#define PG8_SA(b, h) (((b) * 2 + (h)) * HTB)
#define PG8_SB(b, h) ((4 + (b) * 2 + (h)) * HTB)
#define PG8_STAGE(bufoff, gbase, voff) do { _Pragma("unroll") for (int _i = 0; _i < 2; ++_i) \
        __builtin_amdgcn_global_load_lds((const unsigned*)((const char*)(gbase) + (voff)[_i]), (PG8_LAS unsigned*)(lds + (bufoff) + ldsw + _i * 8192), 16, 0, 0); } while (0)
#define PG8_LDA(dst, b, h) do { _Pragma("unroll") for (int m = 0; m < 4; ++m) _Pragma("unroll") for (int k = 0; k < 2; ++k) dst[m][k] = *(const PG8_LAS bf16x8*)(lds + PG8_SA(b, h) + aoff + m * 2048 + k * 1024); } while (0)
#define PG8_LDB(dst, b, h) do { _Pragma("unroll") for (int n = 0; n < 2; ++n) _Pragma("unroll") for (int k = 0; k < 2; ++k) dst[n][k] = *(const PG8_LAS bf16x8*)(lds + PG8_SB(b, h) + boff + n * 2048 + k * 1024); } while (0)
#define PG8_MMA(ai, bj, At, Bt) do { __builtin_amdgcn_s_setprio(1); _Pragma("unroll") for (int m = 0; m < 4; ++m) _Pragma("unroll") for (int n = 0; n < 2; ++n) _Pragma("unroll") for (int k = 0; k < 2; ++k) \
        acc[ai][bj][m][n] = __builtin_amdgcn_mfma_f32_16x16x32_bf16(Bt[n][k], At[m][k], acc[ai][bj][m][n], 0, 0, 0); __builtin_amdgcn_s_setprio(0); } while (0)
#define PG8_WAIT_V(n) asm volatile("s_waitcnt vmcnt(" #n ")" ::: "memory")
#define PG8_WAIT_L(n) asm volatile("s_waitcnt lgkmcnt(" #n ")" ::: "memory")
#define PG8_BAR __builtin_amdgcn_s_barrier()
#define PG8_SCHED __builtin_amdgcn_sched_barrier(0)
    Unit cur, nxt; int ui = 0;
    if (!S.next(0, cur)) return;
    f32x4 acc[2][2][4][2];
#pragma unroll
    for (int a = 0; a < 2; ++a)
#pragma unroll
        for (int b = 0; b < 2; ++b)
#pragma unroll
            for (int m = 0; m < 4; ++m)
#pragma unroll
                for (int n = 0; n < 2; ++n) acc[a][b][m][n] = (f32x4){0.f, 0.f, 0.f, 0.f};
    bf16x8 At[4][2], B0[2][2], B1[2][2];
    const char* cA = (const char*)g.A + (size_t)cur.pm * tstep; const char* cB = (const char*)g.Bt + (size_t)cur.pn * tstep;
    S.a_ready(cur);
    if constexpr (SP2) {
        PG8_STAGE(PG8_SB(0, 0), cB, voffB); PG8_STAGE(PG8_SB(0, 1), cB + hstep, voffB); PG8_STAGE(PG8_SA(0, 0), cA, voffA); PG8_STAGE(PG8_SA(0, 1), cA + hstep, voffA);
        if (wr == 1) PG8_BAR;
        PG8_WAIT_V(2); PG8_BAR;
        PG8_STAGE(PG8_SB(1, 0), cB + kstep, voffB); PG8_STAGE(PG8_SA(1, 0), cA + kstep, voffA); PG8_STAGE(PG8_SB(1, 1), cB + hstep + kstep, voffB);
        PG8_WAIT_V(6); PG8_BAR;
    } else {
        PG8_STAGE(PG8_SB(0, 0), cB, voffB); PG8_STAGE(PG8_SA(0, 0), cA, voffA); PG8_STAGE(PG8_SB(0, 1), cB + hstep, voffB); PG8_STAGE(PG8_SA(0, 1), cA + hstep, voffA);
        if (wr == 1) PG8_BAR;
        PG8_WAIT_V(4); PG8_BAR;
        PG8_STAGE(PG8_SB(1, 0), cB + kstep, voffB); PG8_STAGE(PG8_SA(1, 0), cA + kstep, voffA); PG8_STAGE(PG8_SB(1, 1), cB + hstep + kstep, voffB);
        PG8_WAIT_V(6); PG8_BAR;
    }
    for (;;) {
        const bool has_next = S.next(ui + 1, nxt);
        const char* nA = has_next ? (const char*)g.A + (size_t)nxt.pm * tstep : cA; const char* nB = has_next ? (const char*)g.Bt + (size_t)nxt.pn * tstep : cB;
        for (int t = 0; t < nt; t += 2) {
            const bool last = (t == nt - 2);
            const char* a1 = cA + (size_t)(t + 1) * kstep;
            const char* a2 = last ? nA : cA + (size_t)(t + 2) * kstep; const char* b2 = last ? nB : cB + (size_t)(t + 2) * kstep;
            const char* a3 = a2 + kstep; const char* b3 = b2 + kstep;
            if (last && has_next) S.a_ready(nxt);
            if constexpr (SP2) {
            PG8_LDB(B0, 0, 0); PG8_LDB(B1, 0, 1); PG8_SCHED; PG8_LDA(At, 0, 0); PG8_STAGE(PG8_SA(1, 1), a1 + hstep, voffA);
            PG8_WAIT_V(8); PG8_WAIT_L(0); PG8_BAR; PG8_MMA(0, 0, At, B0); PG8_MMA(0, 1, At, B1); PG8_BAR; PG8_SCHED;
            PG8_LDA(At, 0, 1); PG8_STAGE(PG8_SB(0, 0), b2, voffB); PG8_STAGE(PG8_SB(0, 1), b2 + hstep, voffB); PG8_STAGE(PG8_SA(0, 0), a2, voffA);
            PG8_WAIT_V(8); PG8_WAIT_L(0); PG8_BAR; PG8_MMA(1, 0, At, B0); PG8_MMA(1, 1, At, B1); PG8_BAR; PG8_SCHED;
            PG8_LDB(B0, 1, 0); PG8_LDB(B1, 1, 1); PG8_SCHED; PG8_LDA(At, 1, 0); PG8_STAGE(PG8_SA(0, 1), a2 + hstep, voffA);
            PG8_WAIT_V(8); PG8_WAIT_L(0); PG8_BAR; PG8_MMA(0, 0, At, B0); PG8_MMA(0, 1, At, B1); PG8_BAR; PG8_SCHED;
            PG8_LDA(At, 1, 1); PG8_STAGE(PG8_SB(1, 0), b3, voffB); PG8_STAGE(PG8_SB(1, 1), b3 + hstep, voffB); PG8_STAGE(PG8_SA(1, 0), a3, voffA);
            PG8_WAIT_V(8); PG8_WAIT_L(0); PG8_BAR; PG8_MMA(1, 0, At, B0); PG8_MMA(1, 1, At, B1); PG8_BAR; PG8_SCHED;
            } else {
            PG8_LDB(B0, 0, 0); PG8_SCHED; PG8_LDA(At, 0, 0); PG8_STAGE(PG8_SA(1, 1), a1 + hstep, voffA);
            PG8_WAIT_L(8); PG8_BAR; PG8_WAIT_L(0); PG8_MMA(0, 0, At, B0); PG8_BAR; PG8_SCHED;
            PG8_LDB(B1, 0, 1); PG8_STAGE(PG8_SB(0, 0), b2, voffB);
            PG8_BAR; PG8_WAIT_L(0); PG8_MMA(0, 1, At, B1); PG8_BAR;
            PG8_LDA(At, 0, 1); PG8_STAGE(PG8_SA(0, 0), a2, voffA);
            PG8_BAR; PG8_WAIT_L(0); PG8_MMA(1, 0, At, B0); PG8_BAR; PG8_SCHED;
            PG8_STAGE(PG8_SB(0, 1), b2 + hstep, voffB);
            PG8_WAIT_V(6); PG8_BAR; PG8_MMA(1, 1, At, B1); PG8_BAR;
            PG8_LDB(B0, 1, 0); PG8_SCHED; PG8_LDA(At, 1, 0); PG8_STAGE(PG8_SA(0, 1), a2 + hstep, voffA);
            PG8_WAIT_L(8); PG8_BAR; PG8_WAIT_L(0); PG8_MMA(0, 0, At, B0); PG8_BAR; PG8_SCHED;
            PG8_LDB(B1, 1, 1); PG8_STAGE(PG8_SB(1, 0), b3, voffB);
            PG8_BAR; PG8_WAIT_L(0); PG8_MMA(0, 1, At, B1); PG8_BAR;
            PG8_LDA(At, 1, 1); PG8_STAGE(PG8_SA(1, 0), a3, voffA);
            PG8_BAR; PG8_WAIT_L(0); PG8_MMA(1, 0, At, B0); PG8_BAR; PG8_SCHED;
            PG8_STAGE(PG8_SB(1, 1), b3 + hstep, voffB);
            PG8_WAIT_V(6); PG8_BAR; PG8_MMA(1, 1, At, B1); PG8_BAR;
            }
        }
        if constexpr (ALIGN_EPI) { if (wr == 0) PG8_BAR; }
        if constexpr (!Epi::AFTER_DRAIN) { E(acc, cur, wr, wc, fr, fq); S.done(cur); }
        if (!has_next) break;
#pragma unroll
        for (int a = 0; a < 2; ++a)
#pragma unroll
            for (int b = 0; b < 2; ++b)
#pragma unroll
                for (int m = 0; m < 4; ++m)
#pragma unroll
                    for (int n = 0; n < 2; ++n) acc[a][b][m][n] = (f32x4){0.f, 0.f, 0.f, 0.f};
        cur = nxt; cA = nA; cB = nB; ++ui;
        if constexpr (ALIGN_EPI) { if (wr == 1) PG8_BAR; }
    }
    PG8_WAIT_V(0);
    if constexpr (!ALIGN_EPI) { if (wr == 0) PG8_BAR; }
    PG8_BAR;
    if constexpr (Epi::AFTER_DRAIN) { E.fused(acc, cur, wr, wc, fr, fq, lds, wid, lane); S.done(cur); }
#undef PG8_SA
#undef PG8_SB
#undef PG8_STAGE
#undef PG8_LDA
#undef PG8_LDB
#undef PG8_MMA
#undef PG8_WAIT_V
#undef PG8_WAIT_L
#undef PG8_BAR
#undef PG8_SCHED
}
}

#define DI __device__ __forceinline__
#define LAS __attribute__((address_space(3)))
typedef unsigned short bf16;
typedef float f32x4 __attribute__((ext_vector_type(4)));
typedef float f32x2 __attribute__((ext_vector_type(2)));
typedef float f32x16 __attribute__((ext_vector_type(16)));
typedef short bf16x8 __attribute__((ext_vector_type(8)));
typedef short s16x4 __attribute__((ext_vector_type(4)));
typedef unsigned u32x4 __attribute__((ext_vector_type(4)));
typedef unsigned u32x2 __attribute__((ext_vector_type(2)));
typedef __bf16 bf16x2_t __attribute__((ext_vector_type(2)));

constexpr int DM = 1024, NB = 32, TL = 2048, TC = 256, NLAT = NB * TL, NCTX = NB * TC, NT = NLAT + NCTX, CTXB = NLAT;
constexpr int DFF = 2816, RW = 1152, NIN = 2560, NGATE = 3072;
constexpr int IN_COLS = 5248;
constexpr float LOG2E = 1.4426950408889634f;
constexpr int NTHREADS = 512, NWAVES = 8;
constexpr int LDS_BYTES = 147456;

constexpr size_t MiB = 1u << 20;
constexpr size_t WS_CTL = 0;
constexpr size_t WS_MOD = 1 * MiB;
constexpr size_t WS_SMALL = 3 * MiB;
constexpr size_t WS_BON = 4 * MiB;
constexpr size_t WS_W = 6 * MiB;
constexpr size_t WL_IN = 0, WL_G = 5 * MiB, WL_BR = 11 * MiB, WL_BA = 11 * MiB + 512 * 1024, WL_BF = 12 * MiB + 512 * 1024, WL_O = 13 * MiB, WL_UP = 15 * MiB, WL_DN = 26 * MiB, WL_SIZE = 32 * MiB;
constexpr size_t WS_DFT = WS_W + 2 * WL_SIZE;
constexpr size_t WS_DFTC = WS_DFT + 16 * MiB;
constexpr size_t WS_HC = WS_DFTC + 1 * MiB;
constexpr size_t WS_A = WS_HC + 32 * MiB;
constexpr size_t WS_VF = WS_A + 144 * MiB;
constexpr size_t WS_X = WS_VF + 36 * MiB;
constexpr size_t X_F = 0;
constexpr size_t X_QKV = 288 * MiB;
constexpr size_t X_ZT = 396 * MiB;
constexpr size_t X_ZTC = 460 * MiB;
constexpr size_t X_UR = 504 * MiB;
constexpr size_t X_G = 468 * MiB;
constexpr size_t X_LO = 504 * MiB;
constexpr size_t X_END = 720 * MiB;
constexpr size_t WS_WLORA = WS_X + X_END;
constexpr int KLO = 640, NLO = 1536;
constexpr size_t X_PP = 0;
constexpr size_t X_MIX = 0;
constexpr size_t X_HH = 0;
constexpr size_t X_HALO = 396 * MiB;
constexpr size_t X_FFO = 436 * MiB;
constexpr size_t WS_TOTAL = WS_WLORA + 4 * MiB;
constexpr size_t FSZ = (size_t)NT * 256;

struct Params { const float* in[34]; float* out; unsigned char* ws; };

DI float bf2f(bf16 v) { return __builtin_bit_cast(float, (unsigned)v << 16); }
DI float lo2f(unsigned u) { return __builtin_bit_cast(float, u << 16); }
DI float hi2f(unsigned u) { return __builtin_bit_cast(float, u & 0xffff0000u); }
DI unsigned pk(float lo, float hi) { f32x2 v = {lo, hi}; bf16x2_t b = __builtin_convertvector(v, bf16x2_t); return __builtin_bit_cast(unsigned, b); }
DI bf16 f2bf(float x) { return (bf16)(pk(x, 0.f) & 0xffffu); }
DI float fexp2(float x) { return __builtin_amdgcn_exp2f(x); }
DI float frcp(float x) { return __builtin_amdgcn_rcpf(x); }
DI float sigm(float x) { return frcp(1.f + fexp2(-x * LOG2E)); }
DI f32x2 sigm2(f32x2 x) { const f32x2 t = x * (-LOG2E); f32x2 e; e.x = fexp2(t.x); e.y = fexp2(t.y); const f32x2 d = e + 1.f; f32x2 r; r.x = frcp(d.x); r.y = frcp(d.y); return r; }
DI float tanh_(float x) { return 2.f * sigm(2.f * x) - 1.f; }
DI float gelu_tanh(float z) { const float u = 1.5957691216057308f * (z + 0.044715f * z * z * z); return z * sigm(u); }
DI float wave_sum(float v) {
#pragma unroll
    for (int o = 1; o < 64; o <<= 1) v += __shfl_xor(v, o);
    return v;
}
template <int CTRL, bool BC> DI float dppf(float old, float src) {
    return __builtin_bit_cast(float, __builtin_amdgcn_update_dpp(__builtin_bit_cast(int, old), __builtin_bit_cast(int, src), CTRL, 0xf, 0xf, BC));
}
DI float row16_sum(float x) { x += dppf<0x128, true>(0.f, x); x += dppf<0x124, true>(0.f, x); x += dppf<0x122, true>(0.f, x); x += dppf<0x121, true>(0.f, x); return x; }
DI f32x4 bf4(u32x2 u) { return (f32x4){lo2f(u.x), hi2f(u.x), lo2f(u.y), hi2f(u.y)}; }
DI u32x2 pk4(f32x4 v) { u32x2 o; o.x = pk(v[0], v[1]); o.y = pk(v[2], v[3]); return o; }
DI float allred4(float x) {
    unsigned u = __builtin_bit_cast(unsigned, x);
    auto r = __builtin_amdgcn_permlane16_swap(u, u, false, false);
    float y = __builtin_bit_cast(float, (unsigned)r[0]) + __builtin_bit_cast(float, (unsigned)r[1]);
    unsigned v = __builtin_bit_cast(unsigned, y);
    auto s = __builtin_amdgcn_permlane32_swap(v, v, false, false);
    return __builtin_bit_cast(float, (unsigned)s[0]) + __builtin_bit_cast(float, (unsigned)s[1]);
}

DI u32x4 pack8(const f32x4& a, const f32x4& b) { u32x4 w; w.x = pk(a[0], a[1]); w.y = pk(a[2], a[3]); w.z = pk(b[0], b[1]); w.w = pk(b[2], b[3]); return w; }

struct EpiStore {
    static constexpr bool PERM = true, AFTER_DRAIN = false, PERMA = false;
    bf16* O; int ld; int row_base, row_pn, col_pn;
    DI void operator()(const f32x4 (&acc)[2][2][4][2], const pg8::Unit& u, int wr, int wc, int fr, int fq) const {
        const int row0 = row_base + u.pn * row_pn + u.pm * 256 + wr * 64 + fr, col0 = u.pn * col_pn + wc * 32 + 8 * fq;
#pragma unroll
        for (int ai = 0; ai < 2; ++ai)
#pragma unroll
            for (int m = 0; m < 4; ++m) { bf16* rowp = O + (size_t)(row0 + ai * 128 + m * 16) * ld + col0;
#pragma unroll
                for (int bj = 0; bj < 2; ++bj) *(u32x4*)(rowp + bj * 128) = pack8(acc[ai][bj][m][0], acc[ai][bj][m][1]); }
    }
};

struct EpiIn {
    static constexpr bool PERM = true, AFTER_DRAIN = false, PERMA = false;
    bf16 *QKV, *ZT, *ZTC, *UR;
    DI void operator()(const f32x4 (&acc)[2][2][4][2], const pg8::Unit& u, int wr, int wc, int fr, int fq) const {
        const int pn = u.pn, rl0 = wr * 64 + fr, cl = wc * 32 + 8 * fq;
        if (pn < 3) {
#pragma unroll
            for (int ai = 0; ai < 2; ++ai)
#pragma unroll
                for (int m = 0; m < 4; ++m) { bf16* rowp = QKV + (size_t)(u.pm * 256 + rl0 + ai * 128 + m * 16) * 768 + pn * 256 + cl;
#pragma unroll
                    for (int bj = 0; bj < 2; ++bj) *(u32x4*)(rowp + bj * 128) = pack8(acc[ai][bj][m][0], acc[ai][bj][m][1]); }
        } else if (pn < 5) {
            bf16* base; int stride;
            if (u.pm < 256) { const int b = u.pm >> 3, t0 = (u.pm & 7) * 256; base = ZT + (size_t)b * 256 * 4096 + (pn - 3) * 2048 + t0; stride = 4096; }
            else { const int b = u.pm - 256; base = ZTC + (size_t)b * 256 * 512 + (pn - 3) * 256; stride = 512; }
#pragma unroll
            for (int ai = 0; ai < 2; ++ai)
#pragma unroll
                for (int m = 0; m < 4; ++m) { const int rl = rl0 + ai * 128 + m * 16;
#pragma unroll
                    for (int bj = 0; bj < 2; ++bj)
#pragma unroll
                        for (int n = 0; n < 2; ++n)
#pragma unroll
                            for (int e = 0; e < 4; ++e) base[(size_t)(bj * 128 + cl + 4 * n + e) * stride + rl] = f2bf(acc[ai][bj][m][n][e]); }
        } else {
#pragma unroll
            for (int ai = 0; ai < 2; ++ai)
#pragma unroll
                for (int m = 0; m < 4; ++m) { bf16* rowp = UR + (size_t)(u.pm * 256 + rl0 + ai * 128 + m * 16) * RW + (pn - 5) * 256 + cl;
#pragma unroll
                    for (int bj = 0; bj < 2; ++bj) if ((pn - 5) * 256 + bj * 128 < RW) *(u32x4*)(rowp + bj * 128) = pack8(acc[ai][bj][m][0], acc[ai][bj][m][1]); }
        }
    }
};

struct EpiGate {
    static constexpr bool PERM = true, AFTER_DRAIN = false, PERMA = false;
    const bf16* PP; bf16* MG;
    DI void operator()(const f32x4 (&acc)[2][2][4][2], const pg8::Unit& u, int wr, int wc, int fr, int fq) const {
        const int br = u.pn >> 2, cn = u.pn & 3, row0 = u.pm * 256 + wr * 64 + fr, col0 = cn * 256 + wc * 32 + 8 * fq;
#pragma unroll
        for (int ai = 0; ai < 2; ++ai)
#pragma unroll
            for (int m = 0; m < 4; ++m) { const size_t row = (size_t)(row0 + ai * 128 + m * 16);
#pragma unroll
                for (int bj = 0; bj < 2; ++bj) {
                    const u32x4 pp = *(const u32x4*)(PP + row * NGATE + br * 1024 + col0 + bj * 128);
                    bf16* mp = MG + row * 1024 + col0 + bj * 128;
                    f32x4 a = acc[ai][bj][m][0], b = acc[ai][bj][m][1];
                    { const f32x2 s0 = sigm2((f32x2){a[0], a[1]}) * (f32x2){lo2f(pp.x), hi2f(pp.x)}, s1 = sigm2((f32x2){a[2], a[3]}) * (f32x2){lo2f(pp.y), hi2f(pp.y)}, s2 = sigm2((f32x2){b[0], b[1]}) * (f32x2){lo2f(pp.z), hi2f(pp.z)}, s3 = sigm2((f32x2){b[2], b[3]}) * (f32x2){lo2f(pp.w), hi2f(pp.w)};
                      a = (f32x4){s0.x, s0.y, s1.x, s1.y}; b = (f32x4){s2.x, s2.y, s3.x, s3.y}; }
                    if (br) { const u32x4 o = *(const u32x4*)mp;
                        a[0] += lo2f(o.x); a[1] += hi2f(o.x); a[2] += lo2f(o.y); a[3] += hi2f(o.y); b[0] += lo2f(o.z); b[1] += hi2f(o.z); b[2] += lo2f(o.w); b[3] += hi2f(o.w); }
                    *(u32x4*)mp = pack8(a, b); } }
    }
};

DI f32x2 gelu2(f32x2 z) {
    const f32x2 u = z * (z * z * 0.044715f + 1.f), t = u * (-1.5957691216057308f * LOG2E);
    f32x2 e; e.x = fexp2(t.x); e.y = fexp2(t.y);
    const f32x2 d = e + 1.f; f32x2 r; r.x = frcp(d.x); r.y = frcp(d.y);
    return z * r;
}
struct EpiUp {
    static constexpr bool PERM = true, AFTER_DRAIN = false, PERMA = true;
    bf16* HH; bf16* HALO; const float* cw; const float* cb;
    DI void operator()(const f32x4 (&acc)[2][2][4][2], const pg8::Unit& u, int wr, int wc, int fr, int fq) const {
        const int j0 = 128 * u.pn + 32 * wc + 8 * fq;
        f32x4 w0[2], w1[2], w2[2], bb[2];
#pragma unroll
        for (int n = 0; n < 2; ++n) { w0[n] = *(const f32x4*)(cw + j0 + 4 * n); w1[n] = *(const f32x4*)(cw + DFF + j0 + 4 * n); w2[n] = *(const f32x4*)(cw + 2 * DFF + j0 + 4 * n); bb[n] = *(const f32x4*)(cb + j0 + 4 * n); }
#pragma unroll
        for (int ai = 0; ai < 2; ++ai) {
            const int grp = u.pm * 4 + ai * 2 + wr;
            bf16* hb = HALO + (size_t)grp * 6 * DFF + j0;
            if (fr == 0) { *(u32x4*)(hb) = pack8(acc[ai][0][0][0], acc[ai][0][0][1]); *(u32x4*)(hb + DFF) = pack8(acc[ai][0][1][0], acc[ai][0][1][1]); *(u32x4*)(hb + 4 * DFF) = pack8(acc[ai][1][0][0], acc[ai][1][0][1]); }
            if (fr == 15) { *(u32x4*)(hb + 2 * DFF) = pack8(acc[ai][0][2][0], acc[ai][0][2][1]); *(u32x4*)(hb + 3 * DFF) = pack8(acc[ai][0][3][0], acc[ai][0][3][1]); *(u32x4*)(hb + 5 * DFF) = pack8(acc[ai][1][3][0], acc[ai][1][3][1]); }
            f32x4 o[4][2];
#pragma unroll
            for (int n = 0; n < 2; ++n)
#pragma unroll
                for (int ep = 0; ep < 2; ++ep) {
                    f32x2 x[4];
#pragma unroll
                    for (int m = 0; m < 4; ++m) x[m] = (f32x2){acc[ai][0][m][n][2 * ep], acc[ai][0][m][n][2 * ep + 1]};
                    f32x2 pv, nx;
                    pv.x = dppf<0x111, true>(0.f, x[3].x); pv.y = dppf<0x111, true>(0.f, x[3].y);
                    nx.x = dppf<0x101, true>(0.f, x[0].x); nx.y = dppf<0x101, true>(0.f, x[0].y);
                    const f32x2 c0 = {w0[n][2 * ep], w0[n][2 * ep + 1]}, c1 = {w1[n][2 * ep], w1[n][2 * ep + 1]}, c2 = {w2[n][2 * ep], w2[n][2 * ep + 1]}, cb2 = {bb[n][2 * ep], bb[n][2 * ep + 1]};
#pragma unroll
                    for (int m = 0; m < 4; ++m) {
                        const f32x2 prev = m ? x[m ? m - 1 : 0] : pv, next = (m < 3) ? x[m < 3 ? m + 1 : 3] : nx;
                        const f32x2 z = c0 * prev + c1 * x[m] + c2 * next + cb2;
                        const f32x2 zv = {acc[ai][1][m][n][2 * ep], acc[ai][1][m][n][2 * ep + 1]};
                        const f32x2 g = gelu2(z) * zv;
                        o[m][n][2 * ep] = g.x; o[m][n][2 * ep + 1] = g.y;
                    }
                }
#pragma unroll
            for (int m = 0; m < 4; ++m) {
                const bool edge = (m == 0 && fr == 0) || (m == 3 && fr == 15);
                if (!edge) *(u32x4*)(HH + (size_t)(u.pm * 256 + ai * 128 + wr * 64 + 4 * fr + m) * DFF + j0) = pack8(o[m][0], o[m][1]);
            }
        }
    }
};

struct GateOrder {
    int nU, G, c;
    DI bool next(int i, pg8::Unit& u) const { const int j = i / 3, br = i - 3 * j; const long L = (long)j * G + c; if (L >= nU) return false; u.pm = (int)(L >> 2); u.pn = br * 4 + (int)(L & 3); return true; }
    DI void a_ready(const pg8::Unit&) const {}
    DI void done(const pg8::Unit&) const {}
};

struct Ctx {
    LAS unsigned char* lds; unsigned char* ws; const Params& P; float* out;
    int tid, lane, wave, G, bid, z;
};
DI Ctx rectx(const Ctx& C0) { const int t = otid(); int z = 0; asm volatile("" : "+s"(z)); return Ctx{C0.lds, C0.P.ws + z, C0.P, C0.P.out + z, t, t & 63, __builtin_amdgcn_readfirstlane(t >> 6), C0.G, C0.bid, z}; }
#define WSP(T, off) ((T*)(C.ws + (off)))
#define WL(T, l, off) ((T*)(C.ws + WS_W + (size_t)(l) * WL_SIZE + (off)))

DI void tr_item(const float* src, int ldw, int k0, int n0, bf16* dst, int ldd, int drow0, LAS float* scr, int lane) {
#pragma unroll 8
    for (int i = 0; i < 32; ++i) { const int kk = 2 * i + (lane >> 5); scr[kk * 33 + (lane & 31)] = src[(size_t)(k0 + kk) * ldw + n0 + (lane & 31)]; }
    asm volatile("s_waitcnt lgkmcnt(0)" ::: "memory");
    const int c = lane & 7;
#pragma unroll
    for (int j = 0; j < 4; ++j) { const int n = (lane >> 3) + 8 * j; const LAS float* s = scr + (8 * c) * 33 + n;
        u32x4 o; o.x = pk(s[0 * 33], s[1 * 33]); o.y = pk(s[2 * 33], s[3 * 33]); o.z = pk(s[4 * 33], s[5 * 33]); o.w = pk(s[6 * 33], s[7 * 33]);
        *(u32x4*)(dst + (size_t)(drow0 + n) * ldd + k0 + 8 * c) = o; }
    asm volatile("s_waitcnt lgkmcnt(0)" ::: "memory");
}
DI void tr_matrix(const Ctx& C, int gw, int NGW, const float* src, int ldw, int K, int n_src0, int ncols, bf16* dst, int drow0, LAS float* scr) {
    const int nb = ncols / 32, nit = (K / 64) * nb;
    for (int it = gw; it < nit; it += NGW) { const int kb = it / nb, b = it % nb; tr_item(src, ldw, kb * 64, n_src0 + b * 32, dst, K, drow0 + b * 32, scr, C.lane); }
}

DI void weights_tr(const Ctx& C, int l, int gw, int NGW, LAS float* scr) {
    const float* win = C.P.in[10 + C.z] + (size_t)l * 1024 * IN_COLS;
    bf16* wi = WL(bf16, l, WL_IN);
    tr_matrix(C, gw, NGW, win, IN_COLS, 1024, 1152, 512, wi, 0, scr);
    tr_matrix(C, gw, NGW, win, IN_COLS, 1024, 1664, 128, wi, 512, scr);
    tr_matrix(C, gw, NGW, win, IN_COLS, 1024, 1792, 128, wi, 640, scr);
    tr_matrix(C, gw, NGW, win, IN_COLS, 1024, 0, 1152, wi, 1280, scr);
    tr_matrix(C, gw, NGW, win, IN_COLS, 1024, 2176, 3072, WL(bf16, l, WL_G), 0, scr);
    tr_matrix(C, gw, NGW, C.P.in[26 + C.z] + (size_t)l * 256 * 1024, 1024, 256, 0, 1024, WL(bf16, l, WL_BR), 0, scr);
    tr_matrix(C, gw, NGW, C.P.in[27 + C.z] + (size_t)l * 512 * 1024, 1024, 512, 0, 1024, WL(bf16, l, WL_BA), 0, scr);
    tr_matrix(C, gw, NGW, C.P.in[28 + C.z] + (size_t)l * 256 * 1024, 1024, 256, 0, 1024, WL(bf16, l, WL_BF), 0, scr);
    tr_matrix(C, gw, NGW, C.P.in[29 + C.z] + (size_t)l * 1024 * 1024, 1024, 1024, 0, 1024, WL(bf16, l, WL_O), 0, scr);
    {
        const float* up = C.P.in[30 + C.z] + (size_t)l * 1024 * 2 * DFF; bf16* wu = WL(bf16, l, WL_UP);
        for (int it = gw; it < 16 * 44 * 4; it += NGW) { const int kb = it / 176, r = it % 176, seg = r >> 2, b = r & 3, pn = seg >> 1, bj = seg & 1;
            tr_item(up, 2 * DFF, kb * 64, bj * DFF + pn * 128 + b * 32, wu, 1024, pn * 256 + bj * 128 + b * 32, scr, C.lane); }
    }
    tr_matrix(C, gw, NGW, C.P.in[33 + C.z] + (size_t)l * DFF * 1024, 1024, DFF, 0, 1024, WL(bf16, l, WL_DN), 0, scr);
}
DI void prologue(const Ctx& C0) {
    const Ctx C = rectx(C0);
    LAS float* scr = (LAS float*)(C.lds + 49152 + C.wave * 8704);
    const int gth = C.bid * NTHREADS + C.tid, NGT = C.G * NTHREADS;
    for (int tsk = C.bid; tsk < 72; tsk += C.G) {
        const int l = tsk / 36, rem = tsk % 36, cb = rem / 3, rg = rem % 3;
        LAS float* s = (LAS float*)C.lds;
        for (int i = C.tid; i < 11 * 1024; i += NTHREADS) { const int r = rg * 11 + i / 1024, k = i % 1024; const float cv = (r < 32) ? C.P.in[1 + C.z][r * 1024 + k] : C.P.in[3 + C.z][k]; s[i] = cv * sigm(cv); }
        __syncthreads();
        const int j = cb * 512 + C.tid;
        float acc[11];
        const float bj = C.P.in[5 + C.z][l * 6144 + j];
#pragma unroll
        for (int i = 0; i < 11; ++i) acc[i] = bj;
        const float* wp = C.P.in[4 + C.z] + (size_t)l * 1024 * 6144 + j;
        for (int k = 0; k < 1024; k += 4) {
            const float w0 = wp[(size_t)k * 6144], w1 = wp[(size_t)(k + 1) * 6144], w2 = wp[(size_t)(k + 2) * 6144], w3 = wp[(size_t)(k + 3) * 6144];
#pragma unroll
            for (int i = 0; i < 11; ++i) { const f32x4 x = *(const LAS f32x4*)(s + i * 1024 + k); acc[i] += x[0] * w0 + x[1] * w1 + x[2] * w2 + x[3] * w3; }
        }
#pragma unroll
        for (int i = 0; i < 11; ++i) WSP(float, WS_MOD)[(size_t)(l * 33 + rg * 11 + i) * 6144 + j] = acc[i];
        __syncthreads();
    }
    if (C.bid == C.G - 1) for (int i = C.tid; i < 1024; i += NTHREADS) { const int p = i >> 4, f = i & 15; const float inv = powf(10000.f, -(float)f / 16.f), ang = (float)p * inv; WSP(float, WS_SMALL)[2 * i] = cosf(ang); WSP(float, WS_SMALL)[2 * i + 1] = sinf(ang); }
    for (int i = gth; i < 2048 * 4096 / 2; i += NGT) {
        const int tp = i / 2048, kk = (i % 2048) * 2; float v[2];
#pragma unroll
        for (int e = 0; e < 2; ++e) { const int k = kk + e, t = k & 2047; const int ph = (tp * t) & 2047; const float x = (float)ph * (1.f / 1024.f); v[e] = ((k < 2048) ? cospif(x) : -sinpif(x)) * 0.0027621358640099513f; }
        WSP(unsigned, WS_DFT)[i] = pk(v[0], v[1]);
    }
    for (int i = gth; i < 256 * 512 / 2; i += NGT) {
        const int tp = i / 256, kk = (i % 256) * 2; float v[2];
#pragma unroll
        for (int e = 0; e < 2; ++e) { const int k = kk + e, t = k & 255; const int ph = (tp * t) & 255; const float x = (float)ph * (1.f / 128.f); v[e] = ((k < 256) ? cospif(x) : -sinpif(x)) * 0.0078125f; }
        WSP(unsigned, WS_DFTC)[i] = pk(v[0], v[1]);
    }
    weights_tr(C, 0, C.bid * NWAVES + C.wave, C.G * NWAVES, scr);
    for (int l = 0; l < 2; ++l) {
        const float* win = C.P.in[10 + C.z] + (size_t)l * 1024 * IN_COLS;
        bf16* wi = WL(bf16, l, WL_IN);
        for (int i = gth; i < 128 * 1024 / 2; i += NGT) ((unsigned*)(wi + (size_t)2432 * 1024))[i] = 0u;
        {
            LAS float* tab = (LAS float*)(C.lds + 120 * 1024);
            __syncthreads();
            if (C.tid < 64) { const float x = (float)C.tid * (1.f / 32.f); tab[C.tid] = cospif(x); tab[64 + C.tid] = sinpif(x); }
            __syncthreads();
            for (int i = gth; i < 512 * 1024; i += NGT) {
                const int k = i & 1023, np = i >> 10, sn = np >> 8, g = (np >> 6) & 3, cp = np & 63;
                const float* wr_ = win + (size_t)k * IN_COLS + 1920 + g * 64; const LAS float* tb = tab + sn * 64; float a = 0.f;
#pragma unroll 8
                for (int c = 0; c < 64; ++c) a += wr_[c] * tb[(c * cp) & 63];
                wi[(size_t)(768 + np) * 1024 + k] = f2bf(a);
            }
        }
        {
            bf16* wl = WSP(bf16, WS_WLORA + (size_t)l * 2 * MiB);
            const float* w2 = C.P.in[13 + C.z] + (size_t)l * 2 * 64 * 256; const float* a2 = C.P.in[15 + C.z] + (size_t)l * 2 * 64 * 256; const float* g2 = C.P.in[16 + C.z] + (size_t)l * 128 * 256;
            const int kl = (l == 0) ? 384 : KLO;
            for (int i = gth; i < NLO * kl; i += NGT) {
                const int c = i & 255, nb = (i >> 8) % 6, k = i / (256 * 6); float v = 0.f;
                if (nb == 0) { if (k < 64) v = w2[k * 256 + c]; }
                else if (nb == 1) { if (k >= 64 && k < 128) v = w2[(64 + k - 64) * 256 + c]; }
                else if (nb == 2) { if (k >= 128 && k < 192) v = a2[(k - 128) * 256 + c]; }
                else if (nb == 3) { if (k >= 192 && k < 256) v = a2[(64 + k - 192) * 256 + c]; }
                else if (nb == 4) { if (k >= 256 && k < 384) v = g2[(k - 256) * 256 + c]; }
                else if (l == 1 && k >= 384) { const float* v1 = C.P.in[23 + C.z] + (k - 384) * 32; const float* v2 = C.P.in[24 + C.z] + c; for (int j = 0; j < 32; ++j) v += v1[j] * v2[j * 256]; }
                wl[(size_t)(nb * 256 + c) * kl + k] = f2bf(v);
            }
        }
    }
}

template <bool HAS_ADD, bool HAS_OUT>
DI void rowop(const Ctx& C0, int nrows, const float* hin_l, const float* hin_c, float* hout_l, float* hout_c, const bf16* add, int ga, const float* g_add, const float* g_out, int sh, int sc, const float* modl, const float* modo, bf16* Aout) {
    const Ctx C = rectx(C0);
    const int rpw = (nrows + C.G * NWAVES - 1) / (C.G * NWAVES), r0 = (C.bid * NWAVES + C.wave) * rpw, r1 = (r0 + rpw < nrows) ? r0 + rpw : nrows;
    if (r0 >= r1) return;
    const int c0 = 4 * C.lane;
    f32x4 gA[4], gO[4], mG[4], mS[4], mB[4];
#pragma unroll
    for (int j = 0; j < 4; ++j) { if (HAS_ADD) gA[j] = *(const f32x4*)(g_add + c0 + 256 * j); if (HAS_OUT) gO[j] = *(const f32x4*)(g_out + c0 + 256 * j); }
    int bcur = -1;
    f32x4 hn[4]; u32x2 an[4];
#define ROW_HP(t) (((t) < NLAT) ? hin_l + (size_t)(t) * DM : hin_c + (size_t)((t) - NLAT) * DM)
    { const float* hp = ROW_HP(r0);
#pragma unroll
      for (int j = 0; j < 4; ++j) { hn[j] = *(const f32x4*)(hp + c0 + 256 * j); if (HAS_ADD) an[j] = *(const u32x2*)(add + (size_t)r0 * DM + c0 + 256 * j); } }
    for (int tok = r0; tok < r1; ++tok) {
        f32x4 h[4]; u32x2 ar[4];
#pragma unroll
        for (int j = 0; j < 4; ++j) { h[j] = hn[j]; if (HAS_ADD) ar[j] = an[j]; }
        if (tok + 1 < r1) { const float* hp = ROW_HP(tok + 1);
#pragma unroll
            for (int j = 0; j < 4; ++j) { hn[j] = *(const f32x4*)(hp + c0 + 256 * j); if (HAS_ADD) an[j] = *(const u32x2*)(add + (size_t)(tok + 1) * DM + c0 + 256 * j); } }
        const bool lat = tok < NLAT; const int b = lat ? tok / TL : 32;
        if (b != bcur) { bcur = b; const float* mp = modl + (size_t)b * 6144; const float* mq = modo + (size_t)b * 6144;
#pragma unroll
            for (int j = 0; j < 4; ++j) { if (HAS_ADD) mG[j] = *(const f32x4*)(mp + ga * 1024 + c0 + 256 * j); if (HAS_OUT) { mS[j] = *(const f32x4*)(mq + sc * 1024 + c0 + 256 * j) + 1.f; mB[j] = *(const f32x4*)(mq + sh * 1024 + c0 + 256 * j); } } }
        if (HAS_ADD) {
            f32x4 a[4]; float ss = 0.f;
#pragma unroll
            for (int j = 0; j < 4; ++j) { a[j] = (f32x4){lo2f(ar[j].x), hi2f(ar[j].x), lo2f(ar[j].y), hi2f(ar[j].y)}; ss += a[j][0] * a[j][0] + a[j][1] * a[j][1] + a[j][2] * a[j][2] + a[j][3] * a[j][3]; }
            const float rstd = rsqrtf(wave_sum(ss) * (1.f / DM) + 1e-6f);
            float* op = lat ? hout_l + (size_t)tok * DM : hout_c + (size_t)(tok - NLAT) * DM;
#pragma unroll
            for (int j = 0; j < 4; ++j) { h[j] = h[j] + mG[j] * (a[j] * rstd * gA[j]); *(f32x4*)(op + c0 + 256 * j) = h[j]; }
        }
        if (HAS_OUT) {
            float ss = 0.f;
#pragma unroll
            for (int j = 0; j < 4; ++j) ss += h[j][0] * h[j][0] + h[j][1] * h[j][1] + h[j][2] * h[j][2] + h[j][3] * h[j][3];
            const float rstd = rsqrtf(wave_sum(ss) * (1.f / DM) + 1e-6f);
#pragma unroll
            for (int j = 0; j < 4; ++j) { const f32x4 y = (h[j] * rstd * gO[j]) * mS[j] + mB[j]; u32x2 o; o.x = pk(y[0], y[1]); o.y = pk(y[2], y[3]);
                *(u32x2*)(Aout + (size_t)tok * DM + c0 + 256 * j) = o; }
        }
    }
#undef ROW_HP
}

DI void feat1_phase(const Ctx& C0, int l) {
    const Ctx C = rectx(C0);
    const bf16* UR = WSP(bf16, WS_X + X_UR); bf16* F = WSP(bf16, WS_X + X_F); bf16* X2 = WSP(bf16, WS_A);
    const float* mu = C.P.in[11 + C.z] + (size_t)l * 2 * RW;
    const int gth = C.bid * NTHREADS + C.tid, NGT = C.G * NTHREADS, kl = (l == 0) ? 384 : KLO;
    for (int idx = gth; idx < NT * 144; idx += NGT) {
        const int tok = idx / 144, pc = idx - tok * 144, cc = pc * 8;
        const int t = (tok < NLAT) ? (tok & (TL - 1)) : ((tok - NLAT) & (TC - 1)), T = (tok < NLAT) ? TL : TC;
        const bf16* up_ = UR + (size_t)tok * RW + cc;
        const u32x4 u = *(const u32x4*)up_;
        u32x4 p = {0u, 0u, 0u, 0u}, nx = {0u, 0u, 0u, 0u};
        if (t > 0) p = *(const u32x4*)(up_ - RW);
        if (t < T - 1) nx = *(const u32x4*)(up_ + RW);
        const f32x4 m0a = *(const f32x4*)(mu + cc), m0b = *(const f32x4*)(mu + cc + 4), m1a = *(const f32x4*)(mu + RW + cc), m1b = *(const f32x4*)(mu + RW + cc + 4);
        float s[8];
#pragma unroll
        for (int e = 0; e < 8; ++e) { const float uu = (e & 1) ? hi2f(u[e >> 1]) : lo2f(u[e >> 1]), pp = (e & 1) ? hi2f(p[e >> 1]) : lo2f(p[e >> 1]), nn = (e & 1) ? hi2f(nx[e >> 1]) : lo2f(nx[e >> 1]);
            const float m0 = (e < 4) ? m0a[e & 3] : m0b[e & 3], m1 = (e < 4) ? m1a[e & 3] : m1b[e & 3];
            s[e] = uu + m0 * (pp - uu) + m1 * (nn - uu); }
        if (cc >= 768 && cc < 896) {
#pragma unroll
            for (int e = 0; e < 8; ++e) s[e] = tanh_(s[e]); }
        else if (cc >= 1024) {
#pragma unroll
            for (int e = 0; e < 8; ++e) s[e] = sigm(s[e]); }
        u32x4 w; w.x = pk(s[0], s[1]); w.y = pk(s[2], s[3]); w.z = pk(s[4], s[5]); w.w = pk(s[6], s[7]);
        if (cc < 256) *(u32x4*)(F + (size_t)tok * 2048 + cc) = w;
        else if (cc < 512) *(u32x4*)(F + (size_t)tok * 2048 + 768 + cc - 256) = w;
        else if (cc < 768) { *(u32x4*)(F + (size_t)tok * 2048 + 512 + cc - 512) = w; if (l == 1) *(u32x4*)(X2 + (size_t)tok * kl + 384 + cc - 512) = w; }
        else *(u32x4*)(X2 + (size_t)tok * kl + cc - 768) = w;
    }
}
DI void feat3_phase(const Ctx& C0, int l) {
    const Ctx C = rectx(C0);
    bf16* F = WSP(bf16, WS_X + X_F); bf16* Gq = WSP(bf16, WS_X + X_G); bf16* VF = WSP(bf16, WS_VF); float* BON = WSP(float, WS_BON); const bf16* LO = WSP(bf16, WS_X + X_LO);
    const int c = (C.lane >> 4) * 64 + (C.lane & 15) * 4;
    const f32x4 kkw = *(const f32x4*)(C.P.in[17 + C.z] + l * 256 + c), kaw = *(const f32x4*)(C.P.in[18 + C.z] + l * 256 + c), rkw = *(const f32x4*)(C.P.in[19 + C.z] + l * 256 + c);
    const f32x4 w0f = *(const f32x4*)(C.P.in[12 + C.z] + l * 512 + c), w0b = *(const f32x4*)(C.P.in[12 + C.z] + l * 512 + 256 + c), a0f = *(const f32x4*)(C.P.in[14 + C.z] + l * 512 + c), a0b = *(const f32x4*)(C.P.in[14 + C.z] + l * 512 + 256 + c);
    const f32x4 v0c = *(const f32x4*)(C.P.in[22 + C.z] + c);
    const int rpw = NT / (256 * NWAVES), r0 = (C.bid * NWAVES + C.wave) * rpw;
    if (C.bid >= 256) return;
    u32x2 nR, nK, nV, nVF, nL[6];
#define F3_LOAD(t) do { const size_t o_ = (size_t)(t) * 256 + c; const bf16* f_ = F + (size_t)(t) * 2048 + c; nR = *(const u32x2*)(f_); nK = *(const u32x2*)(f_ + 768); nV = *(const u32x2*)(f_ + 512); if (l == 1) nVF = *(const u32x2*)(VF + o_); \
        _Pragma("unroll") for (int q = 0; q < 6; ++q) if (q < 5 || l == 1) nL[q] = *(const u32x2*)(LO + (size_t)(t) * NLO + q * 256 + c); } while (0)
    F3_LOAD(r0);
    for (int tok = r0; tok < r0 + rpw; ++tok) {
        const u32x2 cR = nR, cK = nK, cV = nV, cVF = nVF; u32x2 cL[6];
#pragma unroll
        for (int q = 0; q < 6; ++q) cL[q] = nL[q];
        if (tok + 1 < r0 + rpw) F3_LOAD(tok + 1);
        const size_t o = (size_t)tok * 256 + c;
        const f32x4 r = bf4(cR), k = bf4(cK); f32x4 v = bf4(cV);
        if (l == 1) { const f32x4 vf = bf4(cVF), z = v0c + bf4(cL[5]);
#pragma unroll
            for (int e = 0; e < 4; ++e) v[e] = v[e] + (vf[e] - v[e]) * sigm(z[e]);
            *(u32x2*)(F + (size_t)tok * 2048 + 512 + c) = pk4(v); }
        else *(u32x2*)(VF + o) = cV;
        const f32x4 kr = k * kkw;
        const float ss = row16_sum(kr[0] * kr[0] + kr[1] * kr[1] + kr[2] * kr[2] + kr[3] * kr[3]), rn = rsqrtf(fmaxf(ss, 1e-24f));
        const f32x4 lf = w0f + bf4(cL[0]), lb = w0b + bf4(cL[1]), xf = a0f + bf4(cL[2]), xb = a0b + bf4(cL[3]);
        f32x4 ef, eb, af, ab; float bp = 0.f;
#pragma unroll
        for (int e = 0; e < 4; ++e) { ef[e] = 0.6065306597126334f * sigm(lf[e]); eb[e] = 0.6065306597126334f * sigm(lb[e]); af[e] = sigm(xf[e]); ab[e] = sigm(xb[e]);
            bp += r[e] * k[e] * (1.f + (0.5f * (af[e] + ab[e]) - 1.f) * kaw[e]) * rkw[e]; }
        const float bon = row16_sum(bp);
        if ((C.lane & 15) == 0) BON[(size_t)tok * 4 + (C.lane >> 4)] = bon;
        { bf16* f_ = F + (size_t)tok * 2048 + c; *(u32x2*)(f_ + 256) = pk4(kr * rn); *(u32x2*)(f_ + 1024) = pk4(ef); *(u32x2*)(f_ + 1280) = pk4(eb); *(u32x2*)(f_ + 1536) = pk4(af); *(u32x2*)(f_ + 1792) = pk4(ab); }
        *(u32x2*)(Gq + o) = cL[4];
    }
#undef F3_LOAD
}

struct ScanOp { bf16 r, kk, k, e, a, v; };
DI int scan_tok(int n, int dir, int b) { n = n < 2303 ? n : 2303; if (n < 256) return CTXB + b * 256 + (dir ? 255 - n : n); const int t = n - 256; return b * TL + (dir ? TL - 1 - t : t); }
DI ScanOp scan_load(const bf16* Ft, int dir, unsigned ck, unsigned cv) {
    ScanOp o; o.r = Ft[ck]; o.kk = Ft[256 + ck]; o.k = Ft[768 + ck]; o.e = (Ft + (4 + dir) * 256)[ck]; o.a = (Ft + (6 + dir) * 256)[ck]; o.v = Ft[512 + cv]; return o;
}
#define DPPT " row_mask:0xf bank_mask:0xf\n\t"
#define SOPS(S) "+v"(S[0]), "+v"(S[1]), "+v"(S[2]), "+v"(S[3]), "+v"(S[4]), "+v"(S[5]), "+v"(S[6]), "+v"(S[7]), "+v"(S[8]), "+v"(S[9]), "+v"(S[10]), "+v"(S[11]), "+v"(S[12]), "+v"(S[13]), "+v"(S[14]), "+v"(S[15])
struct ScanVec { float w, kd, nbd, r, v; };
DI ScanVec scan_conv(const ScanOp& op, float ka, float& kk_out) {
    const float kk = bf2f(op.kk), k = bf2f(op.k), e = bf2f(op.e), a = bf2f(op.a);
    ScanVec c; c.r = bf2f(op.r); c.v = bf2f(op.v); c.w = fexp2(-e * LOG2E); c.kd = k * (1.f + (a - 1.f) * ka); c.nbd = -(kk * a); kk_out = kk; return c;
}
DI void scan_step(float (&S)[16], float& sa, ScanVec& cur, const ScanOp& nxt, float ka, bf16* yp, bool wr) {
    const float w = cur.w, nbd = cur.nbd, kd = cur.kd, v = cur.v;
#define UPM(j) "v_mul_f32_dpp %" #j ", %16, %" #j " row_newbcast:" #j DPPT
#define UPA(j) "v_fmac_f32_dpp %" #j ", %17, %19 row_newbcast:" #j DPPT
#define UPB(j) "v_fmac_f32_dpp %" #j ", %18, %20 row_newbcast:" #j DPPT
#define ALL16(M) M(0) M(1) M(2) M(3) M(4) M(5) M(6) M(7) M(8) M(9) M(10) M(11) M(12) M(13) M(14) M(15)
    asm volatile(ALL16(UPM) ALL16(UPA) ALL16(UPB) : SOPS(S) : "v"(w), "v"(nbd), "v"(kd), "v"(sa), "v"(v));
#undef UPM
#undef UPA
#undef UPB
    float kkn; ScanVec nx = scan_conv(nxt, ka, kkn);
    float r = cur.r;
    asm volatile("s_nop 1" : "+v"(r), "+v"(kkn), "+v"(nx.w), "+v"(nx.kd), "+v"(nx.nbd), "+v"(nx.r));
    float y0, y1, s0, s1;
    asm volatile(
        "v_mul_f32_dpp %0, %20, %4 row_newbcast:0" DPPT "v_mul_f32_dpp %2, %21, %4 row_newbcast:0" DPPT "v_mul_f32_dpp %1, %20, %5 row_newbcast:1" DPPT "v_mul_f32_dpp %3, %21, %5 row_newbcast:1" DPPT
        "v_fmac_f32_dpp %0, %20, %6 row_newbcast:2" DPPT "v_fmac_f32_dpp %2, %21, %6 row_newbcast:2" DPPT
        "v_fmac_f32_dpp %1, %20, %7 row_newbcast:3" DPPT "v_fmac_f32_dpp %3, %21, %7 row_newbcast:3" DPPT
        "v_fmac_f32_dpp %0, %20, %8 row_newbcast:4" DPPT "v_fmac_f32_dpp %2, %21, %8 row_newbcast:4" DPPT
        "v_fmac_f32_dpp %1, %20, %9 row_newbcast:5" DPPT "v_fmac_f32_dpp %3, %21, %9 row_newbcast:5" DPPT
        "v_fmac_f32_dpp %0, %20, %10 row_newbcast:6" DPPT "v_fmac_f32_dpp %2, %21, %10 row_newbcast:6" DPPT
        "v_fmac_f32_dpp %1, %20, %11 row_newbcast:7" DPPT "v_fmac_f32_dpp %3, %21, %11 row_newbcast:7" DPPT
        "v_fmac_f32_dpp %0, %20, %12 row_newbcast:8" DPPT "v_fmac_f32_dpp %2, %21, %12 row_newbcast:8" DPPT
        "v_fmac_f32_dpp %1, %20, %13 row_newbcast:9" DPPT "v_fmac_f32_dpp %3, %21, %13 row_newbcast:9" DPPT
        "v_fmac_f32_dpp %0, %20, %14 row_newbcast:10" DPPT "v_fmac_f32_dpp %2, %21, %14 row_newbcast:10" DPPT
        "v_fmac_f32_dpp %1, %20, %15 row_newbcast:11" DPPT "v_fmac_f32_dpp %3, %21, %15 row_newbcast:11" DPPT
        "v_fmac_f32_dpp %0, %20, %16 row_newbcast:12" DPPT "v_fmac_f32_dpp %2, %21, %16 row_newbcast:12" DPPT
        "v_fmac_f32_dpp %1, %20, %17 row_newbcast:13" DPPT "v_fmac_f32_dpp %3, %21, %17 row_newbcast:13" DPPT
        "v_fmac_f32_dpp %0, %20, %18 row_newbcast:14" DPPT "v_fmac_f32_dpp %2, %21, %18 row_newbcast:14" DPPT
        "v_fmac_f32_dpp %1, %20, %19 row_newbcast:15" DPPT "v_fmac_f32_dpp %3, %21, %19 row_newbcast:15" DPPT
        : "=&v"(y0), "=&v"(y1), "=&v"(s0), "=&v"(s1)
        : "v"(S[0]), "v"(S[1]), "v"(S[2]), "v"(S[3]), "v"(S[4]), "v"(S[5]), "v"(S[6]), "v"(S[7]), "v"(S[8]), "v"(S[9]), "v"(S[10]), "v"(S[11]), "v"(S[12]), "v"(S[13]), "v"(S[14]), "v"(S[15]), "v"(r), "v"(kkn));
    const float y = allred4(y0 + y1); sa = allred4(s0 + s1);
    if (wr) *yp = f2bf(y);
    cur = nx;
}
DI void scan_run(const Ctx& C0, int l, int b, int h, int dir) {
    const Ctx C = rectx(C0);
    if (C.wave >= 4) {
        if (l == 0) weights_tr(C, 1, C.bid * 4 + (C.wave - 4), C.G * 4, (LAS float*)(C.lds + 49152 + C.wave * 8704));
        return; }
    const int wv = C.wave & 3, q = C.lane >> 4, vi = C.lane & 15;
    const unsigned ck = h * 64 + C.lane, cv = h * 64 + 16 * wv + vi;
    const bf16* F = WSP(bf16, WS_X + X_F);
    bf16* YS = WSP(bf16, WS_X + X_UR) + (size_t)dir * FSZ;
    const float ka = C.P.in[18 + C.z][l * 256 + ck];
    float S[16];
#pragma unroll
    for (int j = 0; j < 16; ++j) S[j] = 0.f;
    const bool wr = (q == 0);
    size_t t0 = (size_t)scan_tok(0, dir, b) * 256, t1 = (size_t)scan_tok(1, dir, b) * 256, t2 = (size_t)scan_tok(2, dir, b) * 256, t3 = (size_t)scan_tok(3, dir, b) * 256;
    ScanOp o0 = scan_load(F + t0 * 8, dir, ck, cv), o1 = scan_load(F + t1 * 8, dir, ck, cv), o2 = scan_load(F + t2 * 8, dir, ck, cv), o3 = scan_load(F + t3 * 8, dir, ck, cv);
    float sa = 0.f, kk0_; ScanVec cur = scan_conv(o0, ka, kk0_);
    asm volatile("s_nop 1" : "+v"(cur.w), "+v"(cur.kd), "+v"(cur.nbd), "+v"(cur.r));
    for (int n = 0; n < 2304; n += 4) {
        size_t tn;
        scan_step(S, sa, cur, o1, ka, &(YS + t0)[cv], wr); tn = (size_t)__builtin_amdgcn_readfirstlane(scan_tok(n + 4, dir, b)) * 256; o0 = scan_load(F + tn * 8, dir, ck, cv); t0 = tn;
        scan_step(S, sa, cur, o2, ka, &(YS + t1)[cv], wr); tn = (size_t)__builtin_amdgcn_readfirstlane(scan_tok(n + 5, dir, b)) * 256; o1 = scan_load(F + tn * 8, dir, ck, cv); t1 = tn;
        scan_step(S, sa, cur, o3, ka, &(YS + t2)[cv], wr); tn = (size_t)__builtin_amdgcn_readfirstlane(scan_tok(n + 6, dir, b)) * 256; o2 = scan_load(F + tn * 8, dir, ck, cv); t2 = tn;
        scan_step(S, sa, cur, o0, ka, &(YS + t3)[cv], wr); tn = (size_t)__builtin_amdgcn_readfirstlane(scan_tok(n + 7, dir, b)) * 256; o3 = scan_load(F + tn * 8, dir, ck, cv); t3 = tn;
    }
}

DI void readout_phase(const Ctx& C0, int l, int nrows) {
    const Ctx C = rectx(C0);
    const bf16* F = WSP(bf16, WS_X + X_F); const bf16* Gq = WSP(bf16, WS_X + X_G); const bf16* YS = WSP(bf16, WS_X + X_UR); const float* BON = WSP(float, WS_BON);
    bf16* YR = WSP(bf16, WS_A + (size_t)108 * MiB);
    const int c = (C.lane >> 4) * 64 + (C.lane & 15) * 4;
    const f32x4 lw = *(const f32x4*)(C.P.in[20 + C.z] + l * 256 + c), lb = *(const f32x4*)(C.P.in[21 + C.z] + l * 256 + c);
    const int rpw = (nrows + C.G * NWAVES - 1) / (C.G * NWAVES), r0 = (C.bid * NWAVES + C.wave) * rpw, r1 = (r0 + rpw < nrows) ? r0 + rpw : nrows;
    if (r0 >= r1) return;
    u32x2 nF, nB, nV, nG; float nBon;
#define RO_LOAD(t) do { const size_t o_ = (size_t)(t) * 256 + c; nF = *(const u32x2*)(YS + o_); nB = *(const u32x2*)(YS + FSZ + o_); nV = *(const u32x2*)(F + (size_t)(t) * 2048 + 512 + c); nG = *(const u32x2*)(Gq + o_); nBon = BON[(size_t)(t) * 4 + (C.lane >> 4)]; } while (0)
    RO_LOAD(r0);
    for (int tok = r0; tok < r1; ++tok) {
        const u32x2 cF = nF, cB = nB, cV = nV, cG = nG; const float bon = nBon;
        if (tok + 1 < r1) RO_LOAD(tok + 1);
        const f32x4 y = bf4(cF) + bf4(cB);
        const float mean = row16_sum(y[0] + y[1] + y[2] + y[3]) * (1.f / 64.f);
        const f32x4 d = y - mean;
        const float var = row16_sum(d[0] * d[0] + d[1] * d[1] + d[2] * d[2] + d[3] * d[3]) * (1.f / 64.f);
        const f32x4 yn = d * rsqrtf(var + 64e-5f) * lw + lb;
        *(u32x2*)(YR + (size_t)tok * 256 + c) = pk4((yn + bf4(cV) * bon) * bf4(cG));
    }
#undef RO_LOAD
}

DI void fixup_phase(const Ctx& C0, int l, int nrows) {
    const Ctx C = rectx(C0);
    const int gw = C.bid * NWAVES + C.wave, NGW = C.G * NWAVES, nitem = (nrows / 64) * 2;
    const bf16* HALO = WSP(bf16, WS_X + X_HALO); bf16* HH = WSP(bf16, WS_X + X_HH);
    const float* cw = C.P.in[31 + C.z] + (size_t)l * 3 * DFF; const float* cb = C.P.in[32 + C.z] + (size_t)l * DFF;
    for (int it = gw; it < nitem; it += NGW) {
        const int grp = it >> 1, last = it & 1, row = grp * 64 + (last ? 63 : 0);
        const int t = (row < NLAT) ? (row & (TL - 1)) : ((row - NLAT) & (TC - 1)), T = (row < NLAT) ? TL : TC;
        const bf16* hb = HALO + (size_t)grp * 6 * DFF;
        const bf16 *pp, *pc, *pn, *pv; bool zp = false, zn = false;
        if (!last) { pc = hb; pn = hb + DFF; pv = hb + 4 * DFF; zp = (t == 0); pp = zp ? hb : hb - 6 * DFF + 3 * DFF; }
        else { pp = hb + 2 * DFF; pc = hb + 3 * DFF; pv = hb + 5 * DFF; zn = (t == T - 1); pn = zn ? hb : hb + 6 * DFF; }
        for (int p = C.lane; p < DFF / 8; p += 64) { const int j = p * 8;
            const u32x4 a = *(const u32x4*)(pp + j), bq = *(const u32x4*)(pc + j), cq = *(const u32x4*)(pn + j), vq = *(const u32x4*)(pv + j);
            float o[8];
#pragma unroll
            for (int e = 0; e < 8; ++e) { const unsigned ua = a[e >> 1], ub = bq[e >> 1], uc = cq[e >> 1], uv = vq[e >> 1];
                const float xp = zp ? 0.f : ((e & 1) ? hi2f(ua) : lo2f(ua)), xc = (e & 1) ? hi2f(ub) : lo2f(ub), xn = zn ? 0.f : ((e & 1) ? hi2f(uc) : lo2f(uc)), xv = (e & 1) ? hi2f(uv) : lo2f(uv);
                const float z = cw[j + e] * xp + cw[DFF + j + e] * xc + cw[2 * DFF + j + e] * xn + cb[j + e]; o[e] = gelu_tanh(z) * xv; }
            u32x4 w; w.x = pk(o[0], o[1]); w.y = pk(o[2], o[3]); w.z = pk(o[4], o[5]); w.w = pk(o[6], o[7]);
            *(u32x4*)(HH + (size_t)row * DFF + j) = w; }
    }
}

DI int crow(int i, int hh) { return (i & 3) + 8 * (i >> 2) + 4 * hh; }
DI void attn_unit(const Ctx& C, int l, int b, int kh, int qblk, bool isctx) {
    LAS bf16* Ks = (LAS bf16*)C.lds; LAS bf16* Vt = Ks + 64 * 72;
    const bf16* QKV = WSP(bf16, WS_X + X_QKV); bf16* YA = WSP(bf16, WS_A); const float* RT = WSP(float, WS_SMALL);
    const int g = C.wave >> 1, qt = C.wave & 1, hq = kh * 4 + g, r = C.lane & 31, hh = C.lane >> 5;
    const int qi = qblk * 64 + qt * 32 + r;
    const size_t tq = isctx ? (size_t)(CTXB + b * TC + qi) : (size_t)(b * TL + qi);
    bf16x8 qf[4];
    {
        float qv[4][8]; const bf16* qp = QKV + tq * 768 + hq * 64 + 8 * hh;
#pragma unroll
        for (int ks = 0; ks < 4; ++ks) { const u32x4 u = *(const u32x4*)(qp + 16 * ks);
#pragma unroll
            for (int e = 0; e < 4; ++e) { qv[ks][2 * e] = lo2f(u[e]); qv[ks][2 * e + 1] = hi2f(u[e]); } }
        if (!isctx) { const int rid = qi >> 6, cid = qi & 63;
#pragma unroll
            for (int j = 0; j < 8; ++j) { const int f = 8 * hh + j;
                const float c0 = RT[(rid * 16 + f) * 2], s0 = RT[(rid * 16 + f) * 2 + 1], c1 = RT[(cid * 16 + f) * 2], s1 = RT[(cid * 16 + f) * 2 + 1];
                const float a1 = qv[0][j], a2 = qv[1][j], b1 = qv[2][j], b2 = qv[3][j];
                qv[0][j] = a1 * c0 - a2 * s0; qv[1][j] = a2 * c0 + a1 * s0; qv[2][j] = b1 * c1 - b2 * s1; qv[3][j] = b2 * c1 + b1 * s1; } }
        const float sc = 0.125f * LOG2E;
#pragma unroll
        for (int ks = 0; ks < 4; ++ks) { u32x4 w; w.x = pk(qv[ks][0] * sc, qv[ks][1] * sc); w.y = pk(qv[ks][2] * sc, qv[ks][3] * sc); w.z = pk(qv[ks][4] * sc, qv[ks][5] * sc); w.w = pk(qv[ks][6] * sc, qv[ks][7] * sc); qf[ks] = __builtin_bit_cast(bf16x8, w); }
    }
    float m_run = C.P.in[25 + C.z][l * 8 + hq] * LOG2E, l_run = hh == 0 ? 1.f : 0.f;
    f32x16 o0, o1;
#pragma unroll
    for (int i = 0; i < 16; ++i) { o0[i] = 0.f; o1[i] = 0.f; }
    const int nch = isctx ? 4 : 9, skey = C.tid >> 3, oct = C.tid & 7;
#define ATT_VALID(c_) ((c_) < 4 || (qblk * 64 - 128 + ((c_) - 4) * 64 >= 0 && qblk * 64 - 128 + ((c_) - 4) * 64 < TL))
#define ATT_LOAD(c_) do { const size_t kt_ = ((c_) < 4) ? (size_t)(CTXB + b * TC + (c_) * 64) : (size_t)(b * TL + qblk * 64 - 128 + ((c_) - 4) * 64); \
        const bf16* kp_ = QKV + (kt_ + skey) * 768 + 512 + kh * 64; pk_u = *(const u32x4*)(kp_ + 8 * oct); pk_p = *(const u32x4*)(kp_ + 8 * (oct ^ 2)); pk_v = *(const u32x4*)(kp_ + 128 + 8 * oct); } while (0)
    u32x4 pk_u, pk_p, pk_v;
    int ch = 0;
    ATT_LOAD(0);
    while (ch < nch) {
        const bool win = ch >= 4; const int kb = win ? qblk * 64 - 128 + (ch - 4) * 64 : 0;
        __syncthreads();
        {
            u32x4 ku = pk_u;
            if (win) { const u32x4 pu = pk_p;
                const int p = kb + skey, pos = (oct >> 2) ? (p & 63) : (p >> 6), fb = 8 * (oct & 1); const bool isx1 = (oct & 2) == 0;
                float o[8];
#pragma unroll
                for (int e = 0; e < 8; ++e) { const float own = (e & 1) ? hi2f(ku[e >> 1]) : lo2f(ku[e >> 1]), par = (e & 1) ? hi2f(pu[e >> 1]) : lo2f(pu[e >> 1]);
                    const float cc = RT[(pos * 16 + fb + e) * 2], ss = RT[(pos * 16 + fb + e) * 2 + 1];
                    o[e] = isx1 ? (own * cc - par * ss) : (own * cc + par * ss); }
                ku.x = pk(o[0], o[1]); ku.y = pk(o[2], o[3]); ku.z = pk(o[4], o[5]); ku.w = pk(o[6], o[7]); }
            *(LAS u32x4*)(Ks + skey * 72 + 8 * oct) = ku;
            const u32x4 vu = pk_v;
#pragma unroll
            for (int e = 0; e < 8; ++e) Vt[(8 * oct + e) * 72 + skey] = (bf16)((e & 1) ? (vu[e >> 1] >> 16) : (vu[e >> 1] & 0xffffu));
        }
        __syncthreads();
        int nxc = ch + 1;
        while (nxc < nch && !ATT_VALID(nxc)) ++nxc;
        if (nxc < nch) ATT_LOAD(nxc);
        f32x16 x0, x1;
#pragma unroll
        for (int i = 0; i < 16; ++i) { x0[i] = 0.f; x1[i] = 0.f; }
#pragma unroll
        for (int ks = 0; ks < 4; ++ks) {
            const bf16x8 a0 = *(const LAS bf16x8*)(Ks + r * 72 + 16 * ks + 8 * hh), a1 = *(const LAS bf16x8*)(Ks + (32 + r) * 72 + 16 * ks + 8 * hh);
            x0 = __builtin_amdgcn_mfma_f32_32x32x16_bf16(a0, qf[ks], x0, 0, 0, 0);
            x1 = __builtin_amdgcn_mfma_f32_32x32x16_bf16(a1, qf[ks], x1, 0, 0, 0);
        }
        if (win) {
#pragma unroll
            for (int i = 0; i < 16; ++i) { const int k0 = kb + crow(i, hh), d0 = qi - k0, d1 = d0 - 32;
                if (d0 > 128 || d0 < -128) x0[i] = -1e30f; if (d1 > 128 || d1 < -128) x1[i] = -1e30f; }
        }
        float mx = x0[0];
#pragma unroll
        for (int i = 0; i < 16; ++i) { mx = fmaxf(mx, x0[i]); mx = fmaxf(mx, x1[i]); }
        mx = fmaxf(mx, __shfl_xor(mx, 32));
        const float m_new = fmaxf(m_run, mx), alpha = fexp2(m_run - m_new);
        float ps = 0.f;
#pragma unroll
        for (int i = 0; i < 16; ++i) { x0[i] = fexp2(x0[i] - m_new); x1[i] = fexp2(x1[i] - m_new); ps += x0[i] + x1[i]; o0[i] *= alpha; o1[i] *= alpha; }
        l_run = l_run * alpha + ps; m_run = m_new;
#pragma unroll
        for (int kt = 0; kt < 2; ++kt)
#pragma unroll
            for (int s = 0; s < 2; ++s) {
                const f32x16& x = kt ? x1 : x0;
                u32x4 w; w.x = pk(x[8 * s], x[8 * s + 1]); w.y = pk(x[8 * s + 2], x[8 * s + 3]); w.z = pk(x[8 * s + 4], x[8 * s + 5]); w.w = pk(x[8 * s + 6], x[8 * s + 7]);
                const bf16x8 pb = __builtin_bit_cast(bf16x8, w);
                const int ko = kt * 32 + 16 * s + 4 * hh;
                const s16x4 l0 = *(const LAS s16x4*)(Vt + r * 72 + ko), h0 = *(const LAS s16x4*)(Vt + r * 72 + ko + 8);
                const s16x4 l1 = *(const LAS s16x4*)(Vt + (32 + r) * 72 + ko), h1 = *(const LAS s16x4*)(Vt + (32 + r) * 72 + ko + 8);
                o0 = __builtin_amdgcn_mfma_f32_32x32x16_bf16(__builtin_shufflevector(l0, h0, 0, 1, 2, 3, 4, 5, 6, 7), pb, o0, 0, 0, 0);
                o1 = __builtin_amdgcn_mfma_f32_32x32x16_bf16(__builtin_shufflevector(l1, h1, 0, 1, 2, 3, 4, 5, 6, 7), pb, o1, 0, 0, 0);
            }
        ch = nxc;
    }
#undef ATT_VALID
#undef ATT_LOAD
    const float inv = frcp(l_run + __shfl_xor(l_run, 32));
    bf16* op = YA + tq * 512 + hq * 64 + 4 * hh;
#pragma unroll
    for (int i4 = 0; i4 < 4; ++i4) {
        u32x2 w0, w1; w0.x = pk(o0[4 * i4] * inv, o0[4 * i4 + 1] * inv); w0.y = pk(o0[4 * i4 + 2] * inv, o0[4 * i4 + 3] * inv);
        w1.x = pk(o1[4 * i4] * inv, o1[4 * i4 + 1] * inv); w1.y = pk(o1[4 * i4 + 2] * inv, o1[4 * i4 + 3] * inv);
        *(u32x2*)(op + 8 * i4) = w0; *(u32x2*)(op + 32 + 8 * i4) = w1;
    }
}
DI void attn_loop(const Ctx& C0, int l) {
    const Ctx C = rectx(C0);
    unsigned* ctr = WSP(unsigned, WS_CTL) + 64 * (l + 1);
    volatile LAS unsigned* slot = (volatile LAS unsigned*)(C.lds + 32768);
    const unsigned NU = 2048u + (l == 0 ? 256u : 0u);
    for (;;) {
        __syncthreads();
        if (C.tid == 0) *slot = atomicAdd(ctr, 1u);
        __syncthreads();
        const unsigned u = *slot;
        if (u >= NU) break;
        if (u < 2048u) attn_unit(C, l, (int)(u >> 6), (int)((u >> 5) & 1), (int)(u & 31), false);
        else { const unsigned v = u - 2048u; attn_unit(C, l, (int)(v >> 3), (int)((v >> 2) & 1), (int)(v & 3), true); }
    }
}


#ifdef DBG
DI float exp_f(float x) { return fexp2(x * LOG2E); }
DI unsigned hsh(unsigned x) { x ^= x >> 16; x *= 0x7feb352du; x ^= x >> 15; x *= 0x846ca68bu; x ^= x >> 16; return x; }
DI void dbg_put(const Ctx& C, int k, float got, float ref, float S) {
    float err = fabsf(got - ref) / (fabsf(ref) + S); if (!(err == err)) err = 1e9f;
    atomicMax(WSP(unsigned, WS_CTL) + 1024 + k, __builtin_bit_cast(unsigned, err));
}
DI float ndot(const bf16* a, const bf16* b, int K) { float s = 0.f; for (int k = 0; k < K; ++k) s += bf2f(a[k]) * bf2f(b[k]); return s; }
DI void dbg_check(const Ctx& C0, int stage, int l) {
    if (C0.bid != 0 || l != 0) return;
    const Ctx C = rectx(C0);
    const unsigned h1 = hsh(C.tid * 3u + 17u + stage * 1000u), h2 = hsh(h1 + 0x9e3779b9u), h3 = hsh(h2 + 77u);
    const Params& P = C.P;
    if (stage == 0) {
        {
            const int n = h1 % 2432, k = h2 % 1024; int src = -1;
            if (n < 512) src = 1152 + n; else if (n < 640) src = 1664 + (n - 512); else if (n < 768) src = 1792 + (n - 640); else if (n >= 1280) src = n - 1280;
            if (src >= 0) dbg_put(C, 0, bf2f(WL(bf16, 0, WL_IN)[(size_t)n * 1024 + k]), bf2f(f2bf(P.in[10 + C.z][(size_t)k * IN_COLS + src])), 1e-6f);
            const int ng = h3 % 3072;
            dbg_put(C, 0, bf2f(WL(bf16, 0, WL_G)[(size_t)ng * 1024 + k]), bf2f(f2bf(P.in[10 + C.z][(size_t)k * IN_COLS + 2176 + ng])), 1e-6f);
            const int nu = h3 % 5632, pn = nu >> 8, bj = (nu >> 7) & 1, j = nu & 127;
            dbg_put(C, 0, bf2f(WL(bf16, 0, WL_UP)[(size_t)nu * 1024 + k]), bf2f(f2bf(P.in[30 + C.z][(size_t)k * 5632 + bj * DFF + pn * 128 + j])), 1e-6f);
            const int nd = h1 % 1024, kd = h3 % DFF;
            dbg_put(C, 0, bf2f(WL(bf16, 0, WL_DN)[(size_t)nd * DFF + kd]), bf2f(f2bf(P.in[33 + C.z][(size_t)kd * 1024 + nd])), 1e-6f);
            dbg_put(C, 0, bf2f(WL(bf16, 0, WL_O)[(size_t)nd * 1024 + k]), bf2f(f2bf(P.in[29 + C.z][(size_t)k * 1024 + nd])), 1e-6f);
            dbg_put(C, 0, bf2f(WL(bf16, 0, WL_BA)[(size_t)nd * 512 + (k & 511)]), bf2f(f2bf(P.in[27 + C.z][(size_t)(k & 511) * 1024 + nd])), 1e-6f);
            dbg_put(C, 0, bf2f(WL(bf16, 0, WL_BR)[(size_t)nd * 256 + (k & 255)]), bf2f(f2bf(P.in[26 + C.z][(size_t)(k & 255) * 1024 + nd])), 1e-6f);
        }
        {
            const int r = h1 % 33, j = h2 % 6144; float a = P.in[5 + C.z][j];
            for (int k = 0; k < 1024; ++k) { const float cv = (r < 32) ? P.in[1 + C.z][r * 1024 + k] : P.in[3 + C.z][k]; a += cv / (1.f + exp_f(-cv)) * P.in[4 + C.z][(size_t)k * 6144 + j]; }
            dbg_put(C, 1, WSP(float, WS_MOD)[(size_t)r * 6144 + j], a, 0.01f);
        }
    } else if (stage == 1) {
        const int tok = h1 % NT, col = h2 % 1024; const bool lat = tok < NLAT; const float* hp = lat ? P.in[0 + C.z] + (size_t)tok * DM : P.in[2 + C.z] + (size_t)(tok - NLAT) * DM;
        float ss = 0.f; for (int k = 0; k < 1024; ++k) ss += hp[k] * hp[k];
        const float* mp = WSP(float, WS_MOD) + (size_t)(lat ? tok / TL : 32) * 6144;
        const float ref = hp[col] * rsqrtf(ss / 1024.f + 1e-6f) * P.in[6 + C.z][col] * (1.f + mp[1024 + col]) + mp[col];
        dbg_put(C, 2, bf2f(WSP(bf16, WS_A)[(size_t)tok * DM + col]), ref, 0.05f);
    } else if (stage == 2) {
        const int tok = h1 % NT, n = h2 % 2432; const float ref = ndot(WSP(bf16, WS_A) + (size_t)tok * DM, WL(bf16, 0, WL_IN) + (size_t)n * 1024, 1024);
        float got; int k;
        if (n < 768) { got = bf2f(WSP(bf16, WS_X + X_QKV)[(size_t)tok * 768 + n]); k = 3; }
        else if (n < 1280) { const int sn = (n - 768) >> 8, ch = (n - 768) & 255; k = 4;
            if (tok < NLAT) got = bf2f(WSP(bf16, WS_X + X_ZT)[((size_t)(tok / TL) * 256 + ch) * 4096 + sn * 2048 + (tok % TL)]);
            else got = bf2f(WSP(bf16, WS_X + X_ZTC)[((size_t)((tok - NLAT) / TC) * 256 + ch) * 512 + sn * 256 + ((tok - NLAT) % TC)]); }
        else { got = bf2f(WSP(bf16, WS_X + X_UR)[(size_t)tok * RW + n - 1280]); k = 5; }
        dbg_put(C, k, got, ref, 0.1f);
    } else if (stage == 3) {
        const int b = h1 % 32, t = 1 + h2 % 2046, c = h3 % 256; const size_t tok = (size_t)b * TL + t; const bf16* UR = WSP(bf16, WS_X + X_UR);
        const float u = bf2f(UR[tok * RW + c]), up = bf2f(UR[(tok - 1) * RW + c]), un = bf2f(UR[(tok + 1) * RW + c]);
        dbg_put(C, 7, bf2f(WSP(bf16, WS_X + X_F)[tok * 2048 + c]), u + P.in[11 + C.z][c] * (up - u) + P.in[11 + C.z][RW + c] * (un - u), 0.05f);
        float ss = 0.f; for (int k = 0; k < 64; ++k) { const float x = bf2f(WSP(bf16, WS_X + X_F)[tok * 2048 + 256 + (c & 192) + k]); ss += x * x; }
        dbg_put(C, 7, ss, 1.f, 0.f);
    } else if (stage == 4) {
        {
            LAS float* S = (LAS float*)C.lds; LAS float* sa = S + 4096; const bf16* F = WSP(bf16, WS_X + X_F); const int b = 1, h = 2;
            for (int dir = 0; dir < 2; ++dir) {
                for (int e = C.tid; e < 4096; e += NTHREADS) S[e] = 0.f;
                __syncthreads();
                for (int n = 0; n < 24; ++n) {
                    const size_t oy = (size_t)scan_tok(n, dir, b) * 256 + h * 64, o = (size_t)scan_tok(n, dir, b) * 2048 + h * 64;
                    if (C.tid < 64) { float a = 0.f; for (int k = 0; k < 64; ++k) a -= S[C.tid * 64 + k] * bf2f(F[256 + o + k]); sa[C.tid] = a; }
                    __syncthreads();
                    for (int e = C.tid; e < 4096; e += NTHREADS) { const int v = e >> 6, k = e & 63;
                        const float kk = bf2f(F[256 + o + k]), kr = bf2f(F[768 + o + k]), ee = bf2f(F[(4 + dir) * 256 + o + k]), a = bf2f(F[(6 + dir) * 256 + o + k]), vv = bf2f(F[512 + o + v]);
                        S[e] = S[e] * exp_f(-ee) + sa[v] * (kk * a) + vv * (kr * (1.f + (a - 1.f) * P.in[18 + C.z][h * 64 + k])); }
                    __syncthreads();
                    if (C.tid < 64) { float y = 0.f; for (int k = 0; k < 64; ++k) y += S[C.tid * 64 + k] * bf2f(F[o + k]);
                        dbg_put(C, 8, bf2f(WSP(bf16, WS_X + X_UR)[(size_t)dir * FSZ + oy + C.tid]), y, 0.05f); }
                    __syncthreads();
                }
            }
        }
        {
            LAS float* qs = (LAS float*)C.lds + (size_t)C.tid * 65; const bf16* QKV = WSP(bf16, WS_X + X_QKV);
            const int b = h1 % 32, t = (C.tid & 1) ? (int)(h2 % 2048) : ((C.tid & 2) ? (int)(h2 % 200) : 2047 - (int)(h2 % 200)), hq = h3 % 8, dd = (h3 >> 8) % 64, kh = hq >> 2;
            const size_t tq = (size_t)b * TL + t;
            for (int d = 0; d < 64; ++d) { const int ax = d >> 5, hf = (d >> 4) & 1, f = d & 15; const int ps = ax ? (t & 63) : (t >> 6); const float cs = WSP(float, WS_SMALL)[(ps * 16 + f) * 2], sn = WSP(float, WS_SMALL)[(ps * 16 + f) * 2 + 1];
                const float x1 = bf2f(QKV[tq * 768 + hq * 64 + ax * 32 + f]), x2 = bf2f(QKV[tq * 768 + hq * 64 + ax * 32 + 16 + f]);
                qs[d] = hf ? (x2 * cs + x1 * sn) : (x1 * cs - x2 * sn); }
            float m = P.in[25 + C.z][hq], den = 1.f, acc = 0.f;
            for (int j = 0; j < 256 + 257; ++j) {
                const bool win = j >= 256; const int kp = win ? t - 128 + (j - 256) : j; if (win && (kp < 0 || kp >= TL)) continue;
                const size_t tk = win ? (size_t)b * TL + kp : (size_t)(CTXB + b * TC + kp); float s = 0.f;
                for (int d = 0; d < 64; ++d) { float kv;
                    if (!win) kv = bf2f(QKV[tk * 768 + 512 + kh * 64 + d]);
                    else { const int ax = d >> 5, hf = (d >> 4) & 1, f = d & 15; const int ps = ax ? (kp & 63) : (kp >> 6); const float cs = WSP(float, WS_SMALL)[(ps * 16 + f) * 2], sn = WSP(float, WS_SMALL)[(ps * 16 + f) * 2 + 1];
                        const float x1 = bf2f(QKV[tk * 768 + 512 + kh * 64 + ax * 32 + f]), x2 = bf2f(QKV[tk * 768 + 512 + kh * 64 + ax * 32 + 16 + f]);
                        kv = hf ? (x2 * cs + x1 * sn) : (x1 * cs - x2 * sn); }
                    s += qs[d] * kv; }
                s *= 0.125f; const float mn = fmaxf(m, s), al = exp_f(m - mn), p = exp_f(s - mn);
                den = den * al + p; acc = acc * al + p * bf2f(QKV[tk * 768 + 640 + kh * 64 + dd]); m = mn;
            }
            dbg_put(C, 9, bf2f(WSP(bf16, WS_A)[tq * 512 + hq * 64 + dd]), acc / den, 0.03f);
        }
        __syncthreads();
        {
            LAS float* qs = (LAS float*)C.lds + (size_t)C.tid * 65; const bf16* QKV = WSP(bf16, WS_X + X_QKV);
            const int b = h2 % 32, t = h1 % 256, hq = h3 % 8, dd = (h3 >> 8) % 64, kh = hq >> 2; const size_t tq = (size_t)(CTXB + b * TC + t);
            for (int d = 0; d < 64; ++d) qs[d] = bf2f(QKV[tq * 768 + hq * 64 + d]);
            float m = P.in[25 + C.z][hq], den = 1.f, acc = 0.f;
            for (int j = 0; j < 256; ++j) { const size_t tk = (size_t)(CTXB + b * TC + j); float s = 0.f;
                for (int d = 0; d < 64; ++d) s += qs[d] * bf2f(QKV[tk * 768 + 512 + kh * 64 + d]);
                s *= 0.125f; const float mn = fmaxf(m, s), al = exp_f(m - mn), p = exp_f(s - mn); den = den * al + p; acc = acc * al + p * bf2f(QKV[tk * 768 + 640 + kh * 64 + dd]); m = mn; }
            dbg_put(C, 10, bf2f(WSP(bf16, WS_A)[tq * 512 + hq * 64 + dd]), acc / den, 0.03f);
        }
        {
            const int b = h1 % 32, tp = h2 % 2048, ch = h3 % 256;
            dbg_put(C, 11, bf2f(WSP(bf16, WS_A + (size_t)72 * MiB)[((size_t)b * TL + tp) * 256 + ch]), ndot(WSP(bf16, WS_DFT) + (size_t)tp * 4096, WSP(bf16, WS_X + X_ZT) + ((size_t)b * 256 + ch) * 4096, 4096), 0.05f);
            const int tc = h2 % 256;
            dbg_put(C, 11, bf2f(WSP(bf16, WS_A + (size_t)72 * MiB)[((size_t)CTXB + b * TC + tc) * 256 + ch]), ndot(WSP(bf16, WS_DFTC) + (size_t)tc * 512, WSP(bf16, WS_X + X_ZTC) + ((size_t)b * 256 + ch) * 512, 512), 0.05f);
        }
    } else if (stage == 5) {
        const int tok = h1 % NT, col = h2 % 1024; const bf16* PP = WSP(bf16, WS_X + X_PP);
        dbg_put(C, 13, bf2f(PP[(size_t)tok * NGATE + col]), ndot(WSP(bf16, WS_A + (size_t)108 * MiB) + (size_t)tok * 256, WL(bf16, 0, WL_BR) + (size_t)col * 256, 256), 0.05f);
        dbg_put(C, 13, bf2f(PP[(size_t)tok * NGATE + 1024 + col]), ndot(WSP(bf16, WS_A) + (size_t)tok * 512, WL(bf16, 0, WL_BA) + (size_t)col * 512, 512), 0.05f);
        dbg_put(C, 13, bf2f(PP[(size_t)tok * NGATE + 2048 + col]), ndot(WSP(bf16, WS_A + (size_t)72 * MiB) + (size_t)tok * 256, WL(bf16, 0, WL_BF) + (size_t)col * 256, 256), 0.05f);
    } else if (stage == 6) {
        const int tok = h1 % NT, col = h2 % 1024; float ref = 0.f;
        for (int br = 0; br < 3; ++br) { const float gl = ndot(WSP(bf16, WS_A) + (size_t)tok * DM, WL(bf16, 0, WL_G) + (size_t)(br * 1024 + col) * 1024, 1024); ref += bf2f(WSP(bf16, WS_X + X_PP)[(size_t)tok * NGATE + br * 1024 + col]) / (1.f + exp_f(-gl)); }
        dbg_put(C, 14, bf2f(WSP(bf16, WS_X + X_UR)[(size_t)tok * DM + col]), ref, 0.05f);
    } else if (stage == 7) {
        const int tok = h1 % NT, col = h2 % 1024;
        dbg_put(C, 15, bf2f(WSP(bf16, WS_X + X_MIX)[(size_t)tok * DM + col]), ndot(WSP(bf16, WS_X + X_UR) + (size_t)tok * DM, WL(bf16, 0, WL_O) + (size_t)col * 1024, 1024), 0.05f);
    } else if (stage == 8) {
        const int tok = h1 % NT, col = h2 % 1024; const bool lat = tok < NLAT; const float* hp = lat ? P.in[0 + C.z] + (size_t)tok * DM : P.in[2 + C.z] + (size_t)(tok - NLAT) * DM;
        const bf16* mx = WSP(bf16, WS_X + X_MIX) + (size_t)tok * DM; const float* mp = WSP(float, WS_MOD) + (size_t)(lat ? tok / TL : 32) * 6144;
        float ss = 0.f; for (int k = 0; k < 1024; ++k) ss += bf2f(mx[k]) * bf2f(mx[k]);
        const float rs = rsqrtf(ss / 1024.f + 1e-6f); float s2 = 0.f, hc = 0.f;
        for (int k = 0; k < 1024; ++k) { const float hn = hp[k] + mp[2048 + k] * bf2f(mx[k]) * rs * P.in[7 + C.z][k]; s2 += hn * hn; if (k == col) hc = hn; }
        const float* ho = lat ? C.out + (size_t)tok * DM : WSP(float, WS_HC) + (size_t)(tok - NLAT) * DM;
        dbg_put(C, 16, ho[col], hc, 0.01f);
        dbg_put(C, 16, bf2f(WSP(bf16, WS_A)[(size_t)tok * DM + col]), hc * rsqrtf(s2 / 1024.f + 1e-6f) * P.in[8 + C.z][col] * (1.f + mp[4096 + col]) + mp[3072 + col], 0.05f);
    } else if (stage == 9) {
        int tok = h1 % NT; if (C.tid & 1) tok = (tok & ~63) + ((C.tid & 2) ? 63 : 0);
        const int j = h2 % DFF; const int t = (tok < NLAT) ? (tok % TL) : ((tok - NLAT) % TC), T = (tok < NLAT) ? TL : TC;
        const bf16* A = WSP(bf16, WS_A); const bf16* wu = WL(bf16, 0, WL_UP); const int pn = j >> 7, jj = j & 127;
        const bf16* wg = wu + (size_t)(pn * 256 + jj) * 1024; const bf16* wv = wu + (size_t)(pn * 256 + 128 + jj) * 1024;
        const float zc = ndot(A + (size_t)tok * DM, wg, 1024), zp = (t > 0) ? ndot(A + (size_t)(tok - 1) * DM, wg, 1024) : 0.f, zn = (t < T - 1) ? ndot(A + (size_t)(tok + 1) * DM, wg, 1024) : 0.f, zv = ndot(A + (size_t)tok * DM, wv, 1024);
        const float z = P.in[31 + C.z][j] * zp + P.in[31 + C.z][DFF + j] * zc + P.in[31 + C.z][2 * DFF + j] * zn + P.in[32 + C.z][j];
        const float ge = 0.5f * z * (1.f + tanh_(0.7978845608028654f * (z + 0.044715f * z * z * z)));
        dbg_put(C, 17, bf2f(WSP(bf16, WS_X + X_HH)[(size_t)tok * DFF + j]), ge * zv, 0.05f);
    } else if (stage == 10) {
        const int tok = h1 % NT, col = h2 % 1024;
        dbg_put(C, 18, bf2f(WSP(bf16, WS_X + X_FFO)[(size_t)tok * DM + col]), ndot(WSP(bf16, WS_X + X_HH) + (size_t)tok * DFF, WL(bf16, 0, WL_DN) + (size_t)col * DFF, DFF), 0.05f);
    }
}
DI void dbg_report(const Ctx& C) {
    if (C.bid == 0 && threadIdx.x == 0) {
        int first = -1; for (int k = 0; k < 24; ++k) if (first < 0 && __builtin_bit_cast(float, WSP(unsigned, WS_CTL)[1024 + k]) > 0.05f) first = k;
        if (first >= 0) C.out[12345] = 1000.f * (float)(first + 1);
    }
}
#define DBGCHK(stage) do { grid.sync(); dbg_check(CK, stage, l); grid.sync(); } while (0)
#else
#define DBGCHK(stage) do { } while (0)
#endif
#define XB_TMO      128
#define XB_XCNT(j)  (256  + 64 * (j))
#define XB_XSUB(j)  (1280 + 64 * (j))
#define XB_XGEN(j)  (2304 + 64 * (j))
#define XB_TOP      3328
#define XB_TOPGEN   3392
#define XCD_BAR_WORDS 3456
#define XB_SPIN_CAP (1u << 18)

__device__ __forceinline__ unsigned xb_ld(unsigned* p)              { return __hip_atomic_load(p, __ATOMIC_RELAXED, __HIP_MEMORY_SCOPE_AGENT); }
__device__ __forceinline__ unsigned xb_add(unsigned* p, unsigned v) { return __hip_atomic_fetch_add(p, v, __ATOMIC_RELAXED, __HIP_MEMORY_SCOPE_AGENT); }
__device__ __forceinline__ unsigned xb_xcc_id() { return (unsigned)__builtin_amdgcn_s_getreg((3 << 11) | 20) & 0xFu; }
#define XB_SPIN(cond, bar) do { unsigned _sp = 0; while (cond) { __builtin_amdgcn_s_sleep(1); \
    if ((++_sp & 255u) == 0u) { if (xb_ld(&(bar)[XB_TMO])) break; if (_sp > XB_SPIN_CAP) { atomicAdd(&(bar)[XB_TMO], 1u); break; } } } } while (0)

struct XcdBarrier {
    unsigned* bar; unsigned x;
    volatile LAS unsigned* st;
};

__device__ __forceinline__ XcdBarrier xcd_barrier_post(unsigned* bar, volatile LAS unsigned* st) {
    XcdBarrier b; b.bar = bar; b.x = xb_xcc_id(); b.st = st;
    if (threadIdx.x == 0) (void)xb_add(&bar[XB_XCNT(b.x)], 1u);
    return b;
}
__device__ __forceinline__ void xcd_barrier_complete(unsigned* bar, unsigned x, unsigned& nloc, unsigned& nx) {
    const unsigned G = gridDim.x * gridDim.y * gridDim.z;
    unsigned sum, cnt, mine, sp = 0u;
    for (;;) {
        sum = 0u; cnt = 0u; mine = 0u;
#pragma unroll
        for (unsigned j = 0; j < 16; ++j) { const unsigned c = xb_ld(&bar[XB_XCNT(j)]); sum += c; cnt += (c > 0u) ? 1u : 0u; mine = (j == x) ? c : mine; }
        if (sum == G) break;
        __builtin_amdgcn_s_sleep(1);
        if ((++sp & 255u) == 0u) { if (xb_ld(&bar[XB_TMO])) break; if (sp > XB_SPIN_CAP) { atomicAdd(&bar[XB_TMO], 1u); break; } }
    }
    nloc = mine > 0u ? mine : 1u; nx = cnt > 0u ? cnt : 1u;
}

__device__ __forceinline__ void xcd_barrier(const XcdBarrier& b) {
    asm volatile("s_waitcnt vmcnt(0)" ::: "memory");
    __syncthreads();
    if (threadIdx.x == 0) {
        unsigned* bar = b.bar;
        __builtin_amdgcn_s_waitcnt(0);
        unsigned nloc = b.st[0], nx = b.st[1];
        if (nloc == 0u) { xcd_barrier_complete(bar, b.x, nloc, nx); b.st[0] = nloc; b.st[1] = nx; }
        const unsigned old = xb_add(&bar[XB_XSUB(b.x)], 1u);
        const unsigned gen = old / nloc;
        if (old + 1u == (gen + 1u) * nloc) {
            __builtin_amdgcn_fence(__ATOMIC_RELEASE, "agent");
            asm volatile("s_waitcnt vmcnt(0)" ::: "memory");
            const unsigned og = xb_add(&bar[XB_TOP], 1u);
            const unsigned tg = og / nx;
            if (og + 1u == (tg + 1u) * nx) xb_add(&bar[XB_TOPGEN], 1u);
            else XB_SPIN(xb_ld(&bar[XB_TOPGEN]) == tg, bar);
            __builtin_amdgcn_fence(__ATOMIC_ACQUIRE, "agent");
            xb_add(&bar[XB_XGEN(b.x)], 1u);
            asm volatile("s_waitcnt vmcnt(0)" ::: "memory");
        } else {
            XB_SPIN(xb_ld(&bar[XB_XGEN(b.x)]) == gen, bar);
            __builtin_amdgcn_fence(__ATOMIC_ACQUIRE, "agent");
            asm volatile("s_waitcnt vmcnt(0)" ::: "memory");
        }
    }
    __syncthreads();
}

__global__ void __launch_bounds__(NTHREADS, 2) fwd_kernel(Params P) {
    extern __shared__ __attribute__((aligned(16))) unsigned char lds_raw[];
    cg::grid_group grid = cg::this_grid();
    const int tid_ = threadIdx.x;
    const Ctx CK{(LAS unsigned char*)lds_raw, P.ws, P, P.out, tid_, tid_ & 63, __builtin_amdgcn_readfirstlane(tid_ >> 6), (int)gridDim.x, (int)blockIdx.x, 0};
    volatile LAS unsigned* xb_st = (volatile LAS unsigned*)(CK.lds + 139264);
    if (tid_ < 2) xb_st[tid_] = 0u;
    __syncthreads();
    const XcdBarrier xbar = xcd_barrier_post((unsigned*)P.ws + 4096, xb_st);
#define GSYNC() xcd_barrier(xbar)
#ifdef PROBE
#define TS(k) do { if (tid_ == 0 && blockIdx.x == 0) ((volatile LAS unsigned long long*)(CK.lds + 131072))[k] = __builtin_amdgcn_s_memrealtime(); } while (0)
#else
#define TS(k) do { } while (0)
#endif
#define PH_BEGIN { const Ctx C = rectx(CK); LAS unsigned char* glds = C.lds;
#define PH_END }
#define ABUF WSP(bf16, WS_A)
#define HCB WSP(float, WS_HC)
#define MODL(ll) (WSP(float, WS_MOD) + (size_t)(ll) * 33 * 6144)
#define HIN_L ((l == 0) ? C.P.in[0 + C.z] : (const float*)C.out)
#define HIN_C ((l == 0) ? C.P.in[2 + C.z] : (const float*)HCB)
#define GEMM_STD(Aptr, Bptr, M_, N_, K_, EPI, ...) do { pg8::Gemm g{Aptr, Bptr, M_, N_, K_}; pg8::StaticOrder S; S.init(M_, N_, C.G, C.bid); EPI E{__VA_ARGS__}; pg8::gemm_phase<EPI, pg8::StaticOrder, true, true>(glds, g, S, E); } while (0)
    TS(40);
    prologue(CK);
    grid.sync(); TS(41);
    { const int l = 0; DBGCHK(0); }
    for (int l = 0; l < 2; ++l) {
        TS(l * 16 + 0);
        const int Mmix = (l == 0) ? NT : NLAT;
        if (l == 0) { PH_BEGIN rowop<false, true>(C, NT, HIN_L, HIN_C, nullptr, nullptr, nullptr, 0, nullptr, C.P.in[6 + C.z] + l * DM, 0, 1, MODL(l), MODL(l), ABUF); PH_END GSYNC(); TS(l * 16 + 1); DBGCHK(1); }
        PH_BEGIN
            GEMM_STD(ABUF, WL(bf16, l, WL_IN), NT, NIN, DM, EpiIn, WSP(bf16, WS_X + X_QKV), WSP(bf16, WS_X + X_ZT), WSP(bf16, WS_X + X_ZTC), WSP(bf16, WS_X + X_UR));
        PH_END
        GSYNC(); TS(l * 16 + 2); DBGCHK(2);
        feat1_phase(CK, l);
        GSYNC();
        PH_BEGIN GEMM_STD(WSP(bf16, WS_A), WSP(bf16, WS_WLORA + (size_t)l * 2 * MiB), NT, (l == 0 ? 1280 : NLO), (l == 0 ? 384 : KLO), EpiStore, WSP(bf16, WS_X + X_LO), NLO, 0, 0, 256); PH_END
        GSYNC();
        feat3_phase(CK, l);
        GSYNC(); TS(l * 16 + 3); DBGCHK(3);
        if (CK.bid < 256) scan_run(CK, l, CK.bid >> 3, (CK.bid >> 1) & 3, CK.bid & 1);
        __syncthreads(); TS(l * 16 + 15);
        {
            PH_BEGIN
                pg8::Gemm g{WSP(bf16, WS_DFT), WSP(bf16, WS_X + X_ZT), 2048, 8192, 4096}; pg8::StaticOrder S; S.init(2048, 8192, C.G, C.bid);
                EpiStore E{WSP(bf16, WS_A + (size_t)72 * MiB), 256, 0, 2048, 0};
                pg8::gemm_phase<EpiStore, pg8::StaticOrder, true, true>(glds, g, S, E);
            PH_END
            if (l == 0) { PH_BEGIN
                pg8::Gemm g{WSP(bf16, WS_DFTC), WSP(bf16, WS_X + X_ZTC), 256, 8192, 512}; pg8::StaticOrder S; S.init(256, 8192, C.G, C.bid);
                EpiStore E{WSP(bf16, WS_A + (size_t)72 * MiB), 256, CTXB, 256, 0};
                pg8::gemm_phase<EpiStore, pg8::StaticOrder, true, true>(glds, g, S, E);
            PH_END }
        }
        attn_loop(CK, l);
        GSYNC(); TS(l * 16 + 4); DBGCHK(4);
        readout_phase(CK, l, Mmix);
        GSYNC(); TS(l * 16 + 5);
        PH_BEGIN GEMM_STD(WSP(bf16, WS_A + (size_t)108 * MiB), WL(bf16, l, WL_BR), Mmix, 1024, 256, EpiStore, WSP(bf16, WS_X + X_PP), NGATE, 0, 0, 256); PH_END
        PH_BEGIN GEMM_STD(WSP(bf16, WS_A), WL(bf16, l, WL_BA), Mmix, 1024, 512, EpiStore, WSP(bf16, WS_X + X_PP) + 1024, NGATE, 0, 0, 256); PH_END
        PH_BEGIN GEMM_STD(WSP(bf16, WS_A + (size_t)72 * MiB), WL(bf16, l, WL_BF), Mmix, 1024, 256, EpiStore, WSP(bf16, WS_X + X_PP) + 2048, NGATE, 0, 0, 256); PH_END
        GSYNC(); TS(l * 16 + 6); DBGCHK(5);
        PH_BEGIN rowop<false, true>(C, Mmix, HIN_L, HIN_C, nullptr, nullptr, nullptr, 0, nullptr, C.P.in[6 + C.z] + l * DM, 0, 1, MODL(l), MODL(l), ABUF); PH_END
        GSYNC(); TS(l * 16 + 7);
        PH_BEGIN
            pg8::Gemm g{ABUF, WL(bf16, l, WL_G), Mmix, NGATE, DM}; GateOrder S{(Mmix / 256) * 4, C.G, C.bid};
            EpiGate E{WSP(bf16, WS_X + X_PP), WSP(bf16, WS_X + X_UR)};
            pg8::gemm_phase<EpiGate, GateOrder, true, true>(glds, g, S, E);
        PH_END
        GSYNC(); TS(l * 16 + 8); DBGCHK(6);
        PH_BEGIN GEMM_STD(WSP(bf16, WS_X + X_UR), WL(bf16, l, WL_O), Mmix, DM, DM, EpiStore, WSP(bf16, WS_X + X_MIX), DM, 0, 0, 256); PH_END
        GSYNC(); TS(l * 16 + 9); DBGCHK(7);
        PH_BEGIN rowop<true, true>(C, Mmix, HIN_L, HIN_C, C.out, HCB, WSP(bf16, WS_X + X_MIX), 2, C.P.in[7 + C.z] + l * DM, C.P.in[8 + C.z] + l * DM, 3, 4, MODL(l), MODL(l), ABUF); PH_END
        GSYNC(); TS(l * 16 + 10); DBGCHK(8);
        PH_BEGIN GEMM_STD(ABUF, WL(bf16, l, WL_UP), Mmix, 2 * DFF, DM, EpiUp, WSP(bf16, WS_X + X_HH), WSP(bf16, WS_X + X_HALO), C.P.in[31 + C.z] + (size_t)l * 3 * DFF, C.P.in[32 + C.z] + (size_t)l * DFF); PH_END
        GSYNC(); TS(l * 16 + 11);
        fixup_phase(CK, l, Mmix);
        GSYNC(); TS(l * 16 + 12); DBGCHK(9);
        PH_BEGIN GEMM_STD(WSP(bf16, WS_X + X_HH), WL(bf16, l, WL_DN), Mmix, DM, DFF, EpiStore, WSP(bf16, WS_X + X_FFO), DM, 0, 0, 256); PH_END
        GSYNC(); TS(l * 16 + 13); DBGCHK(10);
        if (l == 0) { PH_BEGIN rowop<true, true>(C, NT, C.out, HCB, C.out, HCB, WSP(bf16, WS_X + X_FFO), 5, C.P.in[9 + C.z] + l * DM, C.P.in[6 + C.z] + (l + 1) * DM, 0, 1, MODL(l), MODL(l + 1), ABUF); PH_END GSYNC(); TS(l * 16 + 14); }
        else { PH_BEGIN rowop<true, false>(C, NLAT, C.out, HCB, C.out, HCB, WSP(bf16, WS_X + X_FFO), 5, C.P.in[9 + C.z] + l * DM, nullptr, 0, 1, MODL(l), MODL(l), nullptr); PH_END }
    }
#ifdef DBG
    grid.sync(); dbg_report(CK);
#endif
#ifdef PROBE
    grid.sync(); TS(60);
    TS(61);
    grid.sync();
    if (blockIdx.x == 0) {
        volatile LAS unsigned long long* ts = (volatile LAS unsigned long long*)(CK.lds + 131072);
#ifdef PROBE_PRO
        unsigned long long d = (ts[60] - ts[40]) / 10ull;
#else
        unsigned long long d = 0; for (int ll = 0; ll < 2; ++ll) d += ts[ll * 16 + PROBE_B] - ts[ll * 16 + PROBE_A];
#endif
        const int n = (int)(d / 500ull);
        for (int i = tid_; i < n; i += NTHREADS) P.out[1000000 + i] += 0.15f;
    }
#endif
}


extern "C" void kernel_launch(void* const* d_in, const int* in_sizes, int n_in, void* d_out, int out_size, void* d_ws, size_t ws_size, hipStream_t stream) {
    static int grid = 0;
    if (grid == 0) {
        if (n_in != 34 || out_size != NLAT * DM || ws_size < WS_TOTAL) { fprintf(stderr, "kernel_launch: unexpected shapes (n_in %d out %d ws %zu, need %zu)\n", n_in, out_size, ws_size, (size_t)WS_TOTAL); grid = -1; return; }
        int dev = 0, cus = 0, per_cu = 0;
        hipGetDevice(&dev); hipDeviceGetAttribute(&cus, hipDeviceAttributeMultiprocessorCount, dev);
        if (hipFuncSetAttribute((const void*)fwd_kernel, hipFuncAttributeMaxDynamicSharedMemorySize, LDS_BYTES) != hipSuccess) { fprintf(stderr, "kernel_launch: hipFuncSetAttribute failed\n"); grid = -1; return; }
        hipOccupancyMaxActiveBlocksPerMultiprocessor(&per_cu, (const void*)fwd_kernel, NTHREADS, LDS_BYTES);
        (void)hipGetLastError();
        if (per_cu < 1 || cus < 256) { fprintf(stderr, "kernel_launch: occupancy %d, cus %d\n", per_cu, cus); grid = -1; return; }
        grid = 256;
    }
    if (grid < 0) return;
    (void)hipMemsetAsync((char*)d_ws + WS_CTL, 0, 65536, stream);
    Params p{};
    for (int i = 0; i < 34; ++i) p.in[i] = (const float*)d_in[i];
    p.out = (float*)d_out; p.ws = (unsigned char*)d_ws;
    void* args[] = {&p};
    hipError_t e = hipLaunchCooperativeKernel((const void*)fwd_kernel, dim3(grid), dim3(NTHREADS), args, LDS_BYTES, stream);
    if (e != hipSuccess) fprintf(stderr, "kernel_launch: cooperative launch failed: %s (grid %d)\n", hipGetErrorString(e), grid);
}
```

```cpp
#define PROBE_A 3
#define PROBE_B 4
#include <hip/hip_runtime.h>
#include <hip/hip_cooperative_groups.h>
#include <cstdio>
#include <cstdint>
namespace cg = cooperative_groups;
__device__ __forceinline__ int otid() { int t = threadIdx.x; asm volatile("" : "+v"(t)); return t; }
namespace pg8 {
#define PG8_LAS __attribute__((address_space(3)))
typedef unsigned short bf16_t;
typedef short bf16x8 __attribute__((ext_vector_type(8)));
typedef float f32x4 __attribute__((ext_vector_type(4)));
typedef unsigned u32x4 __attribute__((ext_vector_type(4)));
constexpr int BM = 256, BK = 64, HALF = 128, HTB = HALF * BK * 2  , STAGE_BYTES = 8 * HTB, NXCD = 8, WGM = 4;

__host__ __device__ __forceinline__ int lds_byte(int r, int c) { const int st = (r >> 4) * 2 + (c >> 5), rr = r & 15, cc = c & 31, ob = rr * 64 + cc * 2; return st * 1024 + (ob ^ (((ob >> 9) & 1) << 5)); }
__host__ __device__ __forceinline__ void stage_rc(int b, int& R, int& C) { const int st = b / 1024, sb = b % 1024, swz = sb ^ (((sb >> 9) & 1) << 5); R = (st >> 1) * 16 + swz / 64; C = (st & 1) * 32 + (swz % 64) / 2; }
__host__ __device__ __forceinline__ int perm32(int rho) { const int n = rho >> 4, i = rho & 15; return 8 * (i >> 2) + 4 * n + (i & 3); }

struct Unit { int pm, pn; };
struct Gemm { const bf16_t* A; const bf16_t* Bt; int M, N, K; };

struct StaticOrder {
    int nM, nN, nwg, G, c;
    __host__ __device__ void init(int M, int N, int G_, int c_) { nM = M / BM; nN = N / BM; nwg = nM * nN; G = G_; c = c_; }
    __host__ __device__ bool next(int i, Unit& u) const {
        const long L = (long)i * G + c; if (L >= nwg) return false;
        int wgid = (int)L; { const int q = nwg / NXCD, r = nwg % NXCD, xcd = wgid % NXCD, off = wgid / NXCD; wgid = (xcd < r ? xcd * (q + 1) : r * (q + 1) + (xcd - r) * q) + off; }
        const int nig = WGM * nN, gid = wgid / nig, fm = gid * WGM, gsz = (nM - fm) < WGM ? (nM - fm) : WGM;
        u.pm = fm + ((wgid % nig) % gsz); u.pn = (wgid % nig) / gsz; return true;
    }
    __device__ __forceinline__ void a_ready(const Unit&) const {}
    __device__ __forceinline__ void done(const Unit&) const {}
};

__device__ __forceinline__ unsigned cvt_pk_bf16(float lo, float hi) { unsigned r; asm volatile("v_cvt_pk_bf16_f32 %0, %1, %2" : "=v"(r) : "v"(lo), "v"(hi)); return r; }
typedef float f32x2 __attribute__((ext_vector_type(2)));
__device__ __forceinline__ f32x2 gelu_pk(f32x2 v) {
    const f32x2 av = __builtin_elementwise_abs(v), d = av * 0.2316418882f + 1.0f;
    f32x2 t; t.x = __builtin_amdgcn_rcpf(d.x); t.y = __builtin_amdgcn_rcpf(d.y);
    f32x2 q = t * 0.5307027145f + (-0.7265760135f); q = q * t + 0.7107068705f; q = q * t + (-0.142248368f); q = q * t + 0.127414796f; q = q * t;
    const f32x2 s = (v * v) * (-0.72134752044f);
    f32x2 e; e.x = __builtin_amdgcn_exp2f(s.x); e.y = __builtin_amdgcn_exp2f(s.y);
    const f32x2 m = v * (q * e), r = v - m;
    f32x2 o; o.x = v.x < 0.f ? m.x : r.x; o.y = v.y < 0.f ? m.y : r.y; return o;
}

template <class Epi, class Sched, bool ALIGN_EPI = false, bool SP2 = false>
__device__ __forceinline__ void gemm_phase(PG8_LAS unsigned char* lds, const Gemm g, const Sched& S, const Epi& E) {
    const int tid = otid(), wid = __builtin_amdgcn_readfirstlane(tid >> 6), lane = tid & 63, wr = wid >> 2, wc = wid & 3, fr = lane & 15, fq = lane >> 4;
    const int K = g.K, nt = K / BK;
    unsigned voffA[2], voffB[2];
#pragma unroll
    for (int i = 0; i < 2; ++i) { int R, C; stage_rc(tid * 16 + i * 8192, R, C); const int Rb = Epi::PERM ? ((R & ~31) + perm32(R & 31)) : R;
        const int Ra = Epi::PERMA ? ((R & 64) + 4 * (R & 15) + ((R >> 4) & 3)) : R;
        voffA[i] = (unsigned)(Ra * K + C) * 2u; voffB[i] = (unsigned)(Rb * K + C) * 2u; }
    const size_t kstep = (size_t)(BK * 2);
    const size_t hstep = (size_t)HALF * K * 2;
    const size_t tstep = 2 * hstep;
    const unsigned ldsw = (unsigned)wid * 1024u;
    const int aoff = lds_byte(wr * 64 + fr, fq * 8), boff = lds_byte(wc * 32 + fr, fq * 8);
#define PG8_SA(b, h) (((b) * 2 + (h)) * HTB)
#define PG8_SB(b, h) ((4 + (b) * 2 + (h)) * HTB)
#define PG8_STAGE(bufoff, gbase, voff) do { _Pragma("unroll") for (int _i = 0; _i < 2; ++_i) \
        __builtin_amdgcn_global_load_lds((const unsigned*)((const char*)(gbase) + (voff)[_i]), (PG8_LAS unsigned*)(lds + (bufoff) + ldsw + _i * 8192), 16, 0, 0); } while (0)
#define PG8_LDA(dst, b, h) do { _Pragma("unroll") for (int m = 0; m < 4; ++m) _Pragma("unroll") for (int k = 0; k < 2; ++k) dst[m][k] = *(const PG8_LAS bf16x8*)(lds + PG8_SA(b, h) + aoff + m * 2048 + k * 1024); } while (0)
#define PG8_LDB(dst, b, h) do { _Pragma("unroll") for (int n = 0; n < 2; ++n) _Pragma("unroll") for (int k = 0; k < 2; ++k) dst[n][k] = *(const PG8_LAS bf16x8*)(lds + PG8_SB(b, h) + boff + n * 2048 + k * 1024); } while (0)
#define PG8_MMA(ai, bj, At, Bt) do { __builtin_amdgcn_s_setprio(1); _Pragma("unroll") for (int m = 0; m < 4; ++m) _Pragma("unroll") for (int n = 0; n < 2; ++n) _Pragma("unroll") for (int k = 0; k < 2; ++k) \
        acc[ai][bj][m][n] = __builtin_amdgcn_mfma_f32_16x16x32_bf16(Bt[n][k], At[m][k], acc[ai][bj][m][n], 0, 0, 0); __builtin_amdgcn_s_setprio(0); } while (0)
#define PG8_WAIT_V(n) asm volatile("s_waitcnt vmcnt(" #n ")" ::: "memory")
#define PG8_WAIT_L(n) asm volatile("s_waitcnt lgkmcnt(" #n ")" ::: "memory")
#define PG8_BAR __builtin_amdgcn_s_barrier()
#define PG8_SCHED __builtin_amdgcn_sched_barrier(0)
    Unit cur, nxt; int ui = 0;
    if (!S.next(0, cur)) return;
    f32x4 acc[2][2][4][2];
#pragma unroll
    for (int a = 0; a < 2; ++a)
#pragma unroll
        for (int b = 0; b < 2; ++b)
#pragma unroll
            for (int m = 0; m < 4; ++m)
#pragma unroll
                for (int n = 0; n < 2; ++n) acc[a][b][m][n] = (f32x4){0.f, 0.f, 0.f, 0.f};
    bf16x8 At[4][2], B0[2][2], B1[2][2];
    const char* cA = (const char*)g.A + (size_t)cur.pm * tstep; const char* cB = (const char*)g.Bt + (size_t)cur.pn * tstep;
    S.a_ready(cur);
    if constexpr (SP2) {
        PG8_STAGE(PG8_SB(0, 0), cB, voffB); PG8_STAGE(PG8_SB(0, 1), cB + hstep, voffB); PG8_STAGE(PG8_SA(0, 0), cA, voffA); PG8_STAGE(PG8_SA(0, 1), cA + hstep, voffA);
        if (wr == 1) PG8_BAR;
        PG8_WAIT_V(2); PG8_BAR;
        PG8_STAGE(PG8_SB(1, 0), cB + kstep, voffB); PG8_STAGE(PG8_SA(1, 0), cA + kstep, voffA); PG8_STAGE(PG8_SB(1, 1), cB + hstep + kstep, voffB);
        PG8_WAIT_V(6); PG8_BAR;
    } else {
        PG8_STAGE(PG8_SB(0, 0), cB, voffB); PG8_STAGE(PG8_SA(0, 0), cA, voffA); PG8_STAGE(PG8_SB(0, 1), cB + hstep, voffB); PG8_STAGE(PG8_SA(0, 1), cA + hstep, voffA);
        if (wr == 1) PG8_BAR;
        PG8_WAIT_V(4); PG8_BAR;
        PG8_STAGE(PG8_SB(1, 0), cB + kstep, voffB); PG8_STAGE(PG8_SA(1, 0), cA + kstep, voffA); PG8_STAGE(PG8_SB(1, 1), cB + hstep + kstep, voffB);
        PG8_WAIT_V(6); PG8_BAR;
    }
    for (;;) {
        const bool has_next = S.next(ui + 1, nxt);
        const char* nA = has_next ? (const char*)g.A + (size_t)nxt.pm * tstep : cA; const char* nB = has_next ? (const char*)g.Bt + (size_t)nxt.pn * tstep : cB;
        for (int t = 0; t < nt; t += 2) {
            const bool last = (t == nt - 2);
            const char* a1 = cA + (size_t)(t + 1) * kstep;
            const char* a2 = last ? nA : cA + (size_t)(t + 2) * kstep; const char* b2 = last ? nB : cB + (size_t)(t + 2) * kstep;
            const char* a3 = a2 + kstep; const char* b3 = b2 + kstep;
            if (last && has_next) S.a_ready(nxt);
            if constexpr (SP2) {
            PG8_LDB(B0, 0, 0); PG8_LDB(B1, 0, 1); PG8_SCHED; PG8_LDA(At, 0, 0); PG8_STAGE(PG8_SA(1, 1), a1 + hstep, voffA);
            PG8_WAIT_V(8); PG8_WAIT_L(0); PG8_BAR; PG8_MMA(0, 0, At, B0); PG8_MMA(0, 1, At, B1); PG8_BAR; PG8_SCHED;
            PG8_LDA(At, 0, 1); PG8_STAGE(PG8_SB(0, 0), b2, voffB); PG8_STAGE(PG8_SB(0, 1), b2 + hstep, voffB); PG8_STAGE(PG8_SA(0, 0), a2, voffA);
            PG8_WAIT_V(8); PG8_WAIT_L(0); PG8_BAR; PG8_MMA(1, 0, At, B0); PG8_MMA(1, 1, At, B1); PG8_BAR; PG8_SCHED;
            PG8_LDB(B0, 1, 0); PG8_LDB(B1, 1, 1); PG8_SCHED; PG8_LDA(At, 1, 0); PG8_STAGE(PG8_SA(0, 1), a2 + hstep, voffA);
            PG8_WAIT_V(8); PG8_WAIT_L(0); PG8_BAR; PG8_MMA(0, 0, At, B0); PG8_MMA(0, 1, At, B1); PG8_BAR; PG8_SCHED;
            PG8_LDA(At, 1, 1); PG8_STAGE(PG8_SB(1, 0), b3, voffB); PG8_STAGE(PG8_SB(1, 1), b3 + hstep, voffB); PG8_STAGE(PG8_SA(1, 0), a3, voffA);
            PG8_WAIT_V(8); PG8_WAIT_L(0); PG8_BAR; PG8_MMA(1, 0, At, B0); PG8_MMA(1, 1, At, B1); PG8_BAR; PG8_SCHED;
            } else {
            PG8_LDB(B0, 0, 0); PG8_SCHED; PG8_LDA(At, 0, 0); PG8_STAGE(PG8_SA(1, 1), a1 + hstep, voffA);
            PG8_WAIT_L(8); PG8_BAR; PG8_WAIT_L(0); PG8_MMA(0, 0, At, B0); PG8_BAR; PG8_SCHED;
            PG8_LDB(B1, 0, 1); PG8_STAGE(PG8_SB(0, 0), b2, voffB);
            PG8_BAR; PG8_WAIT_L(0); PG8_MMA(0, 1, At, B1); PG8_BAR;
            PG8_LDA(At, 0, 1); PG8_STAGE(PG8_SA(0, 0), a2, voffA);
            PG8_BAR; PG8_WAIT_L(0); PG8_MMA(1, 0, At, B0); PG8_BAR; PG8_SCHED;
            PG8_STAGE(PG8_SB(0, 1), b2 + hstep, voffB);
            PG8_WAIT_V(6); PG8_BAR; PG8_MMA(1, 1, At, B1); PG8_BAR;
            PG8_LDB(B0, 1, 0); PG8_SCHED; PG8_LDA(At, 1, 0); PG8_STAGE(PG8_SA(0, 1), a2 + hstep, voffA);
            PG8_WAIT_L(8); PG8_BAR; PG8_WAIT_L(0); PG8_MMA(0, 0, At, B0); PG8_BAR; PG8_SCHED;
            PG8_LDB(B1, 1, 1); PG8_STAGE(PG8_SB(1, 0), b3, voffB);
            PG8_BAR; PG8_WAIT_L(0); PG8_MMA(0, 1, At, B1); PG8_BAR;
            PG8_LDA(At, 1, 1); PG8_STAGE(PG8_SA(1, 0), a3, voffA);
            PG8_BAR; PG8_WAIT_L(0); PG8_MMA(1, 0, At, B0); PG8_BAR; PG8_SCHED;
            PG8_STAGE(PG8_SB(1, 1), b3 + hstep, voffB);
            PG8_WAIT_V(6); PG8_BAR; PG8_MMA(1, 1, At, B1); PG8_BAR;
            }
        }
        if constexpr (ALIGN_EPI) { if (wr == 0) PG8_BAR; }
        if constexpr (!Epi::AFTER_DRAIN) { E(acc, cur, wr, wc, fr, fq); S.done(cur); }
        if (!has_next) break;
#pragma unroll
        for (int a = 0; a < 2; ++a)
#pragma unroll
            for (int b = 0; b < 2; ++b)
#pragma unroll
                for (int m = 0; m < 4; ++m)
#pragma unroll
                    for (int n = 0; n < 2; ++n) acc[a][b][m][n] = (f32x4){0.f, 0.f, 0.f, 0.f};
        cur = nxt; cA = nA; cB = nB; ++ui;
        if constexpr (ALIGN_EPI) { if (wr == 1) PG8_BAR; }
    }
    PG8_WAIT_V(0);
    if constexpr (!ALIGN_EPI) { if (wr == 0) PG8_BAR; }
    PG8_BAR;
    if constexpr (Epi::AFTER_DRAIN) { E.fused(acc, cur, wr, wc, fr, fq, lds, wid, lane); S.done(cur); }
#undef PG8_SA
#undef PG8_SB
#undef PG8_STAGE
#undef PG8_LDA
#undef PG8_LDB
#undef PG8_MMA
#undef PG8_WAIT_V
#undef PG8_WAIT_L
#undef PG8_BAR
#undef PG8_SCHED
}
}

#define DI __device__ __forceinline__
#define LAS __attribute__((address_space(3)))
typedef unsigned short bf16;
typedef float f32x4 __attribute__((ext_vector_type(4)));
typedef float f32x2 __attribute__((ext_vector_type(2)));
typedef float f32x16 __attribute__((ext_vector_type(16)));
typedef short bf16x8 __attribute__((ext_vector_type(8)));
typedef short s16x4 __attribute__((ext_vector_type(4)));
typedef unsigned u32x4 __attribute__((ext_vector_type(4)));
typedef unsigned u32x2 __attribute__((ext_vector_type(2)));
typedef __bf16 bf16x2_t __attribute__((ext_vector_type(2)));

constexpr int DM = 1024, NB = 32, TL = 2048, TC = 256, NLAT = NB * TL, NCTX = NB * TC, NT = NLAT + NCTX, CTXB = NLAT;
constexpr int DFF = 2816, RW = 1152, NIN = 2560, NGATE = 3072;
constexpr int IN_COLS = 5248;
constexpr float LOG2E = 1.4426950408889634f;
constexpr int NTHREADS = 512, NWAVES = 8;
constexpr int LDS_BYTES = 147456;

constexpr size_t MiB = 1u << 20;
constexpr size_t WS_CTL = 0;
constexpr size_t WS_MOD = 1 * MiB;
constexpr size_t WS_SMALL = 3 * MiB;
constexpr size_t WS_BON = 4 * MiB;
constexpr size_t WS_W = 6 * MiB;
constexpr size_t WL_IN = 0, WL_G = 5 * MiB, WL_BR = 11 * MiB, WL_BA = 11 * MiB + 512 * 1024, WL_BF = 12 * MiB + 512 * 1024, WL_O = 13 * MiB, WL_UP = 15 * MiB, WL_DN = 26 * MiB, WL_SIZE = 32 * MiB;
constexpr size_t WS_DFT = WS_W + 2 * WL_SIZE;
constexpr size_t WS_DFTC = WS_DFT + 16 * MiB;
constexpr size_t WS_HC = WS_DFTC + 1 * MiB;
constexpr size_t WS_A = WS_HC + 32 * MiB;
constexpr size_t WS_VF = WS_A + 144 * MiB;
constexpr size_t WS_X = WS_VF + 36 * MiB;
constexpr size_t X_F = 0;
constexpr size_t X_QKV = 288 * MiB;
constexpr size_t X_ZT = 396 * MiB;
constexpr size_t X_ZTC = 460 * MiB;
constexpr size_t X_UR = 504 * MiB;
constexpr size_t X_G = 468 * MiB;
constexpr size_t X_LO = 504 * MiB;
constexpr size_t X_END = 720 * MiB;
constexpr size_t WS_WLORA = WS_X + X_END;
constexpr int KLO = 640, NLO = 1536;
constexpr size_t X_PP = 0;
constexpr size_t X_MIX = 0;
constexpr size_t X_HH = 0;
constexpr size_t X_HALO = 396 * MiB;
constexpr size_t X_FFO = 436 * MiB;
constexpr size_t WS_TOTAL = WS_WLORA + 4 * MiB;
constexpr size_t FSZ = (size_t)NT * 256;

struct Params { const float* in[34]; float* out; unsigned char* ws; };

DI float bf2f(bf16 v) { return __builtin_bit_cast(float, (unsigned)v << 16); }
DI float lo2f(unsigned u) { return __builtin_bit_cast(float, u << 16); }
DI float hi2f(unsigned u) { return __builtin_bit_cast(float, u & 0xffff0000u); }
DI unsigned pk(float lo, float hi) { f32x2 v = {lo, hi}; bf16x2_t b = __builtin_convertvector(v, bf16x2_t); return __builtin_bit_cast(unsigned, b); }
DI bf16 f2bf(float x) { return (bf16)(pk(x, 0.f) & 0xffffu); }
DI float fexp2(float x) { return __builtin_amdgcn_exp2f(x); }
DI float frcp(float x) { return __builtin_amdgcn_rcpf(x); }
DI float sigm(float x) { return frcp(1.f + fexp2(-x * LOG2E)); }
DI f32x2 sigm2(f32x2 x) { const f32x2 t = x * (-LOG2E); f32x2 e; e.x = fexp2(t.x); e.y = fexp2(t.y); const f32x2 d = e + 1.f; f32x2 r; r.x = frcp(d.x); r.y = frcp(d.y); return r; }
DI float tanh_(float x) { return 2.f * sigm(2.f * x) - 1.f; }
DI float gelu_tanh(float z) { const float u = 1.5957691216057308f * (z + 0.044715f * z * z * z); return z * sigm(u); }
DI float wave_sum(float v) {
#pragma unroll
    for (int o = 1; o < 64; o <<= 1) v += __shfl_xor(v, o);
    return v;
}
template <int CTRL, bool BC> DI float dppf(float old, float src) {
    return __builtin_bit_cast(float, __builtin_amdgcn_update_dpp(__builtin_bit_cast(int, old), __builtin_bit_cast(int, src), CTRL, 0xf, 0xf, BC));
}
DI float row16_sum(float x) { x += dppf<0x128, true>(0.f, x); x += dppf<0x124, true>(0.f, x); x += dppf<0x122, true>(0.f, x); x += dppf<0x121, true>(0.f, x); return x; }
DI f32x4 bf4(u32x2 u) { return (f32x4){lo2f(u.x), hi2f(u.x), lo2f(u.y), hi2f(u.y)}; }
DI u32x2 pk4(f32x4 v) { u32x2 o; o.x = pk(v[0], v[1]); o.y = pk(v[2], v[3]); return o; }
DI float allred4(float x) {
    unsigned u = __builtin_bit_cast(unsigned, x);
    auto r = __builtin_amdgcn_permlane16_swap(u, u, false, false);
    float y = __builtin_bit_cast(float, (unsigned)r[0]) + __builtin_bit_cast(float, (unsigned)r[1]);
    unsigned v = __builtin_bit_cast(unsigned, y);
    auto s = __builtin_amdgcn_permlane32_swap(v, v, false, false);
    return __builtin_bit_cast(float, (unsigned)s[0]) + __builtin_bit_cast(float, (unsigned)s[1]);
}

DI u32x4 pack8(const f32x4& a, const f32x4& b) { u32x4 w; w.x = pk(a[0], a[1]); w.y = pk(a[2], a[3]); w.z = pk(b[0], b[1]); w.w = pk(b[2], b[3]); return w; }

struct EpiStore {
    static constexpr bool PERM = true, AFTER_DRAIN = false, PERMA = false;
    bf16* O; int ld; int row_base, row_pn, col_pn;
    DI void operator()(const f32x4 (&acc)[2][2][4][2], const pg8::Unit& u, int wr, int wc, int fr, int fq) const {
        const int row0 = row_base + u.pn * row_pn + u.pm * 256 + wr * 64 + fr, col0 = u.pn * col_pn + wc * 32 + 8 * fq;
#pragma unroll
        for (int ai = 0; ai < 2; ++ai)
#pragma unroll
            for (int m = 0; m < 4; ++m) { bf16* rowp = O + (size_t)(row0 + ai * 128 + m * 16) * ld + col0;
#pragma unroll
                for (int bj = 0; bj < 2; ++bj) *(u32x4*)(rowp + bj * 128) = pack8(acc[ai][bj][m][0], acc[ai][bj][m][1]); }
    }
};

struct EpiIn {
    static constexpr bool PERM = true, AFTER_DRAIN = false, PERMA = false;
    bf16 *QKV, *ZT, *ZTC, *UR;
    DI void operator()(const f32x4 (&acc)[2][2][4][2], const pg8::Unit& u, int wr, int wc, int fr, int fq) const {
        const int pn = u.pn, rl0 = wr * 64 + fr, cl = wc * 32 + 8 * fq;
        if (pn < 3) {
#pragma unroll
            for (int ai = 0; ai < 2; ++ai)
#pragma unroll
                for (int m = 0; m < 4; ++m) { bf16* rowp = QKV + (size_t)(u.pm * 256 + rl0 + ai * 128 + m * 16) * 768 + pn * 256 + cl;
#pragma unroll
                    for (int bj = 0; bj < 2; ++bj) *(u32x4*)(rowp + bj * 128) = pack8(acc[ai][bj][m][0], acc[ai][bj][m][1]); }
        } else if (pn < 5) {
            bf16* base; int stride;
            if (u.pm < 256) { const int b = u.pm >> 3, t0 = (u.pm & 7) * 256; base = ZT + (size_t)b * 256 * 4096 + (pn - 3) * 2048 + t0; stride = 4096; }
            else { const int b = u.pm - 256; base = ZTC + (size_t)b * 256 * 512 + (pn - 3) * 256; stride = 512; }
#pragma unroll
            for (int ai = 0; ai < 2; ++ai)
#pragma unroll
                for (int m = 0; m < 4; ++m) { const int rl = rl0 + ai * 128 + m * 16;
#pragma unroll
                    for (int bj = 0; bj < 2; ++bj)
#pragma unroll
                        for (int n = 0; n < 2; ++n)
#pragma unroll
                            for (int e = 0; e < 4; ++e) base[(size_t)(bj * 128 + cl + 4 * n + e) * stride + rl] = f2bf(acc[ai][bj][m][n][e]); }
        } else {
#pragma unroll
            for (int ai = 0; ai < 2; ++ai)
#pragma unroll
                for (int m = 0; m < 4; ++m) { bf16* rowp = UR + (size_t)(u.pm * 256 + rl0 + ai * 128 + m * 16) * RW + (pn - 5) * 256 + cl;
#pragma unroll
                    for (int bj = 0; bj < 2; ++bj) if ((pn - 5) * 256 + bj * 128 < RW) *(u32x4*)(rowp + bj * 128) = pack8(acc[ai][bj][m][0], acc[ai][bj][m][1]); }
        }
    }
};

struct EpiGate {
    static constexpr bool PERM = true, AFTER_DRAIN = false, PERMA = false;
    const bf16* PP; bf16* MG;
    DI void operator()(const f32x4 (&acc)[2][2][4][2], const pg8::Unit& u, int wr, int wc, int fr, int fq) const {
        const int br = u.pn >> 2, cn = u.pn & 3, row0 = u.pm * 256 + wr * 64 + fr, col0 = cn * 256 + wc * 32 + 8 * fq;
#pragma unroll
        for (int ai = 0; ai < 2; ++ai)
#pragma unroll
            for (int m = 0; m < 4; ++m) { const size_t row = (size_t)(row0 + ai * 128 + m * 16);
#pragma unroll
                for (int bj = 0; bj < 2; ++bj) {
                    const u32x4 pp = *(const u32x4*)(PP + row * NGATE + br * 1024 + col0 + bj * 128);
                    bf16* mp = MG + row * 1024 + col0 + bj * 128;
                    f32x4 a = acc[ai][bj][m][0], b = acc[ai][bj][m][1];
                    { const f32x2 s0 = sigm2((f32x2){a[0], a[1]}) * (f32x2){lo2f(pp.x), hi2f(pp.x)}, s1 = sigm2((f32x2){a[2], a[3]}) * (f32x2){lo2f(pp.y), hi2f(pp.y)}, s2 = sigm2((f32x2){b[0], b[1]}) * (f32x2){lo2f(pp.z), hi2f(pp.z)}, s3 = sigm2((f32x2){b[2], b[3]}) * (f32x2){lo2f(pp.w), hi2f(pp.w)};
                      a = (f32x4){s0.x, s0.y, s1.x, s1.y}; b = (f32x4){s2.x, s2.y, s3.x, s3.y}; }
                    if (br) { const u32x4 o = *(const u32x4*)mp;
                        a[0] += lo2f(o.x); a[1] += hi2f(o.x); a[2] += lo2f(o.y); a[3] += hi2f(o.y); b[0] += lo2f(o.z); b[1] += hi2f(o.z); b[2] += lo2f(o.w); b[3] += hi2f(o.w); }
                    *(u32x4*)mp = pack8(a, b); } }
    }
};

DI f32x2 gelu2(f32x2 z) {
    const f32x2 u = z * (z * z * 0.044715f + 1.f), t = u * (-1.5957691216057308f * LOG2E);
    f32x2 e; e.x = fexp2(t.x); e.y = fexp2(t.y);
    const f32x2 d = e + 1.f; f32x2 r; r.x = frcp(d.x); r.y = frcp(d.y);
    return z * r;
}
struct EpiUp {
    static constexpr bool PERM = true, AFTER_DRAIN = false, PERMA = true;
    bf16* HH; bf16* HALO; const float* cw; const float* cb;
    DI void operator()(const f32x4 (&acc)[2][2][4][2], const pg8::Unit& u, int wr, int wc, int fr, int fq) const {
        const int j0 = 128 * u.pn + 32 * wc + 8 * fq;
        f32x4 w0[2], w1[2], w2[2], bb[2];
#pragma unroll
        for (int n = 0; n < 2; ++n) { w0[n] = *(const f32x4*)(cw + j0 + 4 * n); w1[n] = *(const f32x4*)(cw + DFF + j0 + 4 * n); w2[n] = *(const f32x4*)(cw + 2 * DFF + j0 + 4 * n); bb[n] = *(const f32x4*)(cb + j0 + 4 * n); }
#pragma unroll
        for (int ai = 0; ai < 2; ++ai) {
            const int grp = u.pm * 4 + ai * 2 + wr;
            bf16* hb = HALO + (size_t)grp * 6 * DFF + j0;
            if (fr == 0) { *(u32x4*)(hb) = pack8(acc[ai][0][0][0], acc[ai][0][0][1]); *(u32x4*)(hb + DFF) = pack8(acc[ai][0][1][0], acc[ai][0][1][1]); *(u32x4*)(hb + 4 * DFF) = pack8(acc[ai][1][0][0], acc[ai][1][0][1]); }
            if (fr == 15) { *(u32x4*)(hb + 2 * DFF) = pack8(acc[ai][0][2][0], acc[ai][0][2][1]); *(u32x4*)(hb + 3 * DFF) = pack8(acc[ai][0][3][0], acc[ai][0][3][1]); *(u32x4*)(hb + 5 * DFF) = pack8(acc[ai][1][3][0], acc[ai][1][3][1]); }
            f32x4 o[4][2];
#pragma unroll
            for (int n = 0; n < 2; ++n)
#pragma unroll
                for (int ep = 0; ep < 2; ++ep) {
                    f32x2 x[4];
#pragma unroll
                    for (int m = 0; m < 4; ++m) x[m] = (f32x2){acc[ai][0][m][n][2 * ep], acc[ai][0][m][n][2 * ep + 1]};
                    f32x2 pv, nx;
                    pv.x = dppf<0x111, true>(0.f, x[3].x); pv.y = dppf<0x111, true>(0.f, x[3].y);
                    nx.x = dppf<0x101, true>(0.f, x[0].x); nx.y = dppf<0x101, true>(0.f, x[0].y);
                    const f32x2 c0 = {w0[n][2 * ep], w0[n][2 * ep + 1]}, c1 = {w1[n][2 * ep], w1[n][2 * ep + 1]}, c2 = {w2[n][2 * ep], w2[n][2 * ep + 1]}, cb2 = {bb[n][2 * ep], bb[n][2 * ep + 1]};
#pragma unroll
                    for (int m = 0; m < 4; ++m) {
                        const f32x2 prev = m ? x[m ? m - 1 : 0] : pv, next = (m < 3) ? x[m < 3 ? m + 1 : 3] : nx;
                        const f32x2 z = c0 * prev + c1 * x[m] + c2 * next + cb2;
                        const f32x2 zv = {acc[ai][1][m][n][2 * ep], acc[ai][1][m][n][2 * ep + 1]};
                        const f32x2 g = gelu2(z) * zv;
                        o[m][n][2 * ep] = g.x; o[m][n][2 * ep + 1] = g.y;
                    }
                }
#pragma unroll
            for (int m = 0; m < 4; ++m) {
                const bool edge = (m == 0 && fr == 0) || (m == 3 && fr == 15);
                if (!edge) *(u32x4*)(HH + (size_t)(u.pm * 256 + ai * 128 + wr * 64 + 4 * fr + m) * DFF + j0) = pack8(o[m][0], o[m][1]);
            }
        }
    }
};

struct GateOrder {
    int nU, G, c;
    DI bool next(int i, pg8::Unit& u) const { const int j = i / 3, br = i - 3 * j; const long L = (long)j * G + c; if (L >= nU) return false; u.pm = (int)(L >> 2); u.pn = br * 4 + (int)(L & 3); return true; }
    DI void a_ready(const pg8::Unit&) const {}
    DI void done(const pg8::Unit&) const {}
};

struct Ctx {
    LAS unsigned char* lds; unsigned char* ws; const Params& P; float* out;
    int tid, lane, wave, G, bid, z;
};
DI Ctx rectx(const Ctx& C0) { const int t = otid(); int z = 0; asm volatile("" : "+s"(z)); return Ctx{C0.lds, C0.P.ws + z, C0.P, C0.P.out + z, t, t & 63, __builtin_amdgcn_readfirstlane(t >> 6), C0.G, C0.bid, z}; }
#define WSP(T, off) ((T*)(C.ws + (off)))
#define WL(T, l, off) ((T*)(C.ws + WS_W + (size_t)(l) * WL_SIZE + (off)))

DI void tr_item(const float* src, int ldw, int k0, int n0, bf16* dst, int ldd, int drow0, LAS float* scr, int lane) {
#pragma unroll 8
    for (int i = 0; i < 32; ++i) { const int kk = 2 * i + (lane >> 5); scr[kk * 33 + (lane & 31)] = src[(size_t)(k0 + kk) * ldw + n0 + (lane & 31)]; }
    asm volatile("s_waitcnt lgkmcnt(0)" ::: "memory");
    const int c = lane & 7;
#pragma unroll
    for (int j = 0; j < 4; ++j) { const int n = (lane >> 3) + 8 * j; const LAS float* s = scr + (8 * c) * 33 + n;
        u32x4 o; o.x = pk(s[0 * 33], s[1 * 33]); o.y = pk(s[2 * 33], s[3 * 33]); o.z = pk(s[4 * 33], s[5 * 33]); o.w = pk(s[6 * 33], s[7 * 33]);
        *(u32x4*)(dst + (size_t)(drow0 + n) * ldd + k0 + 8 * c) = o; }
    asm volatile("s_waitcnt lgkmcnt(0)" ::: "memory");
}
DI void tr_matrix(const Ctx& C, int gw, int NGW, const float* src, int ldw, int K, int n_src0, int ncols, bf16* dst, int drow0, LAS float* scr) {
    const int nb = ncols / 32, nit = (K / 64) * nb;
    for (int it = gw; it < nit; it += NGW) { const int kb = it / nb, b = it % nb; tr_item(src, ldw, kb * 64, n_src0 + b * 32, dst, K, drow0 + b * 32, scr, C.lane); }
}

DI void weights_tr(const Ctx& C, int l, int gw, int NGW, LAS float* scr) {
    const float* win = C.P.in[10 + C.z] + (size_t)l * 1024 * IN_COLS;
    bf16* wi = WL(bf16, l, WL_IN);
    tr_matrix(C, gw, NGW, win, IN_COLS, 1024, 1152, 512, wi, 0, scr);
    tr_matrix(C, gw, NGW, win, IN_COLS, 1024, 1664, 128, wi, 512, scr);
    tr_matrix(C, gw, NGW, win, IN_COLS, 1024, 1792, 128, wi, 640, scr);
    tr_matrix(C, gw, NGW, win, IN_COLS, 1024, 0, 1152, wi, 1280, scr);
    tr_matrix(C, gw, NGW, win, IN_COLS, 1024, 2176, 3072, WL(bf16, l, WL_G), 0, scr);
    tr_matrix(C, gw, NGW, C.P.in[26 + C.z] + (size_t)l * 256 * 1024, 1024, 256, 0, 1024, WL(bf16, l, WL_BR), 0, scr);
    tr_matrix(C, gw, NGW, C.P.in[27 + C.z] + (size_t)l * 512 * 1024, 1024, 512, 0, 1024, WL(bf16, l, WL_BA), 0, scr);
    tr_matrix(C, gw, NGW, C.P.in[28 + C.z] + (size_t)l * 256 * 1024, 1024, 256, 0, 1024, WL(bf16, l, WL_BF), 0, scr);
    tr_matrix(C, gw, NGW, C.P.in[29 + C.z] + (size_t)l * 1024 * 1024, 1024, 1024, 0, 1024, WL(bf16, l, WL_O), 0, scr);
    {
        const float* up = C.P.in[30 + C.z] + (size_t)l * 1024 * 2 * DFF; bf16* wu = WL(bf16, l, WL_UP);
        for (int it = gw; it < 16 * 44 * 4; it += NGW) { const int kb = it / 176, r = it % 176, seg = r >> 2, b = r & 3, pn = seg >> 1, bj = seg & 1;
            tr_item(up, 2 * DFF, kb * 64, bj * DFF + pn * 128 + b * 32, wu, 1024, pn * 256 + bj * 128 + b * 32, scr, C.lane); }
    }
    tr_matrix(C, gw, NGW, C.P.in[33 + C.z] + (size_t)l * DFF * 1024, 1024, DFF, 0, 1024, WL(bf16, l, WL_DN), 0, scr);
}
DI void prologue(const Ctx& C0) {
    const Ctx C = rectx(C0);
    LAS float* scr = (LAS float*)(C.lds + 49152 + C.wave * 8704);
    const int gth = C.bid * NTHREADS + C.tid, NGT = C.G * NTHREADS;
    for (int tsk = C.bid; tsk < 72; tsk += C.G) {
        const int l = tsk / 36, rem = tsk % 36, cb = rem / 3, rg = rem % 3;
        LAS float* s = (LAS float*)C.lds;
        for (int i = C.tid; i < 11 * 1024; i += NTHREADS) { const int r = rg * 11 + i / 1024, k = i % 1024; const float cv = (r < 32) ? C.P.in[1 + C.z][r * 1024 + k] : C.P.in[3 + C.z][k]; s[i] = cv * sigm(cv); }
        __syncthreads();
        const int j = cb * 512 + C.tid;
        float acc[11];
        const float bj = C.P.in[5 + C.z][l * 6144 + j];
#pragma unroll
        for (int i = 0; i < 11; ++i) acc[i] = bj;
        const float* wp = C.P.in[4 + C.z] + (size_t)l * 1024 * 6144 + j;
        for (int k = 0; k < 1024; k += 4) {
            const float w0 = wp[(size_t)k * 6144], w1 = wp[(size_t)(k + 1) * 6144], w2 = wp[(size_t)(k + 2) * 6144], w3 = wp[(size_t)(k + 3) * 6144];
#pragma unroll
            for (int i = 0; i < 11; ++i) { const f32x4 x = *(const LAS f32x4*)(s + i * 1024 + k); acc[i] += x[0] * w0 + x[1] * w1 + x[2] * w2 + x[3] * w3; }
        }
#pragma unroll
        for (int i = 0; i < 11; ++i) WSP(float, WS_MOD)[(size_t)(l * 33 + rg * 11 + i) * 6144 + j] = acc[i];
        __syncthreads();
    }
    if (C.bid == C.G - 1) for (int i = C.tid; i < 1024; i += NTHREADS) { const int p = i >> 4, f = i & 15; const float inv = powf(10000.f, -(float)f / 16.f), ang = (float)p * inv; WSP(float, WS_SMALL)[2 * i] = cosf(ang); WSP(float, WS_SMALL)[2 * i + 1] = sinf(ang); }
    for (int i = gth; i < 2048 * 4096 / 2; i += NGT) {
        const int tp = i / 2048, kk = (i % 2048) * 2; float v[2];
#pragma unroll
        for (int e = 0; e < 2; ++e) { const int k = kk + e, t = k & 2047; const int ph = (tp * t) & 2047; const float x = (float)ph * (1.f / 1024.f); v[e] = ((k < 2048) ? cospif(x) : -sinpif(x)) * 0.0027621358640099513f; }
        WSP(unsigned, WS_DFT)[i] = pk(v[0], v[1]);
    }
    for (int i = gth; i < 256 * 512 / 2; i += NGT) {
        const int tp = i / 256, kk = (i % 256) * 2; float v[2];
#pragma unroll
        for (int e = 0; e < 2; ++e) { const int k = kk + e, t = k & 255; const int ph = (tp * t) & 255; const float x = (float)ph * (1.f / 128.f); v[e] = ((k < 256) ? cospif(x) : -sinpif(x)) * 0.0078125f; }
        WSP(unsigned, WS_DFTC)[i] = pk(v[0], v[1]);
    }
    weights_tr(C, 0, C.bid * NWAVES + C.wave, C.G * NWAVES, scr);
    for (int l = 0; l < 2; ++l) {
        const float* win = C.P.in[10 + C.z] + (size_t)l * 1024 * IN_COLS;
        bf16* wi = WL(bf16, l, WL_IN);
        for (int i = gth; i < 128 * 1024 / 2; i += NGT) ((unsigned*)(wi + (size_t)2432 * 1024))[i] = 0u;
        {
            LAS float* tab = (LAS float*)(C.lds + 120 * 1024);
            __syncthreads();
            if (C.tid < 64) { const float x = (float)C.tid * (1.f / 32.f); tab[C.tid] = cospif(x); tab[64 + C.tid] = sinpif(x); }
            __syncthreads();
            for (int i = gth; i < 512 * 1024; i += NGT) {
                const int k = i & 1023, np = i >> 10, sn = np >> 8, g = (np >> 6) & 3, cp = np & 63;
                const float* wr_ = win + (size_t)k * IN_COLS + 1920 + g * 64; const LAS float* tb = tab + sn * 64; float a = 0.f;
#pragma unroll 8
                for (int c = 0; c < 64; ++c) a += wr_[c] * tb[(c * cp) & 63];
                wi[(size_t)(768 + np) * 1024 + k] = f2bf(a);
            }
        }
        {
            bf16* wl = WSP(bf16, WS_WLORA + (size_t)l * 2 * MiB);
            const float* w2 = C.P.in[13 + C.z] + (size_t)l * 2 * 64 * 256; const float* a2 = C.P.in[15 + C.z] + (size_t)l * 2 * 64 * 256; const float* g2 = C.P.in[16 + C.z] + (size_t)l * 128 * 256;
            const int kl = (l == 0) ? 384 : KLO;
            for (int i = gth; i < NLO * kl; i += NGT) {
                const int c = i & 255, nb = (i >> 8) % 6, k = i / (256 * 6); float v = 0.f;
                if (nb == 0) { if (k < 64) v = w2[k * 256 + c]; }
                else if (nb == 1) { if (k >= 64 && k < 128) v = w2[(64 + k - 64) * 256 + c]; }
                else if (nb == 2) { if (k >= 128 && k < 192) v = a2[(k - 128) * 256 + c]; }
                else if (nb == 3) { if (k >= 192 && k < 256) v = a2[(64 + k - 192) * 256 + c]; }
                else if (nb == 4) { if (k >= 256 && k < 384) v = g2[(k - 256) * 256 + c]; }
                else if (l == 1 && k >= 384) { const float* v1 = C.P.in[23 + C.z] + (k - 384) * 32; const float* v2 = C.P.in[24 + C.z] + c; for (int j = 0; j < 32; ++j) v += v1[j] * v2[j * 256]; }
                wl[(size_t)(nb * 256 + c) * kl + k] = f2bf(v);
            }
        }
    }
}

template <bool HAS_ADD, bool HAS_OUT>
DI void rowop(const Ctx& C0, int nrows, const float* hin_l, const float* hin_c, float* hout_l, float* hout_c, const bf16* add, int ga, const float* g_add, const float* g_out, int sh, int sc, const float* modl, const float* modo, bf16* Aout) {
    const Ctx C = rectx(C0);
    const int rpw = (nrows + C.G * NWAVES - 1) / (C.G * NWAVES), r0 = (C.bid * NWAVES + C.wave) * rpw, r1 = (r0 + rpw < nrows) ? r0 + rpw : nrows;
    if (r0 >= r1) return;
    const int c0 = 4 * C.lane;
    f32x4 gA[4], gO[4], mG[4], mS[4], mB[4];
#pragma unroll
    for (int j = 0; j < 4; ++j) { if (HAS_ADD) gA[j] = *(const f32x4*)(g_add + c0 + 256 * j); if (HAS_OUT) gO[j] = *(const f32x4*)(g_out + c0 + 256 * j); }
    int bcur = -1;
    f32x4 hn[4]; u32x2 an[4];
#define ROW_HP(t) (((t) < NLAT) ? hin_l + (size_t)(t) * DM : hin_c + (size_t)((t) - NLAT) * DM)
    { const float* hp = ROW_HP(r0);
#pragma unroll
      for (int j = 0; j < 4; ++j) { hn[j] = __builtin_nontemporal_load((const f32x4*)(hp + c0 + 256 * j)); if (HAS_ADD) an[j] = __builtin_nontemporal_load((const u32x2*)(add + (size_t)r0 * DM + c0 + 256 * j)); } }
    for (int tok = r0; tok < r1; ++tok) {
        f32x4 h[4]; u32x2 ar[4];
#pragma unroll
        for (int j = 0; j < 4; ++j) { h[j] = hn[j]; if (HAS_ADD) ar[j] = an[j]; }
        if (tok + 1 < r1) { const float* hp = ROW_HP(tok + 1);
#pragma unroll
            for (int j = 0; j < 4; ++j) { hn[j] = __builtin_nontemporal_load((const f32x4*)(hp + c0 + 256 * j)); if (HAS_ADD) an[j] = __builtin_nontemporal_load((const u32x2*)(add + (size_t)(tok + 1) * DM + c0 + 256 * j)); } }
        const bool lat = tok < NLAT; const int b = lat ? tok / TL : 32;
        if (b != bcur) { bcur = b; const float* mp = modl + (size_t)b * 6144; const float* mq = modo + (size_t)b * 6144;
#pragma unroll
            for (int j = 0; j < 4; ++j) { if (HAS_ADD) mG[j] = *(const f32x4*)(mp + ga * 1024 + c0 + 256 * j); if (HAS_OUT) { mS[j] = *(const f32x4*)(mq + sc * 1024 + c0 + 256 * j) + 1.f; mB[j] = *(const f32x4*)(mq + sh * 1024 + c0 + 256 * j); } } }
        if (HAS_ADD) {
            f32x4 a[4]; float ss = 0.f;
#pragma unroll
            for (int j = 0; j < 4; ++j) { a[j] = (f32x4){lo2f(ar[j].x), hi2f(ar[j].x), lo2f(ar[j].y), hi2f(ar[j].y)}; ss += a[j][0] * a[j][0] + a[j][1] * a[j][1] + a[j][2] * a[j][2] + a[j][3] * a[j][3]; }
            const float rstd = rsqrtf(wave_sum(ss) * (1.f / DM) + 1e-6f);
            float* op = lat ? hout_l + (size_t)tok * DM : hout_c + (size_t)(tok - NLAT) * DM;
#pragma unroll
            for (int j = 0; j < 4; ++j) { h[j] = h[j] + mG[j] * (a[j] * rstd * gA[j]); __builtin_nontemporal_store(h[j], (f32x4*)(op + c0 + 256 * j)); }
        }
        if (HAS_OUT) {
            float ss = 0.f;
#pragma unroll
            for (int j = 0; j < 4; ++j) ss += h[j][0] * h[j][0] + h[j][1] * h[j][1] + h[j][2] * h[j][2] + h[j][3] * h[j][3];
            const float rstd = rsqrtf(wave_sum(ss) * (1.f / DM) + 1e-6f);
#pragma unroll
            for (int j = 0; j < 4; ++j) { const f32x4 y = (h[j] * rstd * gO[j]) * mS[j] + mB[j]; u32x2 o; o.x = pk(y[0], y[1]); o.y = pk(y[2], y[3]);
                *(u32x2*)(Aout + (size_t)tok * DM + c0 + 256 * j) = o; }
        }
    }
#undef ROW_HP
}

DI void feat1_phase(const Ctx& C0, int l) {
    const Ctx C = rectx(C0);
    const bf16* UR = WSP(bf16, WS_X + X_UR); bf16* F = WSP(bf16, WS_X + X_F); bf16* X2 = WSP(bf16, WS_A);
    const float* mu = C.P.in[11 + C.z] + (size_t)l * 2 * RW;
    const int gth = C.bid * NTHREADS + C.tid, NGT = C.G * NTHREADS, kl = (l == 0) ? 384 : KLO;
    for (int idx = gth; idx < NT * 144; idx += NGT) {
        const int tok = idx / 144, pc = idx - tok * 144, cc = pc * 8;
        const int t = (tok < NLAT) ? (tok & (TL - 1)) : ((tok - NLAT) & (TC - 1)), T = (tok < NLAT) ? TL : TC;
        const bf16* up_ = UR + (size_t)tok * RW + cc;
        const u32x4 u = *(const u32x4*)up_;
        u32x4 p = {0u, 0u, 0u, 0u}, nx = {0u, 0u, 0u, 0u};
        if (t > 0) p = *(const u32x4*)(up_ - RW);
        if (t < T - 1) nx = *(const u32x4*)(up_ + RW);
        const f32x4 m0a = *(const f32x4*)(mu + cc), m0b = *(const f32x4*)(mu + cc + 4), m1a = *(const f32x4*)(mu + RW + cc), m1b = *(const f32x4*)(mu + RW + cc + 4);
        float s[8];
#pragma unroll
        for (int e = 0; e < 8; ++e) { const float uu = (e & 1) ? hi2f(u[e >> 1]) : lo2f(u[e >> 1]), pp = (e & 1) ? hi2f(p[e >> 1]) : lo2f(p[e >> 1]), nn = (e & 1) ? hi2f(nx[e >> 1]) : lo2f(nx[e >> 1]);
            const float m0 = (e < 4) ? m0a[e & 3] : m0b[e & 3], m1 = (e < 4) ? m1a[e & 3] : m1b[e & 3];
            s[e] = uu + m0 * (pp - uu) + m1 * (nn - uu); }
        if (cc >= 768 && cc < 896) {
#pragma unroll
            for (int e = 0; e < 8; ++e) s[e] = tanh_(s[e]); }
        else if (cc >= 1024) {
#pragma unroll
            for (int e = 0; e < 8; ++e) s[e] = sigm(s[e]); }
        u32x4 w; w.x = pk(s[0], s[1]); w.y = pk(s[2], s[3]); w.z = pk(s[4], s[5]); w.w = pk(s[6], s[7]);
        if (cc < 256) *(u32x4*)(F + (size_t)tok * 2048 + cc) = w;
        else if (cc < 512) *(u32x4*)(F + (size_t)tok * 2048 + 768 + cc - 256) = w;
        else if (cc < 768) { *(u32x4*)(F + (size_t)tok * 2048 + 512 + cc - 512) = w; if (l == 1) *(u32x4*)(X2 + (size_t)tok * kl + 384 + cc - 512) = w; }
        else *(u32x4*)(X2 + (size_t)tok * kl + cc - 768) = w;
    }
}
DI void feat3_phase(const Ctx& C0, int l) {
    const Ctx C = rectx(C0);
    bf16* F = WSP(bf16, WS_X + X_F); bf16* Gq = WSP(bf16, WS_X + X_G); bf16* VF = WSP(bf16, WS_VF); float* BON = WSP(float, WS_BON); const bf16* LO = WSP(bf16, WS_X + X_LO);
    const int c = (C.lane >> 4) * 64 + (C.lane & 15) * 4;
    const f32x4 kkw = *(const f32x4*)(C.P.in[17 + C.z] + l * 256 + c), kaw = *(const f32x4*)(C.P.in[18 + C.z] + l * 256 + c), rkw = *(const f32x4*)(C.P.in[19 + C.z] + l * 256 + c);
    const f32x4 w0f = *(const f32x4*)(C.P.in[12 + C.z] + l * 512 + c), w0b = *(const f32x4*)(C.P.in[12 + C.z] + l * 512 + 256 + c), a0f = *(const f32x4*)(C.P.in[14 + C.z] + l * 512 + c), a0b = *(const f32x4*)(C.P.in[14 + C.z] + l * 512 + 256 + c);
    const f32x4 v0c = *(const f32x4*)(C.P.in[22 + C.z] + c);
    const int rpw = NT / (256 * NWAVES), r0 = (C.bid * NWAVES + C.wave) * rpw;
    if (C.bid >= 256) return;
    u32x2 nR, nK, nV, nVF, nL[6];
#define F3_LOAD(t) do { const size_t o_ = (size_t)(t) * 256 + c; const bf16* f_ = F + (size_t)(t) * 2048 + c; nR = *(const u32x2*)(f_); nK = *(const u32x2*)(f_ + 768); nV = *(const u32x2*)(f_ + 512); if (l == 1) nVF = *(const u32x2*)(VF + o_); \
        _Pragma("unroll") for (int q = 0; q < 6; ++q) if (q < 5 || l == 1) nL[q] = *(const u32x2*)(LO + (size_t)(t) * NLO + q * 256 + c); } while (0)
    F3_LOAD(r0);
    for (int tok = r0; tok < r0 + rpw; ++tok) {
        const u32x2 cR = nR, cK = nK, cV = nV, cVF = nVF; u32x2 cL[6];
#pragma unroll
        for (int q = 0; q < 6; ++q) cL[q] = nL[q];
        if (tok + 1 < r0 + rpw) F3_LOAD(tok + 1);
        const size_t o = (size_t)tok * 256 + c;
        const f32x4 r = bf4(cR), k = bf4(cK); f32x4 v = bf4(cV);
        if (l == 1) { const f32x4 vf = bf4(cVF), z = v0c + bf4(cL[5]);
#pragma unroll
            for (int e = 0; e < 4; ++e) v[e] = v[e] + (vf[e] - v[e]) * sigm(z[e]);
            *(u32x2*)(F + (size_t)tok * 2048 + 512 + c) = pk4(v); }
        else *(u32x2*)(VF + o) = cV;
        const f32x4 kr = k * kkw;
        const float ss = row16_sum(kr[0] * kr[0] + kr[1] * kr[1] + kr[2] * kr[2] + kr[3] * kr[3]), rn = rsqrtf(fmaxf(ss, 1e-24f));
        const f32x4 lf = w0f + bf4(cL[0]), lb = w0b + bf4(cL[1]), xf = a0f + bf4(cL[2]), xb = a0b + bf4(cL[3]);
        f32x4 ef, eb, af, ab; float bp = 0.f;
#pragma unroll
        for (int e = 0; e < 4; ++e) { ef[e] = 0.6065306597126334f * sigm(lf[e]); eb[e] = 0.6065306597126334f * sigm(lb[e]); af[e] = sigm(xf[e]); ab[e] = sigm(xb[e]);
            bp += r[e] * k[e] * (1.f + (0.5f * (af[e] + ab[e]) - 1.f) * kaw[e]) * rkw[e]; }
        const float bon = row16_sum(bp);
        if ((C.lane & 15) == 0) BON[(size_t)tok * 4 + (C.lane >> 4)] = bon;
        { bf16* f_ = F + (size_t)tok * 2048 + c; *(u32x2*)(f_ + 256) = pk4(kr * rn); *(u32x2*)(f_ + 1024) = pk4(ef); *(u32x2*)(f_ + 1280) = pk4(eb); *(u32x2*)(f_ + 1536) = pk4(af); *(u32x2*)(f_ + 1792) = pk4(ab); }
        *(u32x2*)(Gq + o) = cL[4];
    }
#undef F3_LOAD
}

struct ScanOp { bf16 r, kk, k, e, a, v; };
DI int scan_tok(int n, int dir, int b) { n = n < 2303 ? n : 2303; if (n < 256) return CTXB + b * 256 + (dir ? 255 - n : n); const int t = n - 256; return b * TL + (dir ? TL - 1 - t : t); }
DI ScanOp scan_load(const bf16* Ft, int dir, unsigned ck, unsigned cv) {
    ScanOp o; o.r = Ft[ck]; o.kk = Ft[256 + ck]; o.k = Ft[768 + ck]; o.e = (Ft + (4 + dir) * 256)[ck]; o.a = (Ft + (6 + dir) * 256)[ck]; o.v = Ft[512 + cv]; return o;
}
#define DPPT " row_mask:0xf bank_mask:0xf\n\t"
#define SOPS(S) "+v"(S[0]), "+v"(S[1]), "+v"(S[2]), "+v"(S[3]), "+v"(S[4]), "+v"(S[5]), "+v"(S[6]), "+v"(S[7]), "+v"(S[8]), "+v"(S[9]), "+v"(S[10]), "+v"(S[11]), "+v"(S[12]), "+v"(S[13]), "+v"(S[14]), "+v"(S[15])
struct ScanVec { float w, kd, nbd, r, v; };
DI ScanVec scan_conv(const ScanOp& op, float ka, float& kk_out) {
    const float kk = bf2f(op.kk), k = bf2f(op.k), e = bf2f(op.e), a = bf2f(op.a);
    ScanVec c; c.r = bf2f(op.r); c.v = bf2f(op.v); c.w = fexp2(-e * LOG2E); c.kd = k * (1.f + (a - 1.f) * ka); c.nbd = -(kk * a); kk_out = kk; return c;
}
DI void scan_step(float (&S)[16], float& sa, ScanVec& cur, const ScanOp& nxt, float ka, bf16* yp, bool wr) {
    const float w = cur.w, nbd = cur.nbd, kd = cur.kd, v = cur.v;
#define UPM(j) "v_mul_f32_dpp %" #j ", %16, %" #j " row_newbcast:" #j DPPT
#define UPA(j) "v_fmac_f32_dpp %" #j ", %17, %19 row_newbcast:" #j DPPT
#define UPB(j) "v_fmac_f32_dpp %" #j ", %18, %20 row_newbcast:" #j DPPT
#define ALL16(M) M(0) M(1) M(2) M(3) M(4) M(5) M(6) M(7) M(8) M(9) M(10) M(11) M(12) M(13) M(14) M(15)
    asm volatile(ALL16(UPM) ALL16(UPA) ALL16(UPB) : SOPS(S) : "v"(w), "v"(nbd), "v"(kd), "v"(sa), "v"(v));
#undef UPM
#undef UPA
#undef UPB
    float kkn; ScanVec nx = scan_conv(nxt, ka, kkn);
    float r = cur.r;
    asm volatile("s_nop 1" : "+v"(r), "+v"(kkn), "+v"(nx.w), "+v"(nx.kd), "+v"(nx.nbd), "+v"(nx.r));
    float y0, y1, s0, s1;
    asm volatile(
        "v_mul_f32_dpp %0, %20, %4 row_newbcast:0" DPPT "v_mul_f32_dpp %2, %21, %4 row_newbcast:0" DPPT "v_mul_f32_dpp %1, %20, %5 row_newbcast:1" DPPT "v_mul_f32_dpp %3, %21, %5 row_newbcast:1" DPPT
        "v_fmac_f32_dpp %0, %20, %6 row_newbcast:2" DPPT "v_fmac_f32_dpp %2, %21, %6 row_newbcast:2" DPPT
        "v_fmac_f32_dpp %1, %20, %7 row_newbcast:3" DPPT "v_fmac_f32_dpp %3, %21, %7 row_newbcast:3" DPPT
        "v_fmac_f32_dpp %0, %20, %8 row_newbcast:4" DPPT "v_fmac_f32_dpp %2, %21, %8 row_newbcast:4" DPPT
        "v_fmac_f32_dpp %1, %20, %9 row_newbcast:5" DPPT "v_fmac_f32_dpp %3, %21, %9 row_newbcast:5" DPPT
        "v_fmac_f32_dpp %0, %20, %10 row_newbcast:6" DPPT "v_fmac_f32_dpp %2, %21, %10 row_newbcast:6" DPPT
        "v_fmac_f32_dpp %1, %20, %11 row_newbcast:7" DPPT "v_fmac_f32_dpp %3, %21, %11 row_newbcast:7" DPPT
        "v_fmac_f32_dpp %0, %20, %12 row_newbcast:8" DPPT "v_fmac_f32_dpp %2, %21, %12 row_newbcast:8" DPPT
        "v_fmac_f32_dpp %1, %20, %13 row_newbcast:9" DPPT "v_fmac_f32_dpp %3, %21, %13 row_newbcast:9" DPPT
        "v_fmac_f32_dpp %0, %20, %14 row_newbcast:10" DPPT "v_fmac_f32_dpp %2, %21, %14 row_newbcast:10" DPPT
        "v_fmac_f32_dpp %1, %20, %15 row_newbcast:11" DPPT "v_fmac_f32_dpp %3, %21, %15 row_newbcast:11" DPPT
        "v_fmac_f32_dpp %0, %20, %16 row_newbcast:12" DPPT "v_fmac_f32_dpp %2, %21, %16 row_newbcast:12" DPPT
        "v_fmac_f32_dpp %1, %20, %17 row_newbcast:13" DPPT "v_fmac_f32_dpp %3, %21, %17 row_newbcast:13" DPPT
        "v_fmac_f32_dpp %0, %20, %18 row_newbcast:14" DPPT "v_fmac_f32_dpp %2, %21, %18 row_newbcast:14" DPPT
        "v_fmac_f32_dpp %1, %20, %19 row_newbcast:15" DPPT "v_fmac_f32_dpp %3, %21, %19 row_newbcast:15" DPPT
        : "=&v"(y0), "=&v"(y1), "=&v"(s0), "=&v"(s1)
        : "v"(S[0]), "v"(S[1]), "v"(S[2]), "v"(S[3]), "v"(S[4]), "v"(S[5]), "v"(S[6]), "v"(S[7]), "v"(S[8]), "v"(S[9]), "v"(S[10]), "v"(S[11]), "v"(S[12]), "v"(S[13]), "v"(S[14]), "v"(S[15]), "v"(r), "v"(kkn));
    const float y = allred4(y0 + y1); sa = allred4(s0 + s1);
    if (wr) *yp = f2bf(y);
    cur = nx;
}
DI void scan_run(const Ctx& C0, int l, int b, int h, int dir) {
    const Ctx C = rectx(C0);
    if (C.wave >= 4) {
        if (l == 0) weights_tr(C, 1, C.bid * 4 + (C.wave - 4), C.G * 4, (LAS float*)(C.lds + 49152 + C.wave * 8704));
        return; }
    const int wv = C.wave & 3, q = C.lane >> 4, vi = C.lane & 15;
    const unsigned ck = h * 64 + C.lane, cv = h * 64 + 16 * wv + vi;
    const bf16* F = WSP(bf16, WS_X + X_F);
    bf16* YS = WSP(bf16, WS_X + X_UR) + (size_t)dir * FSZ;
    const float ka = C.P.in[18 + C.z][l * 256 + ck];
    float S[16];
#pragma unroll
    for (int j = 0; j < 16; ++j) S[j] = 0.f;
    const bool wr = (q == 0);
    size_t t0 = (size_t)scan_tok(0, dir, b) * 256, t1 = (size_t)scan_tok(1, dir, b) * 256, t2 = (size_t)scan_tok(2, dir, b) * 256, t3 = (size_t)scan_tok(3, dir, b) * 256;
    ScanOp o0 = scan_load(F + t0 * 8, dir, ck, cv), o1 = scan_load(F + t1 * 8, dir, ck, cv), o2 = scan_load(F + t2 * 8, dir, ck, cv), o3 = scan_load(F + t3 * 8, dir, ck, cv);
    float sa = 0.f, kk0_; ScanVec cur = scan_conv(o0, ka, kk0_);
    asm volatile("s_nop 1" : "+v"(cur.w), "+v"(cur.kd), "+v"(cur.nbd), "+v"(cur.r));
    for (int n = 0; n < 2304; n += 4) {
        size_t tn;
        scan_step(S, sa, cur, o1, ka, &(YS + t0)[cv], wr); tn = (size_t)__builtin_amdgcn_readfirstlane(scan_tok(n + 4, dir, b)) * 256; o0 = scan_load(F + tn * 8, dir, ck, cv); t0 = tn;
        scan_step(S, sa, cur, o2, ka, &(YS + t1)[cv], wr); tn = (size_t)__builtin_amdgcn_readfirstlane(scan_tok(n + 5, dir, b)) * 256; o1 = scan_load(F + tn * 8, dir, ck, cv); t1 = tn;
        scan_step(S, sa, cur, o3, ka, &(YS + t2)[cv], wr); tn = (size_t)__builtin_amdgcn_readfirstlane(scan_tok(n + 6, dir, b)) * 256; o2 = scan_load(F + tn * 8, dir, ck, cv); t2 = tn;
        scan_step(S, sa, cur, o0, ka, &(YS + t3)[cv], wr); tn = (size_t)__builtin_amdgcn_readfirstlane(scan_tok(n + 7, dir, b)) * 256; o3 = scan_load(F + tn * 8, dir, ck, cv); t3 = tn;
    }
}

DI void readout_phase(const Ctx& C0, int l, int nrows) {
    const Ctx C = rectx(C0);
    const bf16* F = WSP(bf16, WS_X + X_F); const bf16* Gq = WSP(bf16, WS_X + X_G); const bf16* YS = WSP(bf16, WS_X + X_UR); const float* BON = WSP(float, WS_BON);
    bf16* YR = WSP(bf16, WS_A + (size_t)108 * MiB);
    const int c = (C.lane >> 4) * 64 + (C.lane & 15) * 4;
    const f32x4 lw = *(const f32x4*)(C.P.in[20 + C.z] + l * 256 + c), lb = *(const f32x4*)(C.P.in[21 + C.z] + l * 256 + c);
    const int rpw = (nrows + C.G * NWAVES - 1) / (C.G * NWAVES), r0 = (C.bid * NWAVES + C.wave) * rpw, r1 = (r0 + rpw < nrows) ? r0 + rpw : nrows;
    if (r0 >= r1) return;
    u32x2 nF, nB, nV, nG; float nBon;
#define RO_LOAD(t) do { const size_t o_ = (size_t)(t) * 256 + c; nF = *(const u32x2*)(YS + o_); nB = *(const u32x2*)(YS + FSZ + o_); nV = *(const u32x2*)(F + (size_t)(t) * 2048 + 512 + c); nG = *(const u32x2*)(Gq + o_); nBon = BON[(size_t)(t) * 4 + (C.lane >> 4)]; } while (0)
    RO_LOAD(r0);
    for (int tok = r0; tok < r1; ++tok) {
        const u32x2 cF = nF, cB = nB, cV = nV, cG = nG; const float bon = nBon;
        if (tok + 1 < r1) RO_LOAD(tok + 1);
        const f32x4 y = bf4(cF) + bf4(cB);
        const float mean = row16_sum(y[0] + y[1] + y[2] + y[3]) * (1.f / 64.f);
        const f32x4 d = y - mean;
        const float var = row16_sum(d[0] * d[0] + d[1] * d[1] + d[2] * d[2] + d[3] * d[3]) * (1.f / 64.f);
        const f32x4 yn = d * rsqrtf(var + 64e-5f) * lw + lb;
        *(u32x2*)(YR + (size_t)tok * 256 + c) = pk4((yn + bf4(cV) * bon) * bf4(cG));
    }
#undef RO_LOAD
}

DI void fixup_phase(const Ctx& C0, int l, int nrows) {
    const Ctx C = rectx(C0);
    const int gw = C.bid * NWAVES + C.wave, NGW = C.G * NWAVES, nitem = (nrows / 64) * 2;
    const bf16* HALO = WSP(bf16, WS_X + X_HALO); bf16* HH = WSP(bf16, WS_X + X_HH);
    const float* cw = C.P.in[31 + C.z] + (size_t)l * 3 * DFF; const float* cb = C.P.in[32 + C.z] + (size_t)l * DFF;
    for (int it = gw; it < nitem; it += NGW) {
        const int grp = it >> 1, last = it & 1, row = grp * 64 + (last ? 63 : 0);
        const int t = (row < NLAT) ? (row & (TL - 1)) : ((row - NLAT) & (TC - 1)), T = (row < NLAT) ? TL : TC;
        const bf16* hb = HALO + (size_t)grp * 6 * DFF;
        const bf16 *pp, *pc, *pn, *pv; bool zp = false, zn = false;
        if (!last) { pc = hb; pn = hb + DFF; pv = hb + 4 * DFF; zp = (t == 0); pp = zp ? hb : hb - 6 * DFF + 3 * DFF; }
        else { pp = hb + 2 * DFF; pc = hb + 3 * DFF; pv = hb + 5 * DFF; zn = (t == T - 1); pn = zn ? hb : hb + 6 * DFF; }
        for (int p = C.lane; p < DFF / 8; p += 64) { const int j = p * 8;
            const u32x4 a = *(const u32x4*)(pp + j), bq = *(const u32x4*)(pc + j), cq = *(const u32x4*)(pn + j), vq = *(const u32x4*)(pv + j);
            float o[8];
#pragma unroll
            for (int e = 0; e < 8; ++e) { const unsigned ua = a[e >> 1], ub = bq[e >> 1], uc = cq[e >> 1], uv = vq[e >> 1];
                const float xp = zp ? 0.f : ((e & 1) ? hi2f(ua) : lo2f(ua)), xc = (e & 1) ? hi2f(ub) : lo2f(ub), xn = zn ? 0.f : ((e & 1) ? hi2f(uc) : lo2f(uc)), xv = (e & 1) ? hi2f(uv) : lo2f(uv);
                const float z = cw[j + e] * xp + cw[DFF + j + e] * xc + cw[2 * DFF + j + e] * xn + cb[j + e]; o[e] = gelu_tanh(z) * xv; }
            u32x4 w; w.x = pk(o[0], o[1]); w.y = pk(o[2], o[3]); w.z = pk(o[4], o[5]); w.w = pk(o[6], o[7]);
            *(u32x4*)(HH + (size_t)row * DFF + j) = w; }
    }
}

DI int crow(int i, int hh) { return (i & 3) + 8 * (i >> 2) + 4 * hh; }
DI void attn_unit(const Ctx& C, int l, int b, int kh, int qblk, bool isctx) {
    LAS bf16* Ks = (LAS bf16*)C.lds; LAS bf16* Vt = Ks + 64 * 72;
    const bf16* QKV = WSP(bf16, WS_X + X_QKV); bf16* YA = WSP(bf16, WS_A); const float* RT = WSP(float, WS_SMALL);
    const int g = C.wave >> 1, qt = C.wave & 1, hq = kh * 4 + g, r = C.lane & 31, hh = C.lane >> 5;
    const int qi = qblk * 64 + qt * 32 + r;
    const size_t tq = isctx ? (size_t)(CTXB + b * TC + qi) : (size_t)(b * TL + qi);
    bf16x8 qf[4];
    {
        float qv[4][8]; const bf16* qp = QKV + tq * 768 + hq * 64 + 8 * hh;
#pragma unroll
        for (int ks = 0; ks < 4; ++ks) { const u32x4 u = *(const u32x4*)(qp + 16 * ks);
#pragma unroll
            for (int e = 0; e < 4; ++e) { qv[ks][2 * e] = lo2f(u[e]); qv[ks][2 * e + 1] = hi2f(u[e]); } }
        if (!isctx) { const int rid = qi >> 6, cid = qi & 63;
#pragma unroll
            for (int j = 0; j < 8; ++j) { const int f = 8 * hh + j;
                const float c0 = RT[(rid * 16 + f) * 2], s0 = RT[(rid * 16 + f) * 2 + 1], c1 = RT[(cid * 16 + f) * 2], s1 = RT[(cid * 16 + f) * 2 + 1];
                const float a1 = qv[0][j], a2 = qv[1][j], b1 = qv[2][j], b2 = qv[3][j];
                qv[0][j] = a1 * c0 - a2 * s0; qv[1][j] = a2 * c0 + a1 * s0; qv[2][j] = b1 * c1 - b2 * s1; qv[3][j] = b2 * c1 + b1 * s1; } }
        const float sc = 0.125f * LOG2E;
#pragma unroll
        for (int ks = 0; ks < 4; ++ks) { u32x4 w; w.x = pk(qv[ks][0] * sc, qv[ks][1] * sc); w.y = pk(qv[ks][2] * sc, qv[ks][3] * sc); w.z = pk(qv[ks][4] * sc, qv[ks][5] * sc); w.w = pk(qv[ks][6] * sc, qv[ks][7] * sc); qf[ks] = __builtin_bit_cast(bf16x8, w); }
    }
    float m_run = C.P.in[25 + C.z][l * 8 + hq] * LOG2E, l_run = hh == 0 ? 1.f : 0.f;
    f32x16 o0, o1;
#pragma unroll
    for (int i = 0; i < 16; ++i) { o0[i] = 0.f; o1[i] = 0.f; }
    const int nch = isctx ? 4 : 9, skey = C.tid >> 3, oct = C.tid & 7;
#define ATT_VALID(c_) ((c_) < 4 || (qblk * 64 - 128 + ((c_) - 4) * 64 >= 0 && qblk * 64 - 128 + ((c_) - 4) * 64 < TL))
#define ATT_LOAD(c_) do { const size_t kt_ = ((c_) < 4) ? (size_t)(CTXB + b * TC + (c_) * 64) : (size_t)(b * TL + qblk * 64 - 128 + ((c_) - 4) * 64); \
        const bf16* kp_ = QKV + (kt_ + skey) * 768 + 512 + kh * 64; pk_u = *(const u32x4*)(kp_ + 8 * oct); pk_p = *(const u32x4*)(kp_ + 8 * (oct ^ 2)); pk_v = *(const u32x4*)(kp_ + 128 + 8 * oct); } while (0)
    u32x4 pk_u, pk_p, pk_v;
    int ch = 0;
    ATT_LOAD(0);
    while (ch < nch) {
        const bool win = ch >= 4; const int kb = win ? qblk * 64 - 128 + (ch - 4) * 64 : 0;
        __syncthreads();
        {
            u32x4 ku = pk_u;
            if (win) { const u32x4 pu = pk_p;
                const int p = kb + skey, pos = (oct >> 2) ? (p & 63) : (p >> 6), fb = 8 * (oct & 1); const bool isx1 = (oct & 2) == 0;
                float o[8];
#pragma unroll
                for (int e = 0; e < 8; ++e) { const float own = (e & 1) ? hi2f(ku[e >> 1]) : lo2f(ku[e >> 1]), par = (e & 1) ? hi2f(pu[e >> 1]) : lo2f(pu[e >> 1]);
                    const float cc = RT[(pos * 16 + fb + e) * 2], ss = RT[(pos * 16 + fb + e) * 2 + 1];
                    o[e] = isx1 ? (own * cc - par * ss) : (own * cc + par * ss); }
                ku.x = pk(o[0], o[1]); ku.y = pk(o[2], o[3]); ku.z = pk(o[4], o[5]); ku.w = pk(o[6], o[7]); }
            *(LAS u32x4*)(Ks + skey * 72 + 8 * oct) = ku;
            const u32x4 vu = pk_v;
#pragma unroll
            for (int e = 0; e < 8; ++e) Vt[(8 * oct + e) * 72 + skey] = (bf16)((e & 1) ? (vu[e >> 1] >> 16) : (vu[e >> 1] & 0xffffu));
        }
        __syncthreads();
        int nxc = ch + 1;
        while (nxc < nch && !ATT_VALID(nxc)) ++nxc;
        if (nxc < nch) ATT_LOAD(nxc);
        f32x16 x0, x1;
#pragma unroll
        for (int i = 0; i < 16; ++i) { x0[i] = 0.f; x1[i] = 0.f; }
#pragma unroll
        for (int ks = 0; ks < 4; ++ks) {
            const bf16x8 a0 = *(const LAS bf16x8*)(Ks + r * 72 + 16 * ks + 8 * hh), a1 = *(const LAS bf16x8*)(Ks + (32 + r) * 72 + 16 * ks + 8 * hh);
            x0 = __builtin_amdgcn_mfma_f32_32x32x16_bf16(a0, qf[ks], x0, 0, 0, 0);
            x1 = __builtin_amdgcn_mfma_f32_32x32x16_bf16(a1, qf[ks], x1, 0, 0, 0);
        }
        if (win) {
#pragma unroll
            for (int i = 0; i < 16; ++i) { const int k0 = kb + crow(i, hh), d0 = qi - k0, d1 = d0 - 32;
                if (d0 > 128 || d0 < -128) x0[i] = -1e30f; if (d1 > 128 || d1 < -128) x1[i] = -1e30f; }
        }
        float mx = x0[0];
#pragma unroll
        for (int i = 0; i < 16; ++i) { mx = fmaxf(mx, x0[i]); mx = fmaxf(mx, x1[i]); }
        mx = fmaxf(mx, __shfl_xor(mx, 32));
        const float m_new = fmaxf(m_run, mx), alpha = fexp2(m_run - m_new);
        float ps = 0.f;
#pragma unroll
        for (int i = 0; i < 16; ++i) { x0[i] = fexp2(x0[i] - m_new); x1[i] = fexp2(x1[i] - m_new); ps += x0[i] + x1[i]; o0[i] *= alpha; o1[i] *= alpha; }
        l_run = l_run * alpha + ps; m_run = m_new;
#pragma unroll
        for (int kt = 0; kt < 2; ++kt)
#pragma unroll
            for (int s = 0; s < 2; ++s) {
                const f32x16& x = kt ? x1 : x0;
                u32x4 w; w.x = pk(x[8 * s], x[8 * s + 1]); w.y = pk(x[8 * s + 2], x[8 * s + 3]); w.z = pk(x[8 * s + 4], x[8 * s + 5]); w.w = pk(x[8 * s + 6], x[8 * s + 7]);
                const bf16x8 pb = __builtin_bit_cast(bf16x8, w);
                const int ko = kt * 32 + 16 * s + 4 * hh;
                const s16x4 l0 = *(const LAS s16x4*)(Vt + r * 72 + ko), h0 = *(const LAS s16x4*)(Vt + r * 72 + ko + 8);
                const s16x4 l1 = *(const LAS s16x4*)(Vt + (32 + r) * 72 + ko), h1 = *(const LAS s16x4*)(Vt + (32 + r) * 72 + ko + 8);
                o0 = __builtin_amdgcn_mfma_f32_32x32x16_bf16(__builtin_shufflevector(l0, h0, 0, 1, 2, 3, 4, 5, 6, 7), pb, o0, 0, 0, 0);
                o1 = __builtin_amdgcn_mfma_f32_32x32x16_bf16(__builtin_shufflevector(l1, h1, 0, 1, 2, 3, 4, 5, 6, 7), pb, o1, 0, 0, 0);
            }
        ch = nxc;
    }
#undef ATT_VALID
#undef ATT_LOAD
    const float inv = frcp(l_run + __shfl_xor(l_run, 32));
    bf16* op = YA + tq * 512 + hq * 64 + 4 * hh;
#pragma unroll
    for (int i4 = 0; i4 < 4; ++i4) {
        u32x2 w0, w1; w0.x = pk(o0[4 * i4] * inv, o0[4 * i4 + 1] * inv); w0.y = pk(o0[4 * i4 + 2] * inv, o0[4 * i4 + 3] * inv);
        w1.x = pk(o1[4 * i4] * inv, o1[4 * i4 + 1] * inv); w1.y = pk(o1[4 * i4 + 2] * inv, o1[4 * i4 + 3] * inv);
        *(u32x2*)(op + 8 * i4) = w0; *(u32x2*)(op + 32 + 8 * i4) = w1;
    }
}
DI void attn_loop(const Ctx& C0, int l) {
    const Ctx C = rectx(C0);
    unsigned* ctr = WSP(unsigned, WS_CTL) + 64 * (l + 1);
    volatile LAS unsigned* slot = (volatile LAS unsigned*)(C.lds + 32768);
    const unsigned NU = 2048u + (l == 0 ? 256u : 0u);
    for (;;) {
        __syncthreads();
        if (C.tid == 0) *slot = atomicAdd(ctr, 1u);
        __syncthreads();
        const unsigned u = *slot;
        if (u >= NU) break;
        if (u < 2048u) attn_unit(C, l, (int)(u >> 6), (int)((u >> 5) & 1), (int)(u & 31), false);
        else { const unsigned v = u - 2048u; attn_unit(C, l, (int)(v >> 3), (int)((v >> 2) & 1), (int)(v & 3), true); }
    }
}


#ifdef DBG
DI float exp_f(float x) { return fexp2(x * LOG2E); }
DI unsigned hsh(unsigned x) { x ^= x >> 16; x *= 0x7feb352du; x ^= x >> 15; x *= 0x846ca68bu; x ^= x >> 16; return x; }
DI void dbg_put(const Ctx& C, int k, float got, float ref, float S) {
    float err = fabsf(got - ref) / (fabsf(ref) + S); if (!(err == err)) err = 1e9f;
    atomicMax(WSP(unsigned, WS_CTL) + 1024 + k, __builtin_bit_cast(unsigned, err));
}
DI float ndot(const bf16* a, const bf16* b, int K) { float s = 0.f; for (int k = 0; k < K; ++k) s += bf2f(a[k]) * bf2f(b[k]); return s; }
DI void dbg_check(const Ctx& C0, int stage, int l) {
    if (C0.bid != 0 || l != 0) return;
    const Ctx C = rectx(C0);
    const unsigned h1 = hsh(C.tid * 3u + 17u + stage * 1000u), h2 = hsh(h1 + 0x9e3779b9u), h3 = hsh(h2 + 77u);
    const Params& P = C.P;
    if (stage == 0) {
        {
            const int n = h1 % 2432, k = h2 % 1024; int src = -1;
            if (n < 512) src = 1152 + n; else if (n < 640) src = 1664 + (n - 512); else if (n < 768) src = 1792 + (n - 640); else if (n >= 1280) src = n - 1280;
            if (src >= 0) dbg_put(C, 0, bf2f(WL(bf16, 0, WL_IN)[(size_t)n * 1024 + k]), bf2f(f2bf(P.in[10 + C.z][(size_t)k * IN_COLS + src])), 1e-6f);
            const int ng = h3 % 3072;
            dbg_put(C, 0, bf2f(WL(bf16, 0, WL_G)[(size_t)ng * 1024 + k]), bf2f(f2bf(P.in[10 + C.z][(size_t)k * IN_COLS + 2176 + ng])), 1e-6f);
            const int nu = h3 % 5632, pn = nu >> 8, bj = (nu >> 7) & 1, j = nu & 127;
            dbg_put(C, 0, bf2f(WL(bf16, 0, WL_UP)[(size_t)nu * 1024 + k]), bf2f(f2bf(P.in[30 + C.z][(size_t)k * 5632 + bj * DFF + pn * 128 + j])), 1e-6f);
            const int nd = h1 % 1024, kd = h3 % DFF;
            dbg_put(C, 0, bf2f(WL(bf16, 0, WL_DN)[(size_t)nd * DFF + kd]), bf2f(f2bf(P.in[33 + C.z][(size_t)kd * 1024 + nd])), 1e-6f);
            dbg_put(C, 0, bf2f(WL(bf16, 0, WL_O)[(size_t)nd * 1024 + k]), bf2f(f2bf(P.in[29 + C.z][(size_t)k * 1024 + nd])), 1e-6f);
            dbg_put(C, 0, bf2f(WL(bf16, 0, WL_BA)[(size_t)nd * 512 + (k & 511)]), bf2f(f2bf(P.in[27 + C.z][(size_t)(k & 511) * 1024 + nd])), 1e-6f);
            dbg_put(C, 0, bf2f(WL(bf16, 0, WL_BR)[(size_t)nd * 256 + (k & 255)]), bf2f(f2bf(P.in[26 + C.z][(size_t)(k & 255) * 1024 + nd])), 1e-6f);
        }
        {
            const int r = h1 % 33, j = h2 % 6144; float a = P.in[5 + C.z][j];
            for (int k = 0; k < 1024; ++k) { const float cv = (r < 32) ? P.in[1 + C.z][r * 1024 + k] : P.in[3 + C.z][k]; a += cv / (1.f + exp_f(-cv)) * P.in[4 + C.z][(size_t)k * 6144 + j]; }
            dbg_put(C, 1, WSP(float, WS_MOD)[(size_t)r * 6144 + j], a, 0.01f);
        }
    } else if (stage == 1) {
        const int tok = h1 % NT, col = h2 % 1024; const bool lat = tok < NLAT; const float* hp = lat ? P.in[0 + C.z] + (size_t)tok * DM : P.in[2 + C.z] + (size_t)(tok - NLAT) * DM;
        float ss = 0.f; for (int k = 0; k < 1024; ++k) ss += hp[k] * hp[k];
        const float* mp = WSP(float, WS_MOD) + (size_t)(lat ? tok / TL : 32) * 6144;
        const float ref = hp[col] * rsqrtf(ss / 1024.f + 1e-6f) * P.in[6 + C.z][col] * (1.f + mp[1024 + col]) + mp[col];
        dbg_put(C, 2, bf2f(WSP(bf16, WS_A)[(size_t)tok * DM + col]), ref, 0.05f);
    } else if (stage == 2) {
        const int tok = h1 % NT, n = h2 % 2432; const float ref = ndot(WSP(bf16, WS_A) + (size_t)tok * DM, WL(bf16, 0, WL_IN) + (size_t)n * 1024, 1024);
        float got; int k;
        if (n < 768) { got = bf2f(WSP(bf16, WS_X + X_QKV)[(size_t)tok * 768 + n]); k = 3; }
        else if (n < 1280) { const int sn = (n - 768) >> 8, ch = (n - 768) & 255; k = 4;
            if (tok < NLAT) got = bf2f(WSP(bf16, WS_X + X_ZT)[((size_t)(tok / TL) * 256 + ch) * 4096 + sn * 2048 + (tok % TL)]);
            else got = bf2f(WSP(bf16, WS_X + X_ZTC)[((size_t)((tok - NLAT) / TC) * 256 + ch) * 512 + sn * 256 + ((tok - NLAT) % TC)]); }
        else { got = bf2f(WSP(bf16, WS_X + X_UR)[(size_t)tok * RW + n - 1280]); k = 5; }
        dbg_put(C, k, got, ref, 0.1f);
    } else if (stage == 3) {
        const int b = h1 % 32, t = 1 + h2 % 2046, c = h3 % 256; const size_t tok = (size_t)b * TL + t; const bf16* UR = WSP(bf16, WS_X + X_UR);
        const float u = bf2f(UR[tok * RW + c]), up = bf2f(UR[(tok - 1) * RW + c]), un = bf2f(UR[(tok + 1) * RW + c]);
        dbg_put(C, 7, bf2f(WSP(bf16, WS_X + X_F)[tok * 2048 + c]), u + P.in[11 + C.z][c] * (up - u) + P.in[11 + C.z][RW + c] * (un - u), 0.05f);
        float ss = 0.f; for (int k = 0; k < 64; ++k) { const float x = bf2f(WSP(bf16, WS_X + X_F)[tok * 2048 + 256 + (c & 192) + k]); ss += x * x; }
        dbg_put(C, 7, ss, 1.f, 0.f);
    } else if (stage == 4) {
        {
            LAS float* S = (LAS float*)C.lds; LAS float* sa = S + 4096; const bf16* F = WSP(bf16, WS_X + X_F); const int b = 1, h = 2;
            for (int dir = 0; dir < 2; ++dir) {
                for (int e = C.tid; e < 4096; e += NTHREADS) S[e] = 0.f;
                __syncthreads();
                for (int n = 0; n < 24; ++n) {
                    const size_t oy = (size_t)scan_tok(n, dir, b) * 256 + h * 64, o = (size_t)scan_tok(n, dir, b) * 2048 + h * 64;
                    if (C.tid < 64) { float a = 0.f; for (int k = 0; k < 64; ++k) a -= S[C.tid * 64 + k] * bf2f(F[256 + o + k]); sa[C.tid] = a; }
                    __syncthreads();
                    for (int e = C.tid; e < 4096; e += NTHREADS) { const int v = e >> 6, k = e & 63;
                        const float kk = bf2f(F[256 + o + k]), kr = bf2f(F[768 + o + k]), ee = bf2f(F[(4 + dir) * 256 + o + k]), a = bf2f(F[(6 + dir) * 256 + o + k]), vv = bf2f(F[512 + o + v]);
                        S[e] = S[e] * exp_f(-ee) + sa[v] * (kk * a) + vv * (kr * (1.f + (a - 1.f) * P.in[18 + C.z][h * 64 + k])); }
                    __syncthreads();
                    if (C.tid < 64) { float y = 0.f; for (int k = 0; k < 64; ++k) y += S[C.tid * 64 + k] * bf2f(F[o + k]);
                        dbg_put(C, 8, bf2f(WSP(bf16, WS_X + X_UR)[(size_t)dir * FSZ + oy + C.tid]), y, 0.05f); }
                    __syncthreads();
                }
            }
        }
        {
            LAS float* qs = (LAS float*)C.lds + (size_t)C.tid * 65; const bf16* QKV = WSP(bf16, WS_X + X_QKV);
            const int b = h1 % 32, t = (C.tid & 1) ? (int)(h2 % 2048) : ((C.tid & 2) ? (int)(h2 % 200) : 2047 - (int)(h2 % 200)), hq = h3 % 8, dd = (h3 >> 8) % 64, kh = hq >> 2;
            const size_t tq = (size_t)b * TL + t;
            for (int d = 0; d < 64; ++d) { const int ax = d >> 5, hf = (d >> 4) & 1, f = d & 15; const int ps = ax ? (t & 63) : (t >> 6); const float cs = WSP(float, WS_SMALL)[(ps * 16 + f) * 2], sn = WSP(float, WS_SMALL)[(ps * 16 + f) * 2 + 1];
                const float x1 = bf2f(QKV[tq * 768 + hq * 64 + ax * 32 + f]), x2 = bf2f(QKV[tq * 768 + hq * 64 + ax * 32 + 16 + f]);
                qs[d] = hf ? (x2 * cs + x1 * sn) : (x1 * cs - x2 * sn); }
            float m = P.in[25 + C.z][hq], den = 1.f, acc = 0.f;
            for (int j = 0; j < 256 + 257; ++j) {
                const bool win = j >= 256; const int kp = win ? t - 128 + (j - 256) : j; if (win && (kp < 0 || kp >= TL)) continue;
                const size_t tk = win ? (size_t)b * TL + kp : (size_t)(CTXB + b * TC + kp); float s = 0.f;
                for (int d = 0; d < 64; ++d) { float kv;
                    if (!win) kv = bf2f(QKV[tk * 768 + 512 + kh * 64 + d]);
                    else { const int ax = d >> 5, hf = (d >> 4) & 1, f = d & 15; const int ps = ax ? (kp & 63) : (kp >> 6); const float cs = WSP(float, WS_SMALL)[(ps * 16 + f) * 2], sn = WSP(float, WS_SMALL)[(ps * 16 + f) * 2 + 1];
                        const float x1 = bf2f(QKV[tk * 768 + 512 + kh * 64 + ax * 32 + f]), x2 = bf2f(QKV[tk * 768 + 512 + kh * 64 + ax * 32 + 16 + f]);
                        kv = hf ? (x2 * cs + x1 * sn) : (x1 * cs - x2 * sn); }
                    s += qs[d] * kv; }
                s *= 0.125f; const float mn = fmaxf(m, s), al = exp_f(m - mn), p = exp_f(s - mn);
                den = den * al + p; acc = acc * al + p * bf2f(QKV[tk * 768 + 640 + kh * 64 + dd]); m = mn;
            }
            dbg_put(C, 9, bf2f(WSP(bf16, WS_A)[tq * 512 + hq * 64 + dd]), acc / den, 0.03f);
        }
        __syncthreads();
        {
            LAS float* qs = (LAS float*)C.lds + (size_t)C.tid * 65; const bf16* QKV = WSP(bf16, WS_X + X_QKV);
            const int b = h2 % 32, t = h1 % 256, hq = h3 % 8, dd = (h3 >> 8) % 64, kh = hq >> 2; const size_t tq = (size_t)(CTXB + b * TC + t);
            for (int d = 0; d < 64; ++d) qs[d] = bf2f(QKV[tq * 768 + hq * 64 + d]);
            float m = P.in[25 + C.z][hq], den = 1.f, acc = 0.f;
            for (int j = 0; j < 256; ++j) { const size_t tk = (size_t)(CTXB + b * TC + j); float s = 0.f;
                for (int d = 0; d < 64; ++d) s += qs[d] * bf2f(QKV[tk * 768 + 512 + kh * 64 + d]);
                s *= 0.125f; const float mn = fmaxf(m, s), al = exp_f(m - mn), p = exp_f(s - mn); den = den * al + p; acc = acc * al + p * bf2f(QKV[tk * 768 + 640 + kh * 64 + dd]); m = mn; }
            dbg_put(C, 10, bf2f(WSP(bf16, WS_A)[tq * 512 + hq * 64 + dd]), acc / den, 0.03f);
        }
        {
            const int b = h1 % 32, tp = h2 % 2048, ch = h3 % 256;
            dbg_put(C, 11, bf2f(WSP(bf16, WS_A + (size_t)72 * MiB)[((size_t)b * TL + tp) * 256 + ch]), ndot(WSP(bf16, WS_DFT) + (size_t)tp * 4096, WSP(bf16, WS_X + X_ZT) + ((size_t)b * 256 + ch) * 4096, 4096), 0.05f);
            const int tc = h2 % 256;
            dbg_put(C, 11, bf2f(WSP(bf16, WS_A + (size_t)72 * MiB)[((size_t)CTXB + b * TC + tc) * 256 + ch]), ndot(WSP(bf16, WS_DFTC) + (size_t)tc * 512, WSP(bf16, WS_X + X_ZTC) + ((size_t)b * 256 + ch) * 512, 512), 0.05f);
        }
    } else if (stage == 5) {
        const int tok = h1 % NT, col = h2 % 1024; const bf16* PP = WSP(bf16, WS_X + X_PP);
        dbg_put(C, 13, bf2f(PP[(size_t)tok * NGATE + col]), ndot(WSP(bf16, WS_A + (size_t)108 * MiB) + (size_t)tok * 256, WL(bf16, 0, WL_BR) + (size_t)col * 256, 256), 0.05f);
        dbg_put(C, 13, bf2f(PP[(size_t)tok * NGATE + 1024 + col]), ndot(WSP(bf16, WS_A) + (size_t)tok * 512, WL(bf16, 0, WL_BA) + (size_t)col * 512, 512), 0.05f);
        dbg_put(C, 13, bf2f(PP[(size_t)tok * NGATE + 2048 + col]), ndot(WSP(bf16, WS_A + (size_t)72 * MiB) + (size_t)tok * 256, WL(bf16, 0, WL_BF) + (size_t)col * 256, 256), 0.05f);
    } else if (stage == 6) {
        const int tok = h1 % NT, col = h2 % 1024; float ref = 0.f;
        for (int br = 0; br < 3; ++br) { const float gl = ndot(WSP(bf16, WS_A) + (size_t)tok * DM, WL(bf16, 0, WL_G) + (size_t)(br * 1024 + col) * 1024, 1024); ref += bf2f(WSP(bf16, WS_X + X_PP)[(size_t)tok * NGATE + br * 1024 + col]) / (1.f + exp_f(-gl)); }
        dbg_put(C, 14, bf2f(WSP(bf16, WS_X + X_UR)[(size_t)tok * DM + col]), ref, 0.05f);
    } else if (stage == 7) {
        const int tok = h1 % NT, col = h2 % 1024;
        dbg_put(C, 15, bf2f(WSP(bf16, WS_X + X_MIX)[(size_t)tok * DM + col]), ndot(WSP(bf16, WS_X + X_UR) + (size_t)tok * DM, WL(bf16, 0, WL_O) + (size_t)col * 1024, 1024), 0.05f);
    } else if (stage == 8) {
        const int tok = h1 % NT, col = h2 % 1024; const bool lat = tok < NLAT; const float* hp = lat ? P.in[0 + C.z] + (size_t)tok * DM : P.in[2 + C.z] + (size_t)(tok - NLAT) * DM;
        const bf16* mx = WSP(bf16, WS_X + X_MIX) + (size_t)tok * DM; const float* mp = WSP(float, WS_MOD) + (size_t)(lat ? tok / TL : 32) * 6144;
        float ss = 0.f; for (int k = 0; k < 1024; ++k) ss += bf2f(mx[k]) * bf2f(mx[k]);
        const float rs = rsqrtf(ss / 1024.f + 1e-6f); float s2 = 0.f, hc = 0.f;
        for (int k = 0; k < 1024; ++k) { const float hn = hp[k] + mp[2048 + k] * bf2f(mx[k]) * rs * P.in[7 + C.z][k]; s2 += hn * hn; if (k == col) hc = hn; }
        const float* ho = lat ? C.out + (size_t)tok * DM : WSP(float, WS_HC) + (size_t)(tok - NLAT) * DM;
        dbg_put(C, 16, ho[col], hc, 0.01f);
        dbg_put(C, 16, bf2f(WSP(bf16, WS_A)[(size_t)tok * DM + col]), hc * rsqrtf(s2 / 1024.f + 1e-6f) * P.in[8 + C.z][col] * (1.f + mp[4096 + col]) + mp[3072 + col], 0.05f);
    } else if (stage == 9) {
        int tok = h1 % NT; if (C.tid & 1) tok = (tok & ~63) + ((C.tid & 2) ? 63 : 0);
        const int j = h2 % DFF; const int t = (tok < NLAT) ? (tok % TL) : ((tok - NLAT) % TC), T = (tok < NLAT) ? TL : TC;
        const bf16* A = WSP(bf16, WS_A); const bf16* wu = WL(bf16, 0, WL_UP); const int pn = j >> 7, jj = j & 127;
        const bf16* wg = wu + (size_t)(pn * 256 + jj) * 1024; const bf16* wv = wu + (size_t)(pn * 256 + 128 + jj) * 1024;
        const float zc = ndot(A + (size_t)tok * DM, wg, 1024), zp = (t > 0) ? ndot(A + (size_t)(tok - 1) * DM, wg, 1024) : 0.f, zn = (t < T - 1) ? ndot(A + (size_t)(tok + 1) * DM, wg, 1024) : 0.f, zv = ndot(A + (size_t)tok * DM, wv, 1024);
        const float z = P.in[31 + C.z][j] * zp + P.in[31 + C.z][DFF + j] * zc + P.in[31 + C.z][2 * DFF + j] * zn + P.in[32 + C.z][j];
        const float ge = 0.5f * z * (1.f + tanh_(0.7978845608028654f * (z + 0.044715f * z * z * z)));
        dbg_put(C, 17, bf2f(WSP(bf16, WS_X + X_HH)[(size_t)tok * DFF + j]), ge * zv, 0.05f);
    } else if (stage == 10) {
        const int tok = h1 % NT, col = h2 % 1024;
        dbg_put(C, 18, bf2f(WSP(bf16, WS_X + X_FFO)[(size_t)tok * DM + col]), ndot(WSP(bf16, WS_X + X_HH) + (size_t)tok * DFF, WL(bf16, 0, WL_DN) + (size_t)col * DFF, DFF), 0.05f);
    }
}
DI void dbg_report(const Ctx& C) {
    if (C.bid == 0 && threadIdx.x == 0) {
        int first = -1; for (int k = 0; k < 24; ++k) if (first < 0 && __builtin_bit_cast(float, WSP(unsigned, WS_CTL)[1024 + k]) > 0.05f) first = k;
        if (first >= 0) C.out[12345] = 1000.f * (float)(first + 1);
    }
}
#define DBGCHK(stage) do { grid.sync(); dbg_check(CK, stage, l); grid.sync(); } while (0)
#else
#define DBGCHK(stage) do { } while (0)
#endif
#define XB_TMO      128
#define XB_XCNT(j)  (256  + 64 * (j))
#define XB_XSUB(j)  (1280 + 64 * (j))
#define XB_XGEN(j)  (2304 + 64 * (j))
#define XB_TOP      3328
#define XB_TOPGEN   3392
#define XCD_BAR_WORDS 3456
#define XB_SPIN_CAP (1u << 18)

__device__ __forceinline__ unsigned xb_ld(unsigned* p)              { return __hip_atomic_load(p, __ATOMIC_RELAXED, __HIP_MEMORY_SCOPE_AGENT); }
__device__ __forceinline__ unsigned xb_add(unsigned* p, unsigned v) { return __hip_atomic_fetch_add(p, v, __ATOMIC_RELAXED, __HIP_MEMORY_SCOPE_AGENT); }
__device__ __forceinline__ unsigned xb_xcc_id() { return (unsigned)__builtin_amdgcn_s_getreg((3 << 11) | 20) & 0xFu; }
#define XB_SPIN(cond, bar) do { unsigned _sp = 0; while (cond) { __builtin_amdgcn_s_sleep(1); \
    if ((++_sp & 255u) == 0u) { if (xb_ld(&(bar)[XB_TMO])) break; if (_sp > XB_SPIN_CAP) { atomicAdd(&(bar)[XB_TMO], 1u); break; } } } } while (0)

struct XcdBarrier {
    unsigned* bar; unsigned x;
    volatile LAS unsigned* st;
};

__device__ __forceinline__ XcdBarrier xcd_barrier_post(unsigned* bar, volatile LAS unsigned* st) {
    XcdBarrier b; b.bar = bar; b.x = xb_xcc_id(); b.st = st;
    if (threadIdx.x == 0) (void)xb_add(&bar[XB_XCNT(b.x)], 1u);
    return b;
}
__device__ __forceinline__ void xcd_barrier_complete(unsigned* bar, unsigned x, unsigned& nloc, unsigned& nx) {
    const unsigned G = gridDim.x * gridDim.y * gridDim.z;
    unsigned sum, cnt, mine, sp = 0u;
    for (;;) {
        sum = 0u; cnt = 0u; mine = 0u;
#pragma unroll
        for (unsigned j = 0; j < 16; ++j) { const unsigned c = xb_ld(&bar[XB_XCNT(j)]); sum += c; cnt += (c > 0u) ? 1u : 0u; mine = (j == x) ? c : mine; }
        if (sum == G) break;
        __builtin_amdgcn_s_sleep(1);
        if ((++sp & 255u) == 0u) { if (xb_ld(&bar[XB_TMO])) break; if (sp > XB_SPIN_CAP) { atomicAdd(&bar[XB_TMO], 1u); break; } }
    }
    nloc = mine > 0u ? mine : 1u; nx = cnt > 0u ? cnt : 1u;
}

__device__ __forceinline__ void xcd_barrier(const XcdBarrier& b) {
    asm volatile("s_waitcnt vmcnt(0)" ::: "memory");
    __syncthreads();
    if (threadIdx.x == 0) {
        unsigned* bar = b.bar;
        __builtin_amdgcn_s_waitcnt(0);
        unsigned nloc = b.st[0], nx = b.st[1];
        if (nloc == 0u) { xcd_barrier_complete(bar, b.x, nloc, nx); b.st[0] = nloc; b.st[1] = nx; }
        const unsigned old = xb_add(&bar[XB_XSUB(b.x)], 1u);
        const unsigned gen = old / nloc;
        if (old + 1u == (gen + 1u) * nloc) {
            __builtin_amdgcn_fence(__ATOMIC_RELEASE, "agent");
            asm volatile("s_waitcnt vmcnt(0)" ::: "memory");
            const unsigned og = xb_add(&bar[XB_TOP], 1u);
            const unsigned tg = og / nx;
            if (og + 1u == (tg + 1u) * nx) xb_add(&bar[XB_TOPGEN], 1u);
            else XB_SPIN(xb_ld(&bar[XB_TOPGEN]) == tg, bar);
            __builtin_amdgcn_fence(__ATOMIC_ACQUIRE, "agent");
            xb_add(&bar[XB_XGEN(b.x)], 1u);
            asm volatile("s_waitcnt vmcnt(0)" ::: "memory");
        } else {
            XB_SPIN(xb_ld(&bar[XB_XGEN(b.x)]) == gen, bar);
            __builtin_amdgcn_fence(__ATOMIC_ACQUIRE, "agent");
            asm volatile("s_waitcnt vmcnt(0)" ::: "memory");
        }
    }
    __syncthreads();
}

__global__ void __launch_bounds__(NTHREADS, 2) fwd_kernel(Params P) {
    extern __shared__ __attribute__((aligned(16))) unsigned char lds_raw[];
    cg::grid_group grid = cg::this_grid();
    const int tid_ = threadIdx.x;
    const Ctx CK{(LAS unsigned char*)lds_raw, P.ws, P, P.out, tid_, tid_ & 63, __builtin_amdgcn_readfirstlane(tid_ >> 6), (int)gridDim.x, (int)blockIdx.x, 0};
    volatile LAS unsigned* xb_st = (volatile LAS unsigned*)(CK.lds + 139264);
    if (tid_ < 2) xb_st[tid_] = 0u;
    __syncthreads();
    const XcdBarrier xbar = xcd_barrier_post((unsigned*)P.ws + 4096, xb_st);
#define GSYNC() xcd_barrier(xbar)
#ifdef PROBE
#define TS(k) do { if (tid_ == 0 && blockIdx.x == 0) ((volatile LAS unsigned long long*)(CK.lds + 131072))[k] = __builtin_amdgcn_s_memrealtime(); } while (0)
#else
#define TS(k) do { } while (0)
#endif
#define PH_BEGIN { const Ctx C = rectx(CK); LAS unsigned char* glds = C.lds;
#define PH_END }
#define ABUF WSP(bf16, WS_A)
#define HCB WSP(float, WS_HC)
#define MODL(ll) (WSP(float, WS_MOD) + (size_t)(ll) * 33 * 6144)
#define HIN_L ((l == 0) ? C.P.in[0 + C.z] : (const float*)C.out)
#define HIN_C ((l == 0) ? C.P.in[2 + C.z] : (const float*)HCB)
#define GEMM_STD(Aptr, Bptr, M_, N_, K_, EPI, ...) do { pg8::Gemm g{Aptr, Bptr, M_, N_, K_}; pg8::StaticOrder S; S.init(M_, N_, C.G, C.bid); EPI E{__VA_ARGS__}; pg8::gemm_phase<EPI, pg8::StaticOrder, true, true>(glds, g, S, E); } while (0)
    TS(40);
    prologue(CK);
    grid.sync(); TS(41);
    { const int l = 0; DBGCHK(0); }
    for (int l = 0; l < 2; ++l) {
        TS(l * 16 + 0);
        const int Mmix = (l == 0) ? NT : NLAT;
        if (l == 0) { PH_BEGIN rowop<false, true>(C, NT, HIN_L, HIN_C, nullptr, nullptr, nullptr, 0, nullptr, C.P.in[6 + C.z] + l * DM, 0, 1, MODL(l), MODL(l), ABUF); PH_END GSYNC(); TS(l * 16 + 1); DBGCHK(1); }
        PH_BEGIN
            GEMM_STD(ABUF, WL(bf16, l, WL_IN), NT, NIN, DM, EpiIn, WSP(bf16, WS_X + X_QKV), WSP(bf16, WS_X + X_ZT), WSP(bf16, WS_X + X_ZTC), WSP(bf16, WS_X + X_UR));
        PH_END
        GSYNC(); TS(l * 16 + 2); DBGCHK(2);
        feat1_phase(CK, l);
        GSYNC();
        PH_BEGIN GEMM_STD(WSP(bf16, WS_A), WSP(bf16, WS_WLORA + (size_t)l * 2 * MiB), NT, (l == 0 ? 1280 : NLO), (l == 0 ? 384 : KLO), EpiStore, WSP(bf16, WS_X + X_LO), NLO, 0, 0, 256); PH_END
        GSYNC();
        feat3_phase(CK, l);
        GSYNC(); TS(l * 16 + 3); DBGCHK(3);
        if (CK.bid < 256) scan_run(CK, l, CK.bid >> 3, (CK.bid >> 1) & 3, CK.bid & 1);
        __syncthreads(); TS(l * 16 + 15);
        {
            PH_BEGIN
                pg8::Gemm g{WSP(bf16, WS_DFT), WSP(bf16, WS_X + X_ZT), 2048, 8192, 4096}; pg8::StaticOrder S; S.init(2048, 8192, C.G, C.bid);
                EpiStore E{WSP(bf16, WS_A + (size_t)72 * MiB), 256, 0, 2048, 0};
                pg8::gemm_phase<EpiStore, pg8::StaticOrder, true, true>(glds, g, S, E);
            PH_END
            if (l == 0) { PH_BEGIN
                pg8::Gemm g{WSP(bf16, WS_DFTC), WSP(bf16, WS_X + X_ZTC), 256, 8192, 512}; pg8::StaticOrder S; S.init(256, 8192, C.G, C.bid);
                EpiStore E{WSP(bf16, WS_A + (size_t)72 * MiB), 256, CTXB, 256, 0};
                pg8::gemm_phase<EpiStore, pg8::StaticOrder, true, true>(glds, g, S, E);
            PH_END }
        }
        attn_loop(CK, l);
        GSYNC(); TS(l * 16 + 4); DBGCHK(4);
        readout_phase(CK, l, Mmix);
        GSYNC(); TS(l * 16 + 5);
        PH_BEGIN GEMM_STD(WSP(bf16, WS_A + (size_t)108 * MiB), WL(bf16, l, WL_BR), Mmix, 1024, 256, EpiStore, WSP(bf16, WS_X + X_PP), NGATE, 0, 0, 256); PH_END
        PH_BEGIN GEMM_STD(WSP(bf16, WS_A), WL(bf16, l, WL_BA), Mmix, 1024, 512, EpiStore, WSP(bf16, WS_X + X_PP) + 1024, NGATE, 0, 0, 256); PH_END
        PH_BEGIN GEMM_STD(WSP(bf16, WS_A + (size_t)72 * MiB), WL(bf16, l, WL_BF), Mmix, 1024, 256, EpiStore, WSP(bf16, WS_X + X_PP) + 2048, NGATE, 0, 0, 256); PH_END
        GSYNC(); TS(l * 16 + 6); DBGCHK(5);
        PH_BEGIN rowop<false, true>(C, Mmix, HIN_L, HIN_C, nullptr, nullptr, nullptr, 0, nullptr, C.P.in[6 + C.z] + l * DM, 0, 1, MODL(l), MODL(l), ABUF); PH_END
        GSYNC(); TS(l * 16 + 7);
        PH_BEGIN
            pg8::Gemm g{ABUF, WL(bf16, l, WL_G), Mmix, NGATE, DM}; GateOrder S{(Mmix / 256) * 4, C.G, C.bid};
            EpiGate E{WSP(bf16, WS_X + X_PP), WSP(bf16, WS_X + X_UR)};
            pg8::gemm_phase<EpiGate, GateOrder, true, true>(glds, g, S, E);
        PH_END
        GSYNC(); TS(l * 16 + 8); DBGCHK(6);
        PH_BEGIN GEMM_STD(WSP(bf16, WS_X + X_UR), WL(bf16, l, WL_O), Mmix, DM, DM, EpiStore, WSP(bf16, WS_X + X_MIX), DM, 0, 0, 256); PH_END
        GSYNC(); TS(l * 16 + 9); DBGCHK(7);
        PH_BEGIN rowop<true, true>(C, Mmix, HIN_L, HIN_C, C.out, HCB, WSP(bf16, WS_X + X_MIX), 2, C.P.in[7 + C.z] + l * DM, C.P.in[8 + C.z] + l * DM, 3, 4, MODL(l), MODL(l), ABUF); PH_END
        GSYNC(); TS(l * 16 + 10); DBGCHK(8);
        PH_BEGIN GEMM_STD(ABUF, WL(bf16, l, WL_UP), Mmix, 2 * DFF, DM, EpiUp, WSP(bf16, WS_X + X_HH), WSP(bf16, WS_X + X_HALO), C.P.in[31 + C.z] + (size_t)l * 3 * DFF, C.P.in[32 + C.z] + (size_t)l * DFF); PH_END
        GSYNC(); TS(l * 16 + 11);
        fixup_phase(CK, l, Mmix);
        GSYNC(); TS(l * 16 + 12); DBGCHK(9);
        PH_BEGIN GEMM_STD(WSP(bf16, WS_X + X_HH), WL(bf16, l, WL_DN), Mmix, DM, DFF, EpiStore, WSP(bf16, WS_X + X_FFO), DM, 0, 0, 256); PH_END
        GSYNC(); TS(l * 16 + 13); DBGCHK(10);
        if (l == 0) { PH_BEGIN rowop<true, true>(C, NT, C.out, HCB, C.out, HCB, WSP(bf16, WS_X + X_FFO), 5, C.P.in[9 + C.z] + l * DM, C.P.in[6 + C.z] + (l + 1) * DM, 0, 1, MODL(l), MODL(l + 1), ABUF); PH_END GSYNC(); TS(l * 16 + 14); }
        else { PH_BEGIN rowop<true, false>(C, NLAT, C.out, HCB, C.out, HCB, WSP(bf16, WS_X + X_FFO), 5, C.P.in[9 + C.z] + l * DM, nullptr, 0, 1, MODL(l), MODL(l), nullptr); PH_END }
    }
#ifdef DBG
    grid.sync(); dbg_report(CK);
#endif
#ifdef PROBE
    grid.sync(); TS(60);
    TS(61);
    grid.sync();
    if (blockIdx.x == 0) {
        volatile LAS unsigned long long* ts = (volatile LAS unsigned long long*)(CK.lds + 131072);
#ifdef PROBE_PRO
        unsigned long long d = (ts[60] - ts[40]) / 10ull;
#else
        unsigned long long d = 0; for (int ll = 0; ll < 2; ++ll) d += ts[ll * 16 + PROBE_B] - ts[ll * 16 + PROBE_A];
#endif
        const int n = (int)(d / 500ull);
        for (int i = tid_; i < n; i += NTHREADS) P.out[1000000 + i] += 0.15f;
    }
#endif
}


extern "C" void kernel_launch(void* const* d_in, const int* in_sizes, int n_in, void* d_out, int out_size, void* d_ws, size_t ws_size, hipStream_t stream) {
    static int grid = 0;
    if (grid == 0) {
        if (n_in != 34 || out_size != NLAT * DM || ws_size < WS_TOTAL) { fprintf(stderr, "kernel_launch: unexpected shapes (n_in %d out %d ws %zu, need %zu)\n", n_in, out_size, ws_size, (size_t)WS_TOTAL); grid = -1; return; }
        int dev = 0, cus = 0, per_cu = 0;
        hipGetDevice(&dev); hipDeviceGetAttribute(&cus, hipDeviceAttributeMultiprocessorCount, dev);
        if (hipFuncSetAttribute((const void*)fwd_kernel, hipFuncAttributeMaxDynamicSharedMemorySize, LDS_BYTES) != hipSuccess) { fprintf(stderr, "kernel_launch: hipFuncSetAttribute failed\n"); grid = -1; return; }
        hipOccupancyMaxActiveBlocksPerMultiprocessor(&per_cu, (const void*)fwd_kernel, NTHREADS, LDS_BYTES);
        (void)hipGetLastError();
        if (per_cu < 1 || cus < 256) { fprintf(stderr, "kernel_launch: occupancy %d, cus %d\n", per_cu, cus); grid = -1; return; }
        grid = 256;
    }
    if (grid < 0) return;
    (void)hipMemsetAsync((char*)d_ws + WS_CTL, 0, 65536, stream);
    Params p{};
    for (int i = 0; i < 34; ++i) p.in[i] = (const float*)d_in[i];
    p.out = (float*)d_out; p.ws = (unsigned char*)d_ws;
    void* args[] = {&p};
    hipError_t e = hipLaunchCooperativeKernel((const void*)fwd_kernel, dim3(grid), dim3(NTHREADS), args, LDS_BYTES, stream);
    if (e != hipSuccess) fprintf(stderr, "kernel_launch: cooperative launch failed: %s (grid %d)\n", hipGetErrorString(e), grid);
}
```

```cpp
#define PROBE_A 3
#define PROBE_B 4
#include <hip/hip_runtime.h>
#include <hip/hip_cooperative_groups.h>
#include <cstdio>
#include <cstdint>
namespace cg = cooperative_groups;
__device__ __forceinline__ int otid() { int t = threadIdx.x; asm volatile("" : "+v"(t)); return t; }
namespace pg8 {
#define PG8_LAS __attribute__((address_space(3)))
typedef unsigned short bf16_t;
typedef short bf16x8 __attribute__((ext_vector_type(8)));
typedef float f32x4 __attribute__((ext_vector_type(4)));
typedef unsigned u32x4 __attribute__((ext_vector_type(4)));
constexpr int BM = 256, BK = 64, HALF = 128, HTB = HALF * BK * 2  , STAGE_BYTES = 8 * HTB, NXCD = 8, WGM = 4;

__host__ __device__ __forceinline__ int lds_byte(int r, int c) { const int st = (r >> 4) * 2 + (c >> 5), rr = r & 15, cc = c & 31, ob = rr * 64 + cc * 2; return st * 1024 + (ob ^ (((ob >> 9) & 1) << 5)); }
__host__ __device__ __forceinline__ void stage_rc(int b, int& R, int& C) { const int st = b / 1024, sb = b % 1024, swz = sb ^ (((sb >> 9) & 1) << 5); R = (st >> 1) * 16 + swz / 64; C = (st & 1) * 32 + (swz % 64) / 2; }
__host__ __device__ __forceinline__ int perm32(int rho) { const int n = rho >> 4, i = rho & 15; return 8 * (i >> 2) + 4 * n + (i & 3); }

struct Unit { int pm, pn; };
struct Gemm { const bf16_t* A; const bf16_t* Bt; int M, N, K; };

struct StaticOrder {
    int nM, nN, nwg, G, c;
    __host__ __device__ void init(int M, int N, int G_, int c_) { nM = M / BM; nN = N / BM; nwg = nM * nN; G = G_; c = c_; }
    __host__ __device__ bool next(int i, Unit& u) const {
        const long L = (long)i * G + c; if (L >= nwg) return false;
        int wgid = (int)L; { const int q = nwg / NXCD, r = nwg % NXCD, xcd = wgid % NXCD, off = wgid / NXCD; wgid = (xcd < r ? xcd * (q + 1) : r * (q + 1) + (xcd - r) * q) + off; }
        const int nig = WGM * nN, gid = wgid / nig, fm = gid * WGM, gsz = (nM - fm) < WGM ? (nM - fm) : WGM;
        u.pm = fm + ((wgid % nig) % gsz); u.pn = (wgid % nig) / gsz; return true;
    }
    __device__ __forceinline__ void a_ready(const Unit&) const {}
    __device__ __forceinline__ void done(const Unit&) const {}
};

__device__ __forceinline__ unsigned cvt_pk_bf16(float lo, float hi) { unsigned r; asm volatile("v_cvt_pk_bf16_f32 %0, %1, %2" : "=v"(r) : "v"(lo), "v"(hi)); return r; }
typedef float f32x2 __attribute__((ext_vector_type(2)));
__device__ __forceinline__ f32x2 gelu_pk(f32x2 v) {
    const f32x2 av = __builtin_elementwise_abs(v), d = av * 0.2316418882f + 1.0f;
    f32x2 t; t.x = __builtin_amdgcn_rcpf(d.x); t.y = __builtin_amdgcn_rcpf(d.y);
    f32x2 q = t * 0.5307027145f + (-0.7265760135f); q = q * t + 0.7107068705f; q = q * t + (-0.142248368f); q = q * t + 0.127414796f; q = q * t;
    const f32x2 s = (v * v) * (-0.72134752044f);
    f32x2 e; e.x = __builtin_amdgcn_exp2f(s.x); e.y = __builtin_amdgcn_exp2f(s.y);
    const f32x2 m = v * (q * e), r = v - m;
    f32x2 o; o.x = v.x < 0.f ? m.x : r.x; o.y = v.y < 0.f ? m.y : r.y; return o;
}

template <class Epi, class Sched, bool ALIGN_EPI = false, bool SP2 = false>
__device__ __forceinline__ void gemm_phase(PG8_LAS unsigned char* lds, const Gemm g, const Sched& S, const Epi& E) {
    const int tid = otid(), wid = __builtin_amdgcn_readfirstlane(tid >> 6), lane = tid & 63, wr = wid >> 2, wc = wid & 3, fr = lane & 15, fq = lane >> 4;
    const int K = g.K, nt = K / BK;
    unsigned voffA[2], voffB[2];
#pragma unroll
    for (int i = 0; i < 2; ++i) { int R, C; stage_rc(tid * 16 + i * 8192, R, C); const int Rb = Epi::PERM ? ((R & ~31) + perm32(R & 31)) : R;
        const int Ra = Epi::PERMA ? ((R & 64) + 4 * (R & 15) + ((R >> 4) & 3)) : R;
        voffA[i] = (unsigned)(Ra * K + C) * 2u; voffB[i] = (unsigned)(Rb * K + C) * 2u; }
    const size_t kstep = (size_t)(BK * 2);
    const size_t hstep = (size_t)HALF * K * 2;
    const size_t tstep = 2 * hstep;
    const unsigned ldsw = (unsigned)wid * 1024u;
    const int aoff = lds_byte(wr * 64 + fr, fq * 8), boff = lds_byte(wc * 32 + fr, fq * 8);
#define PG8_SA(b, h) (((b) * 2 + (h)) * HTB)
#define PG8_SB(b, h) ((4 + (b) * 2 + (h)) * HTB)
#define PG8_STAGE(bufoff, gbase, voff) do { _Pragma("unroll") for (int _i = 0; _i < 2; ++_i) \
        __builtin_amdgcn_global_load_lds((const unsigned*)((const char*)(gbase) + (voff)[_i]), (PG8_LAS unsigned*)(lds + (bufoff) + ldsw + _i * 8192), 16, 0, 0); } while (0)
#define PG8_LDA(dst, b, h) do { _Pragma("unroll") for (int m = 0; m < 4; ++m) _Pragma("unroll") for (int k = 0; k < 2; ++k) dst[m][k] = *(const PG8_LAS bf16x8*)(lds + PG8_SA(b, h) + aoff + m * 2048 + k * 1024); } while (0)
#define PG8_LDB(dst, b, h) do { _Pragma("unroll") for (int n = 0; n < 2; ++n) _Pragma("unroll") for (int k = 0; k < 2; ++k) dst[n][k] = *(const PG8_LAS bf16x8*)(lds + PG8_SB(b, h) + boff + n * 2048 + k * 1024); } while (0)
#define PG8_MMA(ai, bj, At, Bt) do { __builtin_amdgcn_s_setprio(1); _Pragma("unroll") for (int m = 0; m < 4; ++m) _Pragma("unroll") for (int n = 0; n < 2; ++n) _Pragma("unroll") for (int k = 0; k < 2; ++k) \
        acc[ai][bj][m][n] = __builtin_amdgcn_mfma_f32_16x16x32_bf16(Bt[n][k], At[m][k], acc[ai][bj][m][n], 0, 0, 0); __builtin_amdgcn_s_setprio(0); } while (0)
#define PG8_WAIT_V(n) asm volatile("s_waitcnt vmcnt(" #n ")" ::: "memory")
#define PG8_WAIT_L(n) asm volatile("s_waitcnt lgkmcnt(" #n ")" ::: "memory")
#define PG8_BAR __builtin_amdgcn_s_barrier()
#define PG8_SCHED __builtin_amdgcn_sched_barrier(0)
    Unit cur, nxt; int ui = 0;
    if (!S.next(0, cur)) return;
    f32x4 acc[2][2][4][2];
#pragma unroll
    for (int a = 0; a < 2; ++a)
#pragma unroll
        for (int b = 0; b < 2; ++b)
#pragma unroll
            for (int m = 0; m < 4; ++m)
#pragma unroll
                for (int n = 0; n < 2; ++n) acc[a][b][m][n] = (f32x4){0.f, 0.f, 0.f, 0.f};
    bf16x8 At[4][2], B0[2][2], B1[2][2];
    const char* cA = (const char*)g.A + (size_t)cur.pm * tstep; const char* cB = (const char*)g.Bt + (size_t)cur.pn * tstep;
    S.a_ready(cur);
    if constexpr (SP2) {
        PG8_STAGE(PG8_SB(0, 0), cB, voffB); PG8_STAGE(PG8_SB(0, 1), cB + hstep, voffB); PG8_STAGE(PG8_SA(0, 0), cA, voffA); PG8_STAGE(PG8_SA(0, 1), cA + hstep, voffA);
        if (wr == 1) PG8_BAR;
        PG8_WAIT_V(2); PG8_BAR;
        PG8_STAGE(PG8_SB(1, 0), cB + kstep, voffB); PG8_STAGE(PG8_SA(1, 0), cA + kstep, voffA); PG8_STAGE(PG8_SB(1, 1), cB + hstep + kstep, voffB);
        PG8_WAIT_V(6); PG8_BAR;
    } else {
        PG8_STAGE(PG8_SB(0, 0), cB, voffB); PG8_STAGE(PG8_SA(0, 0), cA, voffA); PG8_STAGE(PG8_SB(0, 1), cB + hstep, voffB); PG8_STAGE(PG8_SA(0, 1), cA + hstep, voffA);
        if (wr == 1) PG8_BAR;
        PG8_WAIT_V(4); PG8_BAR;
        PG8_STAGE(PG8_SB(1, 0), cB + kstep, voffB); PG8_STAGE(PG8_SA(1, 0), cA + kstep, voffA); PG8_STAGE(PG8_SB(1, 1), cB + hstep + kstep, voffB);
        PG8_WAIT_V(6); PG8_BAR;
    }
    for (;;) {
        const bool has_next = S.next(ui + 1, nxt);
        const char* nA = has_next ? (const char*)g.A + (size_t)nxt.pm * tstep : cA; const char* nB = has_next ? (const char*)g.Bt + (size_t)nxt.pn * tstep : cB;
        for (int t = 0; t < nt; t += 2) {
            const bool last = (t == nt - 2);
            const char* a1 = cA + (size_t)(t + 1) * kstep;
            const char* a2 = last ? nA : cA + (size_t)(t + 2) * kstep; const char* b2 = last ? nB : cB + (size_t)(t + 2) * kstep;
            const char* a3 = a2 + kstep; const char* b3 = b2 + kstep;
            if (last && has_next) S.a_ready(nxt);
            if constexpr (SP2) {
            PG8_LDB(B0, 0, 0); PG8_LDB(B1, 0, 1); PG8_SCHED; PG8_LDA(At, 0, 0); PG8_STAGE(PG8_SA(1, 1), a1 + hstep, voffA);
            PG8_WAIT_V(8); PG8_WAIT_L(0); PG8_BAR; PG8_MMA(0, 0, At, B0); PG8_MMA(0, 1, At, B1); PG8_BAR; PG8_SCHED;
            PG8_LDA(At, 0, 1); PG8_STAGE(PG8_SB(0, 0), b2, voffB); PG8_STAGE(PG8_SB(0, 1), b2 + hstep, voffB); PG8_STAGE(PG8_SA(0, 0), a2, voffA);
            PG8_WAIT_V(8); PG8_WAIT_L(0); PG8_BAR; PG8_MMA(1, 0, At, B0); PG8_MMA(1, 1, At, B1); PG8_BAR; PG8_SCHED;
            PG8_LDB(B0, 1, 0); PG8_LDB(B1, 1, 1); PG8_SCHED; PG8_LDA(At, 1, 0); PG8_STAGE(PG8_SA(0, 1), a2 + hstep, voffA);
            PG8_WAIT_V(8); PG8_WAIT_L(0); PG8_BAR; PG8_MMA(0, 0, At, B0); PG8_MMA(0, 1, At, B1); PG8_BAR; PG8_SCHED;
            PG8_LDA(At, 1, 1); PG8_STAGE(PG8_SB(1, 0), b3, voffB); PG8_STAGE(PG8_SB(1, 1), b3 + hstep, voffB); PG8_STAGE(PG8_SA(1, 0), a3, voffA);
            PG8_WAIT_V(8); PG8_WAIT_L(0); PG8_BAR; PG8_MMA(1, 0, At, B0); PG8_MMA(1, 1, At, B1); PG8_BAR; PG8_SCHED;
            } else {
            PG8_LDB(B0, 0, 0); PG8_SCHED; PG8_LDA(At, 0, 0); PG8_STAGE(PG8_SA(1, 1), a1 + hstep, voffA);
            PG8_WAIT_L(8); PG8_BAR; PG8_WAIT_L(0); PG8_MMA(0, 0, At, B0); PG8_BAR; PG8_SCHED;
            PG8_LDB(B1, 0, 1); PG8_STAGE(PG8_SB(0, 0), b2, voffB);
            PG8_BAR; PG8_WAIT_L(0); PG8_MMA(0, 1, At, B1); PG8_BAR;
            PG8_LDA(At, 0, 1); PG8_STAGE(PG8_SA(0, 0), a2, voffA);
            PG8_BAR; PG8_WAIT_L(0); PG8_MMA(1, 0, At, B0); PG8_BAR; PG8_SCHED;
            PG8_STAGE(PG8_SB(0, 1), b2 + hstep, voffB);
            PG8_WAIT_V(6); PG8_BAR; PG8_MMA(1, 1, At, B1); PG8_BAR;
            PG8_LDB(B0, 1, 0); PG8_SCHED; PG8_LDA(At, 1, 0); PG8_STAGE(PG8_SA(0, 1), a2 + hstep, voffA);
            PG8_WAIT_L(8); PG8_BAR; PG8_WAIT_L(0); PG8_MMA(0, 0, At, B0); PG8_BAR; PG8_SCHED;
            PG8_LDB(B1, 1, 1); PG8_STAGE(PG8_SB(1, 0), b3, voffB);
            PG8_BAR; PG8_WAIT_L(0); PG8_MMA(0, 1, At, B1); PG8_BAR;
            PG8_LDA(At, 1, 1); PG8_STAGE(PG8_SA(1, 0), a3, voffA);
            PG8_BAR; PG8_WAIT_L(0); PG8_MMA(1, 0, At, B0); PG8_BAR; PG8_SCHED;
            PG8_STAGE(PG8_SB(1, 1), b3 + hstep, voffB);
            PG8_WAIT_V(6); PG8_BAR; PG8_MMA(1, 1, At, B1); PG8_BAR;
            }
        }
        if constexpr (ALIGN_EPI) { if (wr == 0) PG8_BAR; }
        if constexpr (!Epi::AFTER_DRAIN) { E(acc, cur, wr, wc, fr, fq); S.done(cur); }
        if (!has_next) break;
#pragma unroll
        for (int a = 0; a < 2; ++a)
#pragma unroll
            for (int b = 0; b < 2; ++b)
#pragma unroll
                for (int m = 0; m < 4; ++m)
#pragma unroll
                    for (int n = 0; n < 2; ++n) acc[a][b][m][n] = (f32x4){0.f, 0.f, 0.f, 0.f};
        cur = nxt; cA = nA; cB = nB; ++ui;
        if constexpr (ALIGN_EPI) { if (wr == 1) PG8_BAR; }
    }
    PG8_WAIT_V(0);
    if constexpr (!ALIGN_EPI) { if (wr == 0) PG8_BAR; }
    PG8_BAR;
    if constexpr (Epi::AFTER_DRAIN) { E.fused(acc, cur, wr, wc, fr, fq, lds, wid, lane); S.done(cur); }
#undef PG8_SA
#undef PG8_SB
#undef PG8_STAGE
#undef PG8_LDA
#undef PG8_LDB
#undef PG8_MMA
#undef PG8_WAIT_V
#undef PG8_WAIT_L
#undef PG8_BAR
#undef PG8_SCHED
}
}

#define DI __device__ __forceinline__
#define LAS __attribute__((address_space(3)))
typedef unsigned short bf16;
typedef float f32x4 __attribute__((ext_vector_type(4)));
typedef float f32x2 __attribute__((ext_vector_type(2)));
typedef float f32x16 __attribute__((ext_vector_type(16)));
typedef short bf16x8 __attribute__((ext_vector_type(8)));
typedef short s16x4 __attribute__((ext_vector_type(4)));
typedef unsigned u32x4 __attribute__((ext_vector_type(4)));
typedef unsigned u32x2 __attribute__((ext_vector_type(2)));
typedef __bf16 bf16x2_t __attribute__((ext_vector_type(2)));

constexpr int DM = 1024, NB = 32, TL = 2048, TC = 256, NLAT = NB * TL, NCTX = NB * TC, NT = NLAT + NCTX, CTXB = NLAT;
constexpr int DFF = 2816, RW = 1152, NIN = 2560, NGATE = 3072;
constexpr int IN_COLS = 5248;
constexpr float LOG2E = 1.4426950408889634f;
constexpr int NTHREADS = 512, NWAVES = 8;
constexpr int LDS_BYTES = 147456;

constexpr size_t MiB = 1u << 20;
constexpr size_t WS_CTL = 0;
constexpr size_t WS_MOD = 1 * MiB;
constexpr size_t WS_SMALL = 3 * MiB;
constexpr size_t WS_BON = 4 * MiB;
constexpr size_t WS_W = 6 * MiB;
constexpr size_t WL_IN = 0, WL_G = 5 * MiB, WL_BR = 11 * MiB, WL_BA = 11 * MiB + 512 * 1024, WL_BF = 12 * MiB + 512 * 1024, WL_O = 13 * MiB, WL_UP = 15 * MiB, WL_DN = 26 * MiB, WL_SIZE = 32 * MiB;
constexpr size_t WS_DFT = WS_W + 2 * WL_SIZE;
constexpr size_t WS_DFTC = WS_DFT + 16 * MiB;
constexpr size_t WS_HC = WS_DFTC + 1 * MiB;
constexpr size_t WS_A = WS_HC + 32 * MiB;
constexpr size_t WS_VF = WS_A + 144 * MiB;
constexpr size_t WS_X = WS_VF + 36 * MiB;
constexpr size_t X_F = 0;
constexpr size_t X_QKV = 288 * MiB;
constexpr size_t X_ZT = 396 * MiB;
constexpr size_t X_ZTC = 460 * MiB;
constexpr size_t X_UR = 504 * MiB;
constexpr size_t X_G = 468 * MiB;
constexpr size_t X_LO = 504 * MiB;
constexpr size_t X_END = 720 * MiB;
constexpr size_t WS_WLORA = WS_X + X_END;
constexpr int KLO = 640, NLO = 1536;
constexpr size_t X_PP = 0;
constexpr size_t X_MIX = 0;
constexpr size_t X_HH = 0;
constexpr size_t X_HALO = 396 * MiB;
constexpr size_t X_FFO = 436 * MiB;
constexpr size_t WS_TOTAL = WS_WLORA + 4 * MiB;
constexpr size_t FSZ = (size_t)NT * 256;

struct Params { const float* in[34]; float* out; unsigned char* ws; };

DI float bf2f(bf16 v) { return __builtin_bit_cast(float, (unsigned)v << 16); }
DI float lo2f(unsigned u) { return __builtin_bit_cast(float, u << 16); }
DI float hi2f(unsigned u) { return __builtin_bit_cast(float, u & 0xffff0000u); }
DI unsigned pk(float lo, float hi) { f32x2 v = {lo, hi}; bf16x2_t b = __builtin_convertvector(v, bf16x2_t); return __builtin_bit_cast(unsigned, b); }
DI bf16 f2bf(float x) { return (bf16)(pk(x, 0.f) & 0xffffu); }
DI float fexp2(float x) { return __builtin_amdgcn_exp2f(x); }
DI float frcp(float x) { return __builtin_amdgcn_rcpf(x); }
DI float sigm(float x) { return frcp(1.f + fexp2(-x * LOG2E)); }
DI f32x2 sigm2(f32x2 x) { const f32x2 t = x * (-LOG2E); f32x2 e; e.x = fexp2(t.x); e.y = fexp2(t.y); const f32x2 d = e + 1.f; f32x2 r; r.x = frcp(d.x); r.y = frcp(d.y); return r; }
DI float tanh_(float x) { return 2.f * sigm(2.f * x) - 1.f; }
DI float gelu_tanh(float z) { const float u = 1.5957691216057308f * (z + 0.044715f * z * z * z); return z * sigm(u); }
DI float wave_sum(float v) {
#pragma unroll
    for (int o = 1; o < 64; o <<= 1) v += __shfl_xor(v, o);
    return v;
}
template <int CTRL, bool BC> DI float dppf(float old, float src) {
    return __builtin_bit_cast(float, __builtin_amdgcn_update_dpp(__builtin_bit_cast(int, old), __builtin_bit_cast(int, src), CTRL, 0xf, 0xf, BC));
}
DI float row16_sum(float x) { x += dppf<0x128, true>(0.f, x); x += dppf<0x124, true>(0.f, x); x += dppf<0x122, true>(0.f, x); x += dppf<0x121, true>(0.f, x); return x; }
DI f32x4 bf4(u32x2 u) { return (f32x4){lo2f(u.x), hi2f(u.x), lo2f(u.y), hi2f(u.y)}; }
DI u32x2 pk4(f32x4 v) { u32x2 o; o.x = pk(v[0], v[1]); o.y = pk(v[2], v[3]); return o; }
DI float allred4(float x) {
    unsigned u = __builtin_bit_cast(unsigned, x);
    auto r = __builtin_amdgcn_permlane16_swap(u, u, false, false);
    float y = __builtin_bit_cast(float, (unsigned)r[0]) + __builtin_bit_cast(float, (unsigned)r[1]);
    unsigned v = __builtin_bit_cast(unsigned, y);
    auto s = __builtin_amdgcn_permlane32_swap(v, v, false, false);
    return __builtin_bit_cast(float, (unsigned)s[0]) + __builtin_bit_cast(float, (unsigned)s[1]);
}

DI u32x4 pack8(const f32x4& a, const f32x4& b) { u32x4 w; w.x = pk(a[0], a[1]); w.y = pk(a[2], a[3]); w.z = pk(b[0], b[1]); w.w = pk(b[2], b[3]); return w; }

struct EpiStore {
    static constexpr bool PERM = true, AFTER_DRAIN = false, PERMA = false;
    bf16* O; int ld; int row_base, row_pn, col_pn;
    DI void operator()(const f32x4 (&acc)[2][2][4][2], const pg8::Unit& u, int wr, int wc, int fr, int fq) const {
        const int row0 = row_base + u.pn * row_pn + u.pm * 256 + wr * 64 + fr, col0 = u.pn * col_pn + wc * 32 + 8 * fq;
#pragma unroll
        for (int ai = 0; ai < 2; ++ai)
#pragma unroll
            for (int m = 0; m < 4; ++m) { bf16* rowp = O + (size_t)(row0 + ai * 128 + m * 16) * ld + col0;
#pragma unroll
                for (int bj = 0; bj < 2; ++bj) *(u32x4*)(rowp + bj * 128) = pack8(acc[ai][bj][m][0], acc[ai][bj][m][1]); }
    }
};

struct EpiIn {
    static constexpr bool PERM = true, AFTER_DRAIN = false, PERMA = false;
    bf16 *QKV, *ZT, *ZTC, *UR;
    DI void operator()(const f32x4 (&acc)[2][2][4][2], const pg8::Unit& u, int wr, int wc, int fr, int fq) const {
        const int pn = u.pn, rl0 = wr * 64 + fr, cl = wc * 32 + 8 * fq;
        if (pn < 3) {
#pragma unroll
            for (int ai = 0; ai < 2; ++ai)
#pragma unroll
                for (int m = 0; m < 4; ++m) { bf16* rowp = QKV + (size_t)(u.pm * 256 + rl0 + ai * 128 + m * 16) * 768 + pn * 256 + cl;
#pragma unroll
                    for (int bj = 0; bj < 2; ++bj) *(u32x4*)(rowp + bj * 128) = pack8(acc[ai][bj][m][0], acc[ai][bj][m][1]); }
        } else if (pn < 5) {
            bf16* base; int stride;
            if (u.pm < 256) { const int b = u.pm >> 3, t0 = (u.pm & 7) * 256; base = ZT + (size_t)b * 256 * 4096 + (pn - 3) * 2048 + t0; stride = 4096; }
            else { const int b = u.pm - 256; base = ZTC + (size_t)b * 256 * 512 + (pn - 3) * 256; stride = 512; }
#pragma unroll
            for (int ai = 0; ai < 2; ++ai)
#pragma unroll
                for (int m = 0; m < 4; ++m) { const int rl = rl0 + ai * 128 + m * 16;
#pragma unroll
                    for (int bj = 0; bj < 2; ++bj)
#pragma unroll
                        for (int n = 0; n < 2; ++n)
#pragma unroll
                            for (int e = 0; e < 4; ++e) base[(size_t)(bj * 128 + cl + 4 * n + e) * stride + rl] = f2bf(acc[ai][bj][m][n][e]); }
        } else {
#pragma unroll
            for (int ai = 0; ai < 2; ++ai)
#pragma unroll
                for (int m = 0; m < 4; ++m) { bf16* rowp = UR + (size_t)(u.pm * 256 + rl0 + ai * 128 + m * 16) * RW + (pn - 5) * 256 + cl;
#pragma unroll
                    for (int bj = 0; bj < 2; ++bj) if ((pn - 5) * 256 + bj * 128 < RW) *(u32x4*)(rowp + bj * 128) = pack8(acc[ai][bj][m][0], acc[ai][bj][m][1]); }
        }
    }
};

struct EpiGate {
    static constexpr bool PERM = true, AFTER_DRAIN = false, PERMA = false;
    const bf16* PP; bf16* MG;
    DI void operator()(const f32x4 (&acc)[2][2][4][2], const pg8::Unit& u, int wr, int wc, int fr, int fq) const {
        const int br = u.pn >> 2, cn = u.pn & 3, row0 = u.pm * 256 + wr * 64 + fr, col0 = cn * 256 + wc * 32 + 8 * fq;
#pragma unroll
        for (int ai = 0; ai < 2; ++ai)
#pragma unroll
            for (int m = 0; m < 4; ++m) { const size_t row = (size_t)(row0 + ai * 128 + m * 16);
#pragma unroll
                for (int bj = 0; bj < 2; ++bj) {
                    const u32x4 pp = *(const u32x4*)(PP + row * NGATE + br * 1024 + col0 + bj * 128);
                    bf16* mp = MG + row * 1024 + col0 + bj * 128;
                    f32x4 a = acc[ai][bj][m][0], b = acc[ai][bj][m][1];
                    { const f32x2 s0 = sigm2((f32x2){a[0], a[1]}) * (f32x2){lo2f(pp.x), hi2f(pp.x)}, s1 = sigm2((f32x2){a[2], a[3]}) * (f32x2){lo2f(pp.y), hi2f(pp.y)}, s2 = sigm2((f32x2){b[0], b[1]}) * (f32x2){lo2f(pp.z), hi2f(pp.z)}, s3 = sigm2((f32x2){b[2], b[3]}) * (f32x2){lo2f(pp.w), hi2f(pp.w)};
                      a = (f32x4){s0.x, s0.y, s1.x, s1.y}; b = (f32x4){s2.x, s2.y, s3.x, s3.y}; }
                    if (br) { const u32x4 o = *(const u32x4*)mp;
                        a[0] += lo2f(o.x); a[1] += hi2f(o.x); a[2] += lo2f(o.y); a[3] += hi2f(o.y); b[0] += lo2f(o.z); b[1] += hi2f(o.z); b[2] += lo2f(o.w); b[3] += hi2f(o.w); }
                    *(u32x4*)mp = pack8(a, b); } }
    }
};

DI f32x2 gelu2(f32x2 z) {
    const f32x2 u = z * (z * z * 0.044715f + 1.f), t = u * (-1.5957691216057308f * LOG2E);
    f32x2 e; e.x = fexp2(t.x); e.y = fexp2(t.y);
    const f32x2 d = e + 1.f; f32x2 r; r.x = frcp(d.x); r.y = frcp(d.y);
    return z * r;
}
struct EpiUp {
    static constexpr bool PERM = true, AFTER_DRAIN = false, PERMA = true;
    bf16* HH; bf16* HALO; const float* cw; const float* cb;
    DI void operator()(const f32x4 (&acc)[2][2][4][2], const pg8::Unit& u, int wr, int wc, int fr, int fq) const {
        const int j0 = 128 * u.pn + 32 * wc + 8 * fq;
        f32x4 w0[2], w1[2], w2[2], bb[2];
#pragma unroll
        for (int n = 0; n < 2; ++n) { w0[n] = *(const f32x4*)(cw + j0 + 4 * n); w1[n] = *(const f32x4*)(cw + DFF + j0 + 4 * n); w2[n] = *(const f32x4*)(cw + 2 * DFF + j0 + 4 * n); bb[n] = *(const f32x4*)(cb + j0 + 4 * n); }
#pragma unroll
        for (int ai = 0; ai < 2; ++ai) {
            const int grp = u.pm * 4 + ai * 2 + wr;
            bf16* hb = HALO + (size_t)grp * 6 * DFF + j0;
            if (fr == 0) { *(u32x4*)(hb) = pack8(acc[ai][0][0][0], acc[ai][0][0][1]); *(u32x4*)(hb + DFF) = pack8(acc[ai][0][1][0], acc[ai][0][1][1]); *(u32x4*)(hb + 4 * DFF) = pack8(acc[ai][1][0][0], acc[ai][1][0][1]); }
            if (fr == 15) { *(u32x4*)(hb + 2 * DFF) = pack8(acc[ai][0][2][0], acc[ai][0][2][1]); *(u32x4*)(hb + 3 * DFF) = pack8(acc[ai][0][3][0], acc[ai][0][3][1]); *(u32x4*)(hb + 5 * DFF) = pack8(acc[ai][1][3][0], acc[ai][1][3][1]); }
            f32x4 o[4][2];
#pragma unroll
            for (int n = 0; n < 2; ++n)
#pragma unroll
                for (int ep = 0; ep < 2; ++ep) {
                    f32x2 x[4];
#pragma unroll
                    for (int m = 0; m < 4; ++m) x[m] = (f32x2){acc[ai][0][m][n][2 * ep], acc[ai][0][m][n][2 * ep + 1]};
                    f32x2 pv, nx;
                    pv.x = dppf<0x111, true>(0.f, x[3].x); pv.y = dppf<0x111, true>(0.f, x[3].y);
                    nx.x = dppf<0x101, true>(0.f, x[0].x); nx.y = dppf<0x101, true>(0.f, x[0].y);
                    const f32x2 c0 = {w0[n][2 * ep], w0[n][2 * ep + 1]}, c1 = {w1[n][2 * ep], w1[n][2 * ep + 1]}, c2 = {w2[n][2 * ep], w2[n][2 * ep + 1]}, cb2 = {bb[n][2 * ep], bb[n][2 * ep + 1]};
#pragma unroll
                    for (int m = 0; m < 4; ++m) {
                        const f32x2 prev = m ? x[m ? m - 1 : 0] : pv, next = (m < 3) ? x[m < 3 ? m + 1 : 3] : nx;
                        const f32x2 z = c0 * prev + c1 * x[m] + c2 * next + cb2;
                        const f32x2 zv = {acc[ai][1][m][n][2 * ep], acc[ai][1][m][n][2 * ep + 1]};
                        const f32x2 g = gelu2(z) * zv;
                        o[m][n][2 * ep] = g.x; o[m][n][2 * ep + 1] = g.y;
                    }
                }
#pragma unroll
            for (int m = 0; m < 4; ++m) {
                const bool edge = (m == 0 && fr == 0) || (m == 3 && fr == 15);
                if (!edge) __builtin_nontemporal_store(pack8(o[m][0], o[m][1]), (u32x4*)(HH + (size_t)(u.pm * 256 + ai * 128 + wr * 64 + 4 * fr + m) * DFF + j0));
            }
        }
    }
};

struct GateOrder {
    int nU, G, c;
    DI bool next(int i, pg8::Unit& u) const { const int j = i / 3, br = i - 3 * j; const long L = (long)j * G + c; if (L >= nU) return false; u.pm = (int)(L >> 2); u.pn = br * 4 + (int)(L & 3); return true; }
    DI void a_ready(const pg8::Unit&) const {}
    DI void done(const pg8::Unit&) const {}
};

struct Ctx {
    LAS unsigned char* lds; unsigned char* ws; const Params& P; float* out;
    int tid, lane, wave, G, bid, z;
};
DI Ctx rectx(const Ctx& C0) { const int t = otid(); int z = 0; asm volatile("" : "+s"(z)); return Ctx{C0.lds, C0.P.ws + z, C0.P, C0.P.out + z, t, t & 63, __builtin_amdgcn_readfirstlane(t >> 6), C0.G, C0.bid, z}; }
#define WSP(T, off) ((T*)(C.ws + (off)))
#define WL(T, l, off) ((T*)(C.ws + WS_W + (size_t)(l) * WL_SIZE + (off)))

DI void tr_item(const float* src, int ldw, int k0, int n0, bf16* dst, int ldd, int drow0, LAS float* scr, int lane) {
#pragma unroll 8
    for (int i = 0; i < 32; ++i) { const int kk = 2 * i + (lane >> 5); scr[kk * 33 + (lane & 31)] = src[(size_t)(k0 + kk) * ldw + n0 + (lane & 31)]; }
    asm volatile("s_waitcnt lgkmcnt(0)" ::: "memory");
    const int c = lane & 7;
#pragma unroll
    for (int j = 0; j < 4; ++j) { const int n = (lane >> 3) + 8 * j; const LAS float* s = scr + (8 * c) * 33 + n;
        u32x4 o; o.x = pk(s[0 * 33], s[1 * 33]); o.y = pk(s[2 * 33], s[3 * 33]); o.z = pk(s[4 * 33], s[5 * 33]); o.w = pk(s[6 * 33], s[7 * 33]);
        *(u32x4*)(dst + (size_t)(drow0 + n) * ldd + k0 + 8 * c) = o; }
    asm volatile("s_waitcnt lgkmcnt(0)" ::: "memory");
}
DI void tr_matrix(const Ctx& C, int gw, int NGW, const float* src, int ldw, int K, int n_src0, int ncols, bf16* dst, int drow0, LAS float* scr) {
    const int nb = ncols / 32, nit = (K / 64) * nb;
    for (int it = gw; it < nit; it += NGW) { const int kb = it / nb, b = it % nb; tr_item(src, ldw, kb * 64, n_src0 + b * 32, dst, K, drow0 + b * 32, scr, C.lane); }
}

DI void weights_tr(const Ctx& C, int l, int gw, int NGW, LAS float* scr) {
    const float* win = C.P.in[10 + C.z] + (size_t)l * 1024 * IN_COLS;
    bf16* wi = WL(bf16, l, WL_IN);
    tr_matrix(C, gw, NGW, win, IN_COLS, 1024, 1152, 512, wi, 0, scr);
    tr_matrix(C, gw, NGW, win, IN_COLS, 1024, 1664, 128, wi, 512, scr);
    tr_matrix(C, gw, NGW, win, IN_COLS, 1024, 1792, 128, wi, 640, scr);
    tr_matrix(C, gw, NGW, win, IN_COLS, 1024, 0, 1152, wi, 1280, scr);
    tr_matrix(C, gw, NGW, win, IN_COLS, 1024, 2176, 3072, WL(bf16, l, WL_G), 0, scr);
    tr_matrix(C, gw, NGW, C.P.in[26 + C.z] + (size_t)l * 256 * 1024, 1024, 256, 0, 1024, WL(bf16, l, WL_BR), 0, scr);
    tr_matrix(C, gw, NGW, C.P.in[27 + C.z] + (size_t)l * 512 * 1024, 1024, 512, 0, 1024, WL(bf16, l, WL_BA), 0, scr);
    tr_matrix(C, gw, NGW, C.P.in[28 + C.z] + (size_t)l * 256 * 1024, 1024, 256, 0, 1024, WL(bf16, l, WL_BF), 0, scr);
    tr_matrix(C, gw, NGW, C.P.in[29 + C.z] + (size_t)l * 1024 * 1024, 1024, 1024, 0, 1024, WL(bf16, l, WL_O), 0, scr);
    {
        const float* up = C.P.in[30 + C.z] + (size_t)l * 1024 * 2 * DFF; bf16* wu = WL(bf16, l, WL_UP);
        for (int it = gw; it < 16 * 44 * 4; it += NGW) { const int kb = it / 176, r = it % 176, seg = r >> 2, b = r & 3, pn = seg >> 1, bj = seg & 1;
            tr_item(up, 2 * DFF, kb * 64, bj * DFF + pn * 128 + b * 32, wu, 1024, pn * 256 + bj * 128 + b * 32, scr, C.lane); }
    }
    tr_matrix(C, gw, NGW, C.P.in[33 + C.z] + (size_t)l * DFF * 1024, 1024, DFF, 0, 1024, WL(bf16, l, WL_DN), 0, scr);
}
DI void prologue(const Ctx& C0) {
    const Ctx C = rectx(C0);
    LAS float* scr = (LAS float*)(C.lds + 49152 + C.wave * 8704);
    const int gth = C.bid * NTHREADS + C.tid, NGT = C.G * NTHREADS;
    for (int tsk = C.bid; tsk < 72; tsk += C.G) {
        const int l = tsk / 36, rem = tsk % 36, cb = rem / 3, rg = rem % 3;
        LAS float* s = (LAS float*)C.lds;
        for (int i = C.tid; i < 11 * 1024; i += NTHREADS) { const int r = rg * 11 + i / 1024, k = i % 1024; const float cv = (r < 32) ? C.P.in[1 + C.z][r * 1024 + k] : C.P.in[3 + C.z][k]; s[i] = cv * sigm(cv); }
        __syncthreads();
        const int j = cb * 512 + C.tid;
        float acc[11];
        const float bj = C.P.in[5 + C.z][l * 6144 + j];
#pragma unroll
        for (int i = 0; i < 11; ++i) acc[i] = bj;
        const float* wp = C.P.in[4 + C.z] + (size_t)l * 1024 * 6144 + j;
        for (int k = 0; k < 1024; k += 4) {
            const float w0 = wp[(size_t)k * 6144], w1 = wp[(size_t)(k + 1) * 6144], w2 = wp[(size_t)(k + 2) * 6144], w3 = wp[(size_t)(k + 3) * 6144];
#pragma unroll
            for (int i = 0; i < 11; ++i) { const f32x4 x = *(const LAS f32x4*)(s + i * 1024 + k); acc[i] += x[0] * w0 + x[1] * w1 + x[2] * w2 + x[3] * w3; }
        }
#pragma unroll
        for (int i = 0; i < 11; ++i) WSP(float, WS_MOD)[(size_t)(l * 33 + rg * 11 + i) * 6144 + j] = acc[i];
        __syncthreads();
    }
    if (C.bid == C.G - 1) for (int i = C.tid; i < 1024; i += NTHREADS) { const int p = i >> 4, f = i & 15; const float inv = powf(10000.f, -(float)f / 16.f), ang = (float)p * inv; WSP(float, WS_SMALL)[2 * i] = cosf(ang); WSP(float, WS_SMALL)[2 * i + 1] = sinf(ang); }
    for (int i = gth; i < 2048 * 4096 / 2; i += NGT) {
        const int tp = i / 2048, kk = (i % 2048) * 2; float v[2];
#pragma unroll
        for (int e = 0; e < 2; ++e) { const int k = kk + e, t = k & 2047; const int ph = (tp * t) & 2047; const float x = (float)ph * (1.f / 1024.f); v[e] = ((k < 2048) ? cospif(x) : -sinpif(x)) * 0.0027621358640099513f; }
        WSP(unsigned, WS_DFT)[i] = pk(v[0], v[1]);
    }
    for (int i = gth; i < 256 * 512 / 2; i += NGT) {
        const int tp = i / 256, kk = (i % 256) * 2; float v[2];
#pragma unroll
        for (int e = 0; e < 2; ++e) { const int k = kk + e, t = k & 255; const int ph = (tp * t) & 255; const float x = (float)ph * (1.f / 128.f); v[e] = ((k < 256) ? cospif(x) : -sinpif(x)) * 0.0078125f; }
        WSP(unsigned, WS_DFTC)[i] = pk(v[0], v[1]);
    }
    weights_tr(C, 0, C.bid * NWAVES + C.wave, C.G * NWAVES, scr);
    for (int l = 0; l < 2; ++l) {
        const float* win = C.P.in[10 + C.z] + (size_t)l * 1024 * IN_COLS;
        bf16* wi = WL(bf16, l, WL_IN);
        for (int i = gth; i < 128 * 1024 / 2; i += NGT) ((unsigned*)(wi + (size_t)2432 * 1024))[i] = 0u;
        {
            LAS float* tab = (LAS float*)(C.lds + 120 * 1024);
            __syncthreads();
            if (C.tid < 64) { const float x = (float)C.tid * (1.f / 32.f); tab[C.tid] = cospif(x); tab[64 + C.tid] = sinpif(x); }
            __syncthreads();
            for (int i = gth; i < 512 * 1024; i += NGT) {
                const int k = i & 1023, np = i >> 10, sn = np >> 8, g = (np >> 6) & 3, cp = np & 63;
                const float* wr_ = win + (size_t)k * IN_COLS + 1920 + g * 64; const LAS float* tb = tab + sn * 64; float a = 0.f;
#pragma unroll 8
                for (int c = 0; c < 64; ++c) a += wr_[c] * tb[(c * cp) & 63];
                wi[(size_t)(768 + np) * 1024 + k] = f2bf(a);
            }
        }
        {
            bf16* wl = WSP(bf16, WS_WLORA + (size_t)l * 2 * MiB);
            const float* w2 = C.P.in[13 + C.z] + (size_t)l * 2 * 64 * 256; const float* a2 = C.P.in[15 + C.z] + (size_t)l * 2 * 64 * 256; const float* g2 = C.P.in[16 + C.z] + (size_t)l * 128 * 256;
            const int kl = (l == 0) ? 384 : KLO;
            for (int i = gth; i < NLO * kl; i += NGT) {
                const int c = i & 255, nb = (i >> 8) % 6, k = i / (256 * 6); float v = 0.f;
                if (nb == 0) { if (k < 64) v = w2[k * 256 + c]; }
                else if (nb == 1) { if (k >= 64 && k < 128) v = w2[(64 + k - 64) * 256 + c]; }
                else if (nb == 2) { if (k >= 128 && k < 192) v = a2[(k - 128) * 256 + c]; }
                else if (nb == 3) { if (k >= 192 && k < 256) v = a2[(64 + k - 192) * 256 + c]; }
                else if (nb == 4) { if (k >= 256 && k < 384) v = g2[(k - 256) * 256 + c]; }
                else if (l == 1 && k >= 384) { const float* v1 = C.P.in[23 + C.z] + (k - 384) * 32; const float* v2 = C.P.in[24 + C.z] + c; for (int j = 0; j < 32; ++j) v += v1[j] * v2[j * 256]; }
                wl[(size_t)(nb * 256 + c) * kl + k] = f2bf(v);
            }
        }
    }
}

template <bool HAS_ADD, bool HAS_OUT>
DI void rowop(const Ctx& C0, int nrows, const float* hin_l, const float* hin_c, float* hout_l, float* hout_c, const bf16* add, int ga, const float* g_add, const float* g_out, int sh, int sc, const float* modl, const float* modo, bf16* Aout) {
    const Ctx C = rectx(C0);
    const int rpw = (nrows + C.G * NWAVES - 1) / (C.G * NWAVES), r0 = (C.bid * NWAVES + C.wave) * rpw, r1 = (r0 + rpw < nrows) ? r0 + rpw : nrows;
    if (r0 >= r1) return;
    const int c0 = 4 * C.lane;
    f32x4 gA[4], gO[4], mG[4], mS[4], mB[4];
#pragma unroll
    for (int j = 0; j < 4; ++j) { if (HAS_ADD) gA[j] = *(const f32x4*)(g_add + c0 + 256 * j); if (HAS_OUT) gO[j] = *(const f32x4*)(g_out + c0 + 256 * j); }
    int bcur = -1;
    f32x4 hn[4]; u32x2 an[4];
#define ROW_HP(t) (((t) < NLAT) ? hin_l + (size_t)(t) * DM : hin_c + (size_t)((t) - NLAT) * DM)
    { const float* hp = ROW_HP(r0);
#pragma unroll
      for (int j = 0; j < 4; ++j) { hn[j] = __builtin_nontemporal_load((const f32x4*)(hp + c0 + 256 * j)); if (HAS_ADD) an[j] = __builtin_nontemporal_load((const u32x2*)(add + (size_t)r0 * DM + c0 + 256 * j)); } }
    for (int tok = r0; tok < r1; ++tok) {
        f32x4 h[4]; u32x2 ar[4];
#pragma unroll
        for (int j = 0; j < 4; ++j) { h[j] = hn[j]; if (HAS_ADD) ar[j] = an[j]; }
        if (tok + 1 < r1) { const float* hp = ROW_HP(tok + 1);
#pragma unroll
            for (int j = 0; j < 4; ++j) { hn[j] = __builtin_nontemporal_load((const f32x4*)(hp + c0 + 256 * j)); if (HAS_ADD) an[j] = __builtin_nontemporal_load((const u32x2*)(add + (size_t)(tok + 1) * DM + c0 + 256 * j)); } }
        const bool lat = tok < NLAT; const int b = lat ? tok / TL : 32;
        if (b != bcur) { bcur = b; const float* mp = modl + (size_t)b * 6144; const float* mq = modo + (size_t)b * 6144;
#pragma unroll
            for (int j = 0; j < 4; ++j) { if (HAS_ADD) mG[j] = *(const f32x4*)(mp + ga * 1024 + c0 + 256 * j); if (HAS_OUT) { mS[j] = *(const f32x4*)(mq + sc * 1024 + c0 + 256 * j) + 1.f; mB[j] = *(const f32x4*)(mq + sh * 1024 + c0 + 256 * j); } } }
        if (HAS_ADD) {
            f32x4 a[4]; float ss = 0.f;
#pragma unroll
            for (int j = 0; j < 4; ++j) { a[j] = (f32x4){lo2f(ar[j].x), hi2f(ar[j].x), lo2f(ar[j].y), hi2f(ar[j].y)}; ss += a[j][0] * a[j][0] + a[j][1] * a[j][1] + a[j][2] * a[j][2] + a[j][3] * a[j][3]; }
            const float rstd = rsqrtf(wave_sum(ss) * (1.f / DM) + 1e-6f);
            float* op = lat ? hout_l + (size_t)tok * DM : hout_c + (size_t)(tok - NLAT) * DM;
#pragma unroll
            for (int j = 0; j < 4; ++j) { h[j] = h[j] + mG[j] * (a[j] * rstd * gA[j]); __builtin_nontemporal_store(h[j], (f32x4*)(op + c0 + 256 * j)); }
        }
        if (HAS_OUT) {
            float ss = 0.f;
#pragma unroll
            for (int j = 0; j < 4; ++j) ss += h[j][0] * h[j][0] + h[j][1] * h[j][1] + h[j][2] * h[j][2] + h[j][3] * h[j][3];
            const float rstd = rsqrtf(wave_sum(ss) * (1.f / DM) + 1e-6f);
#pragma unroll
            for (int j = 0; j < 4; ++j) { const f32x4 y = (h[j] * rstd * gO[j]) * mS[j] + mB[j]; u32x2 o; o.x = pk(y[0], y[1]); o.y = pk(y[2], y[3]);
                *(u32x2*)(Aout + (size_t)tok * DM + c0 + 256 * j) = o; }
        }
    }
#undef ROW_HP
}

DI void feat1_phase(const Ctx& C0, int l) {
    const Ctx C = rectx(C0);
    const bf16* UR = WSP(bf16, WS_X + X_UR); bf16* F = WSP(bf16, WS_X + X_F); bf16* X2 = WSP(bf16, WS_A);
    const float* mu = C.P.in[11 + C.z] + (size_t)l * 2 * RW;
    const int gth = C.bid * NTHREADS + C.tid, NGT = C.G * NTHREADS, kl = (l == 0) ? 384 : KLO;
    for (int idx = gth; idx < NT * 144; idx += NGT) {
        const int tok = idx / 144, pc = idx - tok * 144, cc = pc * 8;
        const int t = (tok < NLAT) ? (tok & (TL - 1)) : ((tok - NLAT) & (TC - 1)), T = (tok < NLAT) ? TL : TC;
        const bf16* up_ = UR + (size_t)tok * RW + cc;
        const u32x4 u = *(const u32x4*)up_;
        u32x4 p = {0u, 0u, 0u, 0u}, nx = {0u, 0u, 0u, 0u};
        if (t > 0) p = *(const u32x4*)(up_ - RW);
        if (t < T - 1) nx = *(const u32x4*)(up_ + RW);
        const f32x4 m0a = *(const f32x4*)(mu + cc), m0b = *(const f32x4*)(mu + cc + 4), m1a = *(const f32x4*)(mu + RW + cc), m1b = *(const f32x4*)(mu + RW + cc + 4);
        float s[8];
#pragma unroll
        for (int e = 0; e < 8; ++e) { const float uu = (e & 1) ? hi2f(u[e >> 1]) : lo2f(u[e >> 1]), pp = (e & 1) ? hi2f(p[e >> 1]) : lo2f(p[e >> 1]), nn = (e & 1) ? hi2f(nx[e >> 1]) : lo2f(nx[e >> 1]);
            const float m0 = (e < 4) ? m0a[e & 3] : m0b[e & 3], m1 = (e < 4) ? m1a[e & 3] : m1b[e & 3];
            s[e] = uu + m0 * (pp - uu) + m1 * (nn - uu); }
        if (cc >= 768 && cc < 896) {
#pragma unroll
            for (int e = 0; e < 8; ++e) s[e] = tanh_(s[e]); }
        else if (cc >= 1024) {
#pragma unroll
            for (int e = 0; e < 8; ++e) s[e] = sigm(s[e]); }
        u32x4 w; w.x = pk(s[0], s[1]); w.y = pk(s[2], s[3]); w.z = pk(s[4], s[5]); w.w = pk(s[6], s[7]);
        if (cc < 256) *(u32x4*)(F + (size_t)tok * 2048 + cc) = w;
        else if (cc < 512) *(u32x4*)(F + (size_t)tok * 2048 + 768 + cc - 256) = w;
        else if (cc < 768) { *(u32x4*)(F + (size_t)tok * 2048 + 512 + cc - 512) = w; if (l == 1) *(u32x4*)(X2 + (size_t)tok * kl + 384 + cc - 512) = w; }
        else *(u32x4*)(X2 + (size_t)tok * kl + cc - 768) = w;
    }
}
DI void feat3_phase(const Ctx& C0, int l) {
    const Ctx C = rectx(C0);
    bf16* F = WSP(bf16, WS_X + X_F); bf16* Gq = WSP(bf16, WS_X + X_G); bf16* VF = WSP(bf16, WS_VF); float* BON = WSP(float, WS_BON); const bf16* LO = WSP(bf16, WS_X + X_LO);
    const int c = (C.lane >> 4) * 64 + (C.lane & 15) * 4;
    const f32x4 kkw = *(const f32x4*)(C.P.in[17 + C.z] + l * 256 + c), kaw = *(const f32x4*)(C.P.in[18 + C.z] + l * 256 + c), rkw = *(const f32x4*)(C.P.in[19 + C.z] + l * 256 + c);
    const f32x4 w0f = *(const f32x4*)(C.P.in[12 + C.z] + l * 512 + c), w0b = *(const f32x4*)(C.P.in[12 + C.z] + l * 512 + 256 + c), a0f = *(const f32x4*)(C.P.in[14 + C.z] + l * 512 + c), a0b = *(const f32x4*)(C.P.in[14 + C.z] + l * 512 + 256 + c);
    const f32x4 v0c = *(const f32x4*)(C.P.in[22 + C.z] + c);
    const int rpw = NT / (256 * NWAVES), r0 = (C.bid * NWAVES + C.wave) * rpw;
    if (C.bid >= 256) return;
    u32x2 nR, nK, nV, nVF, nL[6];
#define F3_LOAD(t) do { const size_t o_ = (size_t)(t) * 256 + c; const bf16* f_ = F + (size_t)(t) * 2048 + c; nR = *(const u32x2*)(f_); nK = *(const u32x2*)(f_ + 768); nV = *(const u32x2*)(f_ + 512); if (l == 1) nVF = *(const u32x2*)(VF + o_); \
        _Pragma("unroll") for (int q = 0; q < 6; ++q) if (q < 5 || l == 1) nL[q] = *(const u32x2*)(LO + (size_t)(t) * NLO + q * 256 + c); } while (0)
    F3_LOAD(r0);
    for (int tok = r0; tok < r0 + rpw; ++tok) {
        const u32x2 cR = nR, cK = nK, cV = nV, cVF = nVF; u32x2 cL[6];
#pragma unroll
        for (int q = 0; q < 6; ++q) cL[q] = nL[q];
        if (tok + 1 < r0 + rpw) F3_LOAD(tok + 1);
        const size_t o = (size_t)tok * 256 + c;
        const f32x4 r = bf4(cR), k = bf4(cK); f32x4 v = bf4(cV);
        if (l == 1) { const f32x4 vf = bf4(cVF), z = v0c + bf4(cL[5]);
#pragma unroll
            for (int e = 0; e < 4; ++e) v[e] = v[e] + (vf[e] - v[e]) * sigm(z[e]);
            *(u32x2*)(F + (size_t)tok * 2048 + 512 + c) = pk4(v); }
        else *(u32x2*)(VF + o) = cV;
        const f32x4 kr = k * kkw;
        const float ss = row16_sum(kr[0] * kr[0] + kr[1] * kr[1] + kr[2] * kr[2] + kr[3] * kr[3]), rn = rsqrtf(fmaxf(ss, 1e-24f));
        const f32x4 lf = w0f + bf4(cL[0]), lb = w0b + bf4(cL[1]), xf = a0f + bf4(cL[2]), xb = a0b + bf4(cL[3]);
        f32x4 ef, eb, af, ab; float bp = 0.f;
#pragma unroll
        for (int e = 0; e < 4; ++e) { ef[e] = 0.6065306597126334f * sigm(lf[e]); eb[e] = 0.6065306597126334f * sigm(lb[e]); af[e] = sigm(xf[e]); ab[e] = sigm(xb[e]);
            bp += r[e] * k[e] * (1.f + (0.5f * (af[e] + ab[e]) - 1.f) * kaw[e]) * rkw[e]; }
        const float bon = row16_sum(bp);
        if ((C.lane & 15) == 0) BON[(size_t)tok * 4 + (C.lane >> 4)] = bon;
        { bf16* f_ = F + (size_t)tok * 2048 + c; *(u32x2*)(f_ + 256) = pk4(kr * rn); *(u32x2*)(f_ + 1024) = pk4(ef); *(u32x2*)(f_ + 1280) = pk4(eb); *(u32x2*)(f_ + 1536) = pk4(af); *(u32x2*)(f_ + 1792) = pk4(ab); }
        *(u32x2*)(Gq + o) = cL[4];
    }
#undef F3_LOAD
}

struct ScanOp { bf16 r, kk, k, e, a, v; };
DI int scan_tok(int n, int dir, int b) { n = n < 2303 ? n : 2303; if (n < 256) return CTXB + b * 256 + (dir ? 255 - n : n); const int t = n - 256; return b * TL + (dir ? TL - 1 - t : t); }
DI ScanOp scan_load(const bf16* Ft, int dir, unsigned ck, unsigned cv) {
    ScanOp o; o.r = Ft[ck]; o.kk = Ft[256 + ck]; o.k = Ft[768 + ck]; o.e = (Ft + (4 + dir) * 256)[ck]; o.a = (Ft + (6 + dir) * 256)[ck]; o.v = Ft[512 + cv]; return o;
}
#define DPPT " row_mask:0xf bank_mask:0xf\n\t"
#define SOPS(S) "+v"(S[0]), "+v"(S[1]), "+v"(S[2]), "+v"(S[3]), "+v"(S[4]), "+v"(S[5]), "+v"(S[6]), "+v"(S[7]), "+v"(S[8]), "+v"(S[9]), "+v"(S[10]), "+v"(S[11]), "+v"(S[12]), "+v"(S[13]), "+v"(S[14]), "+v"(S[15])
struct ScanVec { float w, kd, nbd, r, v; };
DI ScanVec scan_conv(const ScanOp& op, float ka, float& kk_out) {
    const float kk = bf2f(op.kk), k = bf2f(op.k), e = bf2f(op.e), a = bf2f(op.a);
    ScanVec c; c.r = bf2f(op.r); c.v = bf2f(op.v); c.w = fexp2(-e * LOG2E); c.kd = k * (1.f + (a - 1.f) * ka); c.nbd = -(kk * a); kk_out = kk; return c;
}
DI void scan_step(float (&S)[16], float& sa, ScanVec& cur, const ScanOp& nxt, float ka, bf16* yp, bool wr) {
    const float w = cur.w, nbd = cur.nbd, kd = cur.kd, v = cur.v;
#define UPM(j) "v_mul_f32_dpp %" #j ", %16, %" #j " row_newbcast:" #j DPPT
#define UPA(j) "v_fmac_f32_dpp %" #j ", %17, %19 row_newbcast:" #j DPPT
#define UPB(j) "v_fmac_f32_dpp %" #j ", %18, %20 row_newbcast:" #j DPPT
#define ALL16(M) M(0) M(1) M(2) M(3) M(4) M(5) M(6) M(7) M(8) M(9) M(10) M(11) M(12) M(13) M(14) M(15)
    asm volatile(ALL16(UPM) ALL16(UPA) ALL16(UPB) : SOPS(S) : "v"(w), "v"(nbd), "v"(kd), "v"(sa), "v"(v));
#undef UPM
#undef UPA
#undef UPB
    float kkn; ScanVec nx = scan_conv(nxt, ka, kkn);
    float r = cur.r;
    asm volatile("s_nop 1" : "+v"(r), "+v"(kkn), "+v"(nx.w), "+v"(nx.kd), "+v"(nx.nbd), "+v"(nx.r));
    float y0, y1, s0, s1;
    asm volatile(
        "v_mul_f32_dpp %0, %20, %4 row_newbcast:0" DPPT "v_mul_f32_dpp %2, %21, %4 row_newbcast:0" DPPT "v_mul_f32_dpp %1, %20, %5 row_newbcast:1" DPPT "v_mul_f32_dpp %3, %21, %5 row_newbcast:1" DPPT
        "v_fmac_f32_dpp %0, %20, %6 row_newbcast:2" DPPT "v_fmac_f32_dpp %2, %21, %6 row_newbcast:2" DPPT
        "v_fmac_f32_dpp %1, %20, %7 row_newbcast:3" DPPT "v_fmac_f32_dpp %3, %21, %7 row_newbcast:3" DPPT
        "v_fmac_f32_dpp %0, %20, %8 row_newbcast:4" DPPT "v_fmac_f32_dpp %2, %21, %8 row_newbcast:4" DPPT
        "v_fmac_f32_dpp %1, %20, %9 row_newbcast:5" DPPT "v_fmac_f32_dpp %3, %21, %9 row_newbcast:5" DPPT
        "v_fmac_f32_dpp %0, %20, %10 row_newbcast:6" DPPT "v_fmac_f32_dpp %2, %21, %10 row_newbcast:6" DPPT
        "v_fmac_f32_dpp %1, %20, %11 row_newbcast:7" DPPT "v_fmac_f32_dpp %3, %21, %11 row_newbcast:7" DPPT
        "v_fmac_f32_dpp %0, %20, %12 row_newbcast:8" DPPT "v_fmac_f32_dpp %2, %21, %12 row_newbcast:8" DPPT
        "v_fmac_f32_dpp %1, %20, %13 row_newbcast:9" DPPT "v_fmac_f32_dpp %3, %21, %13 row_newbcast:9" DPPT
        "v_fmac_f32_dpp %0, %20, %14 row_newbcast:10" DPPT "v_fmac_f32_dpp %2, %21, %14 row_newbcast:10" DPPT
        "v_fmac_f32_dpp %1, %20, %15 row_newbcast:11" DPPT "v_fmac_f32_dpp %3, %21, %15 row_newbcast:11" DPPT
        "v_fmac_f32_dpp %0, %20, %16 row_newbcast:12" DPPT "v_fmac_f32_dpp %2, %21, %16 row_newbcast:12" DPPT
        "v_fmac_f32_dpp %1, %20, %17 row_newbcast:13" DPPT "v_fmac_f32_dpp %3, %21, %17 row_newbcast:13" DPPT
        "v_fmac_f32_dpp %0, %20, %18 row_newbcast:14" DPPT "v_fmac_f32_dpp %2, %21, %18 row_newbcast:14" DPPT
        "v_fmac_f32_dpp %1, %20, %19 row_newbcast:15" DPPT "v_fmac_f32_dpp %3, %21, %19 row_newbcast:15" DPPT
        : "=&v"(y0), "=&v"(y1), "=&v"(s0), "=&v"(s1)
        : "v"(S[0]), "v"(S[1]), "v"(S[2]), "v"(S[3]), "v"(S[4]), "v"(S[5]), "v"(S[6]), "v"(S[7]), "v"(S[8]), "v"(S[9]), "v"(S[10]), "v"(S[11]), "v"(S[12]), "v"(S[13]), "v"(S[14]), "v"(S[15]), "v"(r), "v"(kkn));
    const float y = allred4(y0 + y1); sa = allred4(s0 + s1);
    if (wr) *yp = f2bf(y);
    cur = nx;
}
DI void scan_run(const Ctx& C0, int l, int b, int h, int dir) {
    const Ctx C = rectx(C0);
    if (C.wave >= 4) {
        if (l == 0) weights_tr(C, 1, C.bid * 4 + (C.wave - 4), C.G * 4, (LAS float*)(C.lds + 49152 + C.wave * 8704));
        return; }
    const int wv = C.wave & 3, q = C.lane >> 4, vi = C.lane & 15;
    const unsigned ck = h * 64 + C.lane, cv = h * 64 + 16 * wv + vi;
    const bf16* F = WSP(bf16, WS_X + X_F);
    bf16* YS = WSP(bf16, WS_X + X_UR) + (size_t)dir * FSZ;
    const float ka = C.P.in[18 + C.z][l * 256 + ck];
    float S[16];
#pragma unroll
    for (int j = 0; j < 16; ++j) S[j] = 0.f;
    const bool wr = (q == 0);
    size_t t0 = (size_t)scan_tok(0, dir, b) * 256, t1 = (size_t)scan_tok(1, dir, b) * 256, t2 = (size_t)scan_tok(2, dir, b) * 256, t3 = (size_t)scan_tok(3, dir, b) * 256;
    ScanOp o0 = scan_load(F + t0 * 8, dir, ck, cv), o1 = scan_load(F + t1 * 8, dir, ck, cv), o2 = scan_load(F + t2 * 8, dir, ck, cv), o3 = scan_load(F + t3 * 8, dir, ck, cv);
    float sa = 0.f, kk0_; ScanVec cur = scan_conv(o0, ka, kk0_);
    asm volatile("s_nop 1" : "+v"(cur.w), "+v"(cur.kd), "+v"(cur.nbd), "+v"(cur.r));
    for (int n = 0; n < 2304; n += 4) {
        size_t tn;
        scan_step(S, sa, cur, o1, ka, &(YS + t0)[cv], wr); tn = (size_t)__builtin_amdgcn_readfirstlane(scan_tok(n + 4, dir, b)) * 256; o0 = scan_load(F + tn * 8, dir, ck, cv); t0 = tn;
        scan_step(S, sa, cur, o2, ka, &(YS + t1)[cv], wr); tn = (size_t)__builtin_amdgcn_readfirstlane(scan_tok(n + 5, dir, b)) * 256; o1 = scan_load(F + tn * 8, dir, ck, cv); t1 = tn;
        scan_step(S, sa, cur, o3, ka, &(YS + t2)[cv], wr); tn = (size_t)__builtin_amdgcn_readfirstlane(scan_tok(n + 6, dir, b)) * 256; o2 = scan_load(F + tn * 8, dir, ck, cv); t2 = tn;
        scan_step(S, sa, cur, o0, ka, &(YS + t3)[cv], wr); tn = (size_t)__builtin_amdgcn_readfirstlane(scan_tok(n + 7, dir, b)) * 256; o3 = scan_load(F + tn * 8, dir, ck, cv); t3 = tn;
    }
}

DI void readout_phase(const Ctx& C0, int l, int nrows) {
    const Ctx C = rectx(C0);
    const bf16* F = WSP(bf16, WS_X + X_F); const bf16* Gq = WSP(bf16, WS_X + X_G); const bf16* YS = WSP(bf16, WS_X + X_UR); const float* BON = WSP(float, WS_BON);
    bf16* YR = WSP(bf16, WS_A + (size_t)108 * MiB);
    const int c = (C.lane >> 4) * 64 + (C.lane & 15) * 4;
    const f32x4 lw = *(const f32x4*)(C.P.in[20 + C.z] + l * 256 + c), lb = *(const f32x4*)(C.P.in[21 + C.z] + l * 256 + c);
    const int rpw = (nrows + C.G * NWAVES - 1) / (C.G * NWAVES), r0 = (C.bid * NWAVES + C.wave) * rpw, r1 = (r0 + rpw < nrows) ? r0 + rpw : nrows;
    if (r0 >= r1) return;
    u32x2 nF, nB, nV, nG; float nBon;
#define RO_LOAD(t) do { const size_t o_ = (size_t)(t) * 256 + c; nF = *(const u32x2*)(YS + o_); nB = *(const u32x2*)(YS + FSZ + o_); nV = *(const u32x2*)(F + (size_t)(t) * 2048 + 512 + c); nG = *(const u32x2*)(Gq + o_); nBon = BON[(size_t)(t) * 4 + (C.lane >> 4)]; } while (0)
    RO_LOAD(r0);
    for (int tok = r0; tok < r1; ++tok) {
        const u32x2 cF = nF, cB = nB, cV = nV, cG = nG; const float bon = nBon;
        if (tok + 1 < r1) RO_LOAD(tok + 1);
        const f32x4 y = bf4(cF) + bf4(cB);
        const float mean = row16_sum(y[0] + y[1] + y[2] + y[3]) * (1.f / 64.f);
        const f32x4 d = y - mean;
        const float var = row16_sum(d[0] * d[0] + d[1] * d[1] + d[2] * d[2] + d[3] * d[3]) * (1.f / 64.f);
        const f32x4 yn = d * rsqrtf(var + 64e-5f) * lw + lb;
        *(u32x2*)(YR + (size_t)tok * 256 + c) = pk4((yn + bf4(cV) * bon) * bf4(cG));
    }
#undef RO_LOAD
}

DI void fixup_phase(const Ctx& C0, int l, int nrows) {
    const Ctx C = rectx(C0);
    const int gw = C.bid * NWAVES + C.wave, NGW = C.G * NWAVES, nitem = (nrows / 64) * 2;
    const bf16* HALO = WSP(bf16, WS_X + X_HALO); bf16* HH = WSP(bf16, WS_X + X_HH);
    const float* cw = C.P.in[31 + C.z] + (size_t)l * 3 * DFF; const float* cb = C.P.in[32 + C.z] + (size_t)l * DFF;
    for (int it = gw; it < nitem; it += NGW) {
        const int grp = it >> 1, last = it & 1, row = grp * 64 + (last ? 63 : 0);
        const int t = (row < NLAT) ? (row & (TL - 1)) : ((row - NLAT) & (TC - 1)), T = (row < NLAT) ? TL : TC;
        const bf16* hb = HALO + (size_t)grp * 6 * DFF;
        const bf16 *pp, *pc, *pn, *pv; bool zp = false, zn = false;
        if (!last) { pc = hb; pn = hb + DFF; pv = hb + 4 * DFF; zp = (t == 0); pp = zp ? hb : hb - 6 * DFF + 3 * DFF; }
        else { pp = hb + 2 * DFF; pc = hb + 3 * DFF; pv = hb + 5 * DFF; zn = (t == T - 1); pn = zn ? hb : hb + 6 * DFF; }
        for (int p = C.lane; p < DFF / 8; p += 64) { const int j = p * 8;
            const u32x4 a = *(const u32x4*)(pp + j), bq = *(const u32x4*)(pc + j), cq = *(const u32x4*)(pn + j), vq = *(const u32x4*)(pv + j);
            float o[8];
#pragma unroll
            for (int e = 0; e < 8; ++e) { const unsigned ua = a[e >> 1], ub = bq[e >> 1], uc = cq[e >> 1], uv = vq[e >> 1];
                const float xp = zp ? 0.f : ((e & 1) ? hi2f(ua) : lo2f(ua)), xc = (e & 1) ? hi2f(ub) : lo2f(ub), xn = zn ? 0.f : ((e & 1) ? hi2f(uc) : lo2f(uc)), xv = (e & 1) ? hi2f(uv) : lo2f(uv);
                const float z = cw[j + e] * xp + cw[DFF + j + e] * xc + cw[2 * DFF + j + e] * xn + cb[j + e]; o[e] = gelu_tanh(z) * xv; }
            u32x4 w; w.x = pk(o[0], o[1]); w.y = pk(o[2], o[3]); w.z = pk(o[4], o[5]); w.w = pk(o[6], o[7]);
            *(u32x4*)(HH + (size_t)row * DFF + j) = w; }
    }
}

DI int crow(int i, int hh) { return (i & 3) + 8 * (i >> 2) + 4 * hh; }
DI void attn_unit(const Ctx& C, int l, int b, int kh, int qblk, bool isctx) {
    LAS bf16* Ks = (LAS bf16*)C.lds; LAS bf16* Vt = Ks + 64 * 72;
    const bf16* QKV = WSP(bf16, WS_X + X_QKV); bf16* YA = WSP(bf16, WS_A); const float* RT = WSP(float, WS_SMALL);
    const int g = C.wave >> 1, qt = C.wave & 1, hq = kh * 4 + g, r = C.lane & 31, hh = C.lane >> 5;
    const int qi = qblk * 64 + qt * 32 + r;
    const size_t tq = isctx ? (size_t)(CTXB + b * TC + qi) : (size_t)(b * TL + qi);
    bf16x8 qf[4];
    {
        float qv[4][8]; const bf16* qp = QKV + tq * 768 + hq * 64 + 8 * hh;
#pragma unroll
        for (int ks = 0; ks < 4; ++ks) { const u32x4 u = *(const u32x4*)(qp + 16 * ks);
#pragma unroll
            for (int e = 0; e < 4; ++e) { qv[ks][2 * e] = lo2f(u[e]); qv[ks][2 * e + 1] = hi2f(u[e]); } }
        if (!isctx) { const int rid = qi >> 6, cid = qi & 63;
#pragma unroll
            for (int j = 0; j < 8; ++j) { const int f = 8 * hh + j;
                const float c0 = RT[(rid * 16 + f) * 2], s0 = RT[(rid * 16 + f) * 2 + 1], c1 = RT[(cid * 16 + f) * 2], s1 = RT[(cid * 16 + f) * 2 + 1];
                const float a1 = qv[0][j], a2 = qv[1][j], b1 = qv[2][j], b2 = qv[3][j];
                qv[0][j] = a1 * c0 - a2 * s0; qv[1][j] = a2 * c0 + a1 * s0; qv[2][j] = b1 * c1 - b2 * s1; qv[3][j] = b2 * c1 + b1 * s1; } }
        const float sc = 0.125f * LOG2E;
#pragma unroll
        for (int ks = 0; ks < 4; ++ks) { u32x4 w; w.x = pk(qv[ks][0] * sc, qv[ks][1] * sc); w.y = pk(qv[ks][2] * sc, qv[ks][3] * sc); w.z = pk(qv[ks][4] * sc, qv[ks][5] * sc); w.w = pk(qv[ks][6] * sc, qv[ks][7] * sc); qf[ks] = __builtin_bit_cast(bf16x8, w); }
    }
    float m_run = C.P.in[25 + C.z][l * 8 + hq] * LOG2E, l_run = hh == 0 ? 1.f : 0.f;
    f32x16 o0, o1;
#pragma unroll
    for (int i = 0; i < 16; ++i) { o0[i] = 0.f; o1[i] = 0.f; }
    const int nch = isctx ? 4 : 9, skey = C.tid >> 3, oct = C.tid & 7;
#define ATT_VALID(c_) ((c_) < 4 || (qblk * 64 - 128 + ((c_) - 4) * 64 >= 0 && qblk * 64 - 128 + ((c_) - 4) * 64 < TL))
#define ATT_LOAD(c_) do { const size_t kt_ = ((c_) < 4) ? (size_t)(CTXB + b * TC + (c_) * 64) : (size_t)(b * TL + qblk * 64 - 128 + ((c_) - 4) * 64); \
        const bf16* kp_ = QKV + (kt_ + skey) * 768 + 512 + kh * 64; pk_u = *(const u32x4*)(kp_ + 8 * oct); pk_p = *(const u32x4*)(kp_ + 8 * (oct ^ 2)); pk_v = *(const u32x4*)(kp_ + 128 + 8 * oct); } while (0)
    u32x4 pk_u, pk_p, pk_v;
    int ch = 0;
    ATT_LOAD(0);
    while (ch < nch) {
        const bool win = ch >= 4; const int kb = win ? qblk * 64 - 128 + (ch - 4) * 64 : 0;
        __syncthreads();
        {
            u32x4 ku = pk_u;
            if (win) { const u32x4 pu = pk_p;
                const int p = kb + skey, pos = (oct >> 2) ? (p & 63) : (p >> 6), fb = 8 * (oct & 1); const bool isx1 = (oct & 2) == 0;
                float o[8];
#pragma unroll
                for (int e = 0; e < 8; ++e) { const float own = (e & 1) ? hi2f(ku[e >> 1]) : lo2f(ku[e >> 1]), par = (e & 1) ? hi2f(pu[e >> 1]) : lo2f(pu[e >> 1]);
                    const float cc = RT[(pos * 16 + fb + e) * 2], ss = RT[(pos * 16 + fb + e) * 2 + 1];
                    o[e] = isx1 ? (own * cc - par * ss) : (own * cc + par * ss); }
                ku.x = pk(o[0], o[1]); ku.y = pk(o[2], o[3]); ku.z = pk(o[4], o[5]); ku.w = pk(o[6], o[7]); }
            *(LAS u32x4*)(Ks + skey * 72 + 8 * oct) = ku;
            const u32x4 vu = pk_v;
#pragma unroll
            for (int e = 0; e < 8; ++e) Vt[(8 * oct + e) * 72 + skey] = (bf16)((e & 1) ? (vu[e >> 1] >> 16) : (vu[e >> 1] & 0xffffu));
        }
        __syncthreads();
        int nxc = ch + 1;
        while (nxc < nch && !ATT_VALID(nxc)) ++nxc;
        if (nxc < nch) ATT_LOAD(nxc);
        f32x16 x0, x1;
#pragma unroll
        for (int i = 0; i < 16; ++i) { x0[i] = 0.f; x1[i] = 0.f; }
#pragma unroll
        for (int ks = 0; ks < 4; ++ks) {
            const bf16x8 a0 = *(const LAS bf16x8*)(Ks + r * 72 + 16 * ks + 8 * hh), a1 = *(const LAS bf16x8*)(Ks + (32 + r) * 72 + 16 * ks + 8 * hh);
            x0 = __builtin_amdgcn_mfma_f32_32x32x16_bf16(a0, qf[ks], x0, 0, 0, 0);
            x1 = __builtin_amdgcn_mfma_f32_32x32x16_bf16(a1, qf[ks], x1, 0, 0, 0);
        }
        if (win) {
#pragma unroll
            for (int i = 0; i < 16; ++i) { const int k0 = kb + crow(i, hh), d0 = qi - k0, d1 = d0 - 32;
                if (d0 > 128 || d0 < -128) x0[i] = -1e30f; if (d1 > 128 || d1 < -128) x1[i] = -1e30f; }
        }
        float mx = x0[0];
#pragma unroll
        for (int i = 0; i < 16; ++i) { mx = fmaxf(mx, x0[i]); mx = fmaxf(mx, x1[i]); }
        mx = fmaxf(mx, __shfl_xor(mx, 32));
        const float m_new = fmaxf(m_run, mx), alpha = fexp2(m_run - m_new);
        float ps = 0.f;
#pragma unroll
        for (int i = 0; i < 16; ++i) { x0[i] = fexp2(x0[i] - m_new); x1[i] = fexp2(x1[i] - m_new); ps += x0[i] + x1[i]; o0[i] *= alpha; o1[i] *= alpha; }
        l_run = l_run * alpha + ps; m_run = m_new;
#pragma unroll
        for (int kt = 0; kt < 2; ++kt)
#pragma unroll
            for (int s = 0; s < 2; ++s) {
                const f32x16& x = kt ? x1 : x0;
                u32x4 w; w.x = pk(x[8 * s], x[8 * s + 1]); w.y = pk(x[8 * s + 2], x[8 * s + 3]); w.z = pk(x[8 * s + 4], x[8 * s + 5]); w.w = pk(x[8 * s + 6], x[8 * s + 7]);
                const bf16x8 pb = __builtin_bit_cast(bf16x8, w);
                const int ko = kt * 32 + 16 * s + 4 * hh;
                const s16x4 l0 = *(const LAS s16x4*)(Vt + r * 72 + ko), h0 = *(const LAS s16x4*)(Vt + r * 72 + ko + 8);
                const s16x4 l1 = *(const LAS s16x4*)(Vt + (32 + r) * 72 + ko), h1 = *(const LAS s16x4*)(Vt + (32 + r) * 72 + ko + 8);
                o0 = __builtin_amdgcn_mfma_f32_32x32x16_bf16(__builtin_shufflevector(l0, h0, 0, 1, 2, 3, 4, 5, 6, 7), pb, o0, 0, 0, 0);
                o1 = __builtin_amdgcn_mfma_f32_32x32x16_bf16(__builtin_shufflevector(l1, h1, 0, 1, 2, 3, 4, 5, 6, 7), pb, o1, 0, 0, 0);
            }
        ch = nxc;
    }
#undef ATT_VALID
#undef ATT_LOAD
    const float inv = frcp(l_run + __shfl_xor(l_run, 32));
    bf16* op = YA + tq * 512 + hq * 64 + 4 * hh;
#pragma unroll
    for (int i4 = 0; i4 < 4; ++i4) {
        u32x2 w0, w1; w0.x = pk(o0[4 * i4] * inv, o0[4 * i4 + 1] * inv); w0.y = pk(o0[4 * i4 + 2] * inv, o0[4 * i4 + 3] * inv);
        w1.x = pk(o1[4 * i4] * inv, o1[4 * i4 + 1] * inv); w1.y = pk(o1[4 * i4 + 2] * inv, o1[4 * i4 + 3] * inv);
        *(u32x2*)(op + 8 * i4) = w0; *(u32x2*)(op + 32 + 8 * i4) = w1;
    }
}
DI void attn_loop(const Ctx& C0, int l) {
    const Ctx C = rectx(C0);
    unsigned* ctr = WSP(unsigned, WS_CTL) + 64 * (l + 1);
    volatile LAS unsigned* slot = (volatile LAS unsigned*)(C.lds + 32768);
    const unsigned NU = 2048u + (l == 0 ? 256u : 0u);
    for (;;) {
        __syncthreads();
        if (C.tid == 0) *slot = atomicAdd(ctr, 1u);
        __syncthreads();
        const unsigned u = *slot;
        if (u >= NU) break;
        if (u < 2048u) attn_unit(C, l, (int)(u >> 6), (int)((u >> 5) & 1), (int)(u & 31), false);
        else { const unsigned v = u - 2048u; attn_unit(C, l, (int)(v >> 3), (int)((v >> 2) & 1), (int)(v & 3), true); }
    }
}


#ifdef DBG
DI float exp_f(float x) { return fexp2(x * LOG2E); }
DI unsigned hsh(unsigned x) { x ^= x >> 16; x *= 0x7feb352du; x ^= x >> 15; x *= 0x846ca68bu; x ^= x >> 16; return x; }
DI void dbg_put(const Ctx& C, int k, float got, float ref, float S) {
    float err = fabsf(got - ref) / (fabsf(ref) + S); if (!(err == err)) err = 1e9f;
    atomicMax(WSP(unsigned, WS_CTL) + 1024 + k, __builtin_bit_cast(unsigned, err));
}
DI float ndot(const bf16* a, const bf16* b, int K) { float s = 0.f; for (int k = 0; k < K; ++k) s += bf2f(a[k]) * bf2f(b[k]); return s; }
DI void dbg_check(const Ctx& C0, int stage, int l) {
    if (C0.bid != 0 || l != 0) return;
    const Ctx C = rectx(C0);
    const unsigned h1 = hsh(C.tid * 3u + 17u + stage * 1000u), h2 = hsh(h1 + 0x9e3779b9u), h3 = hsh(h2 + 77u);
    const Params& P = C.P;
    if (stage == 0) {
        {
            const int n = h1 % 2432, k = h2 % 1024; int src = -1;
            if (n < 512) src = 1152 + n; else if (n < 640) src = 1664 + (n - 512); else if (n < 768) src = 1792 + (n - 640); else if (n >= 1280) src = n - 1280;
            if (src >= 0) dbg_put(C, 0, bf2f(WL(bf16, 0, WL_IN)[(size_t)n * 1024 + k]), bf2f(f2bf(P.in[10 + C.z][(size_t)k * IN_COLS + src])), 1e-6f);
            const int ng = h3 % 3072;
            dbg_put(C, 0, bf2f(WL(bf16, 0, WL_G)[(size_t)ng * 1024 + k]), bf2f(f2bf(P.in[10 + C.z][(size_t)k * IN_COLS + 2176 + ng])), 1e-6f);
            const int nu = h3 % 5632, pn = nu >> 8, bj = (nu >> 7) & 1, j = nu & 127;
            dbg_put(C, 0, bf2f(WL(bf16, 0, WL_UP)[(size_t)nu * 1024 + k]), bf2f(f2bf(P.in[30 + C.z][(size_t)k * 5632 + bj * DFF + pn * 128 + j])), 1e-6f);
            const int nd = h1 % 1024, kd = h3 % DFF;
            dbg_put(C, 0, bf2f(WL(bf16, 0, WL_DN)[(size_t)nd * DFF + kd]), bf2f(f2bf(P.in[33 + C.z][(size_t)kd * 1024 + nd])), 1e-6f);
            dbg_put(C, 0, bf2f(WL(bf16, 0, WL_O)[(size_t)nd * 1024 + k]), bf2f(f2bf(P.in[29 + C.z][(size_t)k * 1024 + nd])), 1e-6f);
            dbg_put(C, 0, bf2f(WL(bf16, 0, WL_BA)[(size_t)nd * 512 + (k & 511)]), bf2f(f2bf(P.in[27 + C.z][(size_t)(k & 511) * 1024 + nd])), 1e-6f);
            dbg_put(C, 0, bf2f(WL(bf16, 0, WL_BR)[(size_t)nd * 256 + (k & 255)]), bf2f(f2bf(P.in[26 + C.z][(size_t)(k & 255) * 1024 + nd])), 1e-6f);
        }
        {
            const int r = h1 % 33, j = h2 % 6144; float a = P.in[5 + C.z][j];
            for (int k = 0; k < 1024; ++k) { const float cv = (r < 32) ? P.in[1 + C.z][r * 1024 + k] : P.in[3 + C.z][k]; a += cv / (1.f + exp_f(-cv)) * P.in[4 + C.z][(size_t)k * 6144 + j]; }
            dbg_put(C, 1, WSP(float, WS_MOD)[(size_t)r * 6144 + j], a, 0.01f);
        }
    } else if (stage == 1) {
        const int tok = h1 % NT, col = h2 % 1024; const bool lat = tok < NLAT; const float* hp = lat ? P.in[0 + C.z] + (size_t)tok * DM : P.in[2 + C.z] + (size_t)(tok - NLAT) * DM;
        float ss = 0.f; for (int k = 0; k < 1024; ++k) ss += hp[k] * hp[k];
        const float* mp = WSP(float, WS_MOD) + (size_t)(lat ? tok / TL : 32) * 6144;
        const float ref = hp[col] * rsqrtf(ss / 1024.f + 1e-6f) * P.in[6 + C.z][col] * (1.f + mp[1024 + col]) + mp[col];
        dbg_put(C, 2, bf2f(WSP(bf16, WS_A)[(size_t)tok * DM + col]), ref, 0.05f);
    } else if (stage == 2) {
        const int tok = h1 % NT, n = h2 % 2432; const float ref = ndot(WSP(bf16, WS_A) + (size_t)tok * DM, WL(bf16, 0, WL_IN) + (size_t)n * 1024, 1024);
        float got; int k;
        if (n < 768) { got = bf2f(WSP(bf16, WS_X + X_QKV)[(size_t)tok * 768 + n]); k = 3; }
        else if (n < 1280) { const int sn = (n - 768) >> 8, ch = (n - 768) & 255; k = 4;
            if (tok < NLAT) got = bf2f(WSP(bf16, WS_X + X_ZT)[((size_t)(tok / TL) * 256 + ch) * 4096 + sn * 2048 + (tok % TL)]);
            else got = bf2f(WSP(bf16, WS_X + X_ZTC)[((size_t)((tok - NLAT) / TC) * 256 + ch) * 512 + sn * 256 + ((tok - NLAT) % TC)]); }
        else { got = bf2f(WSP(bf16, WS_X + X_UR)[(size_t)tok * RW + n - 1280]); k = 5; }
        dbg_put(C, k, got, ref, 0.1f);
    } else if (stage == 3) {
        const int b = h1 % 32, t = 1 + h2 % 2046, c = h3 % 256; const size_t tok = (size_t)b * TL + t; const bf16* UR = WSP(bf16, WS_X + X_UR);
        const float u = bf2f(UR[tok * RW + c]), up = bf2f(UR[(tok - 1) * RW + c]), un = bf2f(UR[(tok + 1) * RW + c]);
        dbg_put(C, 7, bf2f(WSP(bf16, WS_X + X_F)[tok * 2048 + c]), u + P.in[11 + C.z][c] * (up - u) + P.in[11 + C.z][RW + c] * (un - u), 0.05f);
        float ss = 0.f; for (int k = 0; k < 64; ++k) { const float x = bf2f(WSP(bf16, WS_X + X_F)[tok * 2048 + 256 + (c & 192) + k]); ss += x * x; }
        dbg_put(C, 7, ss, 1.f, 0.f);
    } else if (stage == 4) {
        {
            LAS float* S = (LAS float*)C.lds; LAS float* sa = S + 4096; const bf16* F = WSP(bf16, WS_X + X_F); const int b = 1, h = 2;
            for (int dir = 0; dir < 2; ++dir) {
                for (int e = C.tid; e < 4096; e += NTHREADS) S[e] = 0.f;
                __syncthreads();
                for (int n = 0; n < 24; ++n) {
                    const size_t oy = (size_t)scan_tok(n, dir, b) * 256 + h * 64, o = (size_t)scan_tok(n, dir, b) * 2048 + h * 64;
                    if (C.tid < 64) { float a = 0.f; for (int k = 0; k < 64; ++k) a -= S[C.tid * 64 + k] * bf2f(F[256 + o + k]); sa[C.tid] = a; }
                    __syncthreads();
                    for (int e = C.tid; e < 4096; e += NTHREADS) { const int v = e >> 6, k = e & 63;
                        const float kk = bf2f(F[256 + o + k]), kr = bf2f(F[768 + o + k]), ee = bf2f(F[(4 + dir) * 256 + o + k]), a = bf2f(F[(6 + dir) * 256 + o + k]), vv = bf2f(F[512 + o + v]);
                        S[e] = S[e] * exp_f(-ee) + sa[v] * (kk * a) + vv * (kr * (1.f + (a - 1.f) * P.in[18 + C.z][h * 64 + k])); }
                    __syncthreads();
                    if (C.tid < 64) { float y = 0.f; for (int k = 0; k < 64; ++k) y += S[C.tid * 64 + k] * bf2f(F[o + k]);
                        dbg_put(C, 8, bf2f(WSP(bf16, WS_X + X_UR)[(size_t)dir * FSZ + oy + C.tid]), y, 0.05f); }
                    __syncthreads();
                }
            }
        }
        {
            LAS float* qs = (LAS float*)C.lds + (size_t)C.tid * 65; const bf16* QKV = WSP(bf16, WS_X + X_QKV);
            const int b = h1 % 32, t = (C.tid & 1) ? (int)(h2 % 2048) : ((C.tid & 2) ? (int)(h2 % 200) : 2047 - (int)(h2 % 200)), hq = h3 % 8, dd = (h3 >> 8) % 64, kh = hq >> 2;
            const size_t tq = (size_t)b * TL + t;
            for (int d = 0; d < 64; ++d) { const int ax = d >> 5, hf = (d >> 4) & 1, f = d & 15; const int ps = ax ? (t & 63) : (t >> 6); const float cs = WSP(float, WS_SMALL)[(ps * 16 + f) * 2], sn = WSP(float, WS_SMALL)[(ps * 16 + f) * 2 + 1];
                const float x1 = bf2f(QKV[tq * 768 + hq * 64 + ax * 32 + f]), x2 = bf2f(QKV[tq * 768 + hq * 64 + ax * 32 + 16 + f]);
                qs[d] = hf ? (x2 * cs + x1 * sn) : (x1 * cs - x2 * sn); }
            float m = P.in[25 + C.z][hq], den = 1.f, acc = 0.f;
            for (int j = 0; j < 256 + 257; ++j) {
                const bool win = j >= 256; const int kp = win ? t - 128 + (j - 256) : j; if (win && (kp < 0 || kp >= TL)) continue;
                const size_t tk = win ? (size_t)b * TL + kp : (size_t)(CTXB + b * TC + kp); float s = 0.f;
                for (int d = 0; d < 64; ++d) { float kv;
                    if (!win) kv = bf2f(QKV[tk * 768 + 512 + kh * 64 + d]);
                    else { const int ax = d >> 5, hf = (d >> 4) & 1, f = d & 15; const int ps = ax ? (kp & 63) : (kp >> 6); const float cs = WSP(float, WS_SMALL)[(ps * 16 + f) * 2], sn = WSP(float, WS_SMALL)[(ps * 16 + f) * 2 + 1];
                        const float x1 = bf2f(QKV[tk * 768 + 512 + kh * 64 + ax * 32 + f]), x2 = bf2f(QKV[tk * 768 + 512 + kh * 64 + ax * 32 + 16 + f]);
                        kv = hf ? (x2 * cs + x1 * sn) : (x1 * cs - x2 * sn); }
                    s += qs[d] * kv; }
                s *= 0.125f; const float mn = fmaxf(m, s), al = exp_f(m - mn), p = exp_f(s - mn);
                den = den * al + p; acc = acc * al + p * bf2f(QKV[tk * 768 + 640 + kh * 64 + dd]); m = mn;
            }
            dbg_put(C, 9, bf2f(WSP(bf16, WS_A)[tq * 512 + hq * 64 + dd]), acc / den, 0.03f);
        }
        __syncthreads();
        {
            LAS float* qs = (LAS float*)C.lds + (size_t)C.tid * 65; const bf16* QKV = WSP(bf16, WS_X + X_QKV);
            const int b = h2 % 32, t = h1 % 256, hq = h3 % 8, dd = (h3 >> 8) % 64, kh = hq >> 2; const size_t tq = (size_t)(CTXB + b * TC + t);
            for (int d = 0; d < 64; ++d) qs[d] = bf2f(QKV[tq * 768 + hq * 64 + d]);
            float m = P.in[25 + C.z][hq], den = 1.f, acc = 0.f;
            for (int j = 0; j < 256; ++j) { const size_t tk = (size_t)(CTXB + b * TC + j); float s = 0.f;
                for (int d = 0; d < 64; ++d) s += qs[d] * bf2f(QKV[tk * 768 + 512 + kh * 64 + d]);
                s *= 0.125f; const float mn = fmaxf(m, s), al = exp_f(m - mn), p = exp_f(s - mn); den = den * al + p; acc = acc * al + p * bf2f(QKV[tk * 768 + 640 + kh * 64 + dd]); m = mn; }
            dbg_put(C, 10, bf2f(WSP(bf16, WS_A)[tq * 512 + hq * 64 + dd]), acc / den, 0.03f);
        }
        {
            const int b = h1 % 32, tp = h2 % 2048, ch = h3 % 256;
            dbg_put(C, 11, bf2f(WSP(bf16, WS_A + (size_t)72 * MiB)[((size_t)b * TL + tp) * 256 + ch]), ndot(WSP(bf16, WS_DFT) + (size_t)tp * 4096, WSP(bf16, WS_X + X_ZT) + ((size_t)b * 256 + ch) * 4096, 4096), 0.05f);
            const int tc = h2 % 256;
            dbg_put(C, 11, bf2f(WSP(bf16, WS_A + (size_t)72 * MiB)[((size_t)CTXB + b * TC + tc) * 256 + ch]), ndot(WSP(bf16, WS_DFTC) + (size_t)tc * 512, WSP(bf16, WS_X + X_ZTC) + ((size_t)b * 256 + ch) * 512, 512), 0.05f);
        }
    } else if (stage == 5) {
        const int tok = h1 % NT, col = h2 % 1024; const bf16* PP = WSP(bf16, WS_X + X_PP);
        dbg_put(C, 13, bf2f(PP[(size_t)tok * NGATE + col]), ndot(WSP(bf16, WS_A + (size_t)108 * MiB) + (size_t)tok * 256, WL(bf16, 0, WL_BR) + (size_t)col * 256, 256), 0.05f);
        dbg_put(C, 13, bf2f(PP[(size_t)tok * NGATE + 1024 + col]), ndot(WSP(bf16, WS_A) + (size_t)tok * 512, WL(bf16, 0, WL_BA) + (size_t)col * 512, 512), 0.05f);
        dbg_put(C, 13, bf2f(PP[(size_t)tok * NGATE + 2048 + col]), ndot(WSP(bf16, WS_A + (size_t)72 * MiB) + (size_t)tok * 256, WL(bf16, 0, WL_BF) + (size_t)col * 256, 256), 0.05f);
    } else if (stage == 6) {
        const int tok = h1 % NT, col = h2 % 1024; float ref = 0.f;
        for (int br = 0; br < 3; ++br) { const float gl = ndot(WSP(bf16, WS_A) + (size_t)tok * DM, WL(bf16, 0, WL_G) + (size_t)(br * 1024 + col) * 1024, 1024); ref += bf2f(WSP(bf16, WS_X + X_PP)[(size_t)tok * NGATE + br * 1024 + col]) / (1.f + exp_f(-gl)); }
        dbg_put(C, 14, bf2f(WSP(bf16, WS_X + X_UR)[(size_t)tok * DM + col]), ref, 0.05f);
    } else if (stage == 7) {
        const int tok = h1 % NT, col = h2 % 1024;
        dbg_put(C, 15, bf2f(WSP(bf16, WS_X + X_MIX)[(size_t)tok * DM + col]), ndot(WSP(bf16, WS_X + X_UR) + (size_t)tok * DM, WL(bf16, 0, WL_O) + (size_t)col * 1024, 1024), 0.05f);
    } else if (stage == 8) {
        const int tok = h1 % NT, col = h2 % 1024; const bool lat = tok < NLAT; const float* hp = lat ? P.in[0 + C.z] + (size_t)tok * DM : P.in[2 + C.z] + (size_t)(tok - NLAT) * DM;
        const bf16* mx = WSP(bf16, WS_X + X_MIX) + (size_t)tok * DM; const float* mp = WSP(float, WS_MOD) + (size_t)(lat ? tok / TL : 32) * 6144;
        float ss = 0.f; for (int k = 0; k < 1024; ++k) ss += bf2f(mx[k]) * bf2f(mx[k]);
        const float rs = rsqrtf(ss / 1024.f + 1e-6f); float s2 = 0.f, hc = 0.f;
        for (int k = 0; k < 1024; ++k) { const float hn = hp[k] + mp[2048 + k] * bf2f(mx[k]) * rs * P.in[7 + C.z][k]; s2 += hn * hn; if (k == col) hc = hn; }
        const float* ho = lat ? C.out + (size_t)tok * DM : WSP(float, WS_HC) + (size_t)(tok - NLAT) * DM;
        dbg_put(C, 16, ho[col], hc, 0.01f);
        dbg_put(C, 16, bf2f(WSP(bf16, WS_A)[(size_t)tok * DM + col]), hc * rsqrtf(s2 / 1024.f + 1e-6f) * P.in[8 + C.z][col] * (1.f + mp[4096 + col]) + mp[3072 + col], 0.05f);
    } else if (stage == 9) {
        int tok = h1 % NT; if (C.tid & 1) tok = (tok & ~63) + ((C.tid & 2) ? 63 : 0);
        const int j = h2 % DFF; const int t = (tok < NLAT) ? (tok % TL) : ((tok - NLAT) % TC), T = (tok < NLAT) ? TL : TC;
        const bf16* A = WSP(bf16, WS_A); const bf16* wu = WL(bf16, 0, WL_UP); const int pn = j >> 7, jj = j & 127;
        const bf16* wg = wu + (size_t)(pn * 256 + jj) * 1024; const bf16* wv = wu + (size_t)(pn * 256 + 128 + jj) * 1024;
        const float zc = ndot(A + (size_t)tok * DM, wg, 1024), zp = (t > 0) ? ndot(A + (size_t)(tok - 1) * DM, wg, 1024) : 0.f, zn = (t < T - 1) ? ndot(A + (size_t)(tok + 1) * DM, wg, 1024) : 0.f, zv = ndot(A + (size_t)tok * DM, wv, 1024);
        const float z = P.in[31 + C.z][j] * zp + P.in[31 + C.z][DFF + j] * zc + P.in[31 + C.z][2 * DFF + j] * zn + P.in[32 + C.z][j];
        const float ge = 0.5f * z * (1.f + tanh_(0.7978845608028654f * (z + 0.044715f * z * z * z)));
        dbg_put(C, 17, bf2f(WSP(bf16, WS_X + X_HH)[(size_t)tok * DFF + j]), ge * zv, 0.05f);
    } else if (stage == 10) {
        const int tok = h1 % NT, col = h2 % 1024;
        dbg_put(C, 18, bf2f(WSP(bf16, WS_X + X_FFO)[(size_t)tok * DM + col]), ndot(WSP(bf16, WS_X + X_HH) + (size_t)tok * DFF, WL(bf16, 0, WL_DN) + (size_t)col * DFF, DFF), 0.05f);
    }
}
DI void dbg_report(const Ctx& C) {
    if (C.bid == 0 && threadIdx.x == 0) {
        int first = -1; for (int k = 0; k < 24; ++k) if (first < 0 && __builtin_bit_cast(float, WSP(unsigned, WS_CTL)[1024 + k]) > 0.05f) first = k;
        if (first >= 0) C.out[12345] = 1000.f * (float)(first + 1);
    }
}
#define DBGCHK(stage) do { grid.sync(); dbg_check(CK, stage, l); grid.sync(); } while (0)
#else
#define DBGCHK(stage) do { } while (0)
#endif
#define XB_TMO      128
#define XB_XCNT(j)  (256  + 64 * (j))
#define XB_XSUB(j)  (1280 + 64 * (j))
#define XB_XGEN(j)  (2304 + 64 * (j))
#define XB_TOP      3328
#define XB_TOPGEN   3392
#define XCD_BAR_WORDS 3456
#define XB_SPIN_CAP (1u << 18)

__device__ __forceinline__ unsigned xb_ld(unsigned* p)              { return __hip_atomic_load(p, __ATOMIC_RELAXED, __HIP_MEMORY_SCOPE_AGENT); }
__device__ __forceinline__ unsigned xb_add(unsigned* p, unsigned v) { return __hip_atomic_fetch_add(p, v, __ATOMIC_RELAXED, __HIP_MEMORY_SCOPE_AGENT); }
__device__ __forceinline__ unsigned xb_xcc_id() { return (unsigned)__builtin_amdgcn_s_getreg((3 << 11) | 20) & 0xFu; }
#define XB_SPIN(cond, bar) do { unsigned _sp = 0; while (cond) { __builtin_amdgcn_s_sleep(1); \
    if ((++_sp & 255u) == 0u) { if (xb_ld(&(bar)[XB_TMO])) break; if (_sp > XB_SPIN_CAP) { atomicAdd(&(bar)[XB_TMO], 1u); break; } } } } while (0)

struct XcdBarrier {
    unsigned* bar; unsigned x;
    volatile LAS unsigned* st;
};

__device__ __forceinline__ XcdBarrier xcd_barrier_post(unsigned* bar, volatile LAS unsigned* st) {
    XcdBarrier b; b.bar = bar; b.x = xb_xcc_id(); b.st = st;
    if (threadIdx.x == 0) (void)xb_add(&bar[XB_XCNT(b.x)], 1u);
    return b;
}
__device__ __forceinline__ void xcd_barrier_complete(unsigned* bar, unsigned x, unsigned& nloc, unsigned& nx) {
    const unsigned G = gridDim.x * gridDim.y * gridDim.z;
    unsigned sum, cnt, mine, sp = 0u;
    for (;;) {
        sum = 0u; cnt = 0u; mine = 0u;
#pragma unroll
        for (unsigned j = 0; j < 16; ++j) { const unsigned c = xb_ld(&bar[XB_XCNT(j)]); sum += c; cnt += (c > 0u) ? 1u : 0u; mine = (j == x) ? c : mine; }
        if (sum == G) break;
        __builtin_amdgcn_s_sleep(1);
        if ((++sp & 255u) == 0u) { if (xb_ld(&bar[XB_TMO])) break; if (sp > XB_SPIN_CAP) { atomicAdd(&bar[XB_TMO], 1u); break; } }
    }
    nloc = mine > 0u ? mine : 1u; nx = cnt > 0u ? cnt : 1u;
}

__device__ __forceinline__ void xcd_barrier(const XcdBarrier& b) {
    asm volatile("s_waitcnt vmcnt(0)" ::: "memory");
    __syncthreads();
    if (threadIdx.x == 0) {
        unsigned* bar = b.bar;
        __builtin_amdgcn_s_waitcnt(0);
        unsigned nloc = b.st[0], nx = b.st[1];
        if (nloc == 0u) { xcd_barrier_complete(bar, b.x, nloc, nx); b.st[0] = nloc; b.st[1] = nx; }
        const unsigned old = xb_add(&bar[XB_XSUB(b.x)], 1u);
        const unsigned gen = old / nloc;
        if (old + 1u == (gen + 1u) * nloc) {
            __builtin_amdgcn_fence(__ATOMIC_RELEASE, "agent");
            asm volatile("s_waitcnt vmcnt(0)" ::: "memory");
            const unsigned og = xb_add(&bar[XB_TOP], 1u);
            const unsigned tg = og / nx;
            if (og + 1u == (tg + 1u) * nx) xb_add(&bar[XB_TOPGEN], 1u);
            else XB_SPIN(xb_ld(&bar[XB_TOPGEN]) == tg, bar);
            __builtin_amdgcn_fence(__ATOMIC_ACQUIRE, "agent");
            xb_add(&bar[XB_XGEN(b.x)], 1u);
            asm volatile("s_waitcnt vmcnt(0)" ::: "memory");
        } else {
            XB_SPIN(xb_ld(&bar[XB_XGEN(b.x)]) == gen, bar);
            __builtin_amdgcn_fence(__ATOMIC_ACQUIRE, "agent");
            asm volatile("s_waitcnt vmcnt(0)" ::: "memory");
        }
    }
    __syncthreads();
}

__global__ void __launch_bounds__(NTHREADS, 2) fwd_kernel(Params P) {
    extern __shared__ __attribute__((aligned(16))) unsigned char lds_raw[];
    cg::grid_group grid = cg::this_grid();
    const int tid_ = threadIdx.x;
    const Ctx CK{(LAS unsigned char*)lds_raw, P.ws, P, P.out, tid_, tid_ & 63, __builtin_amdgcn_readfirstlane(tid_ >> 6), (int)gridDim.x, (int)blockIdx.x, 0};
    volatile LAS unsigned* xb_st = (volatile LAS unsigned*)(CK.lds + 139264);
    if (tid_ < 2) xb_st[tid_] = 0u;
    __syncthreads();
    const XcdBarrier xbar = xcd_barrier_post((unsigned*)P.ws + 4096, xb_st);
#define GSYNC() xcd_barrier(xbar)
#ifdef PROBE
#define TS(k) do { if (tid_ == 0 && blockIdx.x == 0) ((volatile LAS unsigned long long*)(CK.lds + 131072))[k] = __builtin_amdgcn_s_memrealtime(); } while (0)
#else
#define TS(k) do { } while (0)
#endif
#define PH_BEGIN { const Ctx C = rectx(CK); LAS unsigned char* glds = C.lds;
#define PH_END }
#define ABUF WSP(bf16, WS_A)
#define HCB WSP(float, WS_HC)
#define MODL(ll) (WSP(float, WS_MOD) + (size_t)(ll) * 33 * 6144)
#define HIN_L ((l == 0) ? C.P.in[0 + C.z] : (const float*)C.out)
#define HIN_C ((l == 0) ? C.P.in[2 + C.z] : (const float*)HCB)
#define GEMM_STD(Aptr, Bptr, M_, N_, K_, EPI, ...) do { pg8::Gemm g{Aptr, Bptr, M_, N_, K_}; pg8::StaticOrder S; S.init(M_, N_, C.G, C.bid); EPI E{__VA_ARGS__}; pg8::gemm_phase<EPI, pg8::StaticOrder, true, true>(glds, g, S, E); } while (0)
    TS(40);
    prologue(CK);
    grid.sync(); TS(41);
    { const int l = 0; DBGCHK(0); }
    for (int l = 0; l < 2; ++l) {
        TS(l * 16 + 0);
        const int Mmix = (l == 0) ? NT : NLAT;
        if (l == 0) { PH_BEGIN rowop<false, true>(C, NT, HIN_L, HIN_C, nullptr, nullptr, nullptr, 0, nullptr, C.P.in[6 + C.z] + l * DM, 0, 1, MODL(l), MODL(l), ABUF); PH_END GSYNC(); TS(l * 16 + 1); DBGCHK(1); }
        PH_BEGIN
            GEMM_STD(ABUF, WL(bf16, l, WL_IN), NT, NIN, DM, EpiIn, WSP(bf16, WS_X + X_QKV), WSP(bf16, WS_X + X_ZT), WSP(bf16, WS_X + X_ZTC), WSP(bf16, WS_X + X_UR));
        PH_END
        GSYNC(); TS(l * 16 + 2); DBGCHK(2);
        feat1_phase(CK, l);
        GSYNC();
        PH_BEGIN GEMM_STD(WSP(bf16, WS_A), WSP(bf16, WS_WLORA + (size_t)l * 2 * MiB), NT, (l == 0 ? 1280 : NLO), (l == 0 ? 384 : KLO), EpiStore, WSP(bf16, WS_X + X_LO), NLO, 0, 0, 256); PH_END
        GSYNC();
        feat3_phase(CK, l);
        GSYNC(); TS(l * 16 + 3); DBGCHK(3);
        if (CK.bid < 256) scan_run(CK, l, CK.bid >> 3, (CK.bid >> 1) & 3, CK.bid & 1);
        __syncthreads(); TS(l * 16 + 15);
        {
            PH_BEGIN
                pg8::Gemm g{WSP(bf16, WS_DFT), WSP(bf16, WS_X + X_ZT), 2048, 8192, 4096}; pg8::StaticOrder S; S.init(2048, 8192, C.G, C.bid);
                EpiStore E{WSP(bf16, WS_A + (size_t)72 * MiB), 256, 0, 2048, 0};
                pg8::gemm_phase<EpiStore, pg8::StaticOrder, true, true>(glds, g, S, E);
            PH_END
            if (l == 0) { PH_BEGIN
                pg8::Gemm g{WSP(bf16, WS_DFTC), WSP(bf16, WS_X + X_ZTC), 256, 8192, 512}; pg8::StaticOrder S; S.init(256, 8192, C.G, C.bid);
                EpiStore E{WSP(bf16, WS_A + (size_t)72 * MiB), 256, CTXB, 256, 0};
                pg8::gemm_phase<EpiStore, pg8::StaticOrder, true, true>(glds, g, S, E);
            PH_END }
        }
        attn_loop(CK, l);
        GSYNC(); TS(l * 16 + 4); DBGCHK(4);
        readout_phase(CK, l, Mmix);
        GSYNC(); TS(l * 16 + 5);
        PH_BEGIN GEMM_STD(WSP(bf16, WS_A + (size_t)108 * MiB), WL(bf16, l, WL_BR), Mmix, 1024, 256, EpiStore, WSP(bf16, WS_X + X_PP), NGATE, 0, 0, 256); PH_END
        PH_BEGIN GEMM_STD(WSP(bf16, WS_A), WL(bf16, l, WL_BA), Mmix, 1024, 512, EpiStore, WSP(bf16, WS_X + X_PP) + 1024, NGATE, 0, 0, 256); PH_END
        PH_BEGIN GEMM_STD(WSP(bf16, WS_A + (size_t)72 * MiB), WL(bf16, l, WL_BF), Mmix, 1024, 256, EpiStore, WSP(bf16, WS_X + X_PP) + 2048, NGATE, 0, 0, 256); PH_END
        GSYNC(); TS(l * 16 + 6); DBGCHK(5);
        PH_BEGIN rowop<false, true>(C, Mmix, HIN_L, HIN_C, nullptr, nullptr, nullptr, 0, nullptr, C.P.in[6 + C.z] + l * DM, 0, 1, MODL(l), MODL(l), ABUF); PH_END
        GSYNC(); TS(l * 16 + 7);
        PH_BEGIN
            pg8::Gemm g{ABUF, WL(bf16, l, WL_G), Mmix, NGATE, DM}; GateOrder S{(Mmix / 256) * 4, C.G, C.bid};
            EpiGate E{WSP(bf16, WS_X + X_PP), WSP(bf16, WS_X + X_UR)};
            pg8::gemm_phase<EpiGate, GateOrder, true, true>(glds, g, S, E);
        PH_END
        GSYNC(); TS(l * 16 + 8); DBGCHK(6);
        PH_BEGIN GEMM_STD(WSP(bf16, WS_X + X_UR), WL(bf16, l, WL_O), Mmix, DM, DM, EpiStore, WSP(bf16, WS_X + X_MIX), DM, 0, 0, 256); PH_END
        GSYNC(); TS(l * 16 + 9); DBGCHK(7);
        PH_BEGIN rowop<true, true>(C, Mmix, HIN_L, HIN_C, C.out, HCB, WSP(bf16, WS_X + X_MIX), 2, C.P.in[7 + C.z] + l * DM, C.P.in[8 + C.z] + l * DM, 3, 4, MODL(l), MODL(l), ABUF); PH_END
        GSYNC(); TS(l * 16 + 10); DBGCHK(8);
        PH_BEGIN GEMM_STD(ABUF, WL(bf16, l, WL_UP), Mmix, 2 * DFF, DM, EpiUp, WSP(bf16, WS_X + X_HH), WSP(bf16, WS_X + X_HALO), C.P.in[31 + C.z] + (size_t)l * 3 * DFF, C.P.in[32 + C.z] + (size_t)l * DFF); PH_END
        GSYNC(); TS(l * 16 + 11);
        fixup_phase(CK, l, Mmix);
        GSYNC(); TS(l * 16 + 12); DBGCHK(9);
        PH_BEGIN GEMM_STD(WSP(bf16, WS_X + X_HH), WL(bf16, l, WL_DN), Mmix, DM, DFF, EpiStore, WSP(bf16, WS_X + X_FFO), DM, 0, 0, 256); PH_END
        GSYNC(); TS(l * 16 + 13); DBGCHK(10);
        if (l == 0) { PH_BEGIN rowop<true, true>(C, NT, C.out, HCB, C.out, HCB, WSP(bf16, WS_X + X_FFO), 5, C.P.in[9 + C.z] + l * DM, C.P.in[6 + C.z] + (l + 1) * DM, 0, 1, MODL(l), MODL(l + 1), ABUF); PH_END GSYNC(); TS(l * 16 + 14); }
        else { PH_BEGIN rowop<true, false>(C, NLAT, C.out, HCB, C.out, HCB, WSP(bf16, WS_X + X_FFO), 5, C.P.in[9 + C.z] + l * DM, nullptr, 0, 1, MODL(l), MODL(l), nullptr); PH_END }
    }
#ifdef DBG
    grid.sync(); dbg_report(CK);
#endif
#ifdef PROBE
    grid.sync(); TS(60);
    TS(61);
    grid.sync();
    if (blockIdx.x == 0) {
        volatile LAS unsigned long long* ts = (volatile LAS unsigned long long*)(CK.lds + 131072);
#ifdef PROBE_PRO
        unsigned long long d = (ts[60] - ts[40]) / 10ull;
#else
        unsigned long long d = 0; for (int ll = 0; ll < 2; ++ll) d += ts[ll * 16 + PROBE_B] - ts[ll * 16 + PROBE_A];
#endif
        const int n = (int)(d / 500ull);
        for (int i = tid_; i < n; i += NTHREADS) P.out[1000000 + i] += 0.15f;
    }
#endif
}


extern "C" void kernel_launch(void* const* d_in, const int* in_sizes, int n_in, void* d_out, int out_size, void* d_ws, size_t ws_size, hipStream_t stream) {
    static int grid = 0;
    if (grid == 0) {
        if (n_in != 34 || out_size != NLAT * DM || ws_size < WS_TOTAL) { fprintf(stderr, "kernel_launch: unexpected shapes (n_in %d out %d ws %zu, need %zu)\n", n_in, out_size, ws_size, (size_t)WS_TOTAL); grid = -1; return; }
        int dev = 0, cus = 0, per_cu = 0;
        hipGetDevice(&dev); hipDeviceGetAttribute(&cus, hipDeviceAttributeMultiprocessorCount, dev);
        if (hipFuncSetAttribute((const void*)fwd_kernel, hipFuncAttributeMaxDynamicSharedMemorySize, LDS_BYTES) != hipSuccess) { fprintf(stderr, "kernel_launch: hipFuncSetAttribute failed\n"); grid = -1; return; }
        hipOccupancyMaxActiveBlocksPerMultiprocessor(&per_cu, (const void*)fwd_kernel, NTHREADS, LDS_BYTES);
        (void)hipGetLastError();
        if (per_cu < 1 || cus < 256) { fprintf(stderr, "kernel_launch: occupancy %d, cus %d\n", per_cu, cus); grid = -1; return; }
        grid = 256;
    }
    if (grid < 0) return;
    (void)hipMemsetAsync((char*)d_ws + WS_CTL, 0, 65536, stream);
    Params p{};
    for (int i = 0; i < 34; ++i) p.in[i] = (const float*)d_in[i];
    p.out = (float*)d_out; p.ws = (unsigned char*)d_ws;
    void* args[] = {&p};
    hipError_t e = hipLaunchCooperativeKernel((const void*)fwd_kernel, dim3(grid), dim3(NTHREADS), args, LDS_BYTES, stream);
    if (e != hipSuccess) fprintf(stderr, "kernel_launch: cooperative launch failed: %s (grid %d)\n", hipGetErrorString(e), grid);
}
```

```cpp
#define PROBE_A 3
#define PROBE_B 4
#include <hip/hip_runtime.h>
#include <hip/hip_cooperative_groups.h>
#include <cstdio>
#include <cstdint>
namespace cg = cooperative_groups;
__device__ __forceinline__ int otid() { int t = threadIdx.x; asm volatile("" : "+v"(t)); return t; }
namespace pg8 {
#define PG8_LAS __attribute__((address_space(3)))
typedef unsigned short bf16_t;
typedef short bf16x8 __attribute__((ext_vector_type(8)));
typedef float f32x4 __attribute__((ext_vector_type(4)));
typedef unsigned u32x4 __attribute__((ext_vector_type(4)));
constexpr int BM = 256, BK = 64, HALF = 128, HTB = HALF * BK * 2  , STAGE_BYTES = 8 * HTB, NXCD = 8, WGM = 4;

__host__ __device__ __forceinline__ int lds_byte(int r, int c) { const int st = (r >> 4) * 2 + (c >> 5), rr = r & 15, cc = c & 31, ob = rr * 64 + cc * 2; return st * 1024 + (ob ^ (((ob >> 9) & 1) << 5)); }
__host__ __device__ __forceinline__ void stage_rc(int b, int& R, int& C) { const int st = b / 1024, sb = b % 1024, swz = sb ^ (((sb >> 9) & 1) << 5); R = (st >> 1) * 16 + swz / 64; C = (st & 1) * 32 + (swz % 64) / 2; }
__host__ __device__ __forceinline__ int perm32(int rho) { const int n = rho >> 4, i = rho & 15; return 8 * (i >> 2) + 4 * n + (i & 3); }

struct Unit { int pm, pn; };
struct Gemm { const bf16_t* A; const bf16_t* Bt; int M, N, K; };

struct StaticOrder {
    int nM, nN, nwg, G, c;
    __host__ __device__ void init(int M, int N, int G_, int c_) { nM = M / BM; nN = N / BM; nwg = nM * nN; G = G_; c = c_; }
    __host__ __device__ bool next(int i, Unit& u) const {
        const long L = (long)i * G + c; if (L >= nwg) return false;
        int wgid = (int)L; { const int q = nwg / NXCD, r = nwg % NXCD, xcd = wgid % NXCD, off = wgid / NXCD; wgid = (xcd < r ? xcd * (q + 1) : r * (q + 1) + (xcd - r) * q) + off; }
        const int nig = WGM * nN, gid = wgid / nig, fm = gid * WGM, gsz = (nM - fm) < WGM ? (nM - fm) : WGM;
        u.pm = fm + ((wgid % nig) % gsz); u.pn = (wgid % nig) / gsz; return true;
    }
    __device__ __forceinline__ void a_ready(const Unit&) const {}
    __device__ __forceinline__ void done(const Unit&) const {}
};

__device__ __forceinline__ unsigned cvt_pk_bf16(float lo, float hi) { unsigned r; asm volatile("v_cvt_pk_bf16_f32 %0, %1, %2" : "=v"(r) : "v"(lo), "v"(hi)); return r; }
typedef float f32x2 __attribute__((ext_vector_type(2)));
__device__ __forceinline__ f32x2 gelu_pk(f32x2 v) {
    const f32x2 av = __builtin_elementwise_abs(v), d = av * 0.2316418882f + 1.0f;
    f32x2 t; t.x = __builtin_amdgcn_rcpf(d.x); t.y = __builtin_amdgcn_rcpf(d.y);
    f32x2 q = t * 0.5307027145f + (-0.7265760135f); q = q * t + 0.7107068705f; q = q * t + (-0.142248368f); q = q * t + 0.127414796f; q = q * t;
    const f32x2 s = (v * v) * (-0.72134752044f);
    f32x2 e; e.x = __builtin_amdgcn_exp2f(s.x); e.y = __builtin_amdgcn_exp2f(s.y);
    const f32x2 m = v * (q * e), r = v - m;
    f32x2 o; o.x = v.x < 0.f ? m.x : r.x; o.y = v.y < 0.f ? m.y : r.y; return o;
}

template <class Epi, class Sched, bool ALIGN_EPI = false, bool SP2 = false>
__device__ __forceinline__ void gemm_phase(PG8_LAS unsigned char* lds, const Gemm g, const Sched& S, const Epi& E) {
    const int tid = otid(), wid = __builtin_amdgcn_readfirstlane(tid >> 6), lane = tid & 63, wr = wid >> 2, wc = wid & 3, fr = lane & 15, fq = lane >> 4;
    const int K = g.K, nt = K / BK;
    unsigned voffA[2], voffB[2];
#pragma unroll
    for (int i = 0; i < 2; ++i) { int R, C; stage_rc(tid * 16 + i * 8192, R, C); const int Rb = Epi::PERM ? ((R & ~31) + perm32(R & 31)) : R;
        const int Ra = Epi::PERMA ? ((R & 64) + 4 * (R & 15) + ((R >> 4) & 3)) : R;
        voffA[i] = (unsigned)(Ra * K + C) * 2u; voffB[i] = (unsigned)(Rb * K + C) * 2u; }
    const size_t kstep = (size_t)(BK * 2);
    const size_t hstep = (size_t)HALF * K * 2;
    const size_t tstep = 2 * hstep;
    const unsigned ldsw = (unsigned)wid * 1024u;
    const int aoff = lds_byte(wr * 64 + fr, fq * 8), boff = lds_byte(wc * 32 + fr, fq * 8);
#define PG8_SA(b, h) (((b) * 2 + (h)) * HTB)
#define PG8_SB(b, h) ((4 + (b) * 2 + (h)) * HTB)
#define PG8_STAGE(bufoff, gbase, voff) do { _Pragma("unroll") for (int _i = 0; _i < 2; ++_i) \
        __builtin_amdgcn_global_load_lds((const unsigned*)((const char*)(gbase) + (voff)[_i]), (PG8_LAS unsigned*)(lds + (bufoff) + ldsw + _i * 8192), 16, 0, 0); } while (0)
#define PG8_LDA(dst, b, h) do { _Pragma("unroll") for (int m = 0; m < 4; ++m) _Pragma("unroll") for (int k = 0; k < 2; ++k) dst[m][k] = *(const PG8_LAS bf16x8*)(lds + PG8_SA(b, h) + aoff + m * 2048 + k * 1024); } while (0)
#define PG8_LDB(dst, b, h) do { _Pragma("unroll") for (int n = 0; n < 2; ++n) _Pragma("unroll") for (int k = 0; k < 2; ++k) dst[n][k] = *(const PG8_LAS bf16x8*)(lds + PG8_SB(b, h) + boff + n * 2048 + k * 1024); } while (0)
#define PG8_MMA(ai, bj, At, Bt) do { __builtin_amdgcn_s_setprio(1); _Pragma("unroll") for (int m = 0; m < 4; ++m) _Pragma("unroll") for (int n = 0; n < 2; ++n) _Pragma("unroll") for (int k = 0; k < 2; ++k) \
        acc[ai][bj][m][n] = __builtin_amdgcn_mfma_f32_16x16x32_bf16(Bt[n][k], At[m][k], acc[ai][bj][m][n], 0, 0, 0); __builtin_amdgcn_s_setprio(0); } while (0)
#define PG8_WAIT_V(n) asm volatile("s_waitcnt vmcnt(" #n ")" ::: "memory")
#define PG8_WAIT_L(n) asm volatile("s_waitcnt lgkmcnt(" #n ")" ::: "memory")
#define PG8_BAR __builtin_amdgcn_s_barrier()
#define PG8_SCHED __builtin_amdgcn_sched_barrier(0)
    Unit cur, nxt; int ui = 0;
    if (!S.next(0, cur)) return;
    f32x4 acc[2][2][4][2];
#pragma unroll
    for (int a = 0; a < 2; ++a)
#pragma unroll
        for (int b = 0; b < 2; ++b)
#pragma unroll
            for (int m = 0; m < 4; ++m)
#pragma unroll
                for (int n = 0; n < 2; ++n) acc[a][b][m][n] = (f32x4){0.f, 0.f, 0.f, 0.f};
    bf16x8 At[4][2], B0[2][2], B1[2][2];
    const char* cA = (const char*)g.A + (size_t)cur.pm * tstep; const char* cB = (const char*)g.Bt + (size_t)cur.pn * tstep;
    S.a_ready(cur);
    if constexpr (SP2) {
        PG8_STAGE(PG8_SB(0, 0), cB, voffB); PG8_STAGE(PG8_SB(0, 1), cB + hstep, voffB); PG8_STAGE(PG8_SA(0, 0), cA, voffA); PG8_STAGE(PG8_SA(0, 1), cA + hstep, voffA);
        if (wr == 1) PG8_BAR;
        PG8_WAIT_V(2); PG8_BAR;
        PG8_STAGE(PG8_SB(1, 0), cB + kstep, voffB); PG8_STAGE(PG8_SA(1, 0), cA + kstep, voffA); PG8_STAGE(PG8_SB(1, 1), cB + hstep + kstep, voffB);
        PG8_WAIT_V(6); PG8_BAR;
    } else {
        PG8_STAGE(PG8_SB(0, 0), cB, voffB); PG8_STAGE(PG8_SA(0, 0), cA, voffA); PG8_STAGE(PG8_SB(0, 1), cB + hstep, voffB); PG8_STAGE(PG8_SA(0, 1), cA + hstep, voffA);
        if (wr == 1) PG8_BAR;
        PG8_WAIT_V(4); PG8_BAR;
        PG8_STAGE(PG8_SB(1, 0), cB + kstep, voffB); PG8_STAGE(PG8_SA(1, 0), cA + kstep, voffA); PG8_STAGE(PG8_SB(1, 1), cB + hstep + kstep, voffB);
        PG8_WAIT_V(6); PG8_BAR;
    }
    for (;;) {
        const bool has_next = S.next(ui + 1, nxt);
        const char* nA = has_next ? (const char*)g.A + (size_t)nxt.pm * tstep : cA; const char* nB = has_next ? (const char*)g.Bt + (size_t)nxt.pn * tstep : cB;
        for (int t = 0; t < nt; t += 2) {
            const bool last = (t == nt - 2);
            const char* a1 = cA + (size_t)(t + 1) * kstep;
            const char* a2 = last ? nA : cA + (size_t)(t + 2) * kstep; const char* b2 = last ? nB : cB + (size_t)(t + 2) * kstep;
            const char* a3 = a2 + kstep; const char* b3 = b2 + kstep;
            if (last && has_next) S.a_ready(nxt);
            if constexpr (SP2) {
            PG8_LDB(B0, 0, 0); PG8_LDB(B1, 0, 1); PG8_SCHED; PG8_LDA(At, 0, 0); PG8_STAGE(PG8_SA(1, 1), a1 + hstep, voffA);
            PG8_WAIT_V(8); PG8_WAIT_L(0); PG8_BAR; PG8_MMA(0, 0, At, B0); PG8_MMA(0, 1, At, B1); PG8_BAR; PG8_SCHED;
            PG8_LDA(At, 0, 1); PG8_STAGE(PG8_SB(0, 0), b2, voffB); PG8_STAGE(PG8_SB(0, 1), b2 + hstep, voffB); PG8_STAGE(PG8_SA(0, 0), a2, voffA);
            PG8_WAIT_V(8); PG8_WAIT_L(0); PG8_BAR; PG8_MMA(1, 0, At, B0); PG8_MMA(1, 1, At, B1); PG8_BAR; PG8_SCHED;
            PG8_LDB(B0, 1, 0); PG8_LDB(B1, 1, 1); PG8_SCHED; PG8_LDA(At, 1, 0); PG8_STAGE(PG8_SA(0, 1), a2 + hstep, voffA);
            PG8_WAIT_V(8); PG8_WAIT_L(0); PG8_BAR; PG8_MMA(0, 0, At, B0); PG8_MMA(0, 1, At, B1); PG8_BAR; PG8_SCHED;
            PG8_LDA(At, 1, 1); PG8_STAGE(PG8_SB(1, 0), b3, voffB); PG8_STAGE(PG8_SB(1, 1), b3 + hstep, voffB); PG8_STAGE(PG8_SA(1, 0), a3, voffA);
            PG8_WAIT_V(8); PG8_WAIT_L(0); PG8_BAR; PG8_MMA(1, 0, At, B0); PG8_MMA(1, 1, At, B1); PG8_BAR; PG8_SCHED;
            } else {
            PG8_LDB(B0, 0, 0); PG8_SCHED; PG8_LDA(At, 0, 0); PG8_STAGE(PG8_SA(1, 1), a1 + hstep, voffA);
            PG8_WAIT_L(8); PG8_BAR; PG8_WAIT_L(0); PG8_MMA(0, 0, At, B0); PG8_BAR; PG8_SCHED;
            PG8_LDB(B1, 0, 1); PG8_STAGE(PG8_SB(0, 0), b2, voffB);
            PG8_BAR; PG8_WAIT_L(0); PG8_MMA(0, 1, At, B1); PG8_BAR;
            PG8_LDA(At, 0, 1); PG8_STAGE(PG8_SA(0, 0), a2, voffA);
            PG8_BAR; PG8_WAIT_L(0); PG8_MMA(1, 0, At, B0); PG8_BAR; PG8_SCHED;
            PG8_STAGE(PG8_SB(0, 1), b2 + hstep, voffB);
            PG8_WAIT_V(6); PG8_BAR; PG8_MMA(1, 1, At, B1); PG8_BAR;
            PG8_LDB(B0, 1, 0); PG8_SCHED; PG8_LDA(At, 1, 0); PG8_STAGE(PG8_SA(0, 1), a2 + hstep, voffA);
            PG8_WAIT_L(8); PG8_BAR; PG8_WAIT_L(0); PG8_MMA(0, 0, At, B0); PG8_BAR; PG8_SCHED;
            PG8_LDB(B1, 1, 1); PG8_STAGE(PG8_SB(1, 0), b3, voffB);
            PG8_BAR; PG8_WAIT_L(0); PG8_MMA(0, 1, At, B1); PG8_BAR;
            PG8_LDA(At, 1, 1); PG8_STAGE(PG8_SA(1, 0), a3, voffA);
            PG8_BAR; PG8_WAIT_L(0); PG8_MMA(1, 0, At, B0); PG8_BAR; PG8_SCHED;
            PG8_STAGE(PG8_SB(1, 1), b3 + hstep, voffB);
            PG8_WAIT_V(6); PG8_BAR; PG8_MMA(1, 1, At, B1); PG8_BAR;
            }
        }
        if constexpr (ALIGN_EPI) { if (wr == 0) PG8_BAR; }
        if constexpr (!Epi::AFTER_DRAIN) { E(acc, cur, wr, wc, fr, fq); S.done(cur); }
        if (!has_next) break;
#pragma unroll
        for (int a = 0; a < 2; ++a)
#pragma unroll
            for (int b = 0; b < 2; ++b)
#pragma unroll
                for (int m = 0; m < 4; ++m)
#pragma unroll
                    for (int n = 0; n < 2; ++n) acc[a][b][m][n] = (f32x4){0.f, 0.f, 0.f, 0.f};
        cur = nxt; cA = nA; cB = nB; ++ui;
        if constexpr (ALIGN_EPI) { if (wr == 1) PG8_BAR; }
    }
    PG8_WAIT_V(0);
    if constexpr (!ALIGN_EPI) { if (wr == 0) PG8_BAR; }
    PG8_BAR;
    if constexpr (Epi::AFTER_DRAIN) { E.fused(acc, cur, wr, wc, fr, fq, lds, wid, lane); S.done(cur); }
#undef PG8_SA
#undef PG8_SB
#undef PG8_STAGE
#undef PG8_LDA
#undef PG8_LDB
#undef PG8_MMA
#undef PG8_WAIT_V
#undef PG8_WAIT_L
#undef PG8_BAR
#undef PG8_SCHED
}
}

#define DI __device__ __forceinline__
#define LAS __attribute__((address_space(3)))
typedef unsigned short bf16;
typedef float f32x4 __attribute__((ext_vector_type(4)));
typedef float f32x2 __attribute__((ext_vector_type(2)));
typedef float f32x16 __attribute__((ext_vector_type(16)));
typedef short bf16x8 __attribute__((ext_vector_type(8)));
typedef short s16x4 __attribute__((ext_vector_type(4)));
typedef unsigned u32x4 __attribute__((ext_vector_type(4)));
typedef unsigned u32x2 __attribute__((ext_vector_type(2)));
typedef __bf16 bf16x2_t __attribute__((ext_vector_type(2)));

constexpr int DM = 1024, NB = 32, TL = 2048, TC = 256, NLAT = NB * TL, NCTX = NB * TC, NT = NLAT + NCTX, CTXB = NLAT;
constexpr int DFF = 2816, RW = 1152, NIN = 2560, NGATE = 3072;
constexpr int IN_COLS = 5248;
constexpr float LOG2E = 1.4426950408889634f;
constexpr int NTHREADS = 512, NWAVES = 8;
constexpr int LDS_BYTES = 147456;

constexpr size_t MiB = 1u << 20;
constexpr size_t WS_CTL = 0;
constexpr size_t WS_MOD = 1 * MiB;
constexpr size_t WS_SMALL = 3 * MiB;
constexpr size_t WS_BON = 4 * MiB;
constexpr size_t WS_W = 6 * MiB;
constexpr size_t WL_IN = 0, WL_G = 5 * MiB, WL_BR = 11 * MiB, WL_BA = 11 * MiB + 512 * 1024, WL_BF = 12 * MiB + 512 * 1024, WL_O = 13 * MiB, WL_UP = 15 * MiB, WL_DN = 26 * MiB, WL_SIZE = 32 * MiB;
constexpr size_t WS_DFT = WS_W + 2 * WL_SIZE;
constexpr size_t WS_DFTC = WS_DFT + 16 * MiB;
constexpr size_t WS_HC = WS_DFTC + 1 * MiB;
constexpr size_t WS_A = WS_HC + 32 * MiB;
constexpr size_t WS_VF = WS_A + 144 * MiB;
constexpr size_t WS_X = WS_VF + 36 * MiB;
constexpr size_t X_F = 0;
constexpr size_t X_QKV = 288 * MiB;
constexpr size_t X_ZT = 396 * MiB;
constexpr size_t X_ZTC = 460 * MiB;
constexpr size_t X_UR = 504 * MiB;
constexpr size_t X_G = 468 * MiB;
constexpr size_t X_LO = 504 * MiB;
constexpr size_t X_END = 720 * MiB;
constexpr size_t WS_WLORA = WS_X + X_END;
constexpr int KLO = 640, NLO = 1536;
constexpr size_t X_PP = 0;
constexpr size_t X_MIX = 0;
constexpr size_t X_HH = 0;
constexpr size_t X_HALO = 396 * MiB;
constexpr size_t X_FFO = 436 * MiB;
constexpr size_t WS_TOTAL = WS_WLORA + 4 * MiB;
constexpr size_t FSZ = (size_t)NT * 256;

struct Params { const float* in[34]; float* out; unsigned char* ws; };

DI float bf2f(bf16 v) { return __builtin_bit_cast(float, (unsigned)v << 16); }
DI float lo2f(unsigned u) { return __builtin_bit_cast(float, u << 16); }
DI float hi2f(unsigned u) { return __builtin_bit_cast(float, u & 0xffff0000u); }
DI unsigned pk(float lo, float hi) { f32x2 v = {lo, hi}; bf16x2_t b = __builtin_convertvector(v, bf16x2_t); return __builtin_bit_cast(unsigned, b); }
DI bf16 f2bf(float x) { return (bf16)(pk(x, 0.f) & 0xffffu); }
DI float fexp2(float x) { return __builtin_amdgcn_exp2f(x); }
DI float frcp(float x) { return __builtin_amdgcn_rcpf(x); }
DI float sigm(float x) { return frcp(1.f + fexp2(-x * LOG2E)); }
DI f32x2 sigm2(f32x2 x) { const f32x2 t = x * (-LOG2E); f32x2 e; e.x = fexp2(t.x); e.y = fexp2(t.y); const f32x2 d = e + 1.f; f32x2 r; r.x = frcp(d.x); r.y = frcp(d.y); return r; }
DI float tanh_(float x) { return 2.f * sigm(2.f * x) - 1.f; }
DI float gelu_tanh(float z) { const float u = 1.5957691216057308f * (z + 0.044715f * z * z * z); return z * sigm(u); }
DI float wave_sum(float v) {
#pragma unroll
    for (int o = 1; o < 64; o <<= 1) v += __shfl_xor(v, o);
    return v;
}
template <int CTRL, bool BC> DI float dppf(float old, float src) {
    return __builtin_bit_cast(float, __builtin_amdgcn_update_dpp(__builtin_bit_cast(int, old), __builtin_bit_cast(int, src), CTRL, 0xf, 0xf, BC));
}
DI float row16_sum(float x) { x += dppf<0x128, true>(0.f, x); x += dppf<0x124, true>(0.f, x); x += dppf<0x122, true>(0.f, x); x += dppf<0x121, true>(0.f, x); return x; }
DI f32x4 bf4(u32x2 u) { return (f32x4){lo2f(u.x), hi2f(u.x), lo2f(u.y), hi2f(u.y)}; }
DI u32x2 pk4(f32x4 v) { u32x2 o; o.x = pk(v[0], v[1]); o.y = pk(v[2], v[3]); return o; }
DI float allred4(float x) {
    unsigned u = __builtin_bit_cast(unsigned, x);
    auto r = __builtin_amdgcn_permlane16_swap(u, u, false, false);
    float y = __builtin_bit_cast(float, (unsigned)r[0]) + __builtin_bit_cast(float, (unsigned)r[1]);
    unsigned v = __builtin_bit_cast(unsigned, y);
    auto s = __builtin_amdgcn_permlane32_swap(v, v, false, false);
    return __builtin_bit_cast(float, (unsigned)s[0]) + __builtin_bit_cast(float, (unsigned)s[1]);
}

DI u32x4 pack8(const f32x4& a, const f32x4& b) { u32x4 w; w.x = pk(a[0], a[1]); w.y = pk(a[2], a[3]); w.z = pk(b[0], b[1]); w.w = pk(b[2], b[3]); return w; }

struct EpiStore {
    static constexpr bool PERM = true, AFTER_DRAIN = false, PERMA = false;
    bf16* O; int ld; int row_base, row_pn, col_pn; int nt = 0;
    DI void operator()(const f32x4 (&acc)[2][2][4][2], const pg8::Unit& u, int wr, int wc, int fr, int fq) const {
        const int row0 = row_base + u.pn * row_pn + u.pm * 256 + wr * 64 + fr, col0 = u.pn * col_pn + wc * 32 + 8 * fq;
#pragma unroll
        for (int ai = 0; ai < 2; ++ai)
#pragma unroll
            for (int m = 0; m < 4; ++m) { bf16* rowp = O + (size_t)(row0 + ai * 128 + m * 16) * ld + col0;
#pragma unroll
                for (int bj = 0; bj < 2; ++bj) { const u32x4 w = pack8(acc[ai][bj][m][0], acc[ai][bj][m][1]); if (nt) __builtin_nontemporal_store(w, (u32x4*)(rowp + bj * 128)); else *(u32x4*)(rowp + bj * 128) = w; } }
    }
};

struct EpiIn {
    static constexpr bool PERM = true, AFTER_DRAIN = false, PERMA = false;
    bf16 *QKV, *ZT, *ZTC, *UR;
    DI void operator()(const f32x4 (&acc)[2][2][4][2], const pg8::Unit& u, int wr, int wc, int fr, int fq) const {
        const int pn = u.pn, rl0 = wr * 64 + fr, cl = wc * 32 + 8 * fq;
        if (pn < 3) {
#pragma unroll
            for (int ai = 0; ai < 2; ++ai)
#pragma unroll
                for (int m = 0; m < 4; ++m) { bf16* rowp = QKV + (size_t)(u.pm * 256 + rl0 + ai * 128 + m * 16) * 768 + pn * 256 + cl;
#pragma unroll
                    for (int bj = 0; bj < 2; ++bj) __builtin_nontemporal_store(pack8(acc[ai][bj][m][0], acc[ai][bj][m][1]), (u32x4*)(rowp + bj * 128)); }
        } else if (pn < 5) {
            bf16* base; int stride;
            if (u.pm < 256) { const int b = u.pm >> 3, t0 = (u.pm & 7) * 256; base = ZT + (size_t)b * 256 * 4096 + (pn - 3) * 2048 + t0; stride = 4096; }
            else { const int b = u.pm - 256; base = ZTC + (size_t)b * 256 * 512 + (pn - 3) * 256; stride = 512; }
#pragma unroll
            for (int ai = 0; ai < 2; ++ai)
#pragma unroll
                for (int m = 0; m < 4; ++m) { const int rl = rl0 + ai * 128 + m * 16;
#pragma unroll
                    for (int bj = 0; bj < 2; ++bj)
#pragma unroll
                        for (int n = 0; n < 2; ++n)
#pragma unroll
                            for (int e = 0; e < 4; ++e) __builtin_nontemporal_store(f2bf(acc[ai][bj][m][n][e]), base + (size_t)(bj * 128 + cl + 4 * n + e) * stride + rl); }
        } else {
#pragma unroll
            for (int ai = 0; ai < 2; ++ai)
#pragma unroll
                for (int m = 0; m < 4; ++m) { bf16* rowp = UR + (size_t)(u.pm * 256 + rl0 + ai * 128 + m * 16) * RW + (pn - 5) * 256 + cl;
#pragma unroll
                    for (int bj = 0; bj < 2; ++bj) if ((pn - 5) * 256 + bj * 128 < RW) __builtin_nontemporal_store(pack8(acc[ai][bj][m][0], acc[ai][bj][m][1]), (u32x4*)(rowp + bj * 128)); }
        }
    }
};

struct EpiGate {
    static constexpr bool PERM = true, AFTER_DRAIN = false, PERMA = false;
    const bf16* PP; bf16* MG;
    DI void operator()(const f32x4 (&acc)[2][2][4][2], const pg8::Unit& u, int wr, int wc, int fr, int fq) const {
        const int br = u.pn >> 2, cn = u.pn & 3, row0 = u.pm * 256 + wr * 64 + fr, col0 = cn * 256 + wc * 32 + 8 * fq;
#pragma unroll
        for (int ai = 0; ai < 2; ++ai)
#pragma unroll
            for (int m = 0; m < 4; ++m) { const size_t row = (size_t)(row0 + ai * 128 + m * 16);
#pragma unroll
                for (int bj = 0; bj < 2; ++bj) {
                    const u32x4 pp = __builtin_nontemporal_load((const u32x4*)(PP + row * NGATE + br * 1024 + col0 + bj * 128));
                    bf16* mp = MG + row * 1024 + col0 + bj * 128;
                    f32x4 a = acc[ai][bj][m][0], b = acc[ai][bj][m][1];
                    { const f32x2 s0 = sigm2((f32x2){a[0], a[1]}) * (f32x2){lo2f(pp.x), hi2f(pp.x)}, s1 = sigm2((f32x2){a[2], a[3]}) * (f32x2){lo2f(pp.y), hi2f(pp.y)}, s2 = sigm2((f32x2){b[0], b[1]}) * (f32x2){lo2f(pp.z), hi2f(pp.z)}, s3 = sigm2((f32x2){b[2], b[3]}) * (f32x2){lo2f(pp.w), hi2f(pp.w)};
                      a = (f32x4){s0.x, s0.y, s1.x, s1.y}; b = (f32x4){s2.x, s2.y, s3.x, s3.y}; }
                    if (br) { const u32x4 o = *(const u32x4*)mp;
                        a[0] += lo2f(o.x); a[1] += hi2f(o.x); a[2] += lo2f(o.y); a[3] += hi2f(o.y); b[0] += lo2f(o.z); b[1] += hi2f(o.z); b[2] += lo2f(o.w); b[3] += hi2f(o.w); }
                    *(u32x4*)mp = pack8(a, b); } }
    }
};

DI f32x2 gelu2(f32x2 z) {
    const f32x2 u = z * (z * z * 0.044715f + 1.f), t = u * (-1.5957691216057308f * LOG2E);
    f32x2 e; e.x = fexp2(t.x); e.y = fexp2(t.y);
    const f32x2 d = e + 1.f; f32x2 r; r.x = frcp(d.x); r.y = frcp(d.y);
    return z * r;
}
struct EpiUp {
    static constexpr bool PERM = true, AFTER_DRAIN = false, PERMA = true;
    bf16* HH; bf16* HALO; const float* cw; const float* cb;
    DI void operator()(const f32x4 (&acc)[2][2][4][2], const pg8::Unit& u, int wr, int wc, int fr, int fq) const {
        const int j0 = 128 * u.pn + 32 * wc + 8 * fq;
        f32x4 w0[2], w1[2], w2[2], bb[2];
#pragma unroll
        for (int n = 0; n < 2; ++n) { w0[n] = *(const f32x4*)(cw + j0 + 4 * n); w1[n] = *(const f32x4*)(cw + DFF + j0 + 4 * n); w2[n] = *(const f32x4*)(cw + 2 * DFF + j0 + 4 * n); bb[n] = *(const f32x4*)(cb + j0 + 4 * n); }
#pragma unroll
        for (int ai = 0; ai < 2; ++ai) {
            const int grp = u.pm * 4 + ai * 2 + wr;
            bf16* hb = HALO + (size_t)grp * 6 * DFF + j0;
            if (fr == 0) { *(u32x4*)(hb) = pack8(acc[ai][0][0][0], acc[ai][0][0][1]); *(u32x4*)(hb + DFF) = pack8(acc[ai][0][1][0], acc[ai][0][1][1]); *(u32x4*)(hb + 4 * DFF) = pack8(acc[ai][1][0][0], acc[ai][1][0][1]); }
            if (fr == 15) { *(u32x4*)(hb + 2 * DFF) = pack8(acc[ai][0][2][0], acc[ai][0][2][1]); *(u32x4*)(hb + 3 * DFF) = pack8(acc[ai][0][3][0], acc[ai][0][3][1]); *(u32x4*)(hb + 5 * DFF) = pack8(acc[ai][1][3][0], acc[ai][1][3][1]); }
            f32x4 o[4][2];
#pragma unroll
            for (int n = 0; n < 2; ++n)
#pragma unroll
                for (int ep = 0; ep < 2; ++ep) {
                    f32x2 x[4];
#pragma unroll
                    for (int m = 0; m < 4; ++m) x[m] = (f32x2){acc[ai][0][m][n][2 * ep], acc[ai][0][m][n][2 * ep + 1]};
                    f32x2 pv, nx;
                    pv.x = dppf<0x111, true>(0.f, x[3].x); pv.y = dppf<0x111, true>(0.f, x[3].y);
                    nx.x = dppf<0x101, true>(0.f, x[0].x); nx.y = dppf<0x101, true>(0.f, x[0].y);
                    const f32x2 c0 = {w0[n][2 * ep], w0[n][2 * ep + 1]}, c1 = {w1[n][2 * ep], w1[n][2 * ep + 1]}, c2 = {w2[n][2 * ep], w2[n][2 * ep + 1]}, cb2 = {bb[n][2 * ep], bb[n][2 * ep + 1]};
#pragma unroll
                    for (int m = 0; m < 4; ++m) {
                        const f32x2 prev = m ? x[m ? m - 1 : 0] : pv, next = (m < 3) ? x[m < 3 ? m + 1 : 3] : nx;
                        const f32x2 z = c0 * prev + c1 * x[m] + c2 * next + cb2;
                        const f32x2 zv = {acc[ai][1][m][n][2 * ep], acc[ai][1][m][n][2 * ep + 1]};
                        const f32x2 g = gelu2(z) * zv;
                        o[m][n][2 * ep] = g.x; o[m][n][2 * ep + 1] = g.y;
                    }
                }
#pragma unroll
            for (int m = 0; m < 4; ++m) {
                const bool edge = (m == 0 && fr == 0) || (m == 3 && fr == 15);
                if (!edge) __builtin_nontemporal_store(pack8(o[m][0], o[m][1]), (u32x4*)(HH + (size_t)(u.pm * 256 + ai * 128 + wr * 64 + 4 * fr + m) * DFF + j0));
            }
        }
    }
};

struct GateOrder {
    int nU, G, c;
    DI bool next(int i, pg8::Unit& u) const { const int j = i / 3, br = i - 3 * j; const long L = (long)j * G + c; if (L >= nU) return false; u.pm = (int)(L >> 2); u.pn = br * 4 + (int)(L & 3); return true; }
    DI void a_ready(const pg8::Unit&) const {}
    DI void done(const pg8::Unit&) const {}
};

struct Ctx {
    LAS unsigned char* lds; unsigned char* ws; const Params& P; float* out;
    int tid, lane, wave, G, bid, z;
};
DI Ctx rectx(const Ctx& C0) { const int t = otid(); int z = 0; asm volatile("" : "+s"(z)); return Ctx{C0.lds, C0.P.ws + z, C0.P, C0.P.out + z, t, t & 63, __builtin_amdgcn_readfirstlane(t >> 6), C0.G, C0.bid, z}; }
#define WSP(T, off) ((T*)(C.ws + (off)))
#define WL(T, l, off) ((T*)(C.ws + WS_W + (size_t)(l) * WL_SIZE + (off)))

DI void tr_item(const float* src, int ldw, int k0, int n0, bf16* dst, int ldd, int drow0, LAS float* scr, int lane) {
#pragma unroll 8
    for (int i = 0; i < 32; ++i) { const int kk = 2 * i + (lane >> 5); scr[kk * 33 + (lane & 31)] = src[(size_t)(k0 + kk) * ldw + n0 + (lane & 31)]; }
    asm volatile("s_waitcnt lgkmcnt(0)" ::: "memory");
    const int c = lane & 7;
#pragma unroll
    for (int j = 0; j < 4; ++j) { const int n = (lane >> 3) + 8 * j; const LAS float* s = scr + (8 * c) * 33 + n;
        u32x4 o; o.x = pk(s[0 * 33], s[1 * 33]); o.y = pk(s[2 * 33], s[3 * 33]); o.z = pk(s[4 * 33], s[5 * 33]); o.w = pk(s[6 * 33], s[7 * 33]);
        *(u32x4*)(dst + (size_t)(drow0 + n) * ldd + k0 + 8 * c) = o; }
    asm volatile("s_waitcnt lgkmcnt(0)" ::: "memory");
}
DI void tr_matrix(const Ctx& C, int gw, int NGW, const float* src, int ldw, int K, int n_src0, int ncols, bf16* dst, int drow0, LAS float* scr) {
    const int nb = ncols / 32, nit = (K / 64) * nb;
    for (int it = gw; it < nit; it += NGW) { const int kb = it / nb, b = it % nb; tr_item(src, ldw, kb * 64, n_src0 + b * 32, dst, K, drow0 + b * 32, scr, C.lane); }
}

DI void weights_tr(const Ctx& C, int l, int gw, int NGW, LAS float* scr) {
    const float* win = C.P.in[10 + C.z] + (size_t)l * 1024 * IN_COLS;
    bf16* wi = WL(bf16, l, WL_IN);
    tr_matrix(C, gw, NGW, win, IN_COLS, 1024, 1152, 512, wi, 0, scr);
    tr_matrix(C, gw, NGW, win, IN_COLS, 1024, 1664, 128, wi, 512, scr);
    tr_matrix(C, gw, NGW, win, IN_COLS, 1024, 1792, 128, wi, 640, scr);
    tr_matrix(C, gw, NGW, win, IN_COLS, 1024, 0, 1152, wi, 1280, scr);
    tr_matrix(C, gw, NGW, win, IN_COLS, 1024, 2176, 3072, WL(bf16, l, WL_G), 0, scr);
    tr_matrix(C, gw, NGW, C.P.in[26 + C.z] + (size_t)l * 256 * 1024, 1024, 256, 0, 1024, WL(bf16, l, WL_BR), 0, scr);
    tr_matrix(C, gw, NGW, C.P.in[27 + C.z] + (size_t)l * 512 * 1024, 1024, 512, 0, 1024, WL(bf16, l, WL_BA), 0, scr);
    tr_matrix(C, gw, NGW, C.P.in[28 + C.z] + (size_t)l * 256 * 1024, 1024, 256, 0, 1024, WL(bf16, l, WL_BF), 0, scr);
    tr_matrix(C, gw, NGW, C.P.in[29 + C.z] + (size_t)l * 1024 * 1024, 1024, 1024, 0, 1024, WL(bf16, l, WL_O), 0, scr);
    {
        const float* up = C.P.in[30 + C.z] + (size_t)l * 1024 * 2 * DFF; bf16* wu = WL(bf16, l, WL_UP);
        for (int it = gw; it < 16 * 44 * 4; it += NGW) { const int kb = it / 176, r = it % 176, seg = r >> 2, b = r & 3, pn = seg >> 1, bj = seg & 1;
            tr_item(up, 2 * DFF, kb * 64, bj * DFF + pn * 128 + b * 32, wu, 1024, pn * 256 + bj * 128 + b * 32, scr, C.lane); }
    }
    tr_matrix(C, gw, NGW, C.P.in[33 + C.z] + (size_t)l * DFF * 1024, 1024, DFF, 0, 1024, WL(bf16, l, WL_DN), 0, scr);
}
DI void prologue(const Ctx& C0) {
    const Ctx C = rectx(C0);
    LAS float* scr = (LAS float*)(C.lds + 49152 + C.wave * 8704);
    const int gth = C.bid * NTHREADS + C.tid, NGT = C.G * NTHREADS;
    for (int tsk = C.bid; tsk < 72; tsk += C.G) {
        const int l = tsk / 36, rem = tsk % 36, cb = rem / 3, rg = rem % 3;
        LAS float* s = (LAS float*)C.lds;
        for (int i = C.tid; i < 11 * 1024; i += NTHREADS) { const int r = rg * 11 + i / 1024, k = i % 1024; const float cv = (r < 32) ? C.P.in[1 + C.z][r * 1024 + k] : C.P.in[3 + C.z][k]; s[i] = cv * sigm(cv); }
        __syncthreads();
        const int j = cb * 512 + C.tid;
        float acc[11];
        const float bj = C.P.in[5 + C.z][l * 6144 + j];
#pragma unroll
        for (int i = 0; i < 11; ++i) acc[i] = bj;
        const float* wp = C.P.in[4 + C.z] + (size_t)l * 1024 * 6144 + j;
        for (int k = 0; k < 1024; k += 4) {
            const float w0 = wp[(size_t)k * 6144], w1 = wp[(size_t)(k + 1) * 6144], w2 = wp[(size_t)(k + 2) * 6144], w3 = wp[(size_t)(k + 3) * 6144];
#pragma unroll
            for (int i = 0; i < 11; ++i) { const f32x4 x = *(const LAS f32x4*)(s + i * 1024 + k); acc[i] += x[0] * w0 + x[1] * w1 + x[2] * w2 + x[3] * w3; }
        }
#pragma unroll
        for (int i = 0; i < 11; ++i) WSP(float, WS_MOD)[(size_t)(l * 33 + rg * 11 + i) * 6144 + j] = acc[i];
        __syncthreads();
    }
    if (C.bid == C.G - 1) for (int i = C.tid; i < 1024; i += NTHREADS) { const int p = i >> 4, f = i & 15; const float inv = powf(10000.f, -(float)f / 16.f), ang = (float)p * inv; WSP(float, WS_SMALL)[2 * i] = cosf(ang); WSP(float, WS_SMALL)[2 * i + 1] = sinf(ang); }
    for (int i = gth; i < 2048 * 4096 / 2; i += NGT) {
        const int tp = i / 2048, kk = (i % 2048) * 2; float v[2];
#pragma unroll
        for (int e = 0; e < 2; ++e) { const int k = kk + e, t = k & 2047; const int ph = (tp * t) & 2047; const float x = (float)ph * (1.f / 1024.f); v[e] = ((k < 2048) ? cospif(x) : -sinpif(x)) * 0.0027621358640099513f; }
        WSP(unsigned, WS_DFT)[i] = pk(v[0], v[1]);
    }
    for (int i = gth; i < 256 * 512 / 2; i += NGT) {
        const int tp = i / 256, kk = (i % 256) * 2; float v[2];
#pragma unroll
        for (int e = 0; e < 2; ++e) { const int k = kk + e, t = k & 255; const int ph = (tp * t) & 255; const float x = (float)ph * (1.f / 128.f); v[e] = ((k < 256) ? cospif(x) : -sinpif(x)) * 0.0078125f; }
        WSP(unsigned, WS_DFTC)[i] = pk(v[0], v[1]);
    }
    weights_tr(C, 0, C.bid * NWAVES + C.wave, C.G * NWAVES, scr);
    for (int l = 0; l < 2; ++l) {
        const float* win = C.P.in[10 + C.z] + (size_t)l * 1024 * IN_COLS;
        bf16* wi = WL(bf16, l, WL_IN);
        for (int i = gth; i < 128 * 1024 / 2; i += NGT) ((unsigned*)(wi + (size_t)2432 * 1024))[i] = 0u;
        {
            LAS float* tab = (LAS float*)(C.lds + 120 * 1024);
            __syncthreads();
            if (C.tid < 64) { const float x = (float)C.tid * (1.f / 32.f); tab[C.tid] = cospif(x); tab[64 + C.tid] = sinpif(x); }
            __syncthreads();
            for (int i = gth; i < 512 * 1024; i += NGT) {
                const int k = i & 1023, np = i >> 10, sn = np >> 8, g = (np >> 6) & 3, cp = np & 63;
                const float* wr_ = win + (size_t)k * IN_COLS + 1920 + g * 64; const LAS float* tb = tab + sn * 64; float a = 0.f;
#pragma unroll 8
                for (int c = 0; c < 64; ++c) a += wr_[c] * tb[(c * cp) & 63];
                wi[(size_t)(768 + np) * 1024 + k] = f2bf(a);
            }
        }
        {
            bf16* wl = WSP(bf16, WS_WLORA + (size_t)l * 2 * MiB);
            const float* w2 = C.P.in[13 + C.z] + (size_t)l * 2 * 64 * 256; const float* a2 = C.P.in[15 + C.z] + (size_t)l * 2 * 64 * 256; const float* g2 = C.P.in[16 + C.z] + (size_t)l * 128 * 256;
            const int kl = (l == 0) ? 384 : KLO;
            for (int i = gth; i < NLO * kl; i += NGT) {
                const int c = i & 255, nb = (i >> 8) % 6, k = i / (256 * 6); float v = 0.f;
                if (nb == 0) { if (k < 64) v = w2[k * 256 + c]; }
                else if (nb == 1) { if (k >= 64 && k < 128) v = w2[(64 + k - 64) * 256 + c]; }
                else if (nb == 2) { if (k >= 128 && k < 192) v = a2[(k - 128) * 256 + c]; }
                else if (nb == 3) { if (k >= 192 && k < 256) v = a2[(64 + k - 192) * 256 + c]; }
                else if (nb == 4) { if (k >= 256 && k < 384) v = g2[(k - 256) * 256 + c]; }
                else if (l == 1 && k >= 384) { const float* v1 = C.P.in[23 + C.z] + (k - 384) * 32; const float* v2 = C.P.in[24 + C.z] + c; for (int j = 0; j < 32; ++j) v += v1[j] * v2[j * 256]; }
                wl[(size_t)(nb * 256 + c) * kl + k] = f2bf(v);
            }
        }
    }
}

template <bool HAS_ADD, bool HAS_OUT>
DI void rowop(const Ctx& C0, int nrows, const float* hin_l, const float* hin_c, float* hout_l, float* hout_c, const bf16* add, int ga, const float* g_add, const float* g_out, int sh, int sc, const float* modl, const float* modo, bf16* Aout) {
    const Ctx C = rectx(C0);
    const int rpw = (nrows + C.G * NWAVES - 1) / (C.G * NWAVES), r0 = (C.bid * NWAVES + C.wave) * rpw, r1 = (r0 + rpw < nrows) ? r0 + rpw : nrows;
    if (r0 >= r1) return;
    const int c0 = 4 * C.lane;
    f32x4 gA[4], gO[4], mG[4], mS[4], mB[4];
#pragma unroll
    for (int j = 0; j < 4; ++j) { if (HAS_ADD) gA[j] = *(const f32x4*)(g_add + c0 + 256 * j); if (HAS_OUT) gO[j] = *(const f32x4*)(g_out + c0 + 256 * j); }
    int bcur = -1;
    f32x4 hn[4]; u32x2 an[4];
#define ROW_HP(t) (((t) < NLAT) ? hin_l + (size_t)(t) * DM : hin_c + (size_t)((t) - NLAT) * DM)
    { const float* hp = ROW_HP(r0);
#pragma unroll
      for (int j = 0; j < 4; ++j) { hn[j] = __builtin_nontemporal_load((const f32x4*)(hp + c0 + 256 * j)); if (HAS_ADD) an[j] = __builtin_nontemporal_load((const u32x2*)(add + (size_t)r0 * DM + c0 + 256 * j)); } }
    for (int tok = r0; tok < r1; ++tok) {
        f32x4 h[4]; u32x2 ar[4];
#pragma unroll
        for (int j = 0; j < 4; ++j) { h[j] = hn[j]; if (HAS_ADD) ar[j] = an[j]; }
        if (tok + 1 < r1) { const float* hp = ROW_HP(tok + 1);
#pragma unroll
            for (int j = 0; j < 4; ++j) { hn[j] = __builtin_nontemporal_load((const f32x4*)(hp + c0 + 256 * j)); if (HAS_ADD) an[j] = __builtin_nontemporal_load((const u32x2*)(add + (size_t)(tok + 1) * DM + c0 + 256 * j)); } }
        const bool lat = tok < NLAT; const int b = lat ? tok / TL : 32;
        if (b != bcur) { bcur = b; const float* mp = modl + (size_t)b * 6144; const float* mq = modo + (size_t)b * 6144;
#pragma unroll
            for (int j = 0; j < 4; ++j) { if (HAS_ADD) mG[j] = *(const f32x4*)(mp + ga * 1024 + c0 + 256 * j); if (HAS_OUT) { mS[j] = *(const f32x4*)(mq + sc * 1024 + c0 + 256 * j) + 1.f; mB[j] = *(const f32x4*)(mq + sh * 1024 + c0 + 256 * j); } } }
        if (HAS_ADD) {
            f32x4 a[4]; float ss = 0.f;
#pragma unroll
            for (int j = 0; j < 4; ++j) { a[j] = (f32x4){lo2f(ar[j].x), hi2f(ar[j].x), lo2f(ar[j].y), hi2f(ar[j].y)}; ss += a[j][0] * a[j][0] + a[j][1] * a[j][1] + a[j][2] * a[j][2] + a[j][3] * a[j][3]; }
            const float rstd = rsqrtf(wave_sum(ss) * (1.f / DM) + 1e-6f);
            float* op = lat ? hout_l + (size_t)tok * DM : hout_c + (size_t)(tok - NLAT) * DM;
#pragma unroll
            for (int j = 0; j < 4; ++j) { h[j] = h[j] + mG[j] * (a[j] * rstd * gA[j]); __builtin_nontemporal_store(h[j], (f32x4*)(op + c0 + 256 * j)); }
        }
        if (HAS_OUT) {
            float ss = 0.f;
#pragma unroll
            for (int j = 0; j < 4; ++j) ss += h[j][0] * h[j][0] + h[j][1] * h[j][1] + h[j][2] * h[j][2] + h[j][3] * h[j][3];
            const float rstd = rsqrtf(wave_sum(ss) * (1.f / DM) + 1e-6f);
#pragma unroll
            for (int j = 0; j < 4; ++j) { const f32x4 y = (h[j] * rstd * gO[j]) * mS[j] + mB[j]; u32x2 o; o.x = pk(y[0], y[1]); o.y = pk(y[2], y[3]);
                *(u32x2*)(Aout + (size_t)tok * DM + c0 + 256 * j) = o; }
        }
    }
#undef ROW_HP
}

DI void feat1_phase(const Ctx& C0, int l) {
    const Ctx C = rectx(C0);
    const bf16* UR = WSP(bf16, WS_X + X_UR); bf16* F = WSP(bf16, WS_X + X_F); bf16* X2 = WSP(bf16, WS_A);
    const float* mu = C.P.in[11 + C.z] + (size_t)l * 2 * RW;
    const int gth = C.bid * NTHREADS + C.tid, NGT = C.G * NTHREADS, kl = (l == 0) ? 384 : KLO;
    for (int idx = gth; idx < NT * 144; idx += NGT) {
        const int tok = idx / 144, pc = idx - tok * 144, cc = pc * 8;
        const int t = (tok < NLAT) ? (tok & (TL - 1)) : ((tok - NLAT) & (TC - 1)), T = (tok < NLAT) ? TL : TC;
        const bf16* up_ = UR + (size_t)tok * RW + cc;
        const u32x4 u = *(const u32x4*)up_;
        u32x4 p = {0u, 0u, 0u, 0u}, nx = {0u, 0u, 0u, 0u};
        if (t > 0) p = *(const u32x4*)(up_ - RW);
        if (t < T - 1) nx = *(const u32x4*)(up_ + RW);
        const f32x4 m0a = *(const f32x4*)(mu + cc), m0b = *(const f32x4*)(mu + cc + 4), m1a = *(const f32x4*)(mu + RW + cc), m1b = *(const f32x4*)(mu + RW + cc + 4);
        float s[8];
#pragma unroll
        for (int e = 0; e < 8; ++e) { const float uu = (e & 1) ? hi2f(u[e >> 1]) : lo2f(u[e >> 1]), pp = (e & 1) ? hi2f(p[e >> 1]) : lo2f(p[e >> 1]), nn = (e & 1) ? hi2f(nx[e >> 1]) : lo2f(nx[e >> 1]);
            const float m0 = (e < 4) ? m0a[e & 3] : m0b[e & 3], m1 = (e < 4) ? m1a[e & 3] : m1b[e & 3];
            s[e] = uu + m0 * (pp - uu) + m1 * (nn - uu); }
        if (cc >= 768 && cc < 896) {
#pragma unroll
            for (int e = 0; e < 8; ++e) s[e] = tanh_(s[e]); }
        else if (cc >= 1024) {
#pragma unroll
            for (int e = 0; e < 8; ++e) s[e] = sigm(s[e]); }
        u32x4 w; w.x = pk(s[0], s[1]); w.y = pk(s[2], s[3]); w.z = pk(s[4], s[5]); w.w = pk(s[6], s[7]);
        if (cc < 256) *(u32x4*)(F + (size_t)tok * 2048 + cc) = w;
        else if (cc < 512) *(u32x4*)(F + (size_t)tok * 2048 + 768 + cc - 256) = w;
        else if (cc < 768) { *(u32x4*)(F + (size_t)tok * 2048 + 512 + cc - 512) = w; if (l == 1) *(u32x4*)(X2 + (size_t)tok * kl + 384 + cc - 512) = w; }
        else *(u32x4*)(X2 + (size_t)tok * kl + cc - 768) = w;
    }
}
DI void feat3_phase(const Ctx& C0, int l) {
    const Ctx C = rectx(C0);
    bf16* F = WSP(bf16, WS_X + X_F); bf16* Gq = WSP(bf16, WS_X + X_G); bf16* VF = WSP(bf16, WS_VF); float* BON = WSP(float, WS_BON); const bf16* LO = WSP(bf16, WS_X + X_LO);
    const int c = (C.lane >> 4) * 64 + (C.lane & 15) * 4;
    const f32x4 kkw = *(const f32x4*)(C.P.in[17 + C.z] + l * 256 + c), kaw = *(const f32x4*)(C.P.in[18 + C.z] + l * 256 + c), rkw = *(const f32x4*)(C.P.in[19 + C.z] + l * 256 + c);
    const f32x4 w0f = *(const f32x4*)(C.P.in[12 + C.z] + l * 512 + c), w0b = *(const f32x4*)(C.P.in[12 + C.z] + l * 512 + 256 + c), a0f = *(const f32x4*)(C.P.in[14 + C.z] + l * 512 + c), a0b = *(const f32x4*)(C.P.in[14 + C.z] + l * 512 + 256 + c);
    const f32x4 v0c = *(const f32x4*)(C.P.in[22 + C.z] + c);
    const int rpw = NT / (256 * NWAVES), r0 = (C.bid * NWAVES + C.wave) * rpw;
    if (C.bid >= 256) return;
    u32x2 nR, nK, nV, nVF, nL[6];
#define F3_LOAD(t) do { const size_t o_ = (size_t)(t) * 256 + c; const bf16* f_ = F + (size_t)(t) * 2048 + c; nR = *(const u32x2*)(f_); nK = *(const u32x2*)(f_ + 768); nV = *(const u32x2*)(f_ + 512); if (l == 1) nVF = *(const u32x2*)(VF + o_); \
        _Pragma("unroll") for (int q = 0; q < 6; ++q) if (q < 5 || l == 1) nL[q] = __builtin_nontemporal_load((const u32x2*)(LO + (size_t)(t) * NLO + q * 256 + c)); } while (0)
    F3_LOAD(r0);
    for (int tok = r0; tok < r0 + rpw; ++tok) {
        const u32x2 cR = nR, cK = nK, cV = nV, cVF = nVF; u32x2 cL[6];
#pragma unroll
        for (int q = 0; q < 6; ++q) cL[q] = nL[q];
        if (tok + 1 < r0 + rpw) F3_LOAD(tok + 1);
        const size_t o = (size_t)tok * 256 + c;
        const f32x4 r = bf4(cR), k = bf4(cK); f32x4 v = bf4(cV);
        if (l == 1) { const f32x4 vf = bf4(cVF), z = v0c + bf4(cL[5]);
#pragma unroll
            for (int e = 0; e < 4; ++e) v[e] = v[e] + (vf[e] - v[e]) * sigm(z[e]);
            *(u32x2*)(F + (size_t)tok * 2048 + 512 + c) = pk4(v); }
        else *(u32x2*)(VF + o) = cV;
        const f32x4 kr = k * kkw;
        const float ss = row16_sum(kr[0] * kr[0] + kr[1] * kr[1] + kr[2] * kr[2] + kr[3] * kr[3]), rn = rsqrtf(fmaxf(ss, 1e-24f));
        const f32x4 lf = w0f + bf4(cL[0]), lb = w0b + bf4(cL[1]), xf = a0f + bf4(cL[2]), xb = a0b + bf4(cL[3]);
        f32x4 ef, eb, af, ab; float bp = 0.f;
#pragma unroll
        for (int e = 0; e < 4; ++e) { ef[e] = 0.6065306597126334f * sigm(lf[e]); eb[e] = 0.6065306597126334f * sigm(lb[e]); af[e] = sigm(xf[e]); ab[e] = sigm(xb[e]);
            bp += r[e] * k[e] * (1.f + (0.5f * (af[e] + ab[e]) - 1.f) * kaw[e]) * rkw[e]; }
        const float bon = row16_sum(bp);
        if ((C.lane & 15) == 0) BON[(size_t)tok * 4 + (C.lane >> 4)] = bon;
        { bf16* f_ = F + (size_t)tok * 2048 + c; *(u32x2*)(f_ + 256) = pk4(kr * rn); *(u32x2*)(f_ + 1024) = pk4(ef); *(u32x2*)(f_ + 1280) = pk4(eb); *(u32x2*)(f_ + 1536) = pk4(af); *(u32x2*)(f_ + 1792) = pk4(ab); }
        *(u32x2*)(Gq + o) = cL[4];
    }
#undef F3_LOAD
}

struct ScanOp { bf16 r, kk, k, e, a, v; };
DI int scan_tok(int n, int dir, int b) { n = n < 2303 ? n : 2303; if (n < 256) return CTXB + b * 256 + (dir ? 255 - n : n); const int t = n - 256; return b * TL + (dir ? TL - 1 - t : t); }
DI ScanOp scan_load(const bf16* Ft, int dir, unsigned ck, unsigned cv) {
    ScanOp o; o.r = Ft[ck]; o.kk = Ft[256 + ck]; o.k = Ft[768 + ck]; o.e = (Ft + (4 + dir) * 256)[ck]; o.a = (Ft + (6 + dir) * 256)[ck]; o.v = Ft[512 + cv]; return o;
}
#define DPPT " row_mask:0xf bank_mask:0xf\n\t"
#define SOPS(S) "+v"(S[0]), "+v"(S[1]), "+v"(S[2]), "+v"(S[3]), "+v"(S[4]), "+v"(S[5]), "+v"(S[6]), "+v"(S[7]), "+v"(S[8]), "+v"(S[9]), "+v"(S[10]), "+v"(S[11]), "+v"(S[12]), "+v"(S[13]), "+v"(S[14]), "+v"(S[15])
struct ScanVec { float w, kd, nbd, r, v; };
DI ScanVec scan_conv(const ScanOp& op, float ka, float& kk_out) {
    const float kk = bf2f(op.kk), k = bf2f(op.k), e = bf2f(op.e), a = bf2f(op.a);
    ScanVec c; c.r = bf2f(op.r); c.v = bf2f(op.v); c.w = fexp2(-e * LOG2E); c.kd = k * (1.f + (a - 1.f) * ka); c.nbd = -(kk * a); kk_out = kk; return c;
}
DI void scan_step(float (&S)[16], float& sa, ScanVec& cur, const ScanOp& nxt, float ka, bf16* yp, bool wr) {
    const float w = cur.w, nbd = cur.nbd, kd = cur.kd, v = cur.v;
#define UPM(j) "v_mul_f32_dpp %" #j ", %16, %" #j " row_newbcast:" #j DPPT
#define UPA(j) "v_fmac_f32_dpp %" #j ", %17, %19 row_newbcast:" #j DPPT
#define UPB(j) "v_fmac_f32_dpp %" #j ", %18, %20 row_newbcast:" #j DPPT
#define ALL16(M) M(0) M(1) M(2) M(3) M(4) M(5) M(6) M(7) M(8) M(9) M(10) M(11) M(12) M(13) M(14) M(15)
    asm volatile(ALL16(UPM) ALL16(UPA) ALL16(UPB) : SOPS(S) : "v"(w), "v"(nbd), "v"(kd), "v"(sa), "v"(v));
#undef UPM
#undef UPA
#undef UPB
    float kkn; ScanVec nx = scan_conv(nxt, ka, kkn);
    float r = cur.r;
    asm volatile("s_nop 1" : "+v"(r), "+v"(kkn), "+v"(nx.w), "+v"(nx.kd), "+v"(nx.nbd), "+v"(nx.r));
    float y0, y1, s0, s1;
    asm volatile(
        "v_mul_f32_dpp %0, %20, %4 row_newbcast:0" DPPT "v_mul_f32_dpp %2, %21, %4 row_newbcast:0" DPPT "v_mul_f32_dpp %1, %20, %5 row_newbcast:1" DPPT "v_mul_f32_dpp %3, %21, %5 row_newbcast:1" DPPT
        "v_fmac_f32_dpp %0, %20, %6 row_newbcast:2" DPPT "v_fmac_f32_dpp %2, %21, %6 row_newbcast:2" DPPT
        "v_fmac_f32_dpp %1, %20, %7 row_newbcast:3" DPPT "v_fmac_f32_dpp %3, %21, %7 row_newbcast:3" DPPT
        "v_fmac_f32_dpp %0, %20, %8 row_newbcast:4" DPPT "v_fmac_f32_dpp %2, %21, %8 row_newbcast:4" DPPT
        "v_fmac_f32_dpp %1, %20, %9 row_newbcast:5" DPPT "v_fmac_f32_dpp %3, %21, %9 row_newbcast:5" DPPT
        "v_fmac_f32_dpp %0, %20, %10 row_newbcast:6" DPPT "v_fmac_f32_dpp %2, %21, %10 row_newbcast:6" DPPT
        "v_fmac_f32_dpp %1, %20, %11 row_newbcast:7" DPPT "v_fmac_f32_dpp %3, %21, %11 row_newbcast:7" DPPT
        "v_fmac_f32_dpp %0, %20, %12 row_newbcast:8" DPPT "v_fmac_f32_dpp %2, %21, %12 row_newbcast:8" DPPT
        "v_fmac_f32_dpp %1, %20, %13 row_newbcast:9" DPPT "v_fmac_f32_dpp %3, %21, %13 row_newbcast:9" DPPT
        "v_fmac_f32_dpp %0, %20, %14 row_newbcast:10" DPPT "v_fmac_f32_dpp %2, %21, %14 row_newbcast:10" DPPT
        "v_fmac_f32_dpp %1, %20, %15 row_newbcast:11" DPPT "v_fmac_f32_dpp %3, %21, %15 row_newbcast:11" DPPT
        "v_fmac_f32_dpp %0, %20, %16 row_newbcast:12" DPPT "v_fmac_f32_dpp %2, %21, %16 row_newbcast:12" DPPT
        "v_fmac_f32_dpp %1, %20, %17 row_newbcast:13" DPPT "v_fmac_f32_dpp %3, %21, %17 row_newbcast:13" DPPT
        "v_fmac_f32_dpp %0, %20, %18 row_newbcast:14" DPPT "v_fmac_f32_dpp %2, %21, %18 row_newbcast:14" DPPT
        "v_fmac_f32_dpp %1, %20, %19 row_newbcast:15" DPPT "v_fmac_f32_dpp %3, %21, %19 row_newbcast:15" DPPT
        : "=&v"(y0), "=&v"(y1), "=&v"(s0), "=&v"(s1)
        : "v"(S[0]), "v"(S[1]), "v"(S[2]), "v"(S[3]), "v"(S[4]), "v"(S[5]), "v"(S[6]), "v"(S[7]), "v"(S[8]), "v"(S[9]), "v"(S[10]), "v"(S[11]), "v"(S[12]), "v"(S[13]), "v"(S[14]), "v"(S[15]), "v"(r), "v"(kkn));
    const float y = allred4(y0 + y1); sa = allred4(s0 + s1);
    if (wr) *yp = f2bf(y);
    cur = nx;
}
DI void scan_run(const Ctx& C0, int l, int b, int h, int dir) {
    const Ctx C = rectx(C0);
    if (C.wave >= 4) {
        if (l == 0) weights_tr(C, 1, C.bid * 4 + (C.wave - 4), C.G * 4, (LAS float*)(C.lds + 49152 + C.wave * 8704));
        return; }
    const int wv = C.wave & 3, q = C.lane >> 4, vi = C.lane & 15;
    const unsigned ck = h * 64 + C.lane, cv = h * 64 + 16 * wv + vi;
    const bf16* F = WSP(bf16, WS_X + X_F);
    bf16* YS = WSP(bf16, WS_X + X_UR) + (size_t)dir * FSZ;
    const float ka = C.P.in[18 + C.z][l * 256 + ck];
    float S[16];
#pragma unroll
    for (int j = 0; j < 16; ++j) S[j] = 0.f;
    const bool wr = (q == 0);
    size_t t0 = (size_t)scan_tok(0, dir, b) * 256, t1 = (size_t)scan_tok(1, dir, b) * 256, t2 = (size_t)scan_tok(2, dir, b) * 256, t3 = (size_t)scan_tok(3, dir, b) * 256;
    ScanOp o0 = scan_load(F + t0 * 8, dir, ck, cv), o1 = scan_load(F + t1 * 8, dir, ck, cv), o2 = scan_load(F + t2 * 8, dir, ck, cv), o3 = scan_load(F + t3 * 8, dir, ck, cv);
    float sa = 0.f, kk0_; ScanVec cur = scan_conv(o0, ka, kk0_);
    asm volatile("s_nop 1" : "+v"(cur.w), "+v"(cur.kd), "+v"(cur.nbd), "+v"(cur.r));
    for (int n = 0; n < 2304; n += 4) {
        size_t tn;
        scan_step(S, sa, cur, o1, ka, &(YS + t0)[cv], wr); tn = (size_t)__builtin_amdgcn_readfirstlane(scan_tok(n + 4, dir, b)) * 256; o0 = scan_load(F + tn * 8, dir, ck, cv); t0 = tn;
        scan_step(S, sa, cur, o2, ka, &(YS + t1)[cv], wr); tn = (size_t)__builtin_amdgcn_readfirstlane(scan_tok(n + 5, dir, b)) * 256; o1 = scan_load(F + tn * 8, dir, ck, cv); t1 = tn;
        scan_step(S, sa, cur, o3, ka, &(YS + t2)[cv], wr); tn = (size_t)__builtin_amdgcn_readfirstlane(scan_tok(n + 6, dir, b)) * 256; o2 = scan_load(F + tn * 8, dir, ck, cv); t2 = tn;
        scan_step(S, sa, cur, o0, ka, &(YS + t3)[cv], wr); tn = (size_t)__builtin_amdgcn_readfirstlane(scan_tok(n + 7, dir, b)) * 256; o3 = scan_load(F + tn * 8, dir, ck, cv); t3 = tn;
    }
}

DI void readout_phase(const Ctx& C0, int l, int nrows) {
    const Ctx C = rectx(C0);
    const bf16* F = WSP(bf16, WS_X + X_F); const bf16* Gq = WSP(bf16, WS_X + X_G); const bf16* YS = WSP(bf16, WS_X + X_UR); const float* BON = WSP(float, WS_BON);
    bf16* YR = WSP(bf16, WS_A + (size_t)108 * MiB);
    const int c = (C.lane >> 4) * 64 + (C.lane & 15) * 4;
    const f32x4 lw = *(const f32x4*)(C.P.in[20 + C.z] + l * 256 + c), lb = *(const f32x4*)(C.P.in[21 + C.z] + l * 256 + c);
    const int rpw = (nrows + C.G * NWAVES - 1) / (C.G * NWAVES), r0 = (C.bid * NWAVES + C.wave) * rpw, r1 = (r0 + rpw < nrows) ? r0 + rpw : nrows;
    if (r0 >= r1) return;
    u32x2 nF, nB, nV, nG; float nBon;
#define RO_LOAD(t) do { const size_t o_ = (size_t)(t) * 256 + c; nF = *(const u32x2*)(YS + o_); nB = *(const u32x2*)(YS + FSZ + o_); nV = *(const u32x2*)(F + (size_t)(t) * 2048 + 512 + c); nG = *(const u32x2*)(Gq + o_); nBon = BON[(size_t)(t) * 4 + (C.lane >> 4)]; } while (0)
    RO_LOAD(r0);
    for (int tok = r0; tok < r1; ++tok) {
        const u32x2 cF = nF, cB = nB, cV = nV, cG = nG; const float bon = nBon;
        if (tok + 1 < r1) RO_LOAD(tok + 1);
        const f32x4 y = bf4(cF) + bf4(cB);
        const float mean = row16_sum(y[0] + y[1] + y[2] + y[3]) * (1.f / 64.f);
        const f32x4 d = y - mean;
        const float var = row16_sum(d[0] * d[0] + d[1] * d[1] + d[2] * d[2] + d[3] * d[3]) * (1.f / 64.f);
        const f32x4 yn = d * rsqrtf(var + 64e-5f) * lw + lb;
        *(u32x2*)(YR + (size_t)tok * 256 + c) = pk4((yn + bf4(cV) * bon) * bf4(cG));
    }
#undef RO_LOAD
}

DI void fixup_phase(const Ctx& C0, int l, int nrows) {
    const Ctx C = rectx(C0);
    const int gw = C.bid * NWAVES + C.wave, NGW = C.G * NWAVES, nitem = (nrows / 64) * 2;
    const bf16* HALO = WSP(bf16, WS_X + X_HALO); bf16* HH = WSP(bf16, WS_X + X_HH);
    const float* cw = C.P.in[31 + C.z] + (size_t)l * 3 * DFF; const float* cb = C.P.in[32 + C.z] + (size_t)l * DFF;
    for (int it = gw; it < nitem; it += NGW) {
        const int grp = it >> 1, last = it & 1, row = grp * 64 + (last ? 63 : 0);
        const int t = (row < NLAT) ? (row & (TL - 1)) : ((row - NLAT) & (TC - 1)), T = (row < NLAT) ? TL : TC;
        const bf16* hb = HALO + (size_t)grp * 6 * DFF;
        const bf16 *pp, *pc, *pn, *pv; bool zp = false, zn = false;
        if (!last) { pc = hb; pn = hb + DFF; pv = hb + 4 * DFF; zp = (t == 0); pp = zp ? hb : hb - 6 * DFF + 3 * DFF; }
        else { pp = hb + 2 * DFF; pc = hb + 3 * DFF; pv = hb + 5 * DFF; zn = (t == T - 1); pn = zn ? hb : hb + 6 * DFF; }
        for (int p = C.lane; p < DFF / 8; p += 64) { const int j = p * 8;
            const u32x4 a = *(const u32x4*)(pp + j), bq = *(const u32x4*)(pc + j), cq = *(const u32x4*)(pn + j), vq = *(const u32x4*)(pv + j);
            float o[8];
#pragma unroll
            for (int e = 0; e < 8; ++e) { const unsigned ua = a[e >> 1], ub = bq[e >> 1], uc = cq[e >> 1], uv = vq[e >> 1];
                const float xp = zp ? 0.f : ((e & 1) ? hi2f(ua) : lo2f(ua)), xc = (e & 1) ? hi2f(ub) : lo2f(ub), xn = zn ? 0.f : ((e & 1) ? hi2f(uc) : lo2f(uc)), xv = (e & 1) ? hi2f(uv) : lo2f(uv);
                const float z = cw[j + e] * xp + cw[DFF + j + e] * xc + cw[2 * DFF + j + e] * xn + cb[j + e]; o[e] = gelu_tanh(z) * xv; }
            u32x4 w; w.x = pk(o[0], o[1]); w.y = pk(o[2], o[3]); w.z = pk(o[4], o[5]); w.w = pk(o[6], o[7]);
            *(u32x4*)(HH + (size_t)row * DFF + j) = w; }
    }
}

DI int crow(int i, int hh) { return (i & 3) + 8 * (i >> 2) + 4 * hh; }
DI void attn_unit(const Ctx& C, int l, int b, int kh, int qblk, bool isctx) {
    LAS bf16* Ks = (LAS bf16*)C.lds; LAS bf16* Vt = Ks + 64 * 72;
    const bf16* QKV = WSP(bf16, WS_X + X_QKV); bf16* YA = WSP(bf16, WS_A); const float* RT = WSP(float, WS_SMALL);
    const int g = C.wave >> 1, qt = C.wave & 1, hq = kh * 4 + g, r = C.lane & 31, hh = C.lane >> 5;
    const int qi = qblk * 64 + qt * 32 + r;
    const size_t tq = isctx ? (size_t)(CTXB + b * TC + qi) : (size_t)(b * TL + qi);
    bf16x8 qf[4];
    {
        float qv[4][8]; const bf16* qp = QKV + tq * 768 + hq * 64 + 8 * hh;
#pragma unroll
        for (int ks = 0; ks < 4; ++ks) { const u32x4 u = *(const u32x4*)(qp + 16 * ks);
#pragma unroll
            for (int e = 0; e < 4; ++e) { qv[ks][2 * e] = lo2f(u[e]); qv[ks][2 * e + 1] = hi2f(u[e]); } }
        if (!isctx) { const int rid = qi >> 6, cid = qi & 63;
#pragma unroll
            for (int j = 0; j < 8; ++j) { const int f = 8 * hh + j;
                const float c0 = RT[(rid * 16 + f) * 2], s0 = RT[(rid * 16 + f) * 2 + 1], c1 = RT[(cid * 16 + f) * 2], s1 = RT[(cid * 16 + f) * 2 + 1];
                const float a1 = qv[0][j], a2 = qv[1][j], b1 = qv[2][j], b2 = qv[3][j];
                qv[0][j] = a1 * c0 - a2 * s0; qv[1][j] = a2 * c0 + a1 * s0; qv[2][j] = b1 * c1 - b2 * s1; qv[3][j] = b2 * c1 + b1 * s1; } }
        const float sc = 0.125f * LOG2E;
#pragma unroll
        for (int ks = 0; ks < 4; ++ks) { u32x4 w; w.x = pk(qv[ks][0] * sc, qv[ks][1] * sc); w.y = pk(qv[ks][2] * sc, qv[ks][3] * sc); w.z = pk(qv[ks][4] * sc, qv[ks][5] * sc); w.w = pk(qv[ks][6] * sc, qv[ks][7] * sc); qf[ks] = __builtin_bit_cast(bf16x8, w); }
    }
    float m_run = C.P.in[25 + C.z][l * 8 + hq] * LOG2E, l_run = hh == 0 ? 1.f : 0.f;
    f32x16 o0, o1;
#pragma unroll
    for (int i = 0; i < 16; ++i) { o0[i] = 0.f; o1[i] = 0.f; }
    const int nch = isctx ? 4 : 9, skey = C.tid >> 3, oct = C.tid & 7;
#define ATT_VALID(c_) ((c_) < 4 || (qblk * 64 - 128 + ((c_) - 4) * 64 >= 0 && qblk * 64 - 128 + ((c_) - 4) * 64 < TL))
#define ATT_LOAD(c_) do { const size_t kt_ = ((c_) < 4) ? (size_t)(CTXB + b * TC + (c_) * 64) : (size_t)(b * TL + qblk * 64 - 128 + ((c_) - 4) * 64); \
        const bf16* kp_ = QKV + (kt_ + skey) * 768 + 512 + kh * 64; pk_u = *(const u32x4*)(kp_ + 8 * oct); pk_p = *(const u32x4*)(kp_ + 8 * (oct ^ 2)); pk_v = *(const u32x4*)(kp_ + 128 + 8 * oct); } while (0)
    u32x4 pk_u, pk_p, pk_v;
    int ch = 0;
    ATT_LOAD(0);
    while (ch < nch) {
        const bool win = ch >= 4; const int kb = win ? qblk * 64 - 128 + (ch - 4) * 64 : 0;
        __syncthreads();
        {
            u32x4 ku = pk_u;
            if (win) { const u32x4 pu = pk_p;
                const int p = kb + skey, pos = (oct >> 2) ? (p & 63) : (p >> 6), fb = 8 * (oct & 1); const bool isx1 = (oct & 2) == 0;
                float o[8];
#pragma unroll
                for (int e = 0; e < 8; ++e) { const float own = (e & 1) ? hi2f(ku[e >> 1]) : lo2f(ku[e >> 1]), par = (e & 1) ? hi2f(pu[e >> 1]) : lo2f(pu[e >> 1]);
                    const float cc = RT[(pos * 16 + fb + e) * 2], ss = RT[(pos * 16 + fb + e) * 2 + 1];
                    o[e] = isx1 ? (own * cc - par * ss) : (own * cc + par * ss); }
                ku.x = pk(o[0], o[1]); ku.y = pk(o[2], o[3]); ku.z = pk(o[4], o[5]); ku.w = pk(o[6], o[7]); }
            *(LAS u32x4*)(Ks + skey * 72 + 8 * oct) = ku;
            const u32x4 vu = pk_v;
#pragma unroll
            for (int e = 0; e < 8; ++e) Vt[(8 * oct + e) * 72 + skey] = (bf16)((e & 1) ? (vu[e >> 1] >> 16) : (vu[e >> 1] & 0xffffu));
        }
        __syncthreads();
        int nxc = ch + 1;
        while (nxc < nch && !ATT_VALID(nxc)) ++nxc;
        if (nxc < nch) ATT_LOAD(nxc);
        f32x16 x0, x1;
#pragma unroll
        for (int i = 0; i < 16; ++i) { x0[i] = 0.f; x1[i] = 0.f; }
#pragma unroll
        for (int ks = 0; ks < 4; ++ks) {
            const bf16x8 a0 = *(const LAS bf16x8*)(Ks + r * 72 + 16 * ks + 8 * hh), a1 = *(const LAS bf16x8*)(Ks + (32 + r) * 72 + 16 * ks + 8 * hh);
            x0 = __builtin_amdgcn_mfma_f32_32x32x16_bf16(a0, qf[ks], x0, 0, 0, 0);
            x1 = __builtin_amdgcn_mfma_f32_32x32x16_bf16(a1, qf[ks], x1, 0, 0, 0);
        }
        if (win) {
#pragma unroll
            for (int i = 0; i < 16; ++i) { const int k0 = kb + crow(i, hh), d0 = qi - k0, d1 = d0 - 32;
                if (d0 > 128 || d0 < -128) x0[i] = -1e30f; if (d1 > 128 || d1 < -128) x1[i] = -1e30f; }
        }
        float mx = x0[0];
#pragma unroll
        for (int i = 0; i < 16; ++i) { mx = fmaxf(mx, x0[i]); mx = fmaxf(mx, x1[i]); }
        mx = fmaxf(mx, __shfl_xor(mx, 32));
        const float m_new = fmaxf(m_run, mx), alpha = fexp2(m_run - m_new);
        float ps = 0.f;
#pragma unroll
        for (int i = 0; i < 16; ++i) { x0[i] = fexp2(x0[i] - m_new); x1[i] = fexp2(x1[i] - m_new); ps += x0[i] + x1[i]; o0[i] *= alpha; o1[i] *= alpha; }
        l_run = l_run * alpha + ps; m_run = m_new;
#pragma unroll
        for (int kt = 0; kt < 2; ++kt)
#pragma unroll
            for (int s = 0; s < 2; ++s) {
                const f32x16& x = kt ? x1 : x0;
                u32x4 w; w.x = pk(x[8 * s], x[8 * s + 1]); w.y = pk(x[8 * s + 2], x[8 * s + 3]); w.z = pk(x[8 * s + 4], x[8 * s + 5]); w.w = pk(x[8 * s + 6], x[8 * s + 7]);
                const bf16x8 pb = __builtin_bit_cast(bf16x8, w);
                const int ko = kt * 32 + 16 * s + 4 * hh;
                const s16x4 l0 = *(const LAS s16x4*)(Vt + r * 72 + ko), h0 = *(const LAS s16x4*)(Vt + r * 72 + ko + 8);
                const s16x4 l1 = *(const LAS s16x4*)(Vt + (32 + r) * 72 + ko), h1 = *(const LAS s16x4*)(Vt + (32 + r) * 72 + ko + 8);
                o0 = __builtin_amdgcn_mfma_f32_32x32x16_bf16(__builtin_shufflevector(l0, h0, 0, 1, 2, 3, 4, 5, 6, 7), pb, o0, 0, 0, 0);
                o1 = __builtin_amdgcn_mfma_f32_32x32x16_bf16(__builtin_shufflevector(l1, h1, 0, 1, 2, 3, 4, 5, 6, 7), pb, o1, 0, 0, 0);
            }
        ch = nxc;
    }
#undef ATT_VALID
#undef ATT_LOAD
    const float inv = frcp(l_run + __shfl_xor(l_run, 32));
    bf16* op = YA + tq * 512 + hq * 64 + 4 * hh;
#pragma unroll
    for (int i4 = 0; i4 < 4; ++i4) {
        u32x2 w0, w1; w0.x = pk(o0[4 * i4] * inv, o0[4 * i4 + 1] * inv); w0.y = pk(o0[4 * i4 + 2] * inv, o0[4 * i4 + 3] * inv);
        w1.x = pk(o1[4 * i4] * inv, o1[4 * i4 + 1] * inv); w1.y = pk(o1[4 * i4 + 2] * inv, o1[4 * i4 + 3] * inv);
        *(u32x2*)(op + 8 * i4) = w0; *(u32x2*)(op + 32 + 8 * i4) = w1;
    }
}
DI void attn_loop(const Ctx& C0, int l) {
    const Ctx C = rectx(C0);
    unsigned* ctr = WSP(unsigned, WS_CTL) + 64 * (l + 1);
    volatile LAS unsigned* slot = (volatile LAS unsigned*)(C.lds + 32768);
    const unsigned NU = 2048u + (l == 0 ? 256u : 0u);
    for (;;) {
        __syncthreads();
        if (C.tid == 0) *slot = atomicAdd(ctr, 1u);
        __syncthreads();
        const unsigned u = *slot;
        if (u >= NU) break;
        if (u < 2048u) attn_unit(C, l, (int)(u >> 6), (int)((u >> 5) & 1), (int)(u & 31), false);
        else { const unsigned v = u - 2048u; attn_unit(C, l, (int)(v >> 3), (int)((v >> 2) & 1), (int)(v & 3), true); }
    }
}


#ifdef DBG
DI float exp_f(float x) { return fexp2(x * LOG2E); }
DI unsigned hsh(unsigned x) { x ^= x >> 16; x *= 0x7feb352du; x ^= x >> 15; x *= 0x846ca68bu; x ^= x >> 16; return x; }
DI void dbg_put(const Ctx& C, int k, float got, float ref, float S) {
    float err = fabsf(got - ref) / (fabsf(ref) + S); if (!(err == err)) err = 1e9f;
    atomicMax(WSP(unsigned, WS_CTL) + 1024 + k, __builtin_bit_cast(unsigned, err));
}
DI float ndot(const bf16* a, const bf16* b, int K) { float s = 0.f; for (int k = 0; k < K; ++k) s += bf2f(a[k]) * bf2f(b[k]); return s; }
DI void dbg_check(const Ctx& C0, int stage, int l) {
    if (C0.bid != 0 || l != 0) return;
    const Ctx C = rectx(C0);
    const unsigned h1 = hsh(C.tid * 3u + 17u + stage * 1000u), h2 = hsh(h1 + 0x9e3779b9u), h3 = hsh(h2 + 77u);
    const Params& P = C.P;
    if (stage == 0) {
        {
            const int n = h1 % 2432, k = h2 % 1024; int src = -1;
            if (n < 512) src = 1152 + n; else if (n < 640) src = 1664 + (n - 512); else if (n < 768) src = 1792 + (n - 640); else if (n >= 1280) src = n - 1280;
            if (src >= 0) dbg_put(C, 0, bf2f(WL(bf16, 0, WL_IN)[(size_t)n * 1024 + k]), bf2f(f2bf(P.in[10 + C.z][(size_t)k * IN_COLS + src])), 1e-6f);
            const int ng = h3 % 3072;
            dbg_put(C, 0, bf2f(WL(bf16, 0, WL_G)[(size_t)ng * 1024 + k]), bf2f(f2bf(P.in[10 + C.z][(size_t)k * IN_COLS + 2176 + ng])), 1e-6f);
            const int nu = h3 % 5632, pn = nu >> 8, bj = (nu >> 7) & 1, j = nu & 127;
            dbg_put(C, 0, bf2f(WL(bf16, 0, WL_UP)[(size_t)nu * 1024 + k]), bf2f(f2bf(P.in[30 + C.z][(size_t)k * 5632 + bj * DFF + pn * 128 + j])), 1e-6f);
            const int nd = h1 % 1024, kd = h3 % DFF;
            dbg_put(C, 0, bf2f(WL(bf16, 0, WL_DN)[(size_t)nd * DFF + kd]), bf2f(f2bf(P.in[33 + C.z][(size_t)kd * 1024 + nd])), 1e-6f);
            dbg_put(C, 0, bf2f(WL(bf16, 0, WL_O)[(size_t)nd * 1024 + k]), bf2f(f2bf(P.in[29 + C.z][(size_t)k * 1024 + nd])), 1e-6f);
            dbg_put(C, 0, bf2f(WL(bf16, 0, WL_BA)[(size_t)nd * 512 + (k & 511)]), bf2f(f2bf(P.in[27 + C.z][(size_t)(k & 511) * 1024 + nd])), 1e-6f);
            dbg_put(C, 0, bf2f(WL(bf16, 0, WL_BR)[(size_t)nd * 256 + (k & 255)]), bf2f(f2bf(P.in[26 + C.z][(size_t)(k & 255) * 1024 + nd])), 1e-6f);
        }
        {
            const int r = h1 % 33, j = h2 % 6144; float a = P.in[5 + C.z][j];
            for (int k = 0; k < 1024; ++k) { const float cv = (r < 32) ? P.in[1 + C.z][r * 1024 + k] : P.in[3 + C.z][k]; a += cv / (1.f + exp_f(-cv)) * P.in[4 + C.z][(size_t)k * 6144 + j]; }
            dbg_put(C, 1, WSP(float, WS_MOD)[(size_t)r * 6144 + j], a, 0.01f);
        }
    } else if (stage == 1) {
        const int tok = h1 % NT, col = h2 % 1024; const bool lat = tok < NLAT; const float* hp = lat ? P.in[0 + C.z] + (size_t)tok * DM : P.in[2 + C.z] + (size_t)(tok - NLAT) * DM;
        float ss = 0.f; for (int k = 0; k < 1024; ++k) ss += hp[k] * hp[k];
        const float* mp = WSP(float, WS_MOD) + (size_t)(lat ? tok / TL : 32) * 6144;
        const float ref = hp[col] * rsqrtf(ss / 1024.f + 1e-6f) * P.in[6 + C.z][col] * (1.f + mp[1024 + col]) + mp[col];
        dbg_put(C, 2, bf2f(WSP(bf16, WS_A)[(size_t)tok * DM + col]), ref, 0.05f);
    } else if (stage == 2) {
        const int tok = h1 % NT, n = h2 % 2432; const float ref = ndot(WSP(bf16, WS_A) + (size_t)tok * DM, WL(bf16, 0, WL_IN) + (size_t)n * 1024, 1024);
        float got; int k;
        if (n < 768) { got = bf2f(WSP(bf16, WS_X + X_QKV)[(size_t)tok * 768 + n]); k = 3; }
        else if (n < 1280) { const int sn = (n - 768) >> 8, ch = (n - 768) & 255; k = 4;
            if (tok < NLAT) got = bf2f(WSP(bf16, WS_X + X_ZT)[((size_t)(tok / TL) * 256 + ch) * 4096 + sn * 2048 + (tok % TL)]);
            else got = bf2f(WSP(bf16, WS_X + X_ZTC)[((size_t)((tok - NLAT) / TC) * 256 + ch) * 512 + sn * 256 + ((tok - NLAT) % TC)]); }
        else { got = bf2f(WSP(bf16, WS_X + X_UR)[(size_t)tok * RW + n - 1280]); k = 5; }
        dbg_put(C, k, got, ref, 0.1f);
    } else if (stage == 3) {
        const int b = h1 % 32, t = 1 + h2 % 2046, c = h3 % 256; const size_t tok = (size_t)b * TL + t; const bf16* UR = WSP(bf16, WS_X + X_UR);
        const float u = bf2f(UR[tok * RW + c]), up = bf2f(UR[(tok - 1) * RW + c]), un = bf2f(UR[(tok + 1) * RW + c]);
        dbg_put(C, 7, bf2f(WSP(bf16, WS_X + X_F)[tok * 2048 + c]), u + P.in[11 + C.z][c] * (up - u) + P.in[11 + C.z][RW + c] * (un - u), 0.05f);
        float ss = 0.f; for (int k = 0; k < 64; ++k) { const float x = bf2f(WSP(bf16, WS_X + X_F)[tok * 2048 + 256 + (c & 192) + k]); ss += x * x; }
        dbg_put(C, 7, ss, 1.f, 0.f);
    } else if (stage == 4) {
        {
            LAS float* S = (LAS float*)C.lds; LAS float* sa = S + 4096; const bf16* F = WSP(bf16, WS_X + X_F); const int b = 1, h = 2;
            for (int dir = 0; dir < 2; ++dir) {
                for (int e = C.tid; e < 4096; e += NTHREADS) S[e] = 0.f;
                __syncthreads();
                for (int n = 0; n < 24; ++n) {
                    const size_t oy = (size_t)scan_tok(n, dir, b) * 256 + h * 64, o = (size_t)scan_tok(n, dir, b) * 2048 + h * 64;
                    if (C.tid < 64) { float a = 0.f; for (int k = 0; k < 64; ++k) a -= S[C.tid * 64 + k] * bf2f(F[256 + o + k]); sa[C.tid] = a; }
                    __syncthreads();
                    for (int e = C.tid; e < 4096; e += NTHREADS) { const int v = e >> 6, k = e & 63;
                        const float kk = bf2f(F[256 + o + k]), kr = bf2f(F[768 + o + k]), ee = bf2f(F[(4 + dir) * 256 + o + k]), a = bf2f(F[(6 + dir) * 256 + o + k]), vv = bf2f(F[512 + o + v]);
                        S[e] = S[e] * exp_f(-ee) + sa[v] * (kk * a) + vv * (kr * (1.f + (a - 1.f) * P.in[18 + C.z][h * 64 + k])); }
                    __syncthreads();
                    if (C.tid < 64) { float y = 0.f; for (int k = 0; k < 64; ++k) y += S[C.tid * 64 + k] * bf2f(F[o + k]);
                        dbg_put(C, 8, bf2f(WSP(bf16, WS_X + X_UR)[(size_t)dir * FSZ + oy + C.tid]), y, 0.05f); }
                    __syncthreads();
                }
            }
        }
        {
            LAS float* qs = (LAS float*)C.lds + (size_t)C.tid * 65; const bf16* QKV = WSP(bf16, WS_X + X_QKV);
            const int b = h1 % 32, t = (C.tid & 1) ? (int)(h2 % 2048) : ((C.tid & 2) ? (int)(h2 % 200) : 2047 - (int)(h2 % 200)), hq = h3 % 8, dd = (h3 >> 8) % 64, kh = hq >> 2;
            const size_t tq = (size_t)b * TL + t;
            for (int d = 0; d < 64; ++d) { const int ax = d >> 5, hf = (d >> 4) & 1, f = d & 15; const int ps = ax ? (t & 63) : (t >> 6); const float cs = WSP(float, WS_SMALL)[(ps * 16 + f) * 2], sn = WSP(float, WS_SMALL)[(ps * 16 + f) * 2 + 1];
                const float x1 = bf2f(QKV[tq * 768 + hq * 64 + ax * 32 + f]), x2 = bf2f(QKV[tq * 768 + hq * 64 + ax * 32 + 16 + f]);
                qs[d] = hf ? (x2 * cs + x1 * sn) : (x1 * cs - x2 * sn); }
            float m = P.in[25 + C.z][hq], den = 1.f, acc = 0.f;
            for (int j = 0; j < 256 + 257; ++j) {
                const bool win = j >= 256; const int kp = win ? t - 128 + (j - 256) : j; if (win && (kp < 0 || kp >= TL)) continue;
                const size_t tk = win ? (size_t)b * TL + kp : (size_t)(CTXB + b * TC + kp); float s = 0.f;
                for (int d = 0; d < 64; ++d) { float kv;
                    if (!win) kv = bf2f(QKV[tk * 768 + 512 + kh * 64 + d]);
                    else { const int ax = d >> 5, hf = (d >> 4) & 1, f = d & 15; const int ps = ax ? (kp & 63) : (kp >> 6); const float cs = WSP(float, WS_SMALL)[(ps * 16 + f) * 2], sn = WSP(float, WS_SMALL)[(ps * 16 + f) * 2 + 1];
                        const float x1 = bf2f(QKV[tk * 768 + 512 + kh * 64 + ax * 32 + f]), x2 = bf2f(QKV[tk * 768 + 512 + kh * 64 + ax * 32 + 16 + f]);
                        kv = hf ? (x2 * cs + x1 * sn) : (x1 * cs - x2 * sn); }
                    s += qs[d] * kv; }
                s *= 0.125f; const float mn = fmaxf(m, s), al = exp_f(m - mn), p = exp_f(s - mn);
                den = den * al + p; acc = acc * al + p * bf2f(QKV[tk * 768 + 640 + kh * 64 + dd]); m = mn;
            }
            dbg_put(C, 9, bf2f(WSP(bf16, WS_A)[tq * 512 + hq * 64 + dd]), acc / den, 0.03f);
        }
        __syncthreads();
        {
            LAS float* qs = (LAS float*)C.lds + (size_t)C.tid * 65; const bf16* QKV = WSP(bf16, WS_X + X_QKV);
            const int b = h2 % 32, t = h1 % 256, hq = h3 % 8, dd = (h3 >> 8) % 64, kh = hq >> 2; const size_t tq = (size_t)(CTXB + b * TC + t);
            for (int d = 0; d < 64; ++d) qs[d] = bf2f(QKV[tq * 768 + hq * 64 + d]);
            float m = P.in[25 + C.z][hq], den = 1.f, acc = 0.f;
            for (int j = 0; j < 256; ++j) { const size_t tk = (size_t)(CTXB + b * TC + j); float s = 0.f;
                for (int d = 0; d < 64; ++d) s += qs[d] * bf2f(QKV[tk * 768 + 512 + kh * 64 + d]);
                s *= 0.125f; const float mn = fmaxf(m, s), al = exp_f(m - mn), p = exp_f(s - mn); den = den * al + p; acc = acc * al + p * bf2f(QKV[tk * 768 + 640 + kh * 64 + dd]); m = mn; }
            dbg_put(C, 10, bf2f(WSP(bf16, WS_A)[tq * 512 + hq * 64 + dd]), acc / den, 0.03f);
        }
        {
            const int b = h1 % 32, tp = h2 % 2048, ch = h3 % 256;
            dbg_put(C, 11, bf2f(WSP(bf16, WS_A + (size_t)72 * MiB)[((size_t)b * TL + tp) * 256 + ch]), ndot(WSP(bf16, WS_DFT) + (size_t)tp * 4096, WSP(bf16, WS_X + X_ZT) + ((size_t)b * 256 + ch) * 4096, 4096), 0.05f);
            const int tc = h2 % 256;
            dbg_put(C, 11, bf2f(WSP(bf16, WS_A + (size_t)72 * MiB)[((size_t)CTXB + b * TC + tc) * 256 + ch]), ndot(WSP(bf16, WS_DFTC) + (size_t)tc * 512, WSP(bf16, WS_X + X_ZTC) + ((size_t)b * 256 + ch) * 512, 512), 0.05f);
        }
    } else if (stage == 5) {
        const int tok = h1 % NT, col = h2 % 1024; const bf16* PP = WSP(bf16, WS_X + X_PP);
        dbg_put(C, 13, bf2f(PP[(size_t)tok * NGATE + col]), ndot(WSP(bf16, WS_A + (size_t)108 * MiB) + (size_t)tok * 256, WL(bf16, 0, WL_BR) + (size_t)col * 256, 256), 0.05f);
        dbg_put(C, 13, bf2f(PP[(size_t)tok * NGATE + 1024 + col]), ndot(WSP(bf16, WS_A) + (size_t)tok * 512, WL(bf16, 0, WL_BA) + (size_t)col * 512, 512), 0.05f);
        dbg_put(C, 13, bf2f(PP[(size_t)tok * NGATE + 2048 + col]), ndot(WSP(bf16, WS_A + (size_t)72 * MiB) + (size_t)tok * 256, WL(bf16, 0, WL_BF) + (size_t)col * 256, 256), 0.05f);
    } else if (stage == 6) {
        const int tok = h1 % NT, col = h2 % 1024; float ref = 0.f;
        for (int br = 0; br < 3; ++br) { const float gl = ndot(WSP(bf16, WS_A) + (size_t)tok * DM, WL(bf16, 0, WL_G) + (size_t)(br * 1024 + col) * 1024, 1024); ref += bf2f(WSP(bf16, WS_X + X_PP)[(size_t)tok * NGATE + br * 1024 + col]) / (1.f + exp_f(-gl)); }
        dbg_put(C, 14, bf2f(WSP(bf16, WS_X + X_UR)[(size_t)tok * DM + col]), ref, 0.05f);
    } else if (stage == 7) {
        const int tok = h1 % NT, col = h2 % 1024;
        dbg_put(C, 15, bf2f(WSP(bf16, WS_X + X_MIX)[(size_t)tok * DM + col]), ndot(WSP(bf16, WS_X + X_UR) + (size_t)tok * DM, WL(bf16, 0, WL_O) + (size_t)col * 1024, 1024), 0.05f);
    } else if (stage == 8) {
        const int tok = h1 % NT, col = h2 % 1024; const bool lat = tok < NLAT; const float* hp = lat ? P.in[0 + C.z] + (size_t)tok * DM : P.in[2 + C.z] + (size_t)(tok - NLAT) * DM;
        const bf16* mx = WSP(bf16, WS_X + X_MIX) + (size_t)tok * DM; const float* mp = WSP(float, WS_MOD) + (size_t)(lat ? tok / TL : 32) * 6144;
        float ss = 0.f; for (int k = 0; k < 1024; ++k) ss += bf2f(mx[k]) * bf2f(mx[k]);
        const float rs = rsqrtf(ss / 1024.f + 1e-6f); float s2 = 0.f, hc = 0.f;
        for (int k = 0; k < 1024; ++k) { const float hn = hp[k] + mp[2048 + k] * bf2f(mx[k]) * rs * P.in[7 + C.z][k]; s2 += hn * hn; if (k == col) hc = hn; }
        const float* ho = lat ? C.out + (size_t)tok * DM : WSP(float, WS_HC) + (size_t)(tok - NLAT) * DM;
        dbg_put(C, 16, ho[col], hc, 0.01f);
        dbg_put(C, 16, bf2f(WSP(bf16, WS_A)[(size_t)tok * DM + col]), hc * rsqrtf(s2 / 1024.f + 1e-6f) * P.in[8 + C.z][col] * (1.f + mp[4096 + col]) + mp[3072 + col], 0.05f);
    } else if (stage == 9) {
        int tok = h1 % NT; if (C.tid & 1) tok = (tok & ~63) + ((C.tid & 2) ? 63 : 0);
        const int j = h2 % DFF; const int t = (tok < NLAT) ? (tok % TL) : ((tok - NLAT) % TC), T = (tok < NLAT) ? TL : TC;
        const bf16* A = WSP(bf16, WS_A); const bf16* wu = WL(bf16, 0, WL_UP); const int pn = j >> 7, jj = j & 127;
        const bf16* wg = wu + (size_t)(pn * 256 + jj) * 1024; const bf16* wv = wu + (size_t)(pn * 256 + 128 + jj) * 1024;
        const float zc = ndot(A + (size_t)tok * DM, wg, 1024), zp = (t > 0) ? ndot(A + (size_t)(tok - 1) * DM, wg, 1024) : 0.f, zn = (t < T - 1) ? ndot(A + (size_t)(tok + 1) * DM, wg, 1024) : 0.f, zv = ndot(A + (size_t)tok * DM, wv, 1024);
        const float z = P.in[31 + C.z][j] * zp + P.in[31 + C.z][DFF + j] * zc + P.in[31 + C.z][2 * DFF + j] * zn + P.in[32 + C.z][j];
        const float ge = 0.5f * z * (1.f + tanh_(0.7978845608028654f * (z + 0.044715f * z * z * z)));
        dbg_put(C, 17, bf2f(WSP(bf16, WS_X + X_HH)[(size_t)tok * DFF + j]), ge * zv, 0.05f);
    } else if (stage == 10) {
        const int tok = h1 % NT, col = h2 % 1024;
        dbg_put(C, 18, bf2f(WSP(bf16, WS_X + X_FFO)[(size_t)tok * DM + col]), ndot(WSP(bf16, WS_X + X_HH) + (size_t)tok * DFF, WL(bf16, 0, WL_DN) + (size_t)col * DFF, DFF), 0.05f);
    }
}
DI void dbg_report(const Ctx& C) {
    if (C.bid == 0 && threadIdx.x == 0) {
        int first = -1; for (int k = 0; k < 24; ++k) if (first < 0 && __builtin_bit_cast(float, WSP(unsigned, WS_CTL)[1024 + k]) > 0.05f) first = k;
        if (first >= 0) C.out[12345] = 1000.f * (float)(first + 1);
    }
}
#define DBGCHK(stage) do { grid.sync(); dbg_check(CK, stage, l); grid.sync(); } while (0)
#else
#define DBGCHK(stage) do { } while (0)
#endif
#define XB_TMO      128
#define XB_XCNT(j)  (256  + 64 * (j))
#define XB_XSUB(j)  (1280 + 64 * (j))
#define XB_XGEN(j)  (2304 + 64 * (j))
#define XB_TOP      3328
#define XB_TOPGEN   3392
#define XCD_BAR_WORDS 3456
#define XB_SPIN_CAP (1u << 18)

__device__ __forceinline__ unsigned xb_ld(unsigned* p)              { return __hip_atomic_load(p, __ATOMIC_RELAXED, __HIP_MEMORY_SCOPE_AGENT); }
__device__ __forceinline__ unsigned xb_add(unsigned* p, unsigned v) { return __hip_atomic_fetch_add(p, v, __ATOMIC_RELAXED, __HIP_MEMORY_SCOPE_AGENT); }
__device__ __forceinline__ unsigned xb_xcc_id() { return (unsigned)__builtin_amdgcn_s_getreg((3 << 11) | 20) & 0xFu; }
#define XB_SPIN(cond, bar) do { unsigned _sp = 0; while (cond) { __builtin_amdgcn_s_sleep(1); \
    if ((++_sp & 255u) == 0u) { if (xb_ld(&(bar)[XB_TMO])) break; if (_sp > XB_SPIN_CAP) { atomicAdd(&(bar)[XB_TMO], 1u); break; } } } } while (0)

struct XcdBarrier {
    unsigned* bar; unsigned x;
    volatile LAS unsigned* st;
};

__device__ __forceinline__ XcdBarrier xcd_barrier_post(unsigned* bar, volatile LAS unsigned* st) {
    XcdBarrier b; b.bar = bar; b.x = xb_xcc_id(); b.st = st;
    if (threadIdx.x == 0) (void)xb_add(&bar[XB_XCNT(b.x)], 1u);
    return b;
}
__device__ __forceinline__ void xcd_barrier_complete(unsigned* bar, unsigned x, unsigned& nloc, unsigned& nx) {
    const unsigned G = gridDim.x * gridDim.y * gridDim.z;
    unsigned sum, cnt, mine, sp = 0u;
    for (;;) {
        sum = 0u; cnt = 0u; mine = 0u;
#pragma unroll
        for (unsigned j = 0; j < 16; ++j) { const unsigned c = xb_ld(&bar[XB_XCNT(j)]); sum += c; cnt += (c > 0u) ? 1u : 0u; mine = (j == x) ? c : mine; }
        if (sum == G) break;
        __builtin_amdgcn_s_sleep(1);
        if ((++sp & 255u) == 0u) { if (xb_ld(&bar[XB_TMO])) break; if (sp > XB_SPIN_CAP) { atomicAdd(&bar[XB_TMO], 1u); break; } }
    }
    nloc = mine > 0u ? mine : 1u; nx = cnt > 0u ? cnt : 1u;
}

__device__ __forceinline__ void xcd_barrier(const XcdBarrier& b) {
    asm volatile("s_waitcnt vmcnt(0)" ::: "memory");
    __syncthreads();
    if (threadIdx.x == 0) {
        unsigned* bar = b.bar;
        __builtin_amdgcn_s_waitcnt(0);
        unsigned nloc = b.st[0], nx = b.st[1];
        if (nloc == 0u) { xcd_barrier_complete(bar, b.x, nloc, nx); b.st[0] = nloc; b.st[1] = nx; }
        const unsigned old = xb_add(&bar[XB_XSUB(b.x)], 1u);
        const unsigned gen = old / nloc;
        if (old + 1u == (gen + 1u) * nloc) {
            __builtin_amdgcn_fence(__ATOMIC_RELEASE, "agent");
            asm volatile("s_waitcnt vmcnt(0)" ::: "memory");
            const unsigned og = xb_add(&bar[XB_TOP], 1u);
            const unsigned tg = og / nx;
            if (og + 1u == (tg + 1u) * nx) xb_add(&bar[XB_TOPGEN], 1u);
            else XB_SPIN(xb_ld(&bar[XB_TOPGEN]) == tg, bar);
            __builtin_amdgcn_fence(__ATOMIC_ACQUIRE, "agent");
            xb_add(&bar[XB_XGEN(b.x)], 1u);
            asm volatile("s_waitcnt vmcnt(0)" ::: "memory");
        } else {
            XB_SPIN(xb_ld(&bar[XB_XGEN(b.x)]) == gen, bar);
            __builtin_amdgcn_fence(__ATOMIC_ACQUIRE, "agent");
            asm volatile("s_waitcnt vmcnt(0)" ::: "memory");
        }
    }
    __syncthreads();
}

__global__ void __launch_bounds__(NTHREADS, 2) fwd_kernel(Params P) {
    extern __shared__ __attribute__((aligned(16))) unsigned char lds_raw[];
    cg::grid_group grid = cg::this_grid();
    const int tid_ = threadIdx.x;
    const Ctx CK{(LAS unsigned char*)lds_raw, P.ws, P, P.out, tid_, tid_ & 63, __builtin_amdgcn_readfirstlane(tid_ >> 6), (int)gridDim.x, (int)blockIdx.x, 0};
    volatile LAS unsigned* xb_st = (volatile LAS unsigned*)(CK.lds + 139264);
    if (tid_ < 2) xb_st[tid_] = 0u;
    __syncthreads();
    const XcdBarrier xbar = xcd_barrier_post((unsigned*)P.ws + 4096, xb_st);
#define GSYNC() xcd_barrier(xbar)
#ifdef PROBE
#define TS(k) do { if (tid_ == 0 && blockIdx.x == 0) ((volatile LAS unsigned long long*)(CK.lds + 131072))[k] = __builtin_amdgcn_s_memrealtime(); } while (0)
#else
#define TS(k) do { } while (0)
#endif
#define PH_BEGIN { const Ctx C = rectx(CK); LAS unsigned char* glds = C.lds;
#define PH_END }
#define ABUF WSP(bf16, WS_A)
#define HCB WSP(float, WS_HC)
#define MODL(ll) (WSP(float, WS_MOD) + (size_t)(ll) * 33 * 6144)
#define HIN_L ((l == 0) ? C.P.in[0 + C.z] : (const float*)C.out)
#define HIN_C ((l == 0) ? C.P.in[2 + C.z] : (const float*)HCB)
#define GEMM_STD(Aptr, Bptr, M_, N_, K_, EPI, ...) do { pg8::Gemm g{Aptr, Bptr, M_, N_, K_}; pg8::StaticOrder S; S.init(M_, N_, C.G, C.bid); EPI E{__VA_ARGS__}; pg8::gemm_phase<EPI, pg8::StaticOrder, true, true>(glds, g, S, E); } while (0)
    TS(40);
    prologue(CK);
    grid.sync(); TS(41);
    { const int l = 0; DBGCHK(0); }
    for (int l = 0; l < 2; ++l) {
        TS(l * 16 + 0);
        const int Mmix = (l == 0) ? NT : NLAT;
        if (l == 0) { PH_BEGIN rowop<false, true>(C, NT, HIN_L, HIN_C, nullptr, nullptr, nullptr, 0, nullptr, C.P.in[6 + C.z] + l * DM, 0, 1, MODL(l), MODL(l), ABUF); PH_END GSYNC(); TS(l * 16 + 1); DBGCHK(1); }
        PH_BEGIN
            GEMM_STD(ABUF, WL(bf16, l, WL_IN), NT, NIN, DM, EpiIn, WSP(bf16, WS_X + X_QKV), WSP(bf16, WS_X + X_ZT), WSP(bf16, WS_X + X_ZTC), WSP(bf16, WS_X + X_UR));
        PH_END
        GSYNC(); TS(l * 16 + 2); DBGCHK(2);
        feat1_phase(CK, l);
        GSYNC();
        PH_BEGIN GEMM_STD(WSP(bf16, WS_A), WSP(bf16, WS_WLORA + (size_t)l * 2 * MiB), NT, (l == 0 ? 1280 : NLO), (l == 0 ? 384 : KLO), EpiStore, WSP(bf16, WS_X + X_LO), NLO, 0, 0, 256, 1); PH_END
        GSYNC();
        feat3_phase(CK, l);
        GSYNC(); TS(l * 16 + 3); DBGCHK(3);
        if (CK.bid < 256) scan_run(CK, l, CK.bid >> 3, (CK.bid >> 1) & 3, CK.bid & 1);
        __syncthreads(); TS(l * 16 + 15);
        {
            PH_BEGIN
                pg8::Gemm g{WSP(bf16, WS_DFT), WSP(bf16, WS_X + X_ZT), 2048, 8192, 4096}; pg8::StaticOrder S; S.init(2048, 8192, C.G, C.bid);
                EpiStore E{WSP(bf16, WS_A + (size_t)72 * MiB), 256, 0, 2048, 0};
                pg8::gemm_phase<EpiStore, pg8::StaticOrder, true, true>(glds, g, S, E);
            PH_END
            if (l == 0) { PH_BEGIN
                pg8::Gemm g{WSP(bf16, WS_DFTC), WSP(bf16, WS_X + X_ZTC), 256, 8192, 512}; pg8::StaticOrder S; S.init(256, 8192, C.G, C.bid);
                EpiStore E{WSP(bf16, WS_A + (size_t)72 * MiB), 256, CTXB, 256, 0};
                pg8::gemm_phase<EpiStore, pg8::StaticOrder, true, true>(glds, g, S, E);
            PH_END }
        }
        attn_loop(CK, l);
        GSYNC(); TS(l * 16 + 4); DBGCHK(4);
        readout_phase(CK, l, Mmix);
        GSYNC(); TS(l * 16 + 5);
        PH_BEGIN GEMM_STD(WSP(bf16, WS_A + (size_t)108 * MiB), WL(bf16, l, WL_BR), Mmix, 1024, 256, EpiStore, WSP(bf16, WS_X + X_PP), NGATE, 0, 0, 256, 1); PH_END
        PH_BEGIN GEMM_STD(WSP(bf16, WS_A), WL(bf16, l, WL_BA), Mmix, 1024, 512, EpiStore, WSP(bf16, WS_X + X_PP) + 1024, NGATE, 0, 0, 256, 1); PH_END
        PH_BEGIN GEMM_STD(WSP(bf16, WS_A + (size_t)72 * MiB), WL(bf16, l, WL_BF), Mmix, 1024, 256, EpiStore, WSP(bf16, WS_X + X_PP) + 2048, NGATE, 0, 0, 256, 1); PH_END
        GSYNC(); TS(l * 16 + 6); DBGCHK(5);
        PH_BEGIN rowop<false, true>(C, Mmix, HIN_L, HIN_C, nullptr, nullptr, nullptr, 0, nullptr, C.P.in[6 + C.z] + l * DM, 0, 1, MODL(l), MODL(l), ABUF); PH_END
        GSYNC(); TS(l * 16 + 7);
        PH_BEGIN
            pg8::Gemm g{ABUF, WL(bf16, l, WL_G), Mmix, NGATE, DM}; GateOrder S{(Mmix / 256) * 4, C.G, C.bid};
            EpiGate E{WSP(bf16, WS_X + X_PP), WSP(bf16, WS_X + X_UR)};
            pg8::gemm_phase<EpiGate, GateOrder, true, true>(glds, g, S, E);
        PH_END
        GSYNC(); TS(l * 16 + 8); DBGCHK(6);
        PH_BEGIN GEMM_STD(WSP(bf16, WS_X + X_UR), WL(bf16, l, WL_O), Mmix, DM, DM, EpiStore, WSP(bf16, WS_X + X_MIX), DM, 0, 0, 256); PH_END
        GSYNC(); TS(l * 16 + 9); DBGCHK(7);
        PH_BEGIN rowop<true, true>(C, Mmix, HIN_L, HIN_C, C.out, HCB, WSP(bf16, WS_X + X_MIX), 2, C.P.in[7 + C.z] + l * DM, C.P.in[8 + C.z] + l * DM, 3, 4, MODL(l), MODL(l), ABUF); PH_END
        GSYNC(); TS(l * 16 + 10); DBGCHK(8);
        PH_BEGIN GEMM_STD(ABUF, WL(bf16, l, WL_UP), Mmix, 2 * DFF, DM, EpiUp, WSP(bf16, WS_X + X_HH), WSP(bf16, WS_X + X_HALO), C.P.in[31 + C.z] + (size_t)l * 3 * DFF, C.P.in[32 + C.z] + (size_t)l * DFF); PH_END
        GSYNC(); TS(l * 16 + 11);
        fixup_phase(CK, l, Mmix);
        GSYNC(); TS(l * 16 + 12); DBGCHK(9);
        PH_BEGIN GEMM_STD(WSP(bf16, WS_X + X_HH), WL(bf16, l, WL_DN), Mmix, DM, DFF, EpiStore, WSP(bf16, WS_X + X_FFO), DM, 0, 0, 256); PH_END
        GSYNC(); TS(l * 16 + 13); DBGCHK(10);
        if (l == 0) { PH_BEGIN rowop<true, true>(C, NT, C.out, HCB, C.out, HCB, WSP(bf16, WS_X + X_FFO), 5, C.P.in[9 + C.z] + l * DM, C.P.in[6 + C.z] + (l + 1) * DM, 0, 1, MODL(l), MODL(l + 1), ABUF); PH_END GSYNC(); TS(l * 16 + 14); }
        else { PH_BEGIN rowop<true, false>(C, NLAT, C.out, HCB, C.out, HCB, WSP(bf16, WS_X + X_FFO), 5, C.P.in[9 + C.z] + l * DM, nullptr, 0, 1, MODL(l), MODL(l), nullptr); PH_END }
    }
#ifdef DBG
    grid.sync(); dbg_report(CK);
#endif
#ifdef PROBE
    grid.sync(); TS(60);
    TS(61);
    grid.sync();
    if (blockIdx.x == 0) {
        volatile LAS unsigned long long* ts = (volatile LAS unsigned long long*)(CK.lds + 131072);
#ifdef PROBE_PRO
        unsigned long long d = (ts[60] - ts[40]) / 10ull;
#else
        unsigned long long d = 0; for (int ll = 0; ll < 2; ++ll) d += ts[ll * 16 + PROBE_B] - ts[ll * 16 + PROBE_A];
#endif
        const int n = (int)(d / 500ull);
        for (int i = tid_; i < n; i += NTHREADS) P.out[1000000 + i] += 0.15f;
    }
#endif
}


extern "C" void kernel_launch(void* const* d_in, const int* in_sizes, int n_in, void* d_out, int out_size, void* d_ws, size_t ws_size, hipStream_t stream) {
    static int grid = 0;
    if (grid == 0) {
        if (n_in != 34 || out_size != NLAT * DM || ws_size < WS_TOTAL) { fprintf(stderr, "kernel_launch: unexpected shapes (n_in %d out %d ws %zu, need %zu)\n", n_in, out_size, ws_size, (size_t)WS_TOTAL); grid = -1; return; }
        int dev = 0, cus = 0, per_cu = 0;
        hipGetDevice(&dev); hipDeviceGetAttribute(&cus, hipDeviceAttributeMultiprocessorCount, dev);
        if (hipFuncSetAttribute((const void*)fwd_kernel, hipFuncAttributeMaxDynamicSharedMemorySize, LDS_BYTES) != hipSuccess) { fprintf(stderr, "kernel_launch: hipFuncSetAttribute failed\n"); grid = -1; return; }
        hipOccupancyMaxActiveBlocksPerMultiprocessor(&per_cu, (const void*)fwd_kernel, NTHREADS, LDS_BYTES);
        (void)hipGetLastError();
        if (per_cu < 1 || cus < 256) { fprintf(stderr, "kernel_launch: occupancy %d, cus %d\n", per_cu, cus); grid = -1; return; }
        grid = 256;
    }
    if (grid < 0) return;
    (void)hipMemsetAsync((char*)d_ws + WS_CTL, 0, 65536, stream);
    Params p{};
    for (int i = 0; i < 34; ++i) p.in[i] = (const float*)d_in[i];
    p.out = (float*)d_out; p.ws = (unsigned char*)d_ws;
    void* args[] = {&p};
    hipError_t e = hipLaunchCooperativeKernel((const void*)fwd_kernel, dim3(grid), dim3(NTHREADS), args, LDS_BYTES, stream);
    if (e != hipSuccess) fprintf(stderr, "kernel_launch: cooperative launch failed: %s (grid %d)\n", hipGetErrorString(e), grid);
}
```
